# Optimizing an MI355X kernel written in HIP

```python
import math
import jax
import jax.numpy as jnp
from jax import lax
import numpy as np

D_MODEL = 2048
BATCH = 4
SEQ = 8192
DEPTH = 2

GRID_W = 64
CTX_LEN = 256
HEAD_DIM = 128
ROPE_THETA = 10000.0

WA_HEADS = 8
WA_KV_HEADS = 2
WINDOW = 128
WA_BLOCK = 128

DF_HEADS = 8
DF_QK_DIM = 64
DF_V_DIM = 2 * DF_QK_DIM
DF_Q_BLOCK = 128

DN_HEADS = 8
DN_DK = 128
DN_DV = 128
DN_CONV = 3
DN_CHUNK = 64

D_FF = 5632
FFN_CONV = 3

LN_EPS = 1e-6
RMS_EPS = 1e-6
DEEPNORM_ALPHA = (2 * DEPTH) ** 0.25
DEEPNORM_BETA = (8 * DEPTH) ** -0.25

WA_Q = WA_HEADS * HEAD_DIM
WA_KV = WA_KV_HEADS * HEAD_DIM
DF_QK = DF_HEADS * 2 * DF_QK_DIM
DF_V = DF_HEADS * DF_V_DIM
DN_QK = DN_HEADS * DN_DK
DN_V = DN_HEADS * DN_DV
DN_QKV = 2 * DN_QK + DN_V
IN_SPLITS = (WA_Q, WA_KV, WA_KV, DF_QK, DF_QK, DF_V, DN_QKV, DN_V, 2 * DN_HEADS, 2 * DN_HEADS, 3 * D_MODEL)
IN_WIDTH = sum(IN_SPLITS)

f32 = jnp.float32

kernel_name = 'hybrid_gated_branch_diffusion_trunk'


def layer_norm(x, g=None, b=None):
    xf = x.astype(f32)
    mu = jnp.mean(xf, axis=-1, keepdims=True)
    var = jnp.mean(jnp.square(xf - mu), axis=-1, keepdims=True)
    y = (xf - mu) * lax.rsqrt(var + LN_EPS)
    if g is not None:
        y = y * g.astype(f32) + b.astype(f32)
    return y.astype(x.dtype)


def rms_norm(x, w):
    xf = x.astype(f32)
    return xf * lax.rsqrt(jnp.mean(jnp.square(xf), axis=-1, keepdims=True) + RMS_EPS) * w.astype(f32)


def l2_normalize(x):
    return x * lax.rsqrt(jnp.sum(jnp.square(x), axis=-1, keepdims=True) + 1e-6)


def ada_ln(x, shift, scale):
    return layer_norm(x) * (1 + scale[:, None]) + shift[:, None]


def dwconv_centred(x, w, b=None):
    k = w.shape[0]
    pad = k // 2
    n = x.shape[1]
    xp = jnp.pad(x, ((0, 0), (pad, pad), (0, 0)))
    y = xp[:, 0:n] * w[0]
    for i in range(1, k):
        y = y + xp[:, i:i + n] * w[i]
    return y if b is None else y + b


def axial_rope_tables(n, dim):
    rows = n // GRID_W
    row = jnp.repeat(jnp.arange(rows, dtype=f32), GRID_W)
    col = jnp.tile(jnp.arange(GRID_W, dtype=f32), rows)
    axis_dim = dim // 2
    inv_freq = ROPE_THETA ** (-jnp.arange(0, axis_dim, 2, dtype=f32) / axis_dim)
    ang_r = row[:, None] * inv_freq[None]
    ang_c = col[:, None] * inv_freq[None]
    ang = jnp.concatenate([ang_r, ang_r, ang_c, ang_c], axis=-1)
    return jnp.cos(ang), jnp.sin(ang)


def apply_axial_rope(x, cos, sin):
    x1, x2, x3, x4 = jnp.split(x.astype(f32), 4, axis=-1)
    rot = jnp.concatenate([-x2, x1, -x4, x3], axis=-1)
    return (x.astype(f32) * cos[:, None, :] + rot * sin[:, None, :]).astype(x.dtype)


def _in_split(p):
    offs, acc = [], 0
    for w in IN_SPLITS[:-1]:
        acc += w
        offs.append(acc)
    return jnp.split(p, offs, axis=-1)


def window_sink_attention(q, k, v, ck, cv, sink):
    bsz, n, h, d = q.shape
    g = h // WA_KV_HEADS
    nb = n // WA_BLOCK
    scale = d ** -0.5
    qb = q.reshape(bsz, nb, WA_BLOCK, WA_KV_HEADS, g, d)

    def band(t):
        tp = jnp.pad(t, ((0, 0), (WA_BLOCK, WA_BLOCK), (0, 0), (0, 0)))
        tp = tp.reshape(bsz, nb + 2, WA_BLOCK, WA_KV_HEADS, d)
        return jnp.concatenate([tp[:, :-2], tp[:, 1:-1], tp[:, 2:]], axis=2)

    kb, vb = band(k), band(v)
    s_loc = jnp.einsum('bnqkgd,bnjkd->bnkgqj', qb, kb).astype(f32) * scale
    qpos = jnp.arange(nb)[:, None] * WA_BLOCK + jnp.arange(WA_BLOCK)[None]
    kpos = jnp.arange(nb)[:, None] * WA_BLOCK - WA_BLOCK + jnp.arange(3 * WA_BLOCK)[None]
    kp = kpos[:, None, :]
    valid = (kp >= 0) & (kp < n) & (jnp.abs(kp - qpos[:, :, None]) <= WINDOW)
    s_loc = jnp.where(valid[None, :, None, None], s_loc, -jnp.inf)
    s_ctx = jnp.einsum('bnqkgd,bjkd->bnkgqj', qb, ck).astype(f32) * scale
    sink_b = sink.astype(f32).reshape(WA_KV_HEADS, g)[None, None, :, :, None, None]
    m = jnp.maximum(jnp.maximum(s_loc.max(-1, keepdims=True), s_ctx.max(-1, keepdims=True)), sink_b)
    p_loc = jnp.exp(s_loc - m)
    p_ctx = jnp.exp(s_ctx - m)
    inv_den = 1.0 / (p_loc.sum(-1, keepdims=True) + p_ctx.sum(-1, keepdims=True) + jnp.exp(sink_b - m))
    o = (jnp.einsum('bnkgqj,bnjkd->bnqkgd', p_loc * inv_den, vb.astype(f32))
         + jnp.einsum('bnkgqj,bjkd->bnqkgd', p_ctx * inv_den, cv.astype(f32)))
    return o.reshape(bsz, n, h * d)


def ctx_sink_attention(q, k, v, sink):
    bsz, L, h, d = q.shape
    g = h // WA_KV_HEADS
    qg = q.reshape(bsz, L, WA_KV_HEADS, g, d)
    s = jnp.einsum('bqkgd,bjkd->bkgqj', qg, k).astype(f32) * d ** -0.5
    sink_b = sink.astype(f32).reshape(WA_KV_HEADS, g)[None, :, :, None, None]
    m = jnp.maximum(s.max(-1, keepdims=True), sink_b)
    p = jnp.exp(s - m)
    p = p / (p.sum(-1, keepdims=True) + jnp.exp(sink_b - m))
    return jnp.einsum('bkgqj,bjkd->bqkgd', p, v.astype(f32)).reshape(bsz, L, h * d)


def diff_attend(q1, q2, k1, k2, v, lam):
    scale = q1.shape[-1] ** -0.5
    s1 = jnp.einsum('bqhd,bkhd->bhqk', q1, k1).astype(f32) * scale
    s2 = jnp.einsum('bqhd,bkhd->bhqk', q2, k2).astype(f32) * scale
    w = jax.nn.softmax(s1, axis=-1) - lam * jax.nn.softmax(s2, axis=-1)
    return jnp.einsum('bhqk,bkhd->bqhd', w, v.astype(f32))


def diff_attention_blocks(q1, q2, k1, k2, v, lam):
    bsz, n, h, dq = q1.shape
    nb = n // DF_Q_BLOCK

    def blocks(t):
        return jnp.moveaxis(t.reshape(bsz, nb, DF_Q_BLOCK, h, dq), 1, 0)

    o = lax.map(lambda qq: diff_attend(qq[0], qq[1], k1, k2, v, lam), (blocks(q1), blocks(q2)))
    return jnp.moveaxis(o, 0, 1).reshape(bsz, n, h, v.shape[-1])


def diff_post(o, subln, lam_init):
    bsz, n = o.shape[:2]
    return (rms_norm(o, subln) * (1.0 - lam_init)).reshape(bsz, n, DF_V)


def gdn_prep(qkv, conv_w):
    qkv = jax.nn.silu(dwconv_centred(qkv, conv_w)).astype(f32)
    q, k, v = jnp.split(qkv, [DN_QK, 2 * DN_QK], axis=-1)
    bsz, n = q.shape[:2]
    q = l2_normalize(q.reshape(bsz, n, DN_HEADS, DN_DK)) * DN_DK ** -0.5
    k = l2_normalize(k.reshape(bsz, n, DN_HEADS, DN_DK))
    v = v.reshape(bsz, n, DN_HEADS, DN_DV)
    return q, k, v


def gdn_gates(a, b, a_log, dt_bias):
    bsz, n = a.shape[:2]
    a = a.astype(f32).reshape(bsz, n, 2, DN_HEADS)
    b = b.astype(f32).reshape(bsz, n, 2, DN_HEADS)
    g = -jnp.exp(a_log.astype(f32)) * jax.nn.softplus(a + dt_bias.astype(f32))
    return g, jax.nn.sigmoid(b)


def gated_delta_chunked(q, k, v, g, beta, s0, want_out):
    bsz, n, h, dk = k.shape
    dv = v.shape[-1]
    c = DN_CHUNK
    nc = n // c

    def chunks(t):
        return jnp.moveaxis(t.reshape((bsz, nc, c) + t.shape[2:]), 2, 3)

    qc, kc, vc, gc, bc = chunks(q), chunks(k), chunks(v), chunks(g), chunks(beta)
    gcum = jnp.cumsum(gc, axis=-1)
    tril = jnp.tril(jnp.ones((c, c), bool))
    tril_strict = jnp.tril(jnp.ones((c, c), bool), -1)
    decay = jnp.where(tril, jnp.exp(jnp.minimum(gcum[..., :, None] - gcum[..., None, :], 0.0)), 0.0)
    kb = kc * bc[..., None]
    m_low = jnp.where(tril_strict, jnp.einsum('bnhid,bnhjd->bnhij', kb, kc) * decay, 0.0)
    a_mat = m_low + jnp.eye(c, dtype=f32)
    rhs = jnp.concatenate([vc * bc[..., None], kb * jnp.exp(gcum)[..., None]], axis=-1)
    sol = lax.linalg.triangular_solve(a_mat, rhs, left_side=True, lower=True, unit_diagonal=True)
    u, w = sol[..., :dv], sol[..., dv:]
    kdec = kc * jnp.exp(gcum[..., -1:] - gcum)[..., None]
    glast = jnp.exp(gcum[..., -1])
    xs = (u, w, kdec, glast)
    if want_out:
        attn = jnp.einsum('bnhid,bnhjd->bnhij', qc, kc) * decay
        qg = qc * jnp.exp(gcum)[..., None]
        xs = xs + (attn, qg)
    xs = tuple(jnp.moveaxis(t, 1, 0) for t in xs)

    def step(s, inp):
        u_i, w_i, kdec_i, gl_i = inp[:4]
        v_new = u_i - jnp.einsum('bhcd,bhde->bhce', w_i, s)
        s_new = s * gl_i[..., None, None] + jnp.einsum('bhcd,bhce->bhde', kdec_i, v_new)
        o_i = None
        if want_out:
            attn_i, qg_i = inp[4:]
            o_i = jnp.einsum('bhcd,bhde->bhce', qg_i, s) + jnp.einsum('bhij,bhje->bhie', attn_i, v_new)
        return s_new, o_i

    s_final, o = lax.scan(step, s0, xs)
    if not want_out:
        return None, s_final
    o = jnp.moveaxis(jnp.moveaxis(o, 0, 1), 2, 3).reshape(bsz, n, h, dv)
    return o, s_final


def gdn_bidirectional(q, k, v, g, beta, s0, want_out):
    o_f, s_f = gated_delta_chunked(q, k, v, g[:, :, 0], beta[:, :, 0], s0[0], want_out)
    flip = lambda t: jnp.flip(t, axis=1)
    o_b, s_b = gated_delta_chunked(flip(q), flip(k), flip(v), flip(g[:, :, 1]), flip(beta[:, :, 1]), s0[1], want_out)
    o = o_f + flip(o_b) if want_out else None
    return o, (s_f, s_b)


def gdn_output(o, z, w):
    bsz, n = z.shape[:2]
    zf = z.astype(f32).reshape(bsz, n, DN_HEADS, DN_DV)
    return (rms_norm(o, w) * jax.nn.silu(zf)).reshape(bsz, n, DN_V)


def merge_branches(ya, yb, yc, gates, w_pa, w_pb, w_pc, w_o):
    dt = w_o.dtype
    ga, gb, gc = jnp.split(jax.nn.sigmoid(gates.astype(f32)), 3, axis=-1)
    m = ga * (ya.astype(dt) @ w_pa) + gb * (yb.astype(dt) @ w_pb) + gc * (yc.astype(dt) @ w_pc)
    return m.astype(dt) @ w_o


def mix_sublayer(hx, hc, rope_a, rope_d, layer, w_in, sink, lam_q1, lam_k1, lam_q2, lam_k2, df_subln,
                 dn_conv, dn_a_log, dn_dt_bias, dn_norm, w_pa, w_pb, w_pc, w_o, ctx_out):
    bsz, n, _ = hx.shape
    L = hc.shape[1]
    (qa, ka, va, qd, kd, vd, qkv_n, z_n, a_n, b_n, gates) = _in_split(hx @ w_in)
    (qa_c, ka_c, va_c, qd_c, kd_c, vd_c, qkv_nc, z_nc, a_nc, b_nc, gates_c) = _in_split(hc @ w_in)
    cos_a, sin_a = rope_a
    cos_d, sin_d = rope_d

    qa = apply_axial_rope(qa.reshape(bsz, n, WA_HEADS, HEAD_DIM), cos_a, sin_a)
    ka = apply_axial_rope(ka.reshape(bsz, n, WA_KV_HEADS, HEAD_DIM), cos_a, sin_a)
    va = va.reshape(bsz, n, WA_KV_HEADS, HEAD_DIM)
    ka_c = ka_c.reshape(bsz, L, WA_KV_HEADS, HEAD_DIM)
    va_c = va_c.reshape(bsz, L, WA_KV_HEADS, HEAD_DIM)
    ya = window_sink_attention(qa, ka, va, ka_c, va_c, sink)

    lam_init = 0.8 - 0.6 * math.exp(-0.3 * layer)
    lam = (jnp.exp(jnp.sum(lam_q1.astype(f32) * lam_k1.astype(f32)))
           - jnp.exp(jnp.sum(lam_q2.astype(f32) * lam_k2.astype(f32))) + lam_init)
    qd = qd.reshape(bsz, n, DF_HEADS, 2, DF_QK_DIM)
    kd = kd.reshape(bsz, n, DF_HEADS, 2, DF_QK_DIM)
    qd_c = qd_c.reshape(bsz, L, DF_HEADS, 2, DF_QK_DIM)
    kd_c = kd_c.reshape(bsz, L, DF_HEADS, 2, DF_QK_DIM)
    vd_c = vd_c.reshape(bsz, L, DF_HEADS, DF_V_DIM)
    q1 = apply_axial_rope(qd[:, :, :, 0], cos_d, sin_d)
    q2 = apply_axial_rope(qd[:, :, :, 1], cos_d, sin_d)
    k1 = jnp.concatenate([kd_c[:, :, :, 0], apply_axial_rope(kd[:, :, :, 0], cos_d, sin_d)], axis=1)
    k2 = jnp.concatenate([kd_c[:, :, :, 1], apply_axial_rope(kd[:, :, :, 1], cos_d, sin_d)], axis=1)
    v_all = jnp.concatenate([vd_c, vd.reshape(bsz, n, DF_HEADS, DF_V_DIM)], axis=1)
    yb = diff_post(diff_attention_blocks(q1, q2, k1, k2, v_all, lam), df_subln, lam_init)

    zero = jnp.zeros((bsz, DN_HEADS, DN_DK, DN_DV), f32)
    qn_c, kn_c, vn_c = gdn_prep(qkv_nc, dn_conv)
    g_c, beta_c = gdn_gates(a_nc, b_nc, dn_a_log, dn_dt_bias)
    on_c, s_ctx = gdn_bidirectional(qn_c, kn_c, vn_c, g_c, beta_c, (zero, zero), ctx_out)
    qn, kn, vn = gdn_prep(qkv_n, dn_conv)
    g_n, beta_n = gdn_gates(a_n, b_n, dn_a_log, dn_dt_bias)
    on, _ = gdn_bidirectional(qn, kn, vn, g_n, beta_n, s_ctx, True)
    yc = gdn_output(on, z_n, dn_norm)

    out_x = merge_branches(ya, yb, yc, gates, w_pa, w_pb, w_pc, w_o)
    if not ctx_out:
        return out_x, None
    ya_c = ctx_sink_attention(qa_c.reshape(bsz, L, WA_HEADS, HEAD_DIM), ka_c, va_c, sink)
    yb_c = diff_post(diff_attend(qd_c[:, :, :, 0], qd_c[:, :, :, 1], kd_c[:, :, :, 0], kd_c[:, :, :, 1], vd_c, lam),
                     df_subln, lam_init)
    yc_c = gdn_output(on_c, z_nc, dn_norm)
    out_c = merge_branches(ya_c, yb_c, yc_c, gates_c, w_pa, w_pb, w_pc, w_o)
    return out_x, out_c


def conv_ffn(h, w_up, conv_w, conv_b, w_down):
    u = dwconv_centred(h @ w_up, conv_w, conv_b)
    a, b = jnp.split(u, 2, axis=-1)
    return (jax.nn.silu(a) * b) @ w_down


def setup_inputs(seed: int = 0) -> dict:
    key = jax.random.key(seed)
    ks = jax.random.split(key, 32)
    cnt = [0]

    def nxt():
        cnt[0] += 1
        return ks[cnt[0] - 1]

    def nrm(shape, std):
        return jax.random.normal(nxt(), shape, f32) * std

    D = D_MODEL
    beta = DEEPNORM_BETA
    dt = jnp.exp(jax.random.uniform(nxt(), (DEPTH, 2, DN_HEADS), f32, math.log(1e-3), math.log(1e-1)))
    a_log = jnp.log(jax.random.uniform(nxt(), (DEPTH, 2, DN_HEADS), f32, 1.0, 16.0))
    return {
        'x': nrm((BATCH, SEQ, D), 1.0),
        'c': nrm((BATCH, D), 1.0),
        'ctx': nrm((BATCH, CTX_LEN, D), 1.0),
        'c_ctx': nrm((D,), 1.0),
        'w_mod': nrm((DEPTH, D, 6 * D), D ** -0.5),
        'b_mod': nrm((DEPTH, 6 * D), 0.01),
        'w_in': nrm((DEPTH, D, IN_WIDTH), D ** -0.5),
        'wa_sink': nrm((DEPTH, WA_HEADS), 1.0),
        'df_lam_q1': nrm((DEPTH, DF_QK_DIM), 0.1),
        'df_lam_k1': nrm((DEPTH, DF_QK_DIM), 0.1),
        'df_lam_q2': nrm((DEPTH, DF_QK_DIM), 0.1),
        'df_lam_k2': nrm((DEPTH, DF_QK_DIM), 0.1),
        'df_subln': 1.0 + nrm((DEPTH, DF_V_DIM), 0.02),
        'dn_conv': nrm((DEPTH, DN_CONV, DN_QKV), DN_CONV ** -0.5),
        'dn_a_log': a_log,
        'dn_dt_bias': dt + jnp.log(-jnp.expm1(-dt)),
        'dn_norm': 1.0 + nrm((DEPTH, DN_DV), 0.02),
        'w_branch_a': nrm((DEPTH, WA_Q, D), WA_Q ** -0.5 * beta),
        'w_branch_b': nrm((DEPTH, DF_V, D), DF_V ** -0.5 * beta),
        'w_branch_c': nrm((DEPTH, DN_V, D), DN_V ** -0.5 * beta),
        'w_o': nrm((DEPTH, D, D), D ** -0.5 * beta),
        'ln1_g': 1.0 + nrm((DEPTH, D), 0.02),
        'ln1_b': nrm((DEPTH, D), 0.01),
        'w_up': nrm((DEPTH, D, 2 * D_FF), D ** -0.5),
        'ffn_conv_w': nrm((DEPTH, FFN_CONV, 2 * D_FF), FFN_CONV ** -0.5),
        'ffn_conv_b': nrm((DEPTH, 2 * D_FF), 0.01),
        'w_down': nrm((DEPTH, D_FF, D), D_FF ** -0.5 * beta),
        'ln2_g': 1.0 + nrm((DEPTH, D), 0.02),
        'ln2_b': nrm((DEPTH, D), 0.01),
    }


def reference(x, c, ctx, c_ctx, w_mod, b_mod, w_in, wa_sink, df_lam_q1, df_lam_k1, df_lam_q2, df_lam_k2,
              df_subln, dn_conv, dn_a_log, dn_dt_bias, dn_norm, w_branch_a, w_branch_b, w_branch_c, w_o,
              ln1_g, ln1_b, w_up, ffn_conv_w, ffn_conv_b, w_down, ln2_g, ln2_b):
    n = x.shape[1]
    rope_a = axial_rope_tables(n, HEAD_DIM)
    rope_d = axial_rope_tables(n, DF_QK_DIM)
    cc = c_ctx[None]
    cx = ctx
    for l in range(DEPTH):
        ctx_out = l < DEPTH - 1
        mx = jnp.split(jax.nn.silu(c) @ w_mod[l] + b_mod[l], 6, axis=-1)
        mc = jnp.split(jax.nn.silu(cc) @ w_mod[l] + b_mod[l], 6, axis=-1)
        hx = ada_ln(x, mx[0], mx[1])
        hc = ada_ln(cx, mc[0], mc[1])
        ox, oc = mix_sublayer(hx, hc, rope_a, rope_d, l, w_in[l], wa_sink[l], df_lam_q1[l], df_lam_k1[l],
                              df_lam_q2[l], df_lam_k2[l], df_subln[l], dn_conv[l], dn_a_log[l], dn_dt_bias[l],
                              dn_norm[l], w_branch_a[l], w_branch_b[l], w_branch_c[l], w_o[l], ctx_out)
        x = layer_norm(DEEPNORM_ALPHA * x + mx[2][:, None] * ox, ln1_g[l], ln1_b[l])
        fx = conv_ffn(ada_ln(x, mx[3], mx[4]), w_up[l], ffn_conv_w[l], ffn_conv_b[l], w_down[l])
        x = layer_norm(DEEPNORM_ALPHA * x + mx[5][:, None] * fx, ln2_g[l], ln2_b[l])
        if ctx_out:
            cx = layer_norm(DEEPNORM_ALPHA * cx + mc[2][:, None] * oc, ln1_g[l], ln1_b[l])
            fc = conv_ffn(ada_ln(cx, mc[3], mc[4]), w_up[l], ffn_conv_w[l], ffn_conv_b[l], w_down[l])
            cx = layer_norm(DEEPNORM_ALPHA * cx + mc[5][:, None] * fc, ln2_g[l], ln2_b[l])
    return x
```

```cpp
#include <hip/hip_runtime.h>
#include <cstdio>
#include <cstdint>
#include <cmath>
namespace pg8 {
#define PG8_LAS __attribute__((address_space(3)))
typedef unsigned short bf16_t;
typedef short bf16x8 __attribute__((ext_vector_type(8)));
typedef float f32x4 __attribute__((ext_vector_type(4)));
typedef unsigned u32x4 __attribute__((ext_vector_type(4)));
constexpr int BM = 256, BK = 64, HALF = 128, HTB = HALF * BK * 2  , STAGE_BYTES = 8 * HTB, NXCD = 8, WGM = 8;

__host__ __device__ __forceinline__ int lds_byte(int r, int c) { const int st = (r >> 4) * 2 + (c >> 5), rr = r & 15, cc = c & 31, ob = rr * 64 + cc * 2; return st * 1024 + (ob ^ (((ob >> 9) & 1) << 5)); }
__host__ __device__ __forceinline__ void stage_rc(int b, int& R, int& C) { const int st = b / 1024, sb = b % 1024, swz = sb ^ (((sb >> 9) & 1) << 5); R = (st >> 1) * 16 + swz / 64; C = (st & 1) * 32 + (swz % 64) / 2; }
__host__ __device__ __forceinline__ int perm32(int rho) { const int n = rho >> 4, i = rho & 15; return 8 * (i >> 2) + 4 * n + (i & 3); }

struct Unit { int pm, pn; };
struct Gemm { const bf16_t* A; const bf16_t* Bt; int M, N, K, lda; };

struct StaticOrder {
    int nM, nN, nwg, G, c;
    __host__ __device__ void init(int M, int N, int G_, int c_) { nM = M / BM; nN = N / BM; nwg = nM * nN; G = G_; c = c_; }
    __host__ __device__ bool next(int i, Unit& u) const {
        const long L = (long)i * G + c; if (L >= nwg) return false;
        int wgid = (int)L; { const int q = nwg / NXCD, r = nwg % NXCD, xcd = wgid % NXCD, off = wgid / NXCD; wgid = (xcd < r ? xcd * (q + 1) : r * (q + 1) + (xcd - r) * q) + off; }
        const int nig = WGM * nN, gid = wgid / nig, fm = gid * WGM, gsz = (nM - fm) < WGM ? (nM - fm) : WGM;
        u.pm = fm + ((wgid % nig) % gsz); u.pn = (wgid % nig) / gsz; return true;
    }
    __device__ __forceinline__ void a_ready(const Unit&) const {}
    __device__ __forceinline__ void done(const Unit&) const {}
};

__device__ __forceinline__ unsigned cvt_pk_bf16(float lo, float hi) { unsigned r; asm volatile("v_cvt_pk_bf16_f32 %0, %1, %2" : "=v"(r) : "v"(lo), "v"(hi)); return r; }
__device__ __forceinline__ float bf_lo(unsigned w) { return __uint_as_float(w << 16); }
__device__ __forceinline__ float bf_hi(unsigned w) { return __uint_as_float(w & 0xffff0000u); }
__device__ __forceinline__ float sigm(float x) { return 1.0f / (1.0f + __expf(-x)); }

struct EpiF32 {
    static constexpr bool PERM = false, AFTER_DRAIN = false;
    float* C; int ldc;
    __device__ __forceinline__ void operator()(const f32x4 (&acc)[2][2][4][2], const Unit& u, int wr, int wc, int fr, int fq) const {
        const int row0 = u.pm * BM + wr * 64 + fr, col0 = u.pn * BM + wc * 32 + 4 * fq;
#pragma unroll
        for (int ai = 0; ai < 2; ++ai)
#pragma unroll
            for (int m = 0; m < 4; ++m) { float* rowp = C + (size_t)(row0 + ai * HALF + m * 16) * ldc + col0;
#pragma unroll
                for (int bj = 0; bj < 2; ++bj)
#pragma unroll
                    for (int n = 0; n < 2; ++n) *(f32x4*)(rowp + bj * HALF + n * 16) = acc[ai][bj][m][n]; }
    }
};
struct EpiBf16 {
    static constexpr bool PERM = true, AFTER_DRAIN = false;
    bf16_t* O; int ldc;
    __device__ __forceinline__ void operator()(const f32x4 (&acc)[2][2][4][2], const Unit& u, int wr, int wc, int fr, int fq) const {
        const int row0 = u.pm * BM + wr * 64 + fr, col0 = u.pn * BM + wc * 32 + 8 * fq;
#pragma unroll
        for (int ai = 0; ai < 2; ++ai)
#pragma unroll
            for (int m = 0; m < 4; ++m) { bf16_t* rowp = O + (size_t)(row0 + ai * HALF + m * 16) * ldc + col0;
#pragma unroll
                for (int bj = 0; bj < 2; ++bj) { const f32x4 v0 = acc[ai][bj][m][0], v1 = acc[ai][bj][m][1];
                    u32x4 w; w.x = cvt_pk_bf16(v0[0], v0[1]); w.y = cvt_pk_bf16(v0[2], v0[3]); w.z = cvt_pk_bf16(v1[0], v1[1]); w.w = cvt_pk_bf16(v1[2], v1[3]);
                    *(u32x4*)(rowp + bj * HALF) = w; } }
    }
};
template <int MODE> struct EpiMerge {
    static constexpr bool PERM = true, AFTER_DRAIN = false;
    const bf16_t* G; int ldg; float* TOT; bf16_t* Mo; int ldc;
    __device__ __forceinline__ void operator()(const f32x4 (&acc)[2][2][4][2], const Unit& u, int wr, int wc, int fr, int fq) const {
        asm volatile("" : "+v"(fr), "+v"(fq));
        const int row0 = u.pm * BM + wr * 64 + fr, col0 = u.pn * BM + wc * 32 + 8 * fq;
#pragma unroll
        for (int ai = 0; ai < 2; ++ai)
#pragma unroll
            for (int m = 0; m < 4; ++m) { const size_t row = (size_t)(row0 + ai * HALF + m * 16);
#pragma unroll
                for (int bj = 0; bj < 2; ++bj) { const int col = col0 + bj * HALF;
                    const u32x4 gw = *(const u32x4*)(G + row * ldg + col);
                    f32x4 g0 = (f32x4){bf_lo(gw.x), bf_hi(gw.x), bf_lo(gw.y), bf_hi(gw.y)}, g1 = (f32x4){bf_lo(gw.z), bf_hi(gw.z), bf_lo(gw.w), bf_hi(gw.w)};
                    f32x4 v0 = acc[ai][bj][m][0] * g0, v1 = acc[ai][bj][m][1] * g1;
                    float* tp = TOT + row * ldc + col;
                    if (MODE >= 1) { v0 += *(const f32x4*)tp; v1 += *(const f32x4*)(tp + 4); }
                    if (MODE <= 1) { *(f32x4*)tp = v0; *(f32x4*)(tp + 4) = v1; }
                    else { u32x4 w; w.x = cvt_pk_bf16(v0[0], v0[1]); w.y = cvt_pk_bf16(v0[2], v0[3]); w.z = cvt_pk_bf16(v1[0], v1[1]); w.w = cvt_pk_bf16(v1[2], v1[3]);
                        *(u32x4*)(Mo + row * ldc + col) = w; } }
                asm volatile("" ::: "memory"); }
    }
};
struct EpiInProj {
    static constexpr bool PERM = true, AFTER_DRAIN = false;
    bf16_t* P; int ldp; float* AB; const float* ropeA; const float* ropeD; const float* a_log; const float* dt_bias; float sA, sD;
    __device__ __forceinline__ void operator()(const f32x4 (&acc)[2][2][4][2], const Unit& u, int wr, int wc, int fr, int fq) const {
        asm volatile("" : "+v"(fr), "+v"(fq));
        const int pn = u.pn, tib = u.pm % 33; const bool is_ctx = (tib == 0);
        const int row0 = u.pm * BM + wr * 64 + fr, t0 = tib * 256 - 256 + wr * 64 + fr, cl = wc * 32 + 8 * fq;
        int type; float scale = 1.f;
        if (pn <= 3) { type = 1; scale = sA; } else if (pn == 4) type = 1; else if (pn == 5) type = 0; else if (pn <= 9) { type = 2; scale = sD; } else if (pn <= 13) type = 2;
        else if (pn <= 33) type = 0; else if (pn <= 57) type = 3; else type = 4;
        if (type == 4) {
            if (wc == 0) {
                const int c = 8 * fq;
#pragma unroll
                for (int ai = 0; ai < 2; ++ai)
#pragma unroll
                    for (int m = 0; m < 4; ++m) { const size_t row = (size_t)(row0 + ai * HALF + m * 16); f32x4 v0 = acc[ai][0][m][0], v1 = acc[ai][0][m][1]; float o[8] = {v0[0], v0[1], v0[2], v0[3], v1[0], v1[1], v1[2], v1[3]};
#pragma unroll
                        for (int k = 0; k < 8; ++k) { if (c < 16) { const float x = o[k] + dt_bias[c + k]; const float sp = fmaxf(x, 0.f) + log1pf(__expf(-fabsf(x))); o[k] = -__expf(a_log[c + k]) * sp; } else o[k] = sigm(o[k]); }
                        *(f32x4*)(AB + row * 32 + c) = (f32x4){o[0], o[1], o[2], o[3]}; *(f32x4*)(AB + row * 32 + c + 4) = (f32x4){o[4], o[5], o[6], o[7]}; }
            }
            return;
        }
#pragma unroll
        for (int ai = 0; ai < 2; ++ai)
#pragma unroll
            for (int m = 0; m < 4; ++m) { const size_t row = (size_t)(row0 + ai * HALF + m * 16); const int t = t0 + ai * HALF + m * 16;
#pragma unroll
                for (int bj = 0; bj < 2; ++bj) { const int c = cl + bj * HALF; f32x4 v0 = acc[ai][bj][m][0], v1 = acc[ai][bj][m][1];
                    if ((type == 1 || type == 2) && !is_ctx) {
                        const float* tab;
                        if (type == 1) { const int p0 = (c & 127) >> 1; const int pos = (p0 >= 32) ? (t & 63) : (t >> 6); tab = ropeA + (pos * 32 + (p0 & 31)) * 2; }
                        else { const int p0 = (c & 63) >> 1; const int pos = (p0 >= 16) ? (t & 63) : (t >> 6); tab = ropeD + (pos * 16 + (p0 & 15)) * 2; }
                        const f32x4 cs0 = *(const f32x4*)tab, cs1 = *(const f32x4*)(tab + 4);
                        f32x4 r0, r1;
                        r0[0] = v0[0] * cs0[0] - v0[1] * cs0[1]; r0[1] = v0[1] * cs0[0] + v0[0] * cs0[1]; r0[2] = v0[2] * cs0[2] - v0[3] * cs0[3]; r0[3] = v0[3] * cs0[2] + v0[2] * cs0[3];
                        r1[0] = v1[0] * cs1[0] - v1[1] * cs1[1]; r1[1] = v1[1] * cs1[0] + v1[0] * cs1[1]; r1[2] = v1[2] * cs1[2] - v1[3] * cs1[3]; r1[3] = v1[3] * cs1[2] + v1[2] * cs1[3];
                        v0 = r0; v1 = r1;
                    }
                    if (type == 3) {
#pragma unroll
                        for (int k = 0; k < 4; ++k) { v0[k] = sigm(v0[k]); v1[k] = sigm(v1[k]); } }
                    v0 = v0 * scale; v1 = v1 * scale;
                    u32x4 w; w.x = cvt_pk_bf16(v0[0], v0[1]); w.y = cvt_pk_bf16(v0[2], v0[3]); w.z = cvt_pk_bf16(v1[0], v1[1]); w.w = cvt_pk_bf16(v1[2], v1[3]);
                    *(u32x4*)(P + row * ldp + pn * BM + c) = w; }
                asm volatile("" ::: "memory"); }
    }
};

template <class Epi, class Sched, bool ALIGN_EPI = false, bool SP2 = false>
__device__ __forceinline__ void gemm_phase(PG8_LAS unsigned char* lds, const Gemm g, const Sched& S, const Epi& E) {
    int tid_ = threadIdx.x; asm volatile("" : "+v"(tid_));
    const int tid = tid_, wid = __builtin_amdgcn_readfirstlane(tid >> 6), lane = tid & 63, wr = wid >> 2, wc = wid & 3, fr = lane & 15, fq = lane >> 4;
    const int K = g.K, nt = K / BK;
    unsigned voffA[2], voffB[2];
#pragma unroll
    for (int i = 0; i < 2; ++i) { int R, C; stage_rc(tid * 16 + i * 8192, R, C); const int Rb = Epi::PERM ? ((R & ~31) + perm32(R & 31)) : R;
        voffA[i] = (unsigned)(R * g.lda + C) * 2u; voffB[i] = (unsigned)(Rb * K + C) * 2u; }
    const size_t kstep = (size_t)(BK * 2);
    const size_t hstepB = (size_t)HALF * K * 2, hstepA = (size_t)HALF * g.lda * 2;
    const size_t tstepA = 2 * hstepA, tstepB = 2 * hstepB;
    const unsigned ldsw = (unsigned)wid * 1024u;
    const int aoff = lds_byte(wr * 64 + fr, fq * 8), boff = lds_byte(wc * 32 + fr, fq * 8);
#define PG8_SA(b, h) (((b) * 2 + (h)) * HTB)
#define PG8_SB(b, h) ((4 + (b) * 2 + (h)) * HTB)
#define PG8_STAGE(bufoff, gbase, voff) do { _Pragma("unroll") for (int _i = 0; _i < 2; ++_i) \
        __builtin_amdgcn_global_load_lds((const unsigned*)((const char*)(gbase) + (voff)[_i]), (PG8_LAS unsigned*)(lds + (bufoff) + ldsw + _i * 8192), 16, 0, 0); } while (0)
#define PG8_LDA(dst, b, h) do { _Pragma("unroll") for (int m = 0; m < 4; ++m) _Pragma("unroll") for (int k = 0; k < 2; ++k) dst[m][k] = *(const PG8_LAS bf16x8*)(lds + PG8_SA(b, h) + aoff + m * 2048 + k * 1024); } while (0)
#define PG8_LDB(dst, b, h) do { _Pragma("unroll") for (int n = 0; n < 2; ++n) _Pragma("unroll") for (int k = 0; k < 2; ++k) dst[n][k] = *(const PG8_LAS bf16x8*)(lds + PG8_SB(b, h) + boff + n * 2048 + k * 1024); } while (0)
#define PG8_MMA(ai, bj, At, Bt) do { __builtin_amdgcn_s_setprio(1); _Pragma("unroll") for (int m = 0; m < 4; ++m) _Pragma("unroll") for (int n = 0; n < 2; ++n) _Pragma("unroll") for (int k = 0; k < 2; ++k) \
        acc[ai][bj][m][n] = __builtin_amdgcn_mfma_f32_16x16x32_bf16(Bt[n][k], At[m][k], acc[ai][bj][m][n], 0, 0, 0); __builtin_amdgcn_s_setprio(0); } while (0)
#define PG8_WAIT_V(n) asm volatile("s_waitcnt vmcnt(" #n ")" ::: "memory")
#define PG8_WAIT_L(n) asm volatile("s_waitcnt lgkmcnt(" #n ")" ::: "memory")
#define PG8_BAR __builtin_amdgcn_s_barrier()
#define PG8_SCHED __builtin_amdgcn_sched_barrier(0)
    Unit cur, nxt; int ui = 0;
    if (!S.next(0, cur)) return;
    f32x4 acc[2][2][4][2];
#pragma unroll
    for (int a = 0; a < 2; ++a)
#pragma unroll
        for (int b = 0; b < 2; ++b)
#pragma unroll
            for (int m = 0; m < 4; ++m)
#pragma unroll
                for (int n = 0; n < 2; ++n) acc[a][b][m][n] = (f32x4){0.f, 0.f, 0.f, 0.f};
    bf16x8 At[4][2], B0[2][2], B1[2][2];
    const char* cA = (const char*)g.A + (size_t)cur.pm * tstepA; const char* cB = (const char*)g.Bt + (size_t)cur.pn * tstepB;
    S.a_ready(cur);
    if constexpr (SP2) {
        PG8_STAGE(PG8_SB(0, 0), cB, voffB); PG8_STAGE(PG8_SB(0, 1), cB + hstepB, voffB); PG8_STAGE(PG8_SA(0, 0), cA, voffA); PG8_STAGE(PG8_SA(0, 1), cA + hstepA, voffA);
        if (wr == 1) PG8_BAR;
        PG8_WAIT_V(2); PG8_BAR;
        PG8_STAGE(PG8_SB(1, 0), cB + kstep, voffB); PG8_STAGE(PG8_SA(1, 0), cA + kstep, voffA); PG8_STAGE(PG8_SB(1, 1), cB + hstepB + kstep, voffB);
        PG8_WAIT_V(6); PG8_BAR;
    } else {
        PG8_STAGE(PG8_SB(0, 0), cB, voffB); PG8_STAGE(PG8_SA(0, 0), cA, voffA); PG8_STAGE(PG8_SB(0, 1), cB + hstepB, voffB); PG8_STAGE(PG8_SA(0, 1), cA + hstepA, voffA);
        if (wr == 1) PG8_BAR;
        PG8_WAIT_V(4); PG8_BAR;
        PG8_STAGE(PG8_SB(1, 0), cB + kstep, voffB); PG8_STAGE(PG8_SA(1, 0), cA + kstep, voffA); PG8_STAGE(PG8_SB(1, 1), cB + hstepB + kstep, voffB);
        PG8_WAIT_V(6); PG8_BAR;
    }
    for (;;) {
        const bool has_next = S.next(ui + 1, nxt);
        const char* nA = has_next ? (const char*)g.A + (size_t)nxt.pm * tstepA : cA; const char* nB = has_next ? (const char*)g.Bt + (size_t)nxt.pn * tstepB : cB;
        for (int t = 0; t < nt; t += 2) {
            const bool last = (t == nt - 2);
            const char* a1 = cA + (size_t)(t + 1) * kstep;
            const char* a2 = last ? nA : cA + (size_t)(t + 2) * kstep; const char* b2 = last ? nB : cB + (size_t)(t + 2) * kstep;
            const char* a3 = a2 + kstep; const char* b3 = b2 + kstep;
            if (last && has_next) S.a_ready(nxt);
            if constexpr (SP2) {
            PG8_LDB(B0, 0, 0); PG8_LDB(B1, 0, 1); PG8_SCHED; PG8_LDA(At, 0, 0); PG8_STAGE(PG8_SA(1, 1), a1 + hstepA, voffA);
            PG8_WAIT_V(8); PG8_WAIT_L(0); PG8_BAR; PG8_MMA(0, 0, At, B0); PG8_MMA(0, 1, At, B1); PG8_BAR; PG8_SCHED;
            PG8_LDA(At, 0, 1); PG8_STAGE(PG8_SB(0, 0), b2, voffB); PG8_STAGE(PG8_SB(0, 1), b2 + hstepB, voffB); PG8_STAGE(PG8_SA(0, 0), a2, voffA);
            PG8_WAIT_V(8); PG8_WAIT_L(0); PG8_BAR; PG8_MMA(1, 0, At, B0); PG8_MMA(1, 1, At, B1); PG8_BAR; PG8_SCHED;
            PG8_LDB(B0, 1, 0); PG8_LDB(B1, 1, 1); PG8_SCHED; PG8_LDA(At, 1, 0); PG8_STAGE(PG8_SA(0, 1), a2 + hstepA, voffA);
            PG8_WAIT_V(8); PG8_WAIT_L(0); PG8_BAR; PG8_MMA(0, 0, At, B0); PG8_MMA(0, 1, At, B1); PG8_BAR; PG8_SCHED;
            PG8_LDA(At, 1, 1); PG8_STAGE(PG8_SB(1, 0), b3, voffB); PG8_STAGE(PG8_SB(1, 1), b3 + hstepB, voffB); PG8_STAGE(PG8_SA(1, 0), a3, voffA);
            PG8_WAIT_V(8); PG8_WAIT_L(0); PG8_BAR; PG8_MMA(1, 0, At, B0); PG8_MMA(1, 1, At, B1); PG8_BAR; PG8_SCHED;
            } else {
            PG8_LDB(B0, 0, 0); PG8_SCHED; PG8_LDA(At, 0, 0); PG8_STAGE(PG8_SA(1, 1), a1 + hstepA, voffA);
            PG8_WAIT_L(8); PG8_BAR; PG8_WAIT_L(0); PG8_MMA(0, 0, At, B0); PG8_BAR; PG8_SCHED;
            PG8_LDB(B1, 0, 1); PG8_STAGE(PG8_SB(0, 0), b2, voffB);
            PG8_BAR; PG8_WAIT_L(0); PG8_MMA(0, 1, At, B1); PG8_BAR;
            PG8_LDA(At, 0, 1); PG8_STAGE(PG8_SA(0, 0), a2, voffA);
            PG8_BAR; PG8_WAIT_L(0); PG8_MMA(1, 0, At, B0); PG8_BAR; PG8_SCHED;
            PG8_STAGE(PG8_SB(0, 1), b2 + hstepB, voffB);
            PG8_WAIT_V(6); PG8_BAR; PG8_MMA(1, 1, At, B1); PG8_BAR;
            PG8_LDB(B0, 1, 0); PG8_SCHED; PG8_LDA(At, 1, 0); PG8_STAGE(PG8_SA(0, 1), a2 + hstepA, voffA);
            PG8_WAIT_L(8); PG8_BAR; PG8_WAIT_L(0); PG8_MMA(0, 0, At, B0); PG8_BAR; PG8_SCHED;
            PG8_LDB(B1, 1, 1); PG8_STAGE(PG8_SB(1, 0), b3, voffB);
            PG8_BAR; PG8_WAIT_L(0); PG8_MMA(0, 1, At, B1); PG8_BAR;
            PG8_LDA(At, 1, 1); PG8_STAGE(PG8_SA(1, 0), a3, voffA);
            PG8_BAR; PG8_WAIT_L(0); PG8_MMA(1, 0, At, B0); PG8_BAR; PG8_SCHED;
            PG8_STAGE(PG8_SB(1, 1), b3 + hstepB, voffB);
            PG8_WAIT_V(6); PG8_BAR; PG8_MMA(1, 1, At, B1); PG8_BAR;
            }
        }
        if constexpr (ALIGN_EPI) { if (wr == 0) PG8_BAR; }
        if constexpr (!Epi::AFTER_DRAIN) { E(acc, cur, wr, wc, fr, fq); S.done(cur); }
        if (!has_next) break;
#pragma unroll
        for (int a = 0; a < 2; ++a)
#pragma unroll
            for (int b = 0; b < 2; ++b)
#pragma unroll
                for (int m = 0; m < 4; ++m)
#pragma unroll
                    for (int n = 0; n < 2; ++n) acc[a][b][m][n] = (f32x4){0.f, 0.f, 0.f, 0.f};
        cur = nxt; cA = nA; cB = nB; ++ui;
        if constexpr (ALIGN_EPI) { if (wr == 1) PG8_BAR; }
    }
    PG8_WAIT_V(0);
    if constexpr (!ALIGN_EPI) { if (wr == 0) PG8_BAR; }
    PG8_BAR;
    if constexpr (Epi::AFTER_DRAIN) { E.fused(acc, cur, wr, wc, fr, fq, lds, wid, lane); S.done(cur); }
#undef PG8_SA
#undef PG8_SB
#undef PG8_STAGE
#undef PG8_LDA
#undef PG8_LDB
#undef PG8_MMA
#undef PG8_WAIT_V
#undef PG8_WAIT_L
#undef PG8_BAR
#undef PG8_SCHED
}
}

constexpr int DM = 2048, NBATCH = 4, SEQ = 8192, CTXL = 256, RB = CTXL + SEQ  , HB = 2  , HR = HB * RB  ;
constexpr int DFF = 5632, NUP = 2 * DFF, NMOD = 6 * DM, NCH = RB / 64  ;
constexpr int LDP = 14848;
constexpr int NWIN = 15104, INW = 14880;
constexpr int C_QA = 0, C_KA = 1024, C_VA = 1280, C_QD = 1536, C_KD = 2560, C_VD = 3584, C_QKV = 4608, C_Z = 7680, C_G = 8704;
constexpr float LN_EPS = 1e-6f, DN_ALPHA = 1.41421356237f  , LOG2E = 1.4426950408889634f;
constexpr int NWAVES = 8, NTHR = 512;
constexpr size_t MiB = 1u << 20;
constexpr size_t WS_CTL = 0, CTL_ZERO_BYTES = 1 * MiB;
constexpr size_t WS_MOD = 1 * MiB;
constexpr size_t WS_ROPEA = WS_MOD + 512 * 1024, WS_ROPED = WS_ROPEA + 32768, WS_LAM = WS_ROPED + 16384;
constexpr size_t WS_CX = 2 * MiB;
constexpr size_t WS_WIN = 10 * MiB, WS_WPA = 69 * MiB, WS_WPB = 73 * MiB, WS_WPC = 77 * MiB, WS_WO = 81 * MiB, WS_WUP = 89 * MiB, WS_WDN = 133 * MiB;
constexpr size_t WS_H = 155 * MiB;
constexpr size_t WS_AB = 221 * MiB;
constexpr size_t WS_GL = WS_AB + 5 * MiB / 2;
constexpr size_t WS_P = 224 * MiB;
constexpr size_t WS_G = 703 * MiB;
constexpr size_t GU_BYTES = 73728, GU_W = 0, GU_U = 16384, GU_KD = 32768, GU_QG = 49152, GU_AT = 65536;
constexpr size_t WS_END = WS_G + 297 * MiB;
constexpr size_t WS_TOT = WS_G, WS_M = WS_G + 132 * MiB, WS_OX = WS_P, WS_U = WS_P, WS_ACT = WS_G, WS_FX = WS_P;
static_assert((size_t)HR * LDP * 2 <= 479 * MiB && (size_t)4224 * GU_BYTES <= 297 * MiB && (size_t)HR * NUP * 2 <= 479 * MiB && (size_t)HR * DFF * 2 <= 297 * MiB, "d_ws map");
constexpr int CW_BAR = 4096;
constexpr int RING_BYTES = 131072, LDSCTL_OFF = RING_BYTES, LDS_BYTES = 147456;

#define GAS __attribute__((address_space(1)))
#define LAS __attribute__((address_space(3)))
typedef unsigned short bf16_t;
typedef short bf16x8 __attribute__((ext_vector_type(8)));
typedef short s16x4 __attribute__((ext_vector_type(4)));
typedef float f32x4 __attribute__((ext_vector_type(4)));
typedef float f32x2 __attribute__((ext_vector_type(2)));
typedef float f32x16 __attribute__((ext_vector_type(16)));
typedef unsigned u32x4 __attribute__((ext_vector_type(4)));
typedef unsigned u32x2 __attribute__((ext_vector_type(2)));
using pg8::cvt_pk_bf16; using pg8::bf_lo; using pg8::bf_hi; using pg8::sigm;
__device__ __forceinline__ float wave_sum(float v) {
#pragma unroll
    for (int o = 1; o < 64; o <<= 1) v += __shfl_xor(v, o);
    return v;
}
__device__ __forceinline__ int tid_opaque() { int t = threadIdx.x; asm volatile("" : "+v"(t)); return t; }
__device__ __forceinline__ float silu_f(float x) { return x / (1.0f + __expf(-x)); }
__device__ __forceinline__ int crow(int r, int hi) { return (r & 3) + 8 * (r >> 2) + 4 * hi; }
__device__ __forceinline__ bf16x8 pack8(float a0, float a1, float a2, float a3, float a4, float a5, float a6, float a7) {
    u32x4 w; w.x = cvt_pk_bf16(a0, a1); w.y = cvt_pk_bf16(a2, a3); w.z = cvt_pk_bf16(a4, a5); w.w = cvt_pk_bf16(a6, a7); return __builtin_bit_cast(bf16x8, w); }
typedef short v4i16_t __attribute__((ext_vector_type(4)));
__device__ __forceinline__ s16x4 lds_tr(LAS const unsigned char* p) { return __builtin_bit_cast(s16x4, __builtin_amdgcn_ds_read_tr16_b64_v4i16((LAS v4i16_t*)p)); }
#define MFMA32(a, b, c) __builtin_amdgcn_mfma_f32_32x32x16_bf16((a), (b), (c), 0, 0, 0)

#define XB_TMO      128
#define XB_XCNT(j)  (256  + 64 * (j))
#define XB_XSUB(j)  (1280 + 64 * (j))
#define XB_XGEN(j)  (2304 + 64 * (j))
#define XB_TOP      3328
#define XB_TOPGEN   3392
#define XCD_BAR_WORDS 3456
#define XB_SPIN_CAP (1u << 18)

__device__ __forceinline__ unsigned xb_ld(unsigned* p)              { return __hip_atomic_load(p, __ATOMIC_RELAXED, __HIP_MEMORY_SCOPE_AGENT); }
__device__ __forceinline__ unsigned xb_add(unsigned* p, unsigned v) { return __hip_atomic_fetch_add(p, v, __ATOMIC_RELAXED, __HIP_MEMORY_SCOPE_AGENT); }
__device__ __forceinline__ unsigned xb_xcc_id() { return (unsigned)__builtin_amdgcn_s_getreg((3 << 11) | 20) & 0xFu; }
#define XB_SPIN(cond, bar) do { unsigned _sp = 0; while (cond) { __builtin_amdgcn_s_sleep(1); \
    if ((++_sp & 255u) == 0u) { if (xb_ld(&(bar)[XB_TMO])) break; if (_sp > XB_SPIN_CAP) { atomicAdd(&(bar)[XB_TMO], 1u); break; } } } } while (0)

struct XcdBarrier {
    unsigned* bar; unsigned x;
    volatile LAS unsigned* st;
};

__device__ __forceinline__ XcdBarrier xcd_barrier_post(unsigned* bar, volatile LAS unsigned* st) {
    XcdBarrier b; b.bar = bar; b.x = xb_xcc_id(); b.st = st;
    if (threadIdx.x == 0) (void)xb_add(&bar[XB_XCNT(b.x)], 1u);
    return b;
}
__device__ __forceinline__ void xcd_barrier_complete(unsigned* bar, unsigned x, unsigned& nloc, unsigned& nx) {
    const unsigned G = gridDim.x * gridDim.y * gridDim.z;
    unsigned sum, cnt, mine, sp = 0u;
    for (;;) {
        sum = 0u; cnt = 0u; mine = 0u;
#pragma unroll
        for (unsigned j = 0; j < 16; ++j) { const unsigned c = xb_ld(&bar[XB_XCNT(j)]); sum += c; cnt += (c > 0u) ? 1u : 0u; mine = (j == x) ? c : mine; }
        if (sum == G) break;
        __builtin_amdgcn_s_sleep(1);
        if ((++sp & 255u) == 0u) { if (xb_ld(&bar[XB_TMO])) break; if (sp > XB_SPIN_CAP) { atomicAdd(&bar[XB_TMO], 1u); break; } }
    }
    nloc = mine > 0u ? mine : 1u; nx = cnt > 0u ? cnt : 1u;
}

__device__ __forceinline__ void xcd_barrier(const XcdBarrier& b) {
    asm volatile("s_waitcnt vmcnt(0)" ::: "memory");
    __syncthreads();
    if (threadIdx.x == 0) {
        unsigned* bar = b.bar;
        __builtin_amdgcn_s_waitcnt(0);
        unsigned nloc = b.st[0], nx = b.st[1];
        if (nloc == 0u) { xcd_barrier_complete(bar, b.x, nloc, nx); b.st[0] = nloc; b.st[1] = nx; }
        const unsigned old = xb_add(&bar[XB_XSUB(b.x)], 1u);
        const unsigned gen = old / nloc;
        if (old + 1u == (gen + 1u) * nloc) {
            __builtin_amdgcn_fence(__ATOMIC_RELEASE, "agent");
            asm volatile("s_waitcnt vmcnt(0)" ::: "memory");
            const unsigned og = xb_add(&bar[XB_TOP], 1u);
            const unsigned tg = og / nx;
            if (og + 1u == (tg + 1u) * nx) xb_add(&bar[XB_TOPGEN], 1u);
            else XB_SPIN(xb_ld(&bar[XB_TOPGEN]) == tg, bar);
            __builtin_amdgcn_fence(__ATOMIC_ACQUIRE, "agent");
            xb_add(&bar[XB_XGEN(b.x)], 1u);
            asm volatile("s_waitcnt vmcnt(0)" ::: "memory");
        } else {
            XB_SPIN(xb_ld(&bar[XB_XGEN(b.x)]) == gen, bar);
            __builtin_amdgcn_fence(__ATOMIC_ACQUIRE, "agent");
            asm volatile("s_waitcnt vmcnt(0)" ::: "memory");
        }
    }
    __syncthreads();
}
struct Args { const float* in[29]; float* out; unsigned char* ws; int ph_lo, ph_hi; };
enum { I_X = 0, I_C, I_CTX, I_CCTX, I_WMOD, I_BMOD, I_WIN, I_SINK, I_LQ1, I_LK1, I_LQ2, I_LK2, I_SUBLN, I_DNCONV, I_ALOG, I_DTB, I_DNNORM, I_WPA, I_WPB, I_WPC, I_WO, I_LN1G, I_LN1B, I_WUP, I_FCW, I_FCB, I_WDN, I_LN2G, I_LN2B };

__device__ __forceinline__ void ph_prologue(const Args& A, LAS unsigned char* lds) {
    const int tid = tid_opaque(), lane = tid & 63, wave = tid >> 6, G = gridDim.x, bid = blockIdx.x;
    const int gt = bid * NTHR + tid, NT = G * NTHR;
    float* ropeA = (float*)(A.ws + WS_ROPEA); float* ropeD = (float*)(A.ws + WS_ROPED); float* LAM = (float*)(A.ws + WS_LAM); float* MOD = (float*)(A.ws + WS_MOD);
    for (int e = gt; e < 128 * 32; e += NT) { const int pos = e >> 5, f = e & 31; const float inv = powf(10000.0f, -(float)(2 * f) / 64.0f); const float ang = (float)pos * inv; ropeA[2 * e] = cosf(ang); ropeA[2 * e + 1] = sinf(ang); }
    for (int e = gt; e < 128 * 16; e += NT) { const int pos = e >> 4, f = e & 15; const float inv = powf(10000.0f, -(float)(2 * f) / 32.0f); const float ang = (float)pos * inv; ropeD[2 * e] = cosf(ang); ropeD[2 * e + 1] = sinf(ang); }
    if (gt < 2) { const int l = gt; float s1 = 0.f, s2 = 0.f;
        for (int i = 0; i < 64; ++i) { s1 += A.in[I_LQ1][l * 64 + i] * A.in[I_LK1][l * 64 + i]; s2 += A.in[I_LQ2][l * 64 + i] * A.in[I_LK2][l * 64 + i]; }
        const float lam_init = 0.8f - 0.6f * expf(-0.3f * (float)l); LAM[2 * l] = expf(s1) - expf(s2) + lam_init; LAM[2 * l + 1] = 1.0f - lam_init; }
    LAS float* sc = (LAS float*)lds;
    LAS float* red = (LAS float*)(lds + 40960);
    for (int e = tid; e < 5 * 2048; e += NTHR) { const int idx = e >> 11, k = e & 2047; const float v = (idx < 4) ? A.in[I_C][idx * 2048 + k] : A.in[I_CCTX][k]; sc[e] = silu_f(v); }
    __syncthreads();
    for (int u = bid; u < 192; u += G) {
        const int l = u / 96, n0 = (u % 96) * 128;
        const float* W = A.in[I_WMOD] + (size_t)l * 2048 * NMOD + n0 + 2 * lane;
        float acc[5][2];
#pragma unroll
        for (int i = 0; i < 5; ++i) { acc[i][0] = 0.f; acc[i][1] = 0.f; }
        const int k0 = wave * 256;
#pragma unroll 4
        for (int k = k0; k < k0 + 256; ++k) { const f32x2 w = *(const f32x2*)(W + (size_t)k * NMOD);
#pragma unroll
            for (int i = 0; i < 5; ++i) { const float s = sc[i * 2048 + k]; acc[i][0] += s * w.x; acc[i][1] += s * w.y; } }
#pragma unroll
        for (int i = 0; i < 5; ++i) { red[(wave * 5 + i) * 128 + 2 * lane] = acc[i][0]; red[(wave * 5 + i) * 128 + 2 * lane + 1] = acc[i][1]; }
        __syncthreads();
        for (int e = tid; e < 640; e += NTHR) { const int idx = e >> 7, n = e & 127; float s = 0.f;
#pragma unroll
            for (int w = 0; w < 8; ++w) s += red[(w * 5 + idx) * 128 + n];
            MOD[(size_t)(l * 5 + idx) * NMOD + n0 + n] = s + A.in[I_BMOD][l * NMOD + n0 + n]; }
        __syncthreads();
    }
}
__device__ __forceinline__ int win_src(int n) {
    if (n < 1280) { const int j = n & 127, p = j >> 1, s = j & 1; const int dim = (p < 32) ? (s * 32 + p) : (64 + s * 32 + (p - 32)); return (n & ~127) + dim; }
    if (n < 1536) return n;
    if (n < 3584) { const int j = n & 63, p = j >> 1, s = j & 1; const int dim = (p < 16) ? (s * 16 + p) : (32 + s * 16 + (p - 16)); return (n & ~63) + dim; }
    if (n < 8704) return n;
    if (n < 14848) return n + 32;
    if (n < 14880) return n - 14848 + 8704;
    return -1;
}
template <int MODE> __device__ __forceinline__ void transpose_item(const float* W, int K, int N, bf16_t* WT, LAS float* scr, int kb, int nb, int lane) {
    const int k0 = 64 * kb, n0 = 32 * nb, nn = n0 + (lane & 31);
    const int sc = (MODE == 1) ? win_src(nn) : nn;
    const float* src = W + (size_t)(k0 + (lane >> 5)) * N + (sc >= 0 ? sc : 0);
#pragma unroll 8
    for (int i = 0; i < 32; ++i) { const float v = src[(size_t)(2 * i) * N]; scr[(2 * i + (lane >> 5)) * 33 + (lane & 31)] = (sc >= 0) ? v : 0.f; }
    asm volatile("s_waitcnt lgkmcnt(0)" ::: "memory");
    const int c = lane & 7;
#pragma unroll
    for (int j = 0; j < 4; ++j) { const int n = (lane >> 3) + 8 * j; const LAS float* s = scr + (8 * c) * 33 + n;
        u32x4 o; o.x = cvt_pk_bf16(s[0 * 33], s[1 * 33]); o.y = cvt_pk_bf16(s[2 * 33], s[3 * 33]); o.z = cvt_pk_bf16(s[4 * 33], s[5 * 33]); o.w = cvt_pk_bf16(s[6 * 33], s[7 * 33]);
        *(u32x4*)(WT + (size_t)(n0 + n) * K + k0 + 8 * c) = o; }
    asm volatile("s_waitcnt lgkmcnt(0)" ::: "memory");
}
__device__ __forceinline__ void ph_weights(const Args& A, LAS unsigned char* lds, int l) {
    const int tid = tid_opaque(), lane = tid & 63, wave = tid >> 6, G = gridDim.x, bid = blockIdx.x;
    LAS float* scr = (LAS float*)(lds + wave * 8448);
    unsigned char* ws = A.ws;
    constexpr int I0 = 32 * 472, I1 = 16 * 64, I2 = 32 * 64, I3 = 32 * 352, I4 = 88 * 64, NIT = I0 + 3 * I1 + I2 + I3 + I4;
    for (int it = bid * NWAVES + wave; it < NIT; it += G * NWAVES) {
        int r = it;
        if (r < I0) { transpose_item<1>(A.in[I_WIN] + (size_t)l * 2048 * INW, 2048, INW, (bf16_t*)(ws + WS_WIN), scr, r / 472, r % 472, lane); continue; } r -= I0;
        if (r < I1) { transpose_item<0>(A.in[I_WPA] + (size_t)l * 1024 * 2048, 1024, 2048, (bf16_t*)(ws + WS_WPA), scr, r / 64, r % 64, lane); continue; } r -= I1;
        if (r < I1) { transpose_item<0>(A.in[I_WPB] + (size_t)l * 1024 * 2048, 1024, 2048, (bf16_t*)(ws + WS_WPB), scr, r / 64, r % 64, lane); continue; } r -= I1;
        if (r < I1) { transpose_item<0>(A.in[I_WPC] + (size_t)l * 1024 * 2048, 1024, 2048, (bf16_t*)(ws + WS_WPC), scr, r / 64, r % 64, lane); continue; } r -= I1;
        if (r < I2) { transpose_item<0>(A.in[I_WO] + (size_t)l * 2048 * 2048, 2048, 2048, (bf16_t*)(ws + WS_WO), scr, r / 64, r % 64, lane); continue; } r -= I2;
        if (r < I3) { transpose_item<0>(A.in[I_WUP] + (size_t)l * 2048 * NUP, 2048, NUP, (bf16_t*)(ws + WS_WUP), scr, r / 352, r % 352, lane); continue; } r -= I3;
        transpose_item<0>(A.in[I_WDN] + (size_t)l * DFF * 2048, DFF, 2048, (bf16_t*)(ws + WS_WDN), scr, r / 64, r % 64, lane);
    }
}
__device__ __forceinline__ void row_src(const Args& A, int l, int half, int r, const float*& src, float*& dst, const float*& mod, bool& is_ctx) {
    const int bl = r / RB, tp = r - bl * RB, b = half * HB + bl; is_ctx = tp < CTXL;
    float* cx = (float*)(A.ws + WS_CX);
    dst = is_ctx ? cx + (size_t)(b * CTXL + tp) * DM : A.out + (size_t)(b * SEQ + tp - CTXL) * DM;
    if (l == 0) src = is_ctx ? A.in[I_CTX] + (size_t)(b * CTXL + tp) * DM : A.in[I_X] + (size_t)(b * SEQ + tp - CTXL) * DM; else src = dst;
    mod = (const float*)(A.ws + WS_MOD) + (size_t)(l * 5 + (is_ctx ? 4 : b)) * NMOD;
}
__device__ __forceinline__ void ln_stats(const f32x4 (&v)[8], float& mean, float& rstd) {
    float s = 0.f;
#pragma unroll
    for (int j = 0; j < 8; ++j) s += (v[j].x + v[j].y) + (v[j].z + v[j].w);
    mean = wave_sum(s) * (1.0f / DM); float q = 0.f;
#pragma unroll
    for (int j = 0; j < 8; ++j) { const f32x4 d = v[j] - mean; q += (d.x * d.x + d.y * d.y) + (d.z * d.z + d.w * d.w); }
    rstd = 1.0f / sqrtf(wave_sum(q) * (1.0f / DM) + LN_EPS);
}
__device__ __forceinline__ void ada_store(const f32x4 (&v)[8], float mean, float rstd, const float* shift, const float* scale, bf16_t* hrow, int lane) {
#pragma unroll
    for (int j = 0; j < 8; ++j) { const int e = (64 * j + lane) * 4; const f32x4 sh = *(const f32x4*)(shift + e), sc = *(const f32x4*)(scale + e);
        const f32x4 y = (v[j] - mean) * rstd * (sc + 1.0f) + sh; u32x2 w; w.x = cvt_pk_bf16(y.x, y.y); w.y = cvt_pk_bf16(y.z, y.w); *(u32x2*)(hrow + e) = w; }
}
__device__ __forceinline__ void ph_adaln(const Args& A, int l, int half) {
    const int tid = tid_opaque(), lane = tid & 63, gw = blockIdx.x * NWAVES + (tid >> 6), NGW = gridDim.x * NWAVES;
    bf16_t* H = (bf16_t*)(A.ws + WS_H);
    for (int r = gw; r < HR; r += NGW) {
        const float* src; float* dst; const float* mod; bool is_ctx; row_src(A, l, half, r, src, dst, mod, is_ctx);
        f32x4 v[8];
#pragma unroll
        for (int j = 0; j < 8; ++j) v[j] = *((const f32x4*)src + 64 * j + lane);
        float mean, rstd; ln_stats(v, mean, rstd);
        ada_store(v, mean, rstd, mod, mod + DM, H + (size_t)r * DM, lane);
    }
}
template <bool WITH_H> __device__ __forceinline__ void ph_resln(const Args& A, int l, int half, const float* Y, int gate_idx, const float* lng, const float* lnb) {
    const int tid = tid_opaque(), lane = tid & 63, gw = blockIdx.x * NWAVES + (tid >> 6), NGW = gridDim.x * NWAVES;
    bf16_t* H = (bf16_t*)(A.ws + WS_H);
    for (int r = gw; r < HR; r += NGW) {
        const float* src; float* dst; const float* mod; bool is_ctx; row_src(A, l, half, r, src, dst, mod, is_ctx);
        if (is_ctx && l == 1) continue;
        if (!WITH_H) src = dst;
        const float* gate = mod + gate_idx * DM; const float* yrow = Y + (size_t)r * DM;
        f32x4 v[8];
#pragma unroll
        for (int j = 0; j < 8; ++j) { const int e = 64 * j + lane; v[j] = *((const f32x4*)src + e) * DN_ALPHA + *((const f32x4*)gate + e) * *((const f32x4*)yrow + e); }
        float mean, rstd; ln_stats(v, mean, rstd);
#pragma unroll
        for (int j = 0; j < 8; ++j) { const int e = 64 * j + lane; v[j] = (v[j] - mean) * rstd * *((const f32x4*)lng + e) + *((const f32x4*)lnb + e); *((f32x4*)dst + e) = v[j]; }
        if (WITH_H) { ln_stats(v, mean, rstd); ada_store(v, mean, rstd, mod + 3 * DM, mod + 4 * DM, H + (size_t)r * DM, lane); }
    }
}
__device__ __forceinline__ void ph_convact(const Args& A, int l) {
    const int gt = blockIdx.x * NTHR + tid_opaque(), NT = gridDim.x * NTHR;
    const bf16_t* U = (const bf16_t*)(A.ws + WS_U); bf16_t* ACT = (bf16_t*)(A.ws + WS_ACT);
    const float* cw = A.in[I_FCW] + (size_t)l * 3 * NUP; const float* cb = A.in[I_FCB] + (size_t)l * NUP;
    constexpr int NVC = DFF / 8, NRB = HR / 32;
    for (int idx = gt; idx < NRB * NVC; idx += NT) {
        const int rbk = idx / NVC, vc = idx - rbk * NVC, r0 = rbk * 32, tp0 = r0 % RB;
        const bool first_start = (tp0 == 0 || tp0 == CTXL), last_end = (tp0 + 31 == CTXL - 1 || tp0 + 31 == RB - 1);
        const int ca = vc * 8, cbk = DFF + vc * 8;
        float wa[3][8], wb[3][8], ba[8], bb[8];
#pragma unroll
        for (int t = 0; t < 3; ++t) {
#pragma unroll
            for (int k = 0; k < 8; ++k) { wa[t][k] = cw[t * NUP + ca + k]; wb[t][k] = cw[t * NUP + cbk + k]; } }
#pragma unroll
        for (int k = 0; k < 8; ++k) { ba[k] = cb[ca + k]; bb[k] = cb[cbk + k]; }
        const u32x4 z4 = (u32x4){0u, 0u, 0u, 0u};
        u32x4 pa = z4, pb = z4, qa, qb, na, nb;
        if (!first_start) { pa = *(const u32x4*)(U + (size_t)(r0 - 1) * NUP + ca); pb = *(const u32x4*)(U + (size_t)(r0 - 1) * NUP + cbk); }
        qa = *(const u32x4*)(U + (size_t)r0 * NUP + ca); qb = *(const u32x4*)(U + (size_t)r0 * NUP + cbk);
        for (int r = 0; r < 32; ++r) {
            if (r == 31 && last_end) { na = z4; nb = z4; } else { na = *(const u32x4*)(U + (size_t)(r0 + r + 1) * NUP + ca); nb = *(const u32x4*)(U + (size_t)(r0 + r + 1) * NUP + cbk); }
            float o[8];
#pragma unroll
            for (int k = 0; k < 4; ++k) {
                const unsigned a0 = pa[k], a1 = qa[k], a2 = na[k], b0 = pb[k], b1 = qb[k], b2 = nb[k];
                const float xa0 = wa[0][2 * k] * bf_lo(a0) + wa[1][2 * k] * bf_lo(a1) + wa[2][2 * k] * bf_lo(a2) + ba[2 * k];
                const float xa1 = wa[0][2 * k + 1] * bf_hi(a0) + wa[1][2 * k + 1] * bf_hi(a1) + wa[2][2 * k + 1] * bf_hi(a2) + ba[2 * k + 1];
                const float xb0 = wb[0][2 * k] * bf_lo(b0) + wb[1][2 * k] * bf_lo(b1) + wb[2][2 * k] * bf_lo(b2) + bb[2 * k];
                const float xb1 = wb[0][2 * k + 1] * bf_hi(b0) + wb[1][2 * k + 1] * bf_hi(b1) + wb[2][2 * k + 1] * bf_hi(b2) + bb[2 * k + 1];
                o[2 * k] = silu_f(xa0) * xb0; o[2 * k + 1] = silu_f(xa1) * xb1; }
            u32x4 w; w.x = cvt_pk_bf16(o[0], o[1]); w.y = cvt_pk_bf16(o[2], o[3]); w.z = cvt_pk_bf16(o[4], o[5]); w.w = cvt_pk_bf16(o[6], o[7]);
            *(u32x4*)(ACT + (size_t)(r0 + r) * DFF + vc * 8) = w;
            pa = qa; pb = qb; qa = na; qb = nb;
        }
    }
}
template <int DQK>
__device__ __forceinline__ void attn_core(LAS unsigned char* lds, const bf16_t* Qrow, int kc0, const bf16_t* K0, const bf16_t* V0, int n0, const bf16_t* K1, const bf16_t* V1, int n1,
                                          bool mask1, int qpos, int k1pos0, f32x16 (&oT)[4], float& mref, float& lsum) {
    const int tid = tid_opaque(), lane = tid & 63, r32 = lane & 31, hi = lane >> 5;
    bf16x8 qf[DQK / 16];
#pragma unroll
    for (int d0 = 0; d0 < DQK / 16; ++d0) qf[d0] = *(const bf16x8*)(Qrow + d0 * 16 + hi * 8);
    const int srow = tid >> 4, sch = tid & 15;
    const size_t goff0 = (size_t)srow * LDP + sch * 8, goff1 = goff0 + (size_t)32 * LDP;
    const int kl0 = sch * 1024 + ((srow ^ sch) << 4), kl1 = kl0 + 512;
    const int vl0 = ((sch >> 2) * 8 + (srow >> 3)) * 512 + (srow & 7) * 64 + (sch & 3) * 16, vl1 = vl0 + 4 * 512;
    const int nt = n0 + n1;
    const int vbase = (4 * hi + ((lane & 15) >> 2)) * 64 + ((lane >> 4) & 1) * 32 + (lane & 3) * 8;
    u32x4 sk0, sk1, sv0, sv1;
    { const bf16_t* kp = (n0 > 0) ? K0 : K1; const bf16_t* vp = (n0 > 0) ? V0 : V1;
      sk0 = *(const u32x4*)(kp + goff0); sk1 = *(const u32x4*)(kp + goff1); sv0 = *(const u32x4*)(vp + goff0); sv1 = *(const u32x4*)(vp + goff1);
      *(LAS u32x4*)(lds + kl0) = sk0; *(LAS u32x4*)(lds + kl1) = sk1; *(LAS u32x4*)(lds + 32768 + vl0) = sv0; *(LAS u32x4*)(lds + 32768 + vl1) = sv1; }
    __syncthreads();
    for (int t = 0; t < nt; ++t) {
        const int b = t & 1; const bool more = (t + 1 < nt);
        if (more) { const int tn = t + 1; const bf16_t* kp = (tn < n0) ? K0 + (size_t)tn * 64 * LDP : K1 + (size_t)(tn - n0) * 64 * LDP; const bf16_t* vp = (tn < n0) ? V0 + (size_t)tn * 64 * LDP : V1 + (size_t)(tn - n0) * 64 * LDP;
            sk0 = *(const u32x4*)(kp + goff0); sk1 = *(const u32x4*)(kp + goff1); sv0 = *(const u32x4*)(vp + goff0); sv1 = *(const u32x4*)(vp + goff1); }
        LAS const unsigned char* Kb = lds + b * 16384; LAS const unsigned char* Vb = lds + 32768 + b * 16384;
        f32x16 p0, p1;
#pragma unroll
        for (int r = 0; r < 16; ++r) { p0[r] = 0.f; p1[r] = 0.f; }
#pragma unroll
        for (int d0 = 0; d0 < DQK / 16; ++d0) { const int c = (kc0 >> 3) + 2 * d0 + hi; const int off = c * 1024 + ((r32 ^ c) << 4);
            const bf16x8 a0 = *(LAS const bf16x8*)(Kb + off), a1 = *(LAS const bf16x8*)(Kb + off + 512);
            p0 = MFMA32(a0, qf[d0], p0); p1 = MFMA32(a1, qf[d0], p1); }
        if (mask1 && t >= n0) { const int kb = k1pos0 + (t - n0) * 64 + 4 * hi - qpos;
#pragma unroll
            for (int r = 0; r < 16; ++r) { const int dl = kb + (r & 3) + 8 * (r >> 2); if (dl > 128 || dl < -128) p0[r] = -INFINITY; if (dl + 32 > 128 || dl + 32 < -128) p1[r] = -INFINITY; } }
        float tm = fmaxf(p0[0], p1[0]);
#pragma unroll
        for (int r = 1; r < 16; ++r) tm = fmaxf(tm, fmaxf(p0[r], p1[r]));
        tm = fmaxf(tm, __shfl_xor(tm, 32));
        if (__any(tm > mref + 8.0f)) { const float mn = fmaxf(mref, tm); const float al = __builtin_amdgcn_exp2f(mref - mn);
#pragma unroll
            for (int q = 0; q < 4; ++q) oT[q] = oT[q] * al;
            lsum *= al; mref = mn; }
        float rs = 0.f;
#pragma unroll
        for (int r = 0; r < 16; ++r) { p0[r] = __builtin_amdgcn_exp2f(p0[r] - mref); p1[r] = __builtin_amdgcn_exp2f(p1[r] - mref); rs += p0[r] + p1[r]; }
        lsum += rs;
        bf16x8 pw[4];
        pw[0] = pack8(p0[0], p0[1], p0[2], p0[3], p0[4], p0[5], p0[6], p0[7]); pw[1] = pack8(p0[8], p0[9], p0[10], p0[11], p0[12], p0[13], p0[14], p0[15]);
        pw[2] = pack8(p1[0], p1[1], p1[2], p1[3], p1[4], p1[5], p1[6], p1[7]); pw[3] = pack8(p1[8], p1[9], p1[10], p1[11], p1[12], p1[13], p1[14], p1[15]);
#pragma unroll
        for (int q = 0; q < 4; ++q)
#pragma unroll
            for (int ks = 0; ks < 4; ++ks) { LAS const unsigned char* vp = Vb + (q * 8 + 2 * ks) * 512 + vbase; const s16x4 lo = lds_tr(vp), hh = lds_tr(vp + 512);
                const bf16x8 vf = (bf16x8){lo[0], lo[1], lo[2], lo[3], hh[0], hh[1], hh[2], hh[3]};
                oT[q] = MFMA32(vf, pw[ks], oT[q]); }
        if (more) { LAS unsigned char* Kn = lds + (b ^ 1) * 16384; LAS unsigned char* Vn = lds + 32768 + (b ^ 1) * 16384;
            *(LAS u32x4*)(Kn + kl0) = sk0; *(LAS u32x4*)(Kn + kl1) = sk1; *(LAS u32x4*)(Vn + vl0) = sv0; *(LAS u32x4*)(Vn + vl1) = sv1; }
        __syncthreads();
    }
}
__device__ __forceinline__ void attn_store(bf16_t* orow, const f32x16 (&o)[4], int hi) {
#pragma unroll
    for (int q = 0; q < 4; ++q)
#pragma unroll
        for (int g = 0; g < 4; ++g) { u32x2 w; w.x = cvt_pk_bf16(o[q][4 * g], o[q][4 * g + 1]); w.y = cvt_pk_bf16(o[q][4 * g + 2], o[q][4 * g + 3]); *(u32x2*)(orow + 32 * q + 8 * g + 4 * hi) = w; }
}
__device__ __forceinline__ void attnA_unit(const Args& A, LAS unsigned char* lds, int l, int bl, int nb, int pr, bool ctxq) {
    const int tid = tid_opaque(), lane = tid & 63, r32 = lane & 31, hi = lane >> 5, wave = __builtin_amdgcn_readfirstlane(tid >> 6);
    bf16_t* P = (bf16_t*)(A.ws + WS_P);
    const int head = 2 * pr + (wave >> 2), kvh = pr >> 1, qloc = nb * 128 + 32 * (wave & 3) + r32;
    const size_t brow = (size_t)bl * RB;
    const size_t qrow = brow + (ctxq ? 0 : CTXL) + qloc;
    const bf16_t* Kc = P + brow * LDP + C_KA + kvh * 128; const bf16_t* Vc = P + brow * LDP + C_VA + kvh * 128;
    int ks = 128 * (nb - 1), ke = 128 * (nb + 2); if (ks < 0) ks = 0; if (ke > SEQ) ke = SEQ;
    const int n1 = ctxq ? 0 : (ke - ks) / 64;
    f32x16 oT[4];
#pragma unroll
    for (int q = 0; q < 4; ++q)
#pragma unroll
        for (int r = 0; r < 16; ++r) oT[q][r] = 0.f;
    float mref = -INFINITY, lsum = 0.f;
    attn_core<128>(lds, P + qrow * LDP + C_QA + head * 128, 0, Kc, Vc, 4, Kc + (size_t)(CTXL + ks) * LDP, Vc + (size_t)(CTXL + ks) * LDP, n1, true, qloc, ks, oT, mref, lsum);
    const float sk = A.in[I_SINK][l * 8 + head] * LOG2E;
    const float mf = fmaxf(mref, sk), sc = __builtin_amdgcn_exp2f(mref - mf);
    lsum += __shfl_xor(lsum, 32);
    const float f = sc / (lsum * sc + __builtin_amdgcn_exp2f(sk - mf));
#pragma unroll
    for (int q = 0; q < 4; ++q) oT[q] = oT[q] * f;
    attn_store(P + qrow * LDP + C_QA + head * 128, oT, hi);
}
__device__ __forceinline__ void attnB_unit(const Args& A, LAS unsigned char* lds, int l, int bl, int h, int qb, bool ctxq) {
    const int tid = tid_opaque(), lane = tid & 63, r32 = lane & 31, hi = lane >> 5, wave = __builtin_amdgcn_readfirstlane(tid >> 6);
    bf16_t* P = (bf16_t*)(A.ws + WS_P);
    const int sub = wave >> 2;
    const size_t brow = (size_t)bl * RB;
    const size_t qrow = brow + (ctxq ? 0 : CTXL) + qb * 128 + 32 * (wave & 3) + r32;
    const bf16_t* Kc = P + brow * LDP + C_KD + h * 128; const bf16_t* Vc = P + brow * LDP + C_VD + h * 128;
    f32x16 oT[4];
#pragma unroll
    for (int q = 0; q < 4; ++q)
#pragma unroll
        for (int r = 0; r < 16; ++r) oT[q][r] = 0.f;
    float mref = -INFINITY, lsum = 0.f;
    attn_core<64>(lds, P + qrow * LDP + C_QD + h * 128 + sub * 64, sub * 64, Kc, Vc, ctxq ? 4 : NCH, Kc, Vc, 0, false, 0, 0, oT, mref, lsum);
    lsum += __shfl_xor(lsum, 32);
    const float inv = 1.0f / lsum;
    LAS float* xch = (LAS float*)lds + (wave & 3) * 4096;
    if (sub == 1) {
#pragma unroll
        for (int q = 0; q < 4; ++q)
#pragma unroll
            for (int r = 0; r < 16; ++r) xch[(q * 16 + r) * 64 + lane] = oT[q][r] * inv;
    }
    __syncthreads();
    if (sub == 0) {
        const float lam = ((const float*)(A.ws + WS_LAM))[2 * l], post = ((const float*)(A.ws + WS_LAM))[2 * l + 1];
        float ss = 0.f;
#pragma unroll
        for (int q = 0; q < 4; ++q)
#pragma unroll
            for (int r = 0; r < 16; ++r) { const float v = oT[q][r] * inv - lam * xch[(q * 16 + r) * 64 + lane]; oT[q][r] = v; ss += v * v; }
        ss += __shfl_xor(ss, 32);
        const float rn = post / sqrtf(ss * (1.0f / 128.0f) + 1e-6f);
        const float* sw = A.in[I_SUBLN] + l * 128;
#pragma unroll
        for (int q = 0; q < 4; ++q)
#pragma unroll
            for (int r = 0; r < 16; ++r) oT[q][r] *= rn * sw[32 * q + 8 * (r >> 2) + 4 * hi + (r & 3)];
        attn_store(P + qrow * LDP + C_QD + h * 128, oT, hi);
    }
    __syncthreads();
}
__device__ __forceinline__ void ph_attention(const Args& A, LAS unsigned char* lds, int l, int half) {
    const int G = gridDim.x, bid = blockIdx.x;
    for (int u = bid; u < HB * 8 * 64; u += G) { const int bl = u >> 9, h = (u >> 6) & 7, qb = u & 63; attnB_unit(A, lds, l, bl, h, qb, false); }
    for (int u = bid; u < HB * 64 * 4; u += G) { const int bl = u >> 8, nb = (u >> 2) & 63, pr = u & 3; attnA_unit(A, lds, l, bl, nb, pr, false); }
    if (l == 0) {
        for (int u = bid; u < HB * 8 * 2; u += G) { const int bl = u >> 4, h = (u >> 1) & 7, qb = u & 1; attnB_unit(A, lds, l, bl, h, qb, true); }
        for (int u = bid; u < HB * 2 * 4; u += G) { const int bl = u >> 3, nb = (u >> 2) & 1, pr = u & 3; attnA_unit(A, lds, l, bl, nb, pr, true); }
    }
}
constexpr int GL_QN = 0, GL_KN = 17408, GL_RHS = 34816, GL_MM = 100352, GL_GC = 117760, GL_BETA = 118016, GL_EG = 118272, GL_DK = 118528, GPITCH = 272;
__device__ __forceinline__ void gdn_intra_unit(const Args& A, LAS unsigned char* lds, int l, int bl, int ch, int h, int d) {
    const int tid_ = tid_opaque();
    const int tid = tid_, lane = tid & 63, r32 = lane & 31, hi = lane >> 5, wave = __builtin_amdgcn_readfirstlane(tid >> 6);
    const bf16_t* P = (const bf16_t*)(A.ws + WS_P); const float* AB = (const float*)(A.ws + WS_AB);
    const int uidx = ((bl * NCH + ch) * 8 + h) * 2 + d;
    unsigned char* rec = A.ws + WS_G + (size_t)uidx * GU_BYTES;
    const size_t R0 = (size_t)bl * RB + ch * 64;
    LAS float* GC = (LAS float*)(lds + GL_GC); LAS float* BETA = (LAS float*)(lds + GL_BETA); LAS float* EG = (LAS float*)(lds + GL_EG); LAS float* DKS = (LAS float*)(lds + GL_DK);
    LAS float* RHS = (LAS float*)(lds + GL_RHS); LAS float* MM = (LAS float*)(lds + GL_MM);
    if (wave == 0) {
        const size_t row = R0 + (d ? 63 - lane : lane);
        float g = AB[row * 32 + d * 8 + h]; const float be = AB[row * 32 + 16 + d * 8 + h];
#pragma unroll
        for (int o = 1; o < 64; o <<= 1) { const float t = __shfl_up(g, o); if (lane >= o) g += t; }
        const float glast = __shfl(g, 63);
        GC[lane] = g; BETA[lane] = be; EG[lane] = __expf(g); DKS[lane] = __expf(glast - g);
        if (lane == 0) ((float*)(A.ws + WS_GL))[uidx] = __expf(glast);
    }
    __syncthreads();
    {
        const int i = tid >> 3, sub = tid & 7, c = d ? 63 - i : i;
        const int tp = ch * 64 + c;
        const bool has_prev = !(tp == 0 || tp == CTXL), has_next = !(tp == CTXL - 1 || tp == RB - 1);
        const bf16_t* xr = P + (R0 + c) * LDP + C_QKV + h * 128 + sub * 16;
        const float* cw = A.in[I_DNCONV] + (size_t)l * 3 * 3072 + h * 128 + sub * 16;
        const float be = BETA[i], eg = EG[i];
#pragma unroll
        for (int mat = 0; mat < 3; ++mat) {
            const bf16_t* xm = xr + mat * 1024; const float* wm = cw + mat * 1024;
            float y[16];
            const u32x4 z4 = (u32x4){0u, 0u, 0u, 0u};
#pragma unroll
            for (int hf = 0; hf < 2; ++hf) {
                const u32x4 xc = *(const u32x4*)(xm + hf * 8);
                const u32x4 xp = has_prev ? *(const u32x4*)(xm - LDP + hf * 8) : z4;
                const u32x4 xn = has_next ? *(const u32x4*)(xm + LDP + hf * 8) : z4;
#pragma unroll
                for (int k = 0; k < 4; ++k) { const int e = hf * 8 + 2 * k;
                    const float v0 = wm[e] * bf_lo(xp[k]) + wm[3072 + e] * bf_lo(xc[k]) + wm[6144 + e] * bf_lo(xn[k]);
                    const float v1 = wm[e + 1] * bf_hi(xp[k]) + wm[3072 + e + 1] * bf_hi(xc[k]) + wm[6144 + e + 1] * bf_hi(xn[k]);
                    y[e] = silu_f(v0); y[e + 1] = silu_f(v1); }
            }
            if (mat < 2) {
                float ss = 0.f;
#pragma unroll
                for (int e = 0; e < 16; ++e) ss += y[e] * y[e];
                ss += __shfl_xor(ss, 1); ss += __shfl_xor(ss, 2); ss += __shfl_xor(ss, 4);
                const float rn = (1.0f / sqrtf(ss + 1e-6f)) * (mat == 0 ? 0.08838834764831845f : 1.0f);
#pragma unroll
                for (int e = 0; e < 16; ++e) y[e] *= rn;
                LAS unsigned char* dst = lds + (mat == 0 ? GL_QN : GL_KN) + i * GPITCH + sub * 32;
                u32x4 w0, w1; w0.x = cvt_pk_bf16(y[0], y[1]); w0.y = cvt_pk_bf16(y[2], y[3]); w0.z = cvt_pk_bf16(y[4], y[5]); w0.w = cvt_pk_bf16(y[6], y[7]);
                w1.x = cvt_pk_bf16(y[8], y[9]); w1.y = cvt_pk_bf16(y[10], y[11]); w1.z = cvt_pk_bf16(y[12], y[13]); w1.w = cvt_pk_bf16(y[14], y[15]);
                *(LAS u32x4*)dst = w0; *(LAS u32x4*)(dst + 16) = w1;
                if (mat == 1) { const float s = be * eg;
#pragma unroll
                    for (int e = 0; e < 16; e += 4) *(LAS f32x4*)(RHS + i * 256 + 128 + sub * 16 + e) = (f32x4){y[e] * s, y[e + 1] * s, y[e + 2] * s, y[e + 3] * s}; }
            } else {
#pragma unroll
                for (int e = 0; e < 16; e += 4) *(LAS f32x4*)(RHS + i * 256 + sub * 16 + e) = (f32x4){y[e] * be, y[e + 1] * be, y[e + 2] * be, y[e + 3] * be};
            }
        }
    }
    __syncthreads();
    {
        const int mat = wave >> 2, rbk = (wave >> 1) & 1, cbk = wave & 1;
        LAS const unsigned char* Ab = lds + GL_KN + (32 * rbk + r32) * GPITCH + hi * 16;
        LAS const unsigned char* Bb = lds + (mat == 0 ? GL_KN : GL_QN) + (32 * cbk + r32) * GPITCH + hi * 16;
        f32x16 acc;
#pragma unroll
        for (int r = 0; r < 16; ++r) acc[r] = 0.f;
#pragma unroll
        for (int d0 = 0; d0 < 8; ++d0) { const bf16x8 a = *(LAS const bf16x8*)(Ab + d0 * 32), b = *(LAS const bf16x8*)(Bb + d0 * 32); acc = MFMA32(a, b, acc); }
        const int cc = 32 * cbk + r32; const float gcc = GC[cc];
        if (mat == 0) {
#pragma unroll
            for (int r = 0; r < 16; ++r) { const int i = 32 * rbk + crow(r, hi); const float v = (i > cc) ? BETA[i] * acc[r] * __expf(GC[i] - gcc) : 0.f; MM[i * 68 + cc] = v; }
        } else {
            float v[16];
#pragma unroll
            for (int r = 0; r < 16; ++r) { const int j = 32 * rbk + crow(r, hi); v[r] = (cc >= j) ? acc[r] * __expf(gcc - GC[j]) : 0.f; }
            bf16x8* at = (bf16x8*)(rec + GU_AT);
            at[(cbk * 4 + 2 * rbk + 0) * 64 + lane] = pack8(v[0], v[1], v[2], v[3], v[4], v[5], v[6], v[7]);
            at[(cbk * 4 + 2 * rbk + 1) * 64 + lane] = pack8(v[8], v[9], v[10], v[11], v[12], v[13], v[14], v[15]);
        }
    }
    __syncthreads();
    float x[64];
#define FNMA(acc, a, b) asm("v_fma_f32 %0, -%1, %2, %0" : "+v"(acc) : "v"(a), "v"(b))
    if (tid < 256) {
        LAS const float* MMv = MM; asm volatile("" : "+v"(MMv));
        LAS const float* RHv = RHS + tid; asm volatile("" : "+v"(RHv));
#pragma unroll
        for (int i = 0; i < 64; ++i) {
            float a = RHv[i * 256];
#pragma unroll
            for (int m4 = 0; m4 < i; m4 += 4) { const f32x4 mm = *(LAS const f32x4*)(MMv + i * 68 + m4);
                FNMA(a, mm[0], x[m4]); if (m4 + 1 < i) FNMA(a, mm[1], x[m4 + 1]); if (m4 + 2 < i) FNMA(a, mm[2], x[m4 + 2]); if (m4 + 3 < i) FNMA(a, mm[3], x[m4 + 3]); }
            x[i] = a; asm volatile("" ::: "memory");
        }
    } else {
        const int w4 = wave - 4;
        if (w4 < 2) {
#pragma unroll
            for (int ff = 0; ff < 8; ++ff) { const int f = w4 * 8 + ff, ib = f >> 3, rb = (f >> 1) & 3, s = f & 1; const int i = 32 * ib + r32, dk0 = 32 * rb + 16 * s + 4 * hi;
                const u32x2 a = *(LAS const u32x2*)(lds + GL_QN + i * GPITCH + dk0 * 2), b = *(LAS const u32x2*)(lds + GL_QN + i * GPITCH + (dk0 + 8) * 2); const float e = EG[i];
                ((bf16x8*)(rec + GU_QG))[f * 64 + lane] = pack8(bf_lo(a.x) * e, bf_hi(a.x) * e, bf_lo(a.y) * e, bf_hi(a.y) * e, bf_lo(b.x) * e, bf_hi(b.x) * e, bf_lo(b.y) * e, bf_hi(b.y) * e); }
        } else {
#pragma unroll
            for (int ff = 0; ff < 8; ++ff) { const int f = (w4 - 2) * 8 + ff, rb = f >> 2, ib = (f >> 1) & 1, s = f & 1; const int i0 = 32 * ib + 16 * s + 4 * hi;
                LAS const unsigned char* kp = lds + GL_KN + (i0 + ((lane & 15) >> 2)) * GPITCH + (32 * rb + 16 * ((lane >> 4) & 1) + 4 * (lane & 3)) * 2;
                const s16x4 lo = lds_tr(kp), hh = lds_tr(kp + 8 * GPITCH);
                const f32x4 s0 = *(LAS const f32x4*)(DKS + i0), s1 = *(LAS const f32x4*)(DKS + i0 + 8);
#define BFV(x) __uint_as_float(((unsigned)(unsigned short)(x)) << 16)
                ((bf16x8*)(rec + GU_KD))[f * 64 + lane] = pack8(BFV(lo[0]) * s0[0], BFV(lo[1]) * s0[1], BFV(lo[2]) * s0[2], BFV(lo[3]) * s0[3], BFV(hh[0]) * s1[0], BFV(hh[1]) * s1[1], BFV(hh[2]) * s1[2], BFV(hh[3]) * s1[3]);
#undef BFV
            }
        }
    }
    __syncthreads();
    if (tid < 128) {
        unsigned* up = (unsigned*)(rec + GU_U); const int sl = tid >> 5, dvl = tid & 31;
#pragma unroll
        for (int ib = 0; ib < 2; ++ib)
#pragma unroll
            for (int p = 0; p < 8; ++p)
#pragma unroll
                for (int hh = 0; hh < 2; ++hh) { const int i = 32 * ib + (2 * p & 3) + 8 * (2 * p >> 2) + 4 * hh; up[((ib * 4 + sl) * 8 + p) * 64 + hh * 32 + dvl] = cvt_pk_bf16(x[i], x[i + 1]); }
    } else if (tid < 256) {
        LAS bf16_t* wl = (LAS bf16_t*)(lds + GL_QN);
#pragma unroll
        for (int i = 0; i < 64; ++i) wl[i * (GPITCH / 2) + (tid - 128)] = (bf16_t)(cvt_pk_bf16(x[i], 0.f) & 0xffffu);
    }
    __syncthreads();
#pragma unroll
    for (int ff = 0; ff < 2; ++ff) { const int f = wave * 2 + ff, ib = f >> 3, rb = (f >> 1) & 3, s = f & 1; const int i = 32 * ib + r32, dk0 = 32 * rb + 16 * s + 4 * hi;
        const u32x2 a = *(LAS const u32x2*)(lds + GL_QN + i * GPITCH + dk0 * 2), b = *(LAS const u32x2*)(lds + GL_QN + i * GPITCH + (dk0 + 8) * 2);
        ((u32x4*)(rec + GU_W))[f * 64 + lane] = (u32x4){a.x, a.y, b.x, b.y}; }
    __syncthreads();
}
__device__ __forceinline__ void ph_gdn_intra(const Args& A, LAS unsigned char* lds, int l) {
    for (int u = blockIdx.x; u < HB * NCH * 8 * 2; u += gridDim.x) { const int d = u & 1, h = (u >> 1) & 7, t = u >> 4, ch = t % NCH, bl = t / NCH; gdn_intra_unit(A, lds, l, bl, ch, h, d); }
}
__device__ __forceinline__ void gdn_scan_unit(const Args& A, int bl, int h, int d) {
    const int tid_ = tid_opaque();
    const int tid = tid_, lane = tid & 63, r32 = lane & 31, hi = lane >> 5, sl = __builtin_amdgcn_readfirstlane(tid >> 6);
    if (sl >= 4) return;
    bf16_t* O = (bf16_t*)(A.ws + WS_H) + (size_t)d * HR * 1024;
    const float* GLv = (const float*)(A.ws + WS_GL);
    f32x16 S[4];
#pragma unroll
    for (int rb = 0; rb < 4; ++rb)
#pragma unroll
        for (int r = 0; r < 16; ++r) S[rb][r] = 0.f;
    for (int step = 0; step < NCH; ++step) {
        const int ch = d ? (step < 4 ? 3 - step : NCH + 3 - step) : step;
        const int uidx = ((bl * NCH + ch) * 8 + h) * 2 + d;
        const unsigned char* rec = A.ws + WS_G + (size_t)uidx * GU_BYTES;
        const bf16x8* Wf = (const bf16x8*)(rec + GU_W) + lane; const bf16x8* Qf = (const bf16x8*)(rec + GU_QG) + lane; const bf16x8* Kf = (const bf16x8*)(rec + GU_KD) + lane; const bf16x8* Af = (const bf16x8*)(rec + GU_AT) + lane;
        const unsigned* Up = (const unsigned*)(rec + GU_U) + lane;
        const float gl = GLv[uidx];
        f32x16 vn[2], o[2];
#pragma unroll
        for (int ib = 0; ib < 2; ++ib)
#pragma unroll
            for (int r = 0; r < 16; ++r) { vn[ib][r] = 0.f; o[ib][r] = 0.f; }
#pragma unroll
        for (int rb = 0; rb < 4; ++rb) {
#pragma unroll
            for (int s = 0; s < 2; ++s) {
                const bf16x8 sb = pack8(S[rb][8 * s], S[rb][8 * s + 1], S[rb][8 * s + 2], S[rb][8 * s + 3], S[rb][8 * s + 4], S[rb][8 * s + 5], S[rb][8 * s + 6], S[rb][8 * s + 7]);
#pragma unroll
                for (int ib = 0; ib < 2; ++ib) { const int f = (ib * 4 + rb) * 2 + s; vn[ib] = MFMA32(Wf[f * 64], sb, vn[ib]); o[ib] = MFMA32(Qf[f * 64], sb, o[ib]); }
            }
            asm volatile("" ::: "memory");
        }
#pragma unroll
        for (int ib = 0; ib < 2; ++ib)
#pragma unroll
            for (int p = 0; p < 8; ++p) { const unsigned w = Up[((ib * 4 + sl) * 8 + p) * 64]; vn[ib][2 * p] = bf_lo(w) - vn[ib][2 * p]; vn[ib][2 * p + 1] = bf_hi(w) - vn[ib][2 * p + 1]; }
        bf16x8 vb[2][2];
#pragma unroll
        for (int ib = 0; ib < 2; ++ib) { vb[ib][0] = pack8(vn[ib][0], vn[ib][1], vn[ib][2], vn[ib][3], vn[ib][4], vn[ib][5], vn[ib][6], vn[ib][7]);
            vb[ib][1] = pack8(vn[ib][8], vn[ib][9], vn[ib][10], vn[ib][11], vn[ib][12], vn[ib][13], vn[ib][14], vn[ib][15]); }
        asm volatile("" ::: "memory");
#pragma unroll
        for (int ib = 0; ib < 2; ++ib)
#pragma unroll
            for (int jb = 0; jb < 2; ++jb)
#pragma unroll
                for (int s = 0; s < 2; ++s) o[ib] = MFMA32(Af[(ib * 4 + 2 * jb + s) * 64], vb[jb][s], o[ib]);
        asm volatile("" ::: "memory");
#pragma unroll
        for (int rb = 0; rb < 4; ++rb) { S[rb] = S[rb] * gl;
#pragma unroll
            for (int ib = 0; ib < 2; ++ib)
#pragma unroll
                for (int s = 0; s < 2; ++s) S[rb] = MFMA32(Kf[((rb * 2 + ib) * 2 + s) * 64], vb[ib][s], S[rb]);
            asm volatile("" ::: "memory"); }
        bf16_t* orow = O + ((size_t)bl * RB + ch * 64) * 1024 + h * 128 + 32 * sl + r32;
#pragma unroll
        for (int ib = 0; ib < 2; ++ib)
#pragma unroll
            for (int r = 0; r < 16; ++r) { const int i = 32 * ib + crow(r, hi); const int c = d ? 63 - i : i; orow[(size_t)c * 1024] = (bf16_t)(cvt_pk_bf16(o[ib][r], 0.f) & 0xffffu); }
    }
}
__device__ __forceinline__ void ph_gdn_scan(const Args& A) {
    for (int u = blockIdx.x; u < HB * 8 * 2; u += gridDim.x) gdn_scan_unit(A, u >> 4, (u >> 1) & 7, u & 1);
}
__device__ __forceinline__ void ph_gdn_post(const Args& A, int l) {
    const int tid = tid_opaque(), lane = tid & 63, gw = blockIdx.x * NWAVES + (tid >> 6), NGW = gridDim.x * NWAVES;
    const bf16_t* OF = (const bf16_t*)(A.ws + WS_H); const bf16_t* OB = OF + (size_t)HR * 1024; bf16_t* P = (bf16_t*)(A.ws + WS_P);
    const float* nw = A.in[I_DNNORM] + l * 128 + (lane & 7) * 16;
    for (int r = gw; r < HR; r += NGW) {
        const u32x4 f0 = *(const u32x4*)(OF + (size_t)r * 1024 + lane * 16), f1 = *(const u32x4*)(OF + (size_t)r * 1024 + lane * 16 + 8);
        const u32x4 b0 = *(const u32x4*)(OB + (size_t)r * 1024 + lane * 16), b1 = *(const u32x4*)(OB + (size_t)r * 1024 + lane * 16 + 8);
        bf16_t* zp = P + (size_t)r * LDP + C_Z + lane * 16;
        const u32x4 z0 = *(const u32x4*)zp, z1 = *(const u32x4*)(zp + 8);
        float o[16], z[16]; float ss = 0.f;
#pragma unroll
        for (int k = 0; k < 4; ++k) { o[2 * k] = bf_lo(f0[k]) + bf_lo(b0[k]); o[2 * k + 1] = bf_hi(f0[k]) + bf_hi(b0[k]); o[8 + 2 * k] = bf_lo(f1[k]) + bf_lo(b1[k]); o[8 + 2 * k + 1] = bf_hi(f1[k]) + bf_hi(b1[k]);
            z[2 * k] = bf_lo(z0[k]); z[2 * k + 1] = bf_hi(z0[k]); z[8 + 2 * k] = bf_lo(z1[k]); z[8 + 2 * k + 1] = bf_hi(z1[k]); }
#pragma unroll
        for (int e = 0; e < 16; ++e) ss += o[e] * o[e];
        ss += __shfl_xor(ss, 1); ss += __shfl_xor(ss, 2); ss += __shfl_xor(ss, 4);
        const float rn = 1.0f / sqrtf(ss * (1.0f / 128.0f) + 1e-6f);
#pragma unroll
        for (int e = 0; e < 16; ++e) o[e] = o[e] * rn * nw[e] * silu_f(z[e]);
        u32x4 w0, w1; w0.x = cvt_pk_bf16(o[0], o[1]); w0.y = cvt_pk_bf16(o[2], o[3]); w0.z = cvt_pk_bf16(o[4], o[5]); w0.w = cvt_pk_bf16(o[6], o[7]);
        w1.x = cvt_pk_bf16(o[8], o[9]); w1.y = cvt_pk_bf16(o[10], o[11]); w1.z = cvt_pk_bf16(o[12], o[13]); w1.w = cvt_pk_bf16(o[14], o[15]);
        *(u32x4*)zp = w0; *(u32x4*)(zp + 8) = w1;
    }
}
constexpr int NPH = 1 + 14 * 4;
__host__ __device__ inline bool phase_is_noop(int id) { if (id == 0) return false; const int it = (id - 1) / 14, k = (id - 1) % 14; return k == 0 && it != 2; }
__global__ void __launch_bounds__(NTHR, 2) fwd(Args A) {
    extern __shared__ __attribute__((aligned(16))) unsigned char lds_raw[];
    LAS unsigned char* lds = (LAS unsigned char*)lds_raw;
    volatile LAS unsigned* MISC = (volatile LAS unsigned*)(lds + LDSCTL_OFF + 320);
    for (int u = threadIdx.x; u < (LDS_BYTES - LDSCTL_OFF) / 4; u += NTHR) ((LAS unsigned*)(lds + LDSCTL_OFF))[u] = 0u;
    __syncthreads();
    const int lo = A.ph_lo, hi = A.ph_hi, G = gridDim.x, bid = blockIdx.x;
    unsigned char* ws = A.ws;
    XcdBarrier bar; bar.bar = (unsigned*)(ws + WS_CTL) + CW_BAR; bar.x = 0; bar.st = nullptr;
    if (hi - lo > 1) bar = xcd_barrier_post((unsigned*)(ws + WS_CTL) + CW_BAR, MISC + 8);
#ifndef PHMASK
#define PHMASK 0x7fff
#endif
#define RUNK(k, id, ...) do { if (((PHMASK >> (k)) & 1) && lo <= (id) && (id) < hi) { __VA_ARGS__; if ((id) + 1 < hi) xcd_barrier(bar); } } while (0)
    bf16_t* H = (bf16_t*)(ws + WS_H); bf16_t* P = (bf16_t*)(ws + WS_P);
    RUNK(14, 0, { ph_prologue(A, lds); __syncthreads(); ph_weights(A, lds, 0); });
    for (int it = 0; it < 4; ++it) {
        const int l = it >> 1, half = it & 1, base = 1 + 14 * it;
        if (it == 2) RUNK(0, base + 0, { ph_weights(A, lds, 1); });
        RUNK(1, base + 1, { ph_adaln(A, l, half); });
        RUNK(2, base + 2, {
            pg8::Gemm g{H, (const bf16_t*)(ws + WS_WIN), HR, NWIN, 2048, 2048}; pg8::StaticOrder S; S.init(HR, NWIN, G, bid);
            pg8::EpiInProj E{P, LDP, (float*)(ws + WS_AB), (const float*)(ws + WS_ROPEA), (const float*)(ws + WS_ROPED), A.in[I_ALOG] + l * 16, A.in[I_DTB] + l * 16, 0.08838834764831845f * LOG2E, 0.125f * LOG2E};
            pg8::gemm_phase<pg8::EpiInProj, pg8::StaticOrder, true, true>(lds, g, S, E); });
        RUNK(3, base + 3, { ph_gdn_intra(A, lds, l); });
        RUNK(4, base + 4, { ph_gdn_scan(A); });
        RUNK(5, base + 5, { ph_gdn_post(A, l); });
        RUNK(6, base + 6, { ph_attention(A, lds, l, half); });
        RUNK(7, base + 7, {
            pg8::StaticOrder S; S.init(HR, 2048, G, bid); float* TOT = (float*)(ws + WS_TOT); bf16_t* Mo = (bf16_t*)(ws + WS_M);
            { pg8::Gemm g{P + C_QA, (const bf16_t*)(ws + WS_WPA), HR, 2048, 1024, LDP}; pg8::EpiMerge<0> E{P + C_G, LDP, TOT, Mo, 2048}; pg8::gemm_phase<pg8::EpiMerge<0>, pg8::StaticOrder, true, true>(lds, g, S, E); }
            { pg8::Gemm g{P + C_QD, (const bf16_t*)(ws + WS_WPB), HR, 2048, 1024, LDP}; pg8::EpiMerge<1> E{P + C_G + 2048, LDP, TOT, Mo, 2048}; pg8::gemm_phase<pg8::EpiMerge<1>, pg8::StaticOrder, true, true>(lds, g, S, E); }
            { pg8::Gemm g{P + C_Z, (const bf16_t*)(ws + WS_WPC), HR, 2048, 1024, LDP}; pg8::EpiMerge<2> E{P + C_G + 4096, LDP, TOT, Mo, 2048}; pg8::gemm_phase<pg8::EpiMerge<2>, pg8::StaticOrder, true, true>(lds, g, S, E); } });
        RUNK(8, base + 8, {
            pg8::Gemm g{(const bf16_t*)(ws + WS_M), (const bf16_t*)(ws + WS_WO), HR, 2048, 2048, 2048}; pg8::StaticOrder S; S.init(HR, 2048, G, bid);
            pg8::EpiF32 E{(float*)(ws + WS_OX), 2048}; pg8::gemm_phase<pg8::EpiF32, pg8::StaticOrder, true, true>(lds, g, S, E); });
        RUNK(9, base + 9, { ph_resln<true>(A, l, half, (const float*)(ws + WS_OX), 2, A.in[I_LN1G] + l * DM, A.in[I_LN1B] + l * DM); });
        RUNK(10, base + 10, {
            pg8::Gemm g{H, (const bf16_t*)(ws + WS_WUP), HR, NUP, 2048, 2048}; pg8::StaticOrder S; S.init(HR, NUP, G, bid);
            pg8::EpiBf16 E{(bf16_t*)(ws + WS_U), NUP}; pg8::gemm_phase<pg8::EpiBf16, pg8::StaticOrder, true, true>(lds, g, S, E); });
        RUNK(11, base + 11, { ph_convact(A, l); });
        RUNK(12, base + 12, {
            pg8::Gemm g{(const bf16_t*)(ws + WS_ACT), (const bf16_t*)(ws + WS_WDN), HR, 2048, DFF, DFF}; pg8::StaticOrder S; S.init(HR, 2048, G, bid);
            pg8::EpiF32 E{(float*)(ws + WS_FX), 2048}; pg8::gemm_phase<pg8::EpiF32, pg8::StaticOrder, true, true>(lds, g, S, E); });
        RUNK(13, base + 13, { ph_resln<false>(A, l, half, (const float*)(ws + WS_FX), 5, A.in[I_LN2G] + l * DM, A.in[I_LN2B] + l * DM); });
    }
#undef RUNK
}

#ifndef MK_ONE_LAUNCH
#define MK_ONE_LAUNCH 0
#endif
extern "C" void kernel_launch(void* const* d_in, const int* in_sizes, int n_in, void* d_out, int out_size, void* d_ws, size_t ws_size, hipStream_t stream) {
    static int grid = 0;
    if (grid == 0) {
        if (n_in != 29 || out_size != NBATCH * SEQ * DM || ws_size < WS_END) { fprintf(stderr, "kernel_launch: unexpected problem (n_in %d, out %d, ws %zu < %zu)\n", n_in, out_size, ws_size, (size_t)WS_END); grid = -1; return; }
        int dev = 0, cus = 0, per_cu = 0;
        if (hipGetDevice(&dev) != hipSuccess || hipDeviceGetAttribute(&cus, hipDeviceAttributeMultiprocessorCount, dev) != hipSuccess) { grid = -1; return; }
        if (hipFuncSetAttribute((const void*)fwd, hipFuncAttributeMaxDynamicSharedMemorySize, LDS_BYTES) != hipSuccess) { fprintf(stderr, "kernel_launch: hipFuncSetAttribute failed\n"); grid = -1; return; }
        if (hipOccupancyMaxActiveBlocksPerMultiprocessor(&per_cu, (const void*)fwd, NTHR, LDS_BYTES) != hipSuccess || per_cu < 1) fprintf(stderr, "kernel_launch: occupancy query reports %d\n", per_cu);
        (void)hipGetLastError();
        grid = cus > 256 ? 256 : cus;
    }
    if (grid < 0) return;
    (void)hipMemsetAsync((char*)d_ws + WS_CTL, 0, CTL_ZERO_BYTES, stream);
    Args a{};
    for (int i = 0; i < 29; ++i) a.in[i] = (const float*)d_in[i];
    a.out = (float*)d_out; a.ws = (unsigned char*)d_ws;
#if MK_ONE_LAUNCH
    a.ph_lo = 0; a.ph_hi = NPH;
    hipLaunchKernelGGL(fwd, dim3(grid), dim3(NTHR), LDS_BYTES, stream, a);
#else
    for (int id = 0; id < NPH; ++id) { if (phase_is_noop(id)) continue; a.ph_lo = id; a.ph_hi = id + 1; hipLaunchKernelGGL(fwd, dim3(grid), dim3(NTHR), LDS_BYTES, stream, a); }
#endif
}
```

```cpp
#include <hip/hip_runtime.h>
#include <cstdio>
#include <cstdint>
#include <cmath>
namespace pg8 {
#define PG8_LAS __attribute__((address_space(3)))
typedef unsigned short bf16_t;
typedef short bf16x8 __attribute__((ext_vector_type(8)));
typedef float f32x4 __attribute__((ext_vector_type(4)));
typedef unsigned u32x4 __attribute__((ext_vector_type(4)));
constexpr int BM = 256, BK = 64, HALF = 128, HTB = HALF * BK * 2  , STAGE_BYTES = 8 * HTB, NXCD = 8, WGM = 8;

__host__ __device__ __forceinline__ int lds_byte(int r, int c) { const int st = (r >> 4) * 2 + (c >> 5), rr = r & 15, cc = c & 31, ob = rr * 64 + cc * 2; return st * 1024 + (ob ^ (((ob >> 9) & 1) << 5)); }
__host__ __device__ __forceinline__ void stage_rc(int b, int& R, int& C) { const int st = b / 1024, sb = b % 1024, swz = sb ^ (((sb >> 9) & 1) << 5); R = (st >> 1) * 16 + swz / 64; C = (st & 1) * 32 + (swz % 64) / 2; }
__host__ __device__ __forceinline__ int perm32(int rho) { const int n = rho >> 4, i = rho & 15; return 8 * (i >> 2) + 4 * n + (i & 3); }

struct Unit { int pm, pn; };
struct Gemm { const bf16_t* A; const bf16_t* Bt; int M, N, K, lda; };

struct StaticOrder {
    int nM, nN, nwg, G, c;
    __host__ __device__ void init(int M, int N, int G_, int c_) { nM = M / BM; nN = N / BM; nwg = nM * nN; G = G_; c = c_; }
    __host__ __device__ bool next(int i, Unit& u) const {
        const long L = (long)i * G + c; if (L >= nwg) return false;
        int wgid = (int)L; { const int q = nwg / NXCD, r = nwg % NXCD, xcd = wgid % NXCD, off = wgid / NXCD; wgid = (xcd < r ? xcd * (q + 1) : r * (q + 1) + (xcd - r) * q) + off; }
        const int nig = WGM * nN, gid = wgid / nig, fm = gid * WGM, gsz = (nM - fm) < WGM ? (nM - fm) : WGM;
        u.pm = fm + ((wgid % nig) % gsz); u.pn = (wgid % nig) / gsz; return true;
    }
    __device__ __forceinline__ void a_ready(const Unit&) const {}
    __device__ __forceinline__ void done(const Unit&) const {}
};

__device__ __forceinline__ unsigned cvt_pk_bf16(float lo, float hi) { unsigned r; asm volatile("v_cvt_pk_bf16_f32 %0, %1, %2" : "=v"(r) : "v"(lo), "v"(hi)); return r; }
__device__ __forceinline__ float bf_lo(unsigned w) { return __uint_as_float(w << 16); }
__device__ __forceinline__ float bf_hi(unsigned w) { return __uint_as_float(w & 0xffff0000u); }
__device__ __forceinline__ float sigm(float x) { return 1.0f / (1.0f + __expf(-x)); }

struct EpiF32 {
    static constexpr bool PERM = false, AFTER_DRAIN = false;
    float* C; int ldc;
    __device__ __forceinline__ void operator()(const f32x4 (&acc)[2][2][4][2], const Unit& u, int wr, int wc, int fr, int fq) const {
        const int row0 = u.pm * BM + wr * 64 + fr, col0 = u.pn * BM + wc * 32 + 4 * fq;
#pragma unroll
        for (int ai = 0; ai < 2; ++ai)
#pragma unroll
            for (int m = 0; m < 4; ++m) { float* rowp = C + (size_t)(row0 + ai * HALF + m * 16) * ldc + col0;
#pragma unroll
                for (int bj = 0; bj < 2; ++bj)
#pragma unroll
                    for (int n = 0; n < 2; ++n) *(f32x4*)(rowp + bj * HALF + n * 16) = acc[ai][bj][m][n]; }
    }
};
struct EpiBf16 {
    static constexpr bool PERM = true, AFTER_DRAIN = false;
    bf16_t* O; int ldc;
    __device__ __forceinline__ void operator()(const f32x4 (&acc)[2][2][4][2], const Unit& u, int wr, int wc, int fr, int fq) const {
        const int row0 = u.pm * BM + wr * 64 + fr, col0 = u.pn * BM + wc * 32 + 8 * fq;
#pragma unroll
        for (int ai = 0; ai < 2; ++ai)
#pragma unroll
            for (int m = 0; m < 4; ++m) { bf16_t* rowp = O + (size_t)(row0 + ai * HALF + m * 16) * ldc + col0;
#pragma unroll
                for (int bj = 0; bj < 2; ++bj) { const f32x4 v0 = acc[ai][bj][m][0], v1 = acc[ai][bj][m][1];
                    u32x4 w; w.x = cvt_pk_bf16(v0[0], v0[1]); w.y = cvt_pk_bf16(v0[2], v0[3]); w.z = cvt_pk_bf16(v1[0], v1[1]); w.w = cvt_pk_bf16(v1[2], v1[3]);
                    *(u32x4*)(rowp + bj * HALF) = w; } }
    }
};
template <int MODE> struct EpiMerge {
    static constexpr bool PERM = true, AFTER_DRAIN = false;
    const bf16_t* G; int ldg; float* TOT; bf16_t* Mo; int ldc;
    __device__ __forceinline__ void operator()(const f32x4 (&acc)[2][2][4][2], const Unit& u, int wr, int wc, int fr, int fq) const {
        asm volatile("" : "+v"(fr), "+v"(fq));
        const int row0 = u.pm * BM + wr * 64 + fr, col0 = u.pn * BM + wc * 32 + 8 * fq;
#pragma unroll
        for (int ai = 0; ai < 2; ++ai)
#pragma unroll
            for (int m = 0; m < 4; ++m) { const size_t row = (size_t)(row0 + ai * HALF + m * 16);
#pragma unroll
                for (int bj = 0; bj < 2; ++bj) { const int col = col0 + bj * HALF;
                    const u32x4 gw = *(const u32x4*)(G + row * ldg + col);
                    f32x4 g0 = (f32x4){bf_lo(gw.x), bf_hi(gw.x), bf_lo(gw.y), bf_hi(gw.y)}, g1 = (f32x4){bf_lo(gw.z), bf_hi(gw.z), bf_lo(gw.w), bf_hi(gw.w)};
                    f32x4 v0 = acc[ai][bj][m][0] * g0, v1 = acc[ai][bj][m][1] * g1;
                    float* tp = TOT + row * ldc + col;
                    if (MODE >= 1) { v0 += *(const f32x4*)tp; v1 += *(const f32x4*)(tp + 4); }
                    if (MODE <= 1) { *(f32x4*)tp = v0; *(f32x4*)(tp + 4) = v1; }
                    else { u32x4 w; w.x = cvt_pk_bf16(v0[0], v0[1]); w.y = cvt_pk_bf16(v0[2], v0[3]); w.z = cvt_pk_bf16(v1[0], v1[1]); w.w = cvt_pk_bf16(v1[2], v1[3]);
                        *(u32x4*)(Mo + row * ldc + col) = w; } }
                asm volatile("" ::: "memory"); }
    }
};
struct EpiInProj {
    static constexpr bool PERM = true, AFTER_DRAIN = false;
    bf16_t* P; int ldp; float* AB; const float* ropeA; const float* ropeD; const float* a_log; const float* dt_bias; float sA, sD;
    __device__ __forceinline__ void operator()(const f32x4 (&acc)[2][2][4][2], const Unit& u, int wr, int wc, int fr, int fq) const {
        asm volatile("" : "+v"(fr), "+v"(fq));
        const int pn = u.pn, tib = u.pm % 33; const bool is_ctx = (tib == 0);
        const int row0 = u.pm * BM + wr * 64 + fr, t0 = tib * 256 - 256 + wr * 64 + fr, cl = wc * 32 + 8 * fq;
        int type; float scale = 1.f;
        if (pn <= 3) { type = 1; scale = sA; } else if (pn == 4) type = 1; else if (pn == 5) type = 0; else if (pn <= 9) { type = 2; scale = sD; } else if (pn <= 13) type = 2;
        else if (pn <= 33) type = 0; else if (pn <= 57) type = 3; else type = 4;
        if (type == 4) {
            if (wc == 0) {
                const int c = 8 * fq;
#pragma unroll
                for (int ai = 0; ai < 2; ++ai)
#pragma unroll
                    for (int m = 0; m < 4; ++m) { const size_t row = (size_t)(row0 + ai * HALF + m * 16); f32x4 v0 = acc[ai][0][m][0], v1 = acc[ai][0][m][1]; float o[8] = {v0[0], v0[1], v0[2], v0[3], v1[0], v1[1], v1[2], v1[3]};
#pragma unroll
                        for (int k = 0; k < 8; ++k) { if (c < 16) { const float x = o[k] + dt_bias[c + k]; const float sp = fmaxf(x, 0.f) + log1pf(__expf(-fabsf(x))); o[k] = -__expf(a_log[c + k]) * sp; } else o[k] = sigm(o[k]); }
                        *(f32x4*)(AB + row * 32 + c) = (f32x4){o[0], o[1], o[2], o[3]}; *(f32x4*)(AB + row * 32 + c + 4) = (f32x4){o[4], o[5], o[6], o[7]}; }
            }
            return;
        }
#pragma unroll
        for (int ai = 0; ai < 2; ++ai)
#pragma unroll
            for (int m = 0; m < 4; ++m) { const size_t row = (size_t)(row0 + ai * HALF + m * 16); const int t = t0 + ai * HALF + m * 16;
#pragma unroll
                for (int bj = 0; bj < 2; ++bj) { const int c = cl + bj * HALF; f32x4 v0 = acc[ai][bj][m][0], v1 = acc[ai][bj][m][1];
                    if ((type == 1 || type == 2) && !is_ctx) {
                        const float* tab;
                        if (type == 1) { const int p0 = (c & 127) >> 1; const int pos = (p0 >= 32) ? (t & 63) : (t >> 6); tab = ropeA + (pos * 32 + (p0 & 31)) * 2; }
                        else { const int p0 = (c & 63) >> 1; const int pos = (p0 >= 16) ? (t & 63) : (t >> 6); tab = ropeD + (pos * 16 + (p0 & 15)) * 2; }
                        const f32x4 cs0 = *(const f32x4*)tab, cs1 = *(const f32x4*)(tab + 4);
                        f32x4 r0, r1;
                        r0[0] = v0[0] * cs0[0] - v0[1] * cs0[1]; r0[1] = v0[1] * cs0[0] + v0[0] * cs0[1]; r0[2] = v0[2] * cs0[2] - v0[3] * cs0[3]; r0[3] = v0[3] * cs0[2] + v0[2] * cs0[3];
                        r1[0] = v1[0] * cs1[0] - v1[1] * cs1[1]; r1[1] = v1[1] * cs1[0] + v1[0] * cs1[1]; r1[2] = v1[2] * cs1[2] - v1[3] * cs1[3]; r1[3] = v1[3] * cs1[2] + v1[2] * cs1[3];
                        v0 = r0; v1 = r1;
                    }
                    if (type == 3) {
#pragma unroll
                        for (int k = 0; k < 4; ++k) { v0[k] = sigm(v0[k]); v1[k] = sigm(v1[k]); } }
                    v0 = v0 * scale; v1 = v1 * scale;
                    u32x4 w; w.x = cvt_pk_bf16(v0[0], v0[1]); w.y = cvt_pk_bf16(v0[2], v0[3]); w.z = cvt_pk_bf16(v1[0], v1[1]); w.w = cvt_pk_bf16(v1[2], v1[3]);
                    *(u32x4*)(P + row * ldp + pn * BM + c) = w; }
                asm volatile("" ::: "memory"); }
    }
};

template <class Epi, class Sched, bool ALIGN_EPI = false, bool SP2 = false>
__device__ __forceinline__ void gemm_phase(PG8_LAS unsigned char* lds, const Gemm g, const Sched& S, const Epi& E) {
    int tid_ = threadIdx.x; asm volatile("" : "+v"(tid_));
    const int tid = tid_, wid = __builtin_amdgcn_readfirstlane(tid >> 6), lane = tid & 63, wr = wid >> 2, wc = wid & 3, fr = lane & 15, fq = lane >> 4;
    const int K = g.K, nt = K / BK;
    unsigned voffA[2], voffB[2];
#pragma unroll
    for (int i = 0; i < 2; ++i) { int R, C; stage_rc(tid * 16 + i * 8192, R, C); const int Rb = Epi::PERM ? ((R & ~31) + perm32(R & 31)) : R;
        voffA[i] = (unsigned)(R * g.lda + C) * 2u; voffB[i] = (unsigned)(Rb * K + C) * 2u; }
    const size_t kstep = (size_t)(BK * 2);
    const size_t hstepB = (size_t)HALF * K * 2, hstepA = (size_t)HALF * g.lda * 2;
    const size_t tstepA = 2 * hstepA, tstepB = 2 * hstepB;
    const unsigned ldsw = (unsigned)wid * 1024u;
    const int aoff = lds_byte(wr * 64 + fr, fq * 8), boff = lds_byte(wc * 32 + fr, fq * 8);
#define PG8_SA(b, h) (((b) * 2 + (h)) * HTB)
#define PG8_SB(b, h) ((4 + (b) * 2 + (h)) * HTB)
#define PG8_STAGE(bufoff, gbase, voff) do { _Pragma("unroll") for (int _i = 0; _i < 2; ++_i) \
        __builtin_amdgcn_global_load_lds((const unsigned*)((const char*)(gbase) + (voff)[_i]), (PG8_LAS unsigned*)(lds + (bufoff) + ldsw + _i * 8192), 16, 0, 0); } while (0)
#define PG8_LDA(dst, b, h) do { _Pragma("unroll") for (int m = 0; m < 4; ++m) _Pragma("unroll") for (int k = 0; k < 2; ++k) dst[m][k] = *(const PG8_LAS bf16x8*)(lds + PG8_SA(b, h) + aoff + m * 2048 + k * 1024); } while (0)
#define PG8_LDB(dst, b, h) do { _Pragma("unroll") for (int n = 0; n < 2; ++n) _Pragma("unroll") for (int k = 0; k < 2; ++k) dst[n][k] = *(const PG8_LAS bf16x8*)(lds + PG8_SB(b, h) + boff + n * 2048 + k * 1024); } while (0)
#define PG8_MMA(ai, bj, At, Bt) do { __builtin_amdgcn_s_setprio(1); _Pragma("unroll") for (int m = 0; m < 4; ++m) _Pragma("unroll") for (int n = 0; n < 2; ++n) _Pragma("unroll") for (int k = 0; k < 2; ++k) \
        acc[ai][bj][m][n] = __builtin_amdgcn_mfma_f32_16x16x32_bf16(Bt[n][k], At[m][k], acc[ai][bj][m][n], 0, 0, 0); __builtin_amdgcn_s_setprio(0); } while (0)
#define PG8_WAIT_V(n) asm volatile("s_waitcnt vmcnt(" #n ")" ::: "memory")
#define PG8_WAIT_L(n) asm volatile("s_waitcnt lgkmcnt(" #n ")" ::: "memory")
#define PG8_BAR __builtin_amdgcn_s_barrier()
#define PG8_SCHED __builtin_amdgcn_sched_barrier(0)
    Unit cur, nxt; int ui = 0;
    if (!S.next(0, cur)) return;
    f32x4 acc[2][2][4][2];
#pragma unroll
    for (int a = 0; a < 2; ++a)
#pragma unroll
        for (int b = 0; b < 2; ++b)
#pragma unroll
            for (int m = 0; m < 4; ++m)
#pragma unroll
                for (int n = 0; n < 2; ++n) acc[a][b][m][n] = (f32x4){0.f, 0.f, 0.f, 0.f};
    bf16x8 At[4][2], B0[2][2], B1[2][2];
    const char* cA = (const char*)g.A + (size_t)cur.pm * tstepA; const char* cB = (const char*)g.Bt + (size_t)cur.pn * tstepB;
    S.a_ready(cur);
    if constexpr (SP2) {
        PG8_STAGE(PG8_SB(0, 0), cB, voffB); PG8_STAGE(PG8_SB(0, 1), cB + hstepB, voffB); PG8_STAGE(PG8_SA(0, 0), cA, voffA); PG8_STAGE(PG8_SA(0, 1), cA + hstepA, voffA);
        if (wr == 1) PG8_BAR;
        PG8_WAIT_V(2); PG8_BAR;
        PG8_STAGE(PG8_SB(1, 0), cB + kstep, voffB); PG8_STAGE(PG8_SA(1, 0), cA + kstep, voffA); PG8_STAGE(PG8_SB(1, 1), cB + hstepB + kstep, voffB);
        PG8_WAIT_V(6); PG8_BAR;
    } else {
        PG8_STAGE(PG8_SB(0, 0), cB, voffB); PG8_STAGE(PG8_SA(0, 0), cA, voffA); PG8_STAGE(PG8_SB(0, 1), cB + hstepB, voffB); PG8_STAGE(PG8_SA(0, 1), cA + hstepA, voffA);
        if (wr == 1) PG8_BAR;
        PG8_WAIT_V(4); PG8_BAR;
        PG8_STAGE(PG8_SB(1, 0), cB + kstep, voffB); PG8_STAGE(PG8_SA(1, 0), cA + kstep, voffA); PG8_STAGE(PG8_SB(1, 1), cB + hstepB + kstep, voffB);
        PG8_WAIT_V(6); PG8_BAR;
    }
    for (;;) {
        const bool has_next = S.next(ui + 1, nxt);
        const char* nA = has_next ? (const char*)g.A + (size_t)nxt.pm * tstepA : cA; const char* nB = has_next ? (const char*)g.Bt + (size_t)nxt.pn * tstepB : cB;
        for (int t = 0; t < nt; t += 2) {
            const bool last = (t == nt - 2);
            const char* a1 = cA + (size_t)(t + 1) * kstep;
            const char* a2 = last ? nA : cA + (size_t)(t + 2) * kstep; const char* b2 = last ? nB : cB + (size_t)(t + 2) * kstep;
            const char* a3 = a2 + kstep; const char* b3 = b2 + kstep;
            if (last && has_next) S.a_ready(nxt);
            if constexpr (SP2) {
            PG8_LDB(B0, 0, 0); PG8_LDB(B1, 0, 1); PG8_SCHED; PG8_LDA(At, 0, 0); PG8_STAGE(PG8_SA(1, 1), a1 + hstepA, voffA);
            PG8_WAIT_V(8); PG8_WAIT_L(0); PG8_BAR; PG8_MMA(0, 0, At, B0); PG8_MMA(0, 1, At, B1); PG8_BAR; PG8_SCHED;
            PG8_LDA(At, 0, 1); PG8_STAGE(PG8_SB(0, 0), b2, voffB); PG8_STAGE(PG8_SB(0, 1), b2 + hstepB, voffB); PG8_STAGE(PG8_SA(0, 0), a2, voffA);
            PG8_WAIT_V(8); PG8_WAIT_L(0); PG8_BAR; PG8_MMA(1, 0, At, B0); PG8_MMA(1, 1, At, B1); PG8_BAR; PG8_SCHED;
            PG8_LDB(B0, 1, 0); PG8_LDB(B1, 1, 1); PG8_SCHED; PG8_LDA(At, 1, 0); PG8_STAGE(PG8_SA(0, 1), a2 + hstepA, voffA);
            PG8_WAIT_V(8); PG8_WAIT_L(0); PG8_BAR; PG8_MMA(0, 0, At, B0); PG8_MMA(0, 1, At, B1); PG8_BAR; PG8_SCHED;
            PG8_LDA(At, 1, 1); PG8_STAGE(PG8_SB(1, 0), b3, voffB); PG8_STAGE(PG8_SB(1, 1), b3 + hstepB, voffB); PG8_STAGE(PG8_SA(1, 0), a3, voffA);
            PG8_WAIT_V(8); PG8_WAIT_L(0); PG8_BAR; PG8_MMA(1, 0, At, B0); PG8_MMA(1, 1, At, B1); PG8_BAR; PG8_SCHED;
            } else {
            PG8_LDB(B0, 0, 0); PG8_SCHED; PG8_LDA(At, 0, 0); PG8_STAGE(PG8_SA(1, 1), a1 + hstepA, voffA);
            PG8_WAIT_L(8); PG8_BAR; PG8_WAIT_L(0); PG8_MMA(0, 0, At, B0); PG8_BAR; PG8_SCHED;
            PG8_LDB(B1, 0, 1); PG8_STAGE(PG8_SB(0, 0), b2, voffB);
            PG8_BAR; PG8_WAIT_L(0); PG8_MMA(0, 1, At, B1); PG8_BAR;
            PG8_LDA(At, 0, 1); PG8_STAGE(PG8_SA(0, 0), a2, voffA);
            PG8_BAR; PG8_WAIT_L(0); PG8_MMA(1, 0, At, B0); PG8_BAR; PG8_SCHED;
            PG8_STAGE(PG8_SB(0, 1), b2 + hstepB, voffB);
            PG8_WAIT_V(6); PG8_BAR; PG8_MMA(1, 1, At, B1); PG8_BAR;
            PG8_LDB(B0, 1, 0); PG8_SCHED; PG8_LDA(At, 1, 0); PG8_STAGE(PG8_SA(0, 1), a2 + hstepA, voffA);
            PG8_WAIT_L(8); PG8_BAR; PG8_WAIT_L(0); PG8_MMA(0, 0, At, B0); PG8_BAR; PG8_SCHED;
            PG8_LDB(B1, 1, 1); PG8_STAGE(PG8_SB(1, 0), b3, voffB);
            PG8_BAR; PG8_WAIT_L(0); PG8_MMA(0, 1, At, B1); PG8_BAR;
            PG8_LDA(At, 1, 1); PG8_STAGE(PG8_SA(1, 0), a3, voffA);
            PG8_BAR; PG8_WAIT_L(0); PG8_MMA(1, 0, At, B0); PG8_BAR; PG8_SCHED;
            PG8_STAGE(PG8_SB(1, 1), b3 + hstepB, voffB);
            PG8_WAIT_V(6); PG8_BAR; PG8_MMA(1, 1, At, B1); PG8_BAR;
            }
        }
        if constexpr (ALIGN_EPI) { if (wr == 0) PG8_BAR; }
        if constexpr (!Epi::AFTER_DRAIN) { E(acc, cur, wr, wc, fr, fq); S.done(cur); }
        if (!has_next) break;
#pragma unroll
        for (int a = 0; a < 2; ++a)
#pragma unroll
            for (int b = 0; b < 2; ++b)
#pragma unroll
                for (int m = 0; m < 4; ++m)
#pragma unroll
                    for (int n = 0; n < 2; ++n) acc[a][b][m][n] = (f32x4){0.f, 0.f, 0.f, 0.f};
        cur = nxt; cA = nA; cB = nB; ++ui;
        if constexpr (ALIGN_EPI) { if (wr == 1) PG8_BAR; }
    }
    PG8_WAIT_V(0);
    if constexpr (!ALIGN_EPI) { if (wr == 0) PG8_BAR; }
    PG8_BAR;
    if constexpr (Epi::AFTER_DRAIN) { E.fused(acc, cur, wr, wc, fr, fq, lds, wid, lane); S.done(cur); }
#undef PG8_SA
#undef PG8_SB
#undef PG8_STAGE
#undef PG8_LDA
#undef PG8_LDB
#undef PG8_MMA
#undef PG8_WAIT_V
#undef PG8_WAIT_L
#undef PG8_BAR
#undef PG8_SCHED
}
}

constexpr int DM = 2048, NBATCH = 4, SEQ = 8192, CTXL = 256, RB = CTXL + SEQ  , HB = 2  , HR = HB * RB  ;
constexpr int DFF = 5632, NUP = 2 * DFF, NMOD = 6 * DM, NCH = RB / 64  ;
constexpr int LDP = 14848;
constexpr int NWIN = 15104, INW = 14880;
constexpr int C_QA = 0, C_KA = 1024, C_VA = 1280, C_QD = 1536, C_KD = 2560, C_VD = 3584, C_QKV = 4608, C_Z = 7680, C_G = 8704;
constexpr float LN_EPS = 1e-6f, DN_ALPHA = 1.41421356237f  , LOG2E = 1.4426950408889634f;
constexpr int NWAVES = 8, NTHR = 512;
constexpr size_t MiB = 1u << 20;
constexpr size_t WS_CTL = 0, CTL_ZERO_BYTES = 1 * MiB;
constexpr size_t WS_MOD = 1 * MiB;
constexpr size_t WS_ROPEA = WS_MOD + 512 * 1024, WS_ROPED = WS_ROPEA + 32768, WS_LAM = WS_ROPED + 16384;
constexpr size_t WS_CX = 2 * MiB;
constexpr size_t WS_WIN = 10 * MiB, WS_WPA = 69 * MiB, WS_WPB = 73 * MiB, WS_WPC = 77 * MiB, WS_WO = 81 * MiB, WS_WUP = 89 * MiB, WS_WDN = 133 * MiB;
constexpr size_t WS_H = 155 * MiB;
constexpr size_t WS_AB = 221 * MiB;
constexpr size_t WS_GL = WS_AB + 5 * MiB / 2;
constexpr size_t WS_P = 224 * MiB;
constexpr size_t WS_G = 703 * MiB;
constexpr size_t GU_BYTES = 73728, GU_W = 0, GU_U = 16384, GU_KD = 32768, GU_QG = 49152, GU_AT = 65536;
constexpr size_t WS_END = WS_G + 297 * MiB;
constexpr size_t WS_TOT = WS_G, WS_M = WS_G + 132 * MiB, WS_OX = WS_P, WS_U = WS_P, WS_ACT = WS_G, WS_FX = WS_P;
static_assert((size_t)HR * LDP * 2 <= 479 * MiB && (size_t)4224 * GU_BYTES <= 297 * MiB && (size_t)HR * NUP * 2 <= 479 * MiB && (size_t)HR * DFF * 2 <= 297 * MiB, "d_ws map");
constexpr int CW_BAR = 4096;
constexpr int RING_BYTES = 131072, LDSCTL_OFF = RING_BYTES, LDS_BYTES = 147456;

#define GAS __attribute__((address_space(1)))
#define LAS __attribute__((address_space(3)))
typedef unsigned short bf16_t;
typedef short bf16x8 __attribute__((ext_vector_type(8)));
typedef short s16x4 __attribute__((ext_vector_type(4)));
typedef float f32x4 __attribute__((ext_vector_type(4)));
typedef float f32x2 __attribute__((ext_vector_type(2)));
typedef float f32x16 __attribute__((ext_vector_type(16)));
typedef unsigned u32x4 __attribute__((ext_vector_type(4)));
typedef unsigned u32x2 __attribute__((ext_vector_type(2)));
using pg8::cvt_pk_bf16; using pg8::bf_lo; using pg8::bf_hi; using pg8::sigm;
__device__ __forceinline__ float wave_sum(float v) {
#pragma unroll
    for (int o = 1; o < 64; o <<= 1) v += __shfl_xor(v, o);
    return v;
}
__device__ __forceinline__ int tid_opaque() { int t = threadIdx.x; asm volatile("" : "+v"(t)); return t; }
__device__ __forceinline__ float silu_f(float x) { return x / (1.0f + __expf(-x)); }
__device__ __forceinline__ int crow(int r, int hi) { return (r & 3) + 8 * (r >> 2) + 4 * hi; }
__device__ __forceinline__ bf16x8 pack8(float a0, float a1, float a2, float a3, float a4, float a5, float a6, float a7) {
    u32x4 w; w.x = cvt_pk_bf16(a0, a1); w.y = cvt_pk_bf16(a2, a3); w.z = cvt_pk_bf16(a4, a5); w.w = cvt_pk_bf16(a6, a7); return __builtin_bit_cast(bf16x8, w); }
typedef short v4i16_t __attribute__((ext_vector_type(4)));
__device__ __forceinline__ s16x4 lds_tr(LAS const unsigned char* p) { return __builtin_bit_cast(s16x4, __builtin_amdgcn_ds_read_tr16_b64_v4i16((LAS v4i16_t*)p)); }
#define MFMA32(a, b, c) __builtin_amdgcn_mfma_f32_32x32x16_bf16((a), (b), (c), 0, 0, 0)

#define XB_TMO      128
#define XB_XCNT(j)  (256  + 64 * (j))
#define XB_XSUB(j)  (1280 + 64 * (j))
#define XB_XGEN(j)  (2304 + 64 * (j))
#define XB_TOP      3328
#define XB_TOPGEN   3392
#define XCD_BAR_WORDS 3456
#define XB_SPIN_CAP (1u << 18)

__device__ __forceinline__ unsigned xb_ld(unsigned* p)              { return __hip_atomic_load(p, __ATOMIC_RELAXED, __HIP_MEMORY_SCOPE_AGENT); }
__device__ __forceinline__ unsigned xb_add(unsigned* p, unsigned v) { return __hip_atomic_fetch_add(p, v, __ATOMIC_RELAXED, __HIP_MEMORY_SCOPE_AGENT); }
__device__ __forceinline__ unsigned xb_xcc_id() { return (unsigned)__builtin_amdgcn_s_getreg((3 << 11) | 20) & 0xFu; }
#define XB_SPIN(cond, bar) do { unsigned _sp = 0; while (cond) { __builtin_amdgcn_s_sleep(1); \
    if ((++_sp & 255u) == 0u) { if (xb_ld(&(bar)[XB_TMO])) break; if (_sp > XB_SPIN_CAP) { atomicAdd(&(bar)[XB_TMO], 1u); break; } } } } while (0)

struct XcdBarrier {
    unsigned* bar; unsigned x;
    volatile LAS unsigned* st;
};

__device__ __forceinline__ XcdBarrier xcd_barrier_post(unsigned* bar, volatile LAS unsigned* st) {
    XcdBarrier b; b.bar = bar; b.x = xb_xcc_id(); b.st = st;
    if (threadIdx.x == 0) (void)xb_add(&bar[XB_XCNT(b.x)], 1u);
    return b;
}
__device__ __forceinline__ void xcd_barrier_complete(unsigned* bar, unsigned x, unsigned& nloc, unsigned& nx) {
    const unsigned G = gridDim.x * gridDim.y * gridDim.z;
    unsigned sum, cnt, mine, sp = 0u;
    for (;;) {
        sum = 0u; cnt = 0u; mine = 0u;
#pragma unroll
        for (unsigned j = 0; j < 16; ++j) { const unsigned c = xb_ld(&bar[XB_XCNT(j)]); sum += c; cnt += (c > 0u) ? 1u : 0u; mine = (j == x) ? c : mine; }
        if (sum == G) break;
        __builtin_amdgcn_s_sleep(1);
        if ((++sp & 255u) == 0u) { if (xb_ld(&bar[XB_TMO])) break; if (sp > XB_SPIN_CAP) { atomicAdd(&bar[XB_TMO], 1u); break; } }
    }
    nloc = mine > 0u ? mine : 1u; nx = cnt > 0u ? cnt : 1u;
}

__device__ __forceinline__ void xcd_barrier(const XcdBarrier& b) {
    asm volatile("s_waitcnt vmcnt(0)" ::: "memory");
    __syncthreads();
    if (threadIdx.x == 0) {
        unsigned* bar = b.bar;
        __builtin_amdgcn_s_waitcnt(0);
        unsigned nloc = b.st[0], nx = b.st[1];
        if (nloc == 0u) { xcd_barrier_complete(bar, b.x, nloc, nx); b.st[0] = nloc; b.st[1] = nx; }
        const unsigned old = xb_add(&bar[XB_XSUB(b.x)], 1u);
        const unsigned gen = old / nloc;
        if (old + 1u == (gen + 1u) * nloc) {
            __builtin_amdgcn_fence(__ATOMIC_RELEASE, "agent");
            asm volatile("s_waitcnt vmcnt(0)" ::: "memory");
            const unsigned og = xb_add(&bar[XB_TOP], 1u);
            const unsigned tg = og / nx;
            if (og + 1u == (tg + 1u) * nx) xb_add(&bar[XB_TOPGEN], 1u);
            else XB_SPIN(xb_ld(&bar[XB_TOPGEN]) == tg, bar);
            __builtin_amdgcn_fence(__ATOMIC_ACQUIRE, "agent");
            xb_add(&bar[XB_XGEN(b.x)], 1u);
            asm volatile("s_waitcnt vmcnt(0)" ::: "memory");
        } else {
            XB_SPIN(xb_ld(&bar[XB_XGEN(b.x)]) == gen, bar);
            __builtin_amdgcn_fence(__ATOMIC_ACQUIRE, "agent");
            asm volatile("s_waitcnt vmcnt(0)" ::: "memory");
        }
    }
    __syncthreads();
}
struct Args { const float* in[29]; float* out; unsigned char* ws; int ph_lo, ph_hi; };
enum { I_X = 0, I_C, I_CTX, I_CCTX, I_WMOD, I_BMOD, I_WIN, I_SINK, I_LQ1, I_LK1, I_LQ2, I_LK2, I_SUBLN, I_DNCONV, I_ALOG, I_DTB, I_DNNORM, I_WPA, I_WPB, I_WPC, I_WO, I_LN1G, I_LN1B, I_WUP, I_FCW, I_FCB, I_WDN, I_LN2G, I_LN2B };

__device__ __forceinline__ void ph_prologue(const Args& A, LAS unsigned char* lds) {
    const int tid = tid_opaque(), lane = tid & 63, wave = tid >> 6, G = gridDim.x, bid = blockIdx.x;
    const int gt = bid * NTHR + tid, NT = G * NTHR;
    float* ropeA = (float*)(A.ws + WS_ROPEA); float* ropeD = (float*)(A.ws + WS_ROPED); float* LAM = (float*)(A.ws + WS_LAM); float* MOD = (float*)(A.ws + WS_MOD);
    for (int e = gt; e < 128 * 32; e += NT) { const int pos = e >> 5, f = e & 31; const float inv = powf(10000.0f, -(float)(2 * f) / 64.0f); const float ang = (float)pos * inv; ropeA[2 * e] = cosf(ang); ropeA[2 * e + 1] = sinf(ang); }
    for (int e = gt; e < 128 * 16; e += NT) { const int pos = e >> 4, f = e & 15; const float inv = powf(10000.0f, -(float)(2 * f) / 32.0f); const float ang = (float)pos * inv; ropeD[2 * e] = cosf(ang); ropeD[2 * e + 1] = sinf(ang); }
    if (gt < 2) { const int l = gt; float s1 = 0.f, s2 = 0.f;
        for (int i = 0; i < 64; ++i) { s1 += A.in[I_LQ1][l * 64 + i] * A.in[I_LK1][l * 64 + i]; s2 += A.in[I_LQ2][l * 64 + i] * A.in[I_LK2][l * 64 + i]; }
        const float lam_init = 0.8f - 0.6f * expf(-0.3f * (float)l); LAM[2 * l] = expf(s1) - expf(s2) + lam_init; LAM[2 * l + 1] = 1.0f - lam_init; }
    LAS float* sc = (LAS float*)lds;
    LAS float* red = (LAS float*)(lds + 40960);
    for (int e = tid; e < 5 * 2048; e += NTHR) { const int idx = e >> 11, k = e & 2047; const float v = (idx < 4) ? A.in[I_C][idx * 2048 + k] : A.in[I_CCTX][k]; sc[e] = silu_f(v); }
    __syncthreads();
    for (int u = bid; u < 192; u += G) {
        const int l = u / 96, n0 = (u % 96) * 128;
        const float* W = A.in[I_WMOD] + (size_t)l * 2048 * NMOD + n0 + 2 * lane;
        float acc[5][2];
#pragma unroll
        for (int i = 0; i < 5; ++i) { acc[i][0] = 0.f; acc[i][1] = 0.f; }
        const int k0 = wave * 256;
#pragma unroll 4
        for (int k = k0; k < k0 + 256; ++k) { const f32x2 w = *(const f32x2*)(W + (size_t)k * NMOD);
#pragma unroll
            for (int i = 0; i < 5; ++i) { const float s = sc[i * 2048 + k]; acc[i][0] += s * w.x; acc[i][1] += s * w.y; } }
#pragma unroll
        for (int i = 0; i < 5; ++i) { red[(wave * 5 + i) * 128 + 2 * lane] = acc[i][0]; red[(wave * 5 + i) * 128 + 2 * lane + 1] = acc[i][1]; }
        __syncthreads();
        for (int e = tid; e < 640; e += NTHR) { const int idx = e >> 7, n = e & 127; float s = 0.f;
#pragma unroll
            for (int w = 0; w < 8; ++w) s += red[(w * 5 + idx) * 128 + n];
            MOD[(size_t)(l * 5 + idx) * NMOD + n0 + n] = s + A.in[I_BMOD][l * NMOD + n0 + n]; }
        __syncthreads();
    }
}
__device__ __forceinline__ int win_src(int n) {
    if (n < 1280) { const int j = n & 127, p = j >> 1, s = j & 1; const int dim = (p < 32) ? (s * 32 + p) : (64 + s * 32 + (p - 32)); return (n & ~127) + dim; }
    if (n < 1536) return n;
    if (n < 3584) { const int j = n & 63, p = j >> 1, s = j & 1; const int dim = (p < 16) ? (s * 16 + p) : (32 + s * 16 + (p - 16)); return (n & ~63) + dim; }
    if (n < 8704) return n;
    if (n < 14848) return n + 32;
    if (n < 14880) return n - 14848 + 8704;
    return -1;
}
template <int MODE> __device__ __forceinline__ void transpose_item(const float* W, int K, int N, bf16_t* WT, LAS float* scr, int kb, int nb, int lane) {
    const int k0 = 64 * kb, n0 = 32 * nb, nn = n0 + (lane & 31);
    const int sc = (MODE == 1) ? win_src(nn) : nn;
    const float* src = W + (size_t)(k0 + (lane >> 5)) * N + (sc >= 0 ? sc : 0);
#pragma unroll 8
    for (int i = 0; i < 32; ++i) { const float v = src[(size_t)(2 * i) * N]; scr[(2 * i + (lane >> 5)) * 33 + (lane & 31)] = (sc >= 0) ? v : 0.f; }
    asm volatile("s_waitcnt lgkmcnt(0)" ::: "memory");
    const int c = lane & 7;
#pragma unroll
    for (int j = 0; j < 4; ++j) { const int n = (lane >> 3) + 8 * j; const LAS float* s = scr + (8 * c) * 33 + n;
        u32x4 o; o.x = cvt_pk_bf16(s[0 * 33], s[1 * 33]); o.y = cvt_pk_bf16(s[2 * 33], s[3 * 33]); o.z = cvt_pk_bf16(s[4 * 33], s[5 * 33]); o.w = cvt_pk_bf16(s[6 * 33], s[7 * 33]);
        *(u32x4*)(WT + (size_t)(n0 + n) * K + k0 + 8 * c) = o; }
    asm volatile("s_waitcnt lgkmcnt(0)" ::: "memory");
}
__device__ __forceinline__ void ph_weights(const Args& A, LAS unsigned char* lds, int l) {
    const int tid = tid_opaque(), lane = tid & 63, wave = tid >> 6, G = gridDim.x, bid = blockIdx.x;
    LAS float* scr = (LAS float*)(lds + wave * 8448);
    unsigned char* ws = A.ws;
    constexpr int I0 = 32 * 472, I1 = 16 * 64, I2 = 32 * 64, I3 = 32 * 352, I4 = 88 * 64, NIT = I0 + 3 * I1 + I2 + I3 + I4;
    for (int it = bid * NWAVES + wave; it < NIT; it += G * NWAVES) {
        int r = it;
        if (r < I0) { transpose_item<1>(A.in[I_WIN] + (size_t)l * 2048 * INW, 2048, INW, (bf16_t*)(ws + WS_WIN), scr, r / 472, r % 472, lane); continue; } r -= I0;
        if (r < I1) { transpose_item<0>(A.in[I_WPA] + (size_t)l * 1024 * 2048, 1024, 2048, (bf16_t*)(ws + WS_WPA), scr, r / 64, r % 64, lane); continue; } r -= I1;
        if (r < I1) { transpose_item<0>(A.in[I_WPB] + (size_t)l * 1024 * 2048, 1024, 2048, (bf16_t*)(ws + WS_WPB), scr, r / 64, r % 64, lane); continue; } r -= I1;
        if (r < I1) { transpose_item<0>(A.in[I_WPC] + (size_t)l * 1024 * 2048, 1024, 2048, (bf16_t*)(ws + WS_WPC), scr, r / 64, r % 64, lane); continue; } r -= I1;
        if (r < I2) { transpose_item<0>(A.in[I_WO] + (size_t)l * 2048 * 2048, 2048, 2048, (bf16_t*)(ws + WS_WO), scr, r / 64, r % 64, lane); continue; } r -= I2;
        if (r < I3) { transpose_item<0>(A.in[I_WUP] + (size_t)l * 2048 * NUP, 2048, NUP, (bf16_t*)(ws + WS_WUP), scr, r / 352, r % 352, lane); continue; } r -= I3;
        transpose_item<0>(A.in[I_WDN] + (size_t)l * DFF * 2048, DFF, 2048, (bf16_t*)(ws + WS_WDN), scr, r / 64, r % 64, lane);
    }
}
__device__ __forceinline__ void row_src(const Args& A, int l, int half, int r, const float*& src, float*& dst, const float*& mod, bool& is_ctx) {
    const int bl = r / RB, tp = r - bl * RB, b = half * HB + bl; is_ctx = tp < CTXL;
    float* cx = (float*)(A.ws + WS_CX);
    dst = is_ctx ? cx + (size_t)(b * CTXL + tp) * DM : A.out + (size_t)(b * SEQ + tp - CTXL) * DM;
    if (l == 0) src = is_ctx ? A.in[I_CTX] + (size_t)(b * CTXL + tp) * DM : A.in[I_X] + (size_t)(b * SEQ + tp - CTXL) * DM; else src = dst;
    mod = (const float*)(A.ws + WS_MOD) + (size_t)(l * 5 + (is_ctx ? 4 : b)) * NMOD;
}
__device__ __forceinline__ void ln_stats(const f32x4 (&v)[8], float& mean, float& rstd) {
    float s = 0.f;
#pragma unroll
    for (int j = 0; j < 8; ++j) s += (v[j].x + v[j].y) + (v[j].z + v[j].w);
    mean = wave_sum(s) * (1.0f / DM); float q = 0.f;
#pragma unroll
    for (int j = 0; j < 8; ++j) { const f32x4 d = v[j] - mean; q += (d.x * d.x + d.y * d.y) + (d.z * d.z + d.w * d.w); }
    rstd = 1.0f / sqrtf(wave_sum(q) * (1.0f / DM) + LN_EPS);
}
__device__ __forceinline__ void ada_store(const f32x4 (&v)[8], float mean, float rstd, const float* shift, const float* scale, bf16_t* hrow, int lane) {
#pragma unroll
    for (int j = 0; j < 8; ++j) { const int e = (64 * j + lane) * 4; const f32x4 sh = *(const f32x4*)(shift + e), sc = *(const f32x4*)(scale + e);
        const f32x4 y = (v[j] - mean) * rstd * (sc + 1.0f) + sh; u32x2 w; w.x = cvt_pk_bf16(y.x, y.y); w.y = cvt_pk_bf16(y.z, y.w); *(u32x2*)(hrow + e) = w; }
}
__device__ __forceinline__ void ph_adaln(const Args& A, int l, int half) {
    const int tid = tid_opaque(), lane = tid & 63, gw = blockIdx.x * NWAVES + (tid >> 6), NGW = gridDim.x * NWAVES;
    bf16_t* H = (bf16_t*)(A.ws + WS_H);
    for (int r = gw; r < HR; r += NGW) {
        const float* src; float* dst; const float* mod; bool is_ctx; row_src(A, l, half, r, src, dst, mod, is_ctx);
        f32x4 v[8];
#pragma unroll
        for (int j = 0; j < 8; ++j) v[j] = *((const f32x4*)src + 64 * j + lane);
        float mean, rstd; ln_stats(v, mean, rstd);
        ada_store(v, mean, rstd, mod, mod + DM, H + (size_t)r * DM, lane);
    }
}
template <bool WITH_H> __device__ __forceinline__ void ph_resln(const Args& A, int l, int half, const float* Y, int gate_idx, const float* lng, const float* lnb) {
    const int tid = tid_opaque(), lane = tid & 63, gw = blockIdx.x * NWAVES + (tid >> 6), NGW = gridDim.x * NWAVES;
    bf16_t* H = (bf16_t*)(A.ws + WS_H);
    for (int r = gw; r < HR; r += NGW) {
        const float* src; float* dst; const float* mod; bool is_ctx; row_src(A, l, half, r, src, dst, mod, is_ctx);
        if (is_ctx && l == 1) continue;
        if (!WITH_H) src = dst;
        const float* gate = mod + gate_idx * DM; const float* yrow = Y + (size_t)r * DM;
        f32x4 v[8];
#pragma unroll
        for (int j = 0; j < 8; ++j) { const int e = 64 * j + lane; v[j] = *((const f32x4*)src + e) * DN_ALPHA + *((const f32x4*)gate + e) * *((const f32x4*)yrow + e); }
        float mean, rstd; ln_stats(v, mean, rstd);
#pragma unroll
        for (int j = 0; j < 8; ++j) { const int e = 64 * j + lane; v[j] = (v[j] - mean) * rstd * *((const f32x4*)lng + e) + *((const f32x4*)lnb + e); *((f32x4*)dst + e) = v[j]; }
        if (WITH_H) { ln_stats(v, mean, rstd); ada_store(v, mean, rstd, mod + 3 * DM, mod + 4 * DM, H + (size_t)r * DM, lane); }
    }
}
__device__ __forceinline__ void ph_convact(const Args& A, int l) {
    const int gt = blockIdx.x * NTHR + tid_opaque(), NT = gridDim.x * NTHR;
    const bf16_t* U = (const bf16_t*)(A.ws + WS_U); bf16_t* ACT = (bf16_t*)(A.ws + WS_ACT);
    const float* cw = A.in[I_FCW] + (size_t)l * 3 * NUP; const float* cb = A.in[I_FCB] + (size_t)l * NUP;
    constexpr int NVC = DFF / 8, NRB = HR / 32;
    for (int idx = gt; idx < NRB * NVC; idx += NT) {
        const int rbk = idx / NVC, vc = idx - rbk * NVC, r0 = rbk * 32, tp0 = r0 % RB;
        const bool first_start = (tp0 == 0 || tp0 == CTXL), last_end = (tp0 + 31 == CTXL - 1 || tp0 + 31 == RB - 1);
        const int ca = vc * 8, cbk = DFF + vc * 8;
        float wa[3][8], wb[3][8], ba[8], bb[8];
#pragma unroll
        for (int t = 0; t < 3; ++t) {
#pragma unroll
            for (int k = 0; k < 8; ++k) { wa[t][k] = cw[t * NUP + ca + k]; wb[t][k] = cw[t * NUP + cbk + k]; } }
#pragma unroll
        for (int k = 0; k < 8; ++k) { ba[k] = cb[ca + k]; bb[k] = cb[cbk + k]; }
        const u32x4 z4 = (u32x4){0u, 0u, 0u, 0u};
        u32x4 pa = z4, pb = z4, qa, qb, na, nb;
        if (!first_start) { pa = *(const u32x4*)(U + (size_t)(r0 - 1) * NUP + ca); pb = *(const u32x4*)(U + (size_t)(r0 - 1) * NUP + cbk); }
        qa = *(const u32x4*)(U + (size_t)r0 * NUP + ca); qb = *(const u32x4*)(U + (size_t)r0 * NUP + cbk);
        for (int r = 0; r < 32; ++r) {
            if (r == 31 && last_end) { na = z4; nb = z4; } else { na = *(const u32x4*)(U + (size_t)(r0 + r + 1) * NUP + ca); nb = *(const u32x4*)(U + (size_t)(r0 + r + 1) * NUP + cbk); }
            float o[8];
#pragma unroll
            for (int k = 0; k < 4; ++k) {
                const unsigned a0 = pa[k], a1 = qa[k], a2 = na[k], b0 = pb[k], b1 = qb[k], b2 = nb[k];
                const float xa0 = wa[0][2 * k] * bf_lo(a0) + wa[1][2 * k] * bf_lo(a1) + wa[2][2 * k] * bf_lo(a2) + ba[2 * k];
                const float xa1 = wa[0][2 * k + 1] * bf_hi(a0) + wa[1][2 * k + 1] * bf_hi(a1) + wa[2][2 * k + 1] * bf_hi(a2) + ba[2 * k + 1];
                const float xb0 = wb[0][2 * k] * bf_lo(b0) + wb[1][2 * k] * bf_lo(b1) + wb[2][2 * k] * bf_lo(b2) + bb[2 * k];
                const float xb1 = wb[0][2 * k + 1] * bf_hi(b0) + wb[1][2 * k + 1] * bf_hi(b1) + wb[2][2 * k + 1] * bf_hi(b2) + bb[2 * k + 1];
                o[2 * k] = silu_f(xa0) * xb0; o[2 * k + 1] = silu_f(xa1) * xb1; }
            u32x4 w; w.x = cvt_pk_bf16(o[0], o[1]); w.y = cvt_pk_bf16(o[2], o[3]); w.z = cvt_pk_bf16(o[4], o[5]); w.w = cvt_pk_bf16(o[6], o[7]);
            *(u32x4*)(ACT + (size_t)(r0 + r) * DFF + vc * 8) = w;
            pa = qa; pb = qb; qa = na; qb = nb;
        }
    }
}
template <int DQK>
__device__ __forceinline__ void attn_core(LAS unsigned char* lds, const bf16_t* Qrow, int kc0, const bf16_t* K0, const bf16_t* V0, int n0, const bf16_t* K1, const bf16_t* V1, int n1,
                                          bool mask1, int qpos, int k1pos0, f32x16 (&oT)[4], float& mref, float& lsum) {
    const int tid = tid_opaque(), lane = tid & 63, r32 = lane & 31, hi = lane >> 5;
    bf16x8 qf[DQK / 16];
#pragma unroll
    for (int d0 = 0; d0 < DQK / 16; ++d0) qf[d0] = *(const bf16x8*)(Qrow + d0 * 16 + hi * 8);
    const int srow = tid >> 4, sch = tid & 15;
    const size_t goff0 = (size_t)srow * LDP + sch * 8, goff1 = goff0 + (size_t)32 * LDP;
    const int kl0 = sch * 1024 + ((srow ^ sch) << 4), kl1 = kl0 + 512;
    const int vl0 = ((sch >> 2) * 8 + (srow >> 3)) * 512 + (srow & 7) * 64 + (sch & 3) * 16, vl1 = vl0 + 4 * 512;
    const int nt = n0 + n1;
    const int vbase = (4 * hi + ((lane & 15) >> 2)) * 64 + ((lane >> 4) & 1) * 32 + (lane & 3) * 8;
    u32x4 sk0, sk1, sv0, sv1;
    { const bf16_t* kp = (n0 > 0) ? K0 : K1; const bf16_t* vp = (n0 > 0) ? V0 : V1;
      sk0 = *(const u32x4*)(kp + goff0); sk1 = *(const u32x4*)(kp + goff1); sv0 = *(const u32x4*)(vp + goff0); sv1 = *(const u32x4*)(vp + goff1);
      *(LAS u32x4*)(lds + kl0) = sk0; *(LAS u32x4*)(lds + kl1) = sk1; *(LAS u32x4*)(lds + 32768 + vl0) = sv0; *(LAS u32x4*)(lds + 32768 + vl1) = sv1; }
    __syncthreads();
    for (int t = 0; t < nt; ++t) {
        const int b = t & 1; const bool more = (t + 1 < nt);
        if (more) { const int tn = t + 1; const bf16_t* kp = (tn < n0) ? K0 + (size_t)tn * 64 * LDP : K1 + (size_t)(tn - n0) * 64 * LDP; const bf16_t* vp = (tn < n0) ? V0 + (size_t)tn * 64 * LDP : V1 + (size_t)(tn - n0) * 64 * LDP;
            sk0 = *(const u32x4*)(kp + goff0); sk1 = *(const u32x4*)(kp + goff1); sv0 = *(const u32x4*)(vp + goff0); sv1 = *(const u32x4*)(vp + goff1); }
        LAS const unsigned char* Kb = lds + b * 16384; LAS const unsigned char* Vb = lds + 32768 + b * 16384;
        f32x16 p0, p1;
#pragma unroll
        for (int r = 0; r < 16; ++r) { p0[r] = 0.f; p1[r] = 0.f; }
#pragma unroll
        for (int d0 = 0; d0 < DQK / 16; ++d0) { const int c = (kc0 >> 3) + 2 * d0 + hi; const int off = c * 1024 + ((r32 ^ c) << 4);
            const bf16x8 a0 = *(LAS const bf16x8*)(Kb + off), a1 = *(LAS const bf16x8*)(Kb + off + 512);
            p0 = MFMA32(a0, qf[d0], p0); p1 = MFMA32(a1, qf[d0], p1); }
        if (mask1 && t >= n0) { const int kb = k1pos0 + (t - n0) * 64 + 4 * hi - qpos;
#pragma unroll
            for (int r = 0; r < 16; ++r) { const int dl = kb + (r & 3) + 8 * (r >> 2); if (dl > 128 || dl < -128) p0[r] = -INFINITY; if (dl + 32 > 128 || dl + 32 < -128) p1[r] = -INFINITY; } }
        float tm = fmaxf(p0[0], p1[0]);
#pragma unroll
        for (int r = 1; r < 16; ++r) tm = fmaxf(tm, fmaxf(p0[r], p1[r]));
        tm = fmaxf(tm, __shfl_xor(tm, 32));
        if (__any(tm > mref + 8.0f)) { const float mn = fmaxf(mref, tm); const float al = __builtin_amdgcn_exp2f(mref - mn);
#pragma unroll
            for (int q = 0; q < 4; ++q) oT[q] = oT[q] * al;
            lsum *= al; mref = mn; }
        float rs = 0.f;
#pragma unroll
        for (int r = 0; r < 16; ++r) { p0[r] = __builtin_amdgcn_exp2f(p0[r] - mref); p1[r] = __builtin_amdgcn_exp2f(p1[r] - mref); rs += p0[r] + p1[r]; }
        lsum += rs;
        bf16x8 pw[4];
        pw[0] = pack8(p0[0], p0[1], p0[2], p0[3], p0[4], p0[5], p0[6], p0[7]); pw[1] = pack8(p0[8], p0[9], p0[10], p0[11], p0[12], p0[13], p0[14], p0[15]);
        pw[2] = pack8(p1[0], p1[1], p1[2], p1[3], p1[4], p1[5], p1[6], p1[7]); pw[3] = pack8(p1[8], p1[9], p1[10], p1[11], p1[12], p1[13], p1[14], p1[15]);
#pragma unroll
        for (int q = 0; q < 4; ++q)
#pragma unroll
            for (int ks = 0; ks < 4; ++ks) { LAS const unsigned char* vp = Vb + (q * 8 + 2 * ks) * 512 + vbase; const s16x4 lo = lds_tr(vp), hh = lds_tr(vp + 512);
                const bf16x8 vf = (bf16x8){lo[0], lo[1], lo[2], lo[3], hh[0], hh[1], hh[2], hh[3]};
                oT[q] = MFMA32(vf, pw[ks], oT[q]); }
        if (more) { LAS unsigned char* Kn = lds + (b ^ 1) * 16384; LAS unsigned char* Vn = lds + 32768 + (b ^ 1) * 16384;
            *(LAS u32x4*)(Kn + kl0) = sk0; *(LAS u32x4*)(Kn + kl1) = sk1; *(LAS u32x4*)(Vn + vl0) = sv0; *(LAS u32x4*)(Vn + vl1) = sv1; }
        __syncthreads();
    }
}
__device__ __forceinline__ void attn_store(bf16_t* orow, const f32x16 (&o)[4], int hi) {
#pragma unroll
    for (int q = 0; q < 4; ++q)
#pragma unroll
        for (int g = 0; g < 4; ++g) { u32x2 w; w.x = cvt_pk_bf16(o[q][4 * g], o[q][4 * g + 1]); w.y = cvt_pk_bf16(o[q][4 * g + 2], o[q][4 * g + 3]); *(u32x2*)(orow + 32 * q + 8 * g + 4 * hi) = w; }
}
__device__ __forceinline__ void attnA_unit(const Args& A, LAS unsigned char* lds, int l, int bl, int nb, int pr, bool ctxq) {
    const int tid = tid_opaque(), lane = tid & 63, r32 = lane & 31, hi = lane >> 5, wave = __builtin_amdgcn_readfirstlane(tid >> 6);
    bf16_t* P = (bf16_t*)(A.ws + WS_P);
    const int head = 2 * pr + (wave >> 2), kvh = pr >> 1, qloc = nb * 128 + 32 * (wave & 3) + r32;
    const size_t brow = (size_t)bl * RB;
    const size_t qrow = brow + (ctxq ? 0 : CTXL) + qloc;
    const bf16_t* Kc = P + brow * LDP + C_KA + kvh * 128; const bf16_t* Vc = P + brow * LDP + C_VA + kvh * 128;
    int ks = 128 * (nb - 1), ke = 128 * (nb + 2); if (ks < 0) ks = 0; if (ke > SEQ) ke = SEQ;
    const int n1 = ctxq ? 0 : (ke - ks) / 64;
    f32x16 oT[4];
#pragma unroll
    for (int q = 0; q < 4; ++q)
#pragma unroll
        for (int r = 0; r < 16; ++r) oT[q][r] = 0.f;
    float mref = -INFINITY, lsum = 0.f;
    attn_core<128>(lds, P + qrow * LDP + C_QA + head * 128, 0, Kc, Vc, 4, Kc + (size_t)(CTXL + ks) * LDP, Vc + (size_t)(CTXL + ks) * LDP, n1, true, qloc, ks, oT, mref, lsum);
    const float sk = A.in[I_SINK][l * 8 + head] * LOG2E;
    const float mf = fmaxf(mref, sk), sc = __builtin_amdgcn_exp2f(mref - mf);
    lsum += __shfl_xor(lsum, 32);
    const float f = sc / (lsum * sc + __builtin_amdgcn_exp2f(sk - mf));
#pragma unroll
    for (int q = 0; q < 4; ++q) oT[q] = oT[q] * f;
    attn_store(P + qrow * LDP + C_QA + head * 128, oT, hi);
}
__device__ __forceinline__ void attnB_unit(const Args& A, LAS unsigned char* lds, int l, int bl, int h, int qb, bool ctxq) {
    const int tid = tid_opaque(), lane = tid & 63, r32 = lane & 31, hi = lane >> 5, wave = __builtin_amdgcn_readfirstlane(tid >> 6);
    bf16_t* P = (bf16_t*)(A.ws + WS_P);
    const int sub = wave >> 2;
    const size_t brow = (size_t)bl * RB;
    const size_t qrow = brow + (ctxq ? 0 : CTXL) + qb * 128 + 32 * (wave & 3) + r32;
    const bf16_t* Kc = P + brow * LDP + C_KD + h * 128; const bf16_t* Vc = P + brow * LDP + C_VD + h * 128;
    f32x16 oT[4];
#pragma unroll
    for (int q = 0; q < 4; ++q)
#pragma unroll
        for (int r = 0; r < 16; ++r) oT[q][r] = 0.f;
    float mref = -INFINITY, lsum = 0.f;
    attn_core<64>(lds, P + qrow * LDP + C_QD + h * 128 + sub * 64, sub * 64, Kc, Vc, ctxq ? 4 : NCH, Kc, Vc, 0, false, 0, 0, oT, mref, lsum);
    lsum += __shfl_xor(lsum, 32);
    const float inv = 1.0f / lsum;
    LAS float* xch = (LAS float*)lds + (wave & 3) * 4096;
    if (sub == 1) {
#pragma unroll
        for (int q = 0; q < 4; ++q)
#pragma unroll
            for (int r = 0; r < 16; ++r) xch[(q * 16 + r) * 64 + lane] = oT[q][r] * inv;
    }
    __syncthreads();
    if (sub == 0) {
        const float lam = ((const float*)(A.ws + WS_LAM))[2 * l], post = ((const float*)(A.ws + WS_LAM))[2 * l + 1];
        float ss = 0.f;
#pragma unroll
        for (int q = 0; q < 4; ++q)
#pragma unroll
            for (int r = 0; r < 16; ++r) { const float v = oT[q][r] * inv - lam * xch[(q * 16 + r) * 64 + lane]; oT[q][r] = v; ss += v * v; }
        ss += __shfl_xor(ss, 32);
        const float rn = post / sqrtf(ss * (1.0f / 128.0f) + 1e-6f);
        const float* sw = A.in[I_SUBLN] + l * 128;
#pragma unroll
        for (int q = 0; q < 4; ++q)
#pragma unroll
            for (int r = 0; r < 16; ++r) oT[q][r] *= rn * sw[32 * q + 8 * (r >> 2) + 4 * hi + (r & 3)];
        attn_store(P + qrow * LDP + C_QD + h * 128, oT, hi);
    }
    __syncthreads();
}
__device__ __forceinline__ void ph_attention(const Args& A, LAS unsigned char* lds, int l, int half) {
    const int G = gridDim.x, bid = blockIdx.x;
    for (int u = bid; u < HB * 8 * 64; u += G) { const int bl = u >> 9, h = (u >> 6) & 7, qb = u & 63; attnB_unit(A, lds, l, bl, h, qb, false); }
    for (int u = bid; u < HB * 64 * 4; u += G) { const int bl = u >> 8, nb = (u >> 2) & 63, pr = u & 3; attnA_unit(A, lds, l, bl, nb, pr, false); }
    if (l == 0) {
        for (int u = bid; u < HB * 8 * 2; u += G) { const int bl = u >> 4, h = (u >> 1) & 7, qb = u & 1; attnB_unit(A, lds, l, bl, h, qb, true); }
        for (int u = bid; u < HB * 2 * 4; u += G) { const int bl = u >> 3, nb = (u >> 2) & 1, pr = u & 3; attnA_unit(A, lds, l, bl, nb, pr, true); }
    }
}
constexpr int GL_QN = 0, GL_KN = 17408, GL_RHS = 34816, GL_MM = 100352, GL_GC = 117760, GL_BETA = 118016, GL_EG = 118272, GL_DK = 118528, GPITCH = 272;
__device__ __forceinline__ void gdn_intra_unit(const Args& A, LAS unsigned char* lds, int l, int bl, int ch, int h, int d) {
    const int tid_ = tid_opaque();
    const int tid = tid_, lane = tid & 63, r32 = lane & 31, hi = lane >> 5, wave = __builtin_amdgcn_readfirstlane(tid >> 6);
    const bf16_t* P = (const bf16_t*)(A.ws + WS_P); const float* AB = (const float*)(A.ws + WS_AB);
    const int uidx = ((bl * NCH + ch) * 8 + h) * 2 + d;
    unsigned char* rec = A.ws + WS_G + (size_t)uidx * GU_BYTES;
    const size_t R0 = (size_t)bl * RB + ch * 64;
    LAS float* GC = (LAS float*)(lds + GL_GC); LAS float* BETA = (LAS float*)(lds + GL_BETA); LAS float* EG = (LAS float*)(lds + GL_EG); LAS float* DKS = (LAS float*)(lds + GL_DK);
    LAS float* RHS = (LAS float*)(lds + GL_RHS); LAS float* MM = (LAS float*)(lds + GL_MM);
    if (wave == 0) {
        const size_t row = R0 + (d ? 63 - lane : lane);
        float g = AB[row * 32 + d * 8 + h]; const float be = AB[row * 32 + 16 + d * 8 + h];
#pragma unroll
        for (int o = 1; o < 64; o <<= 1) { const float t = __shfl_up(g, o); if (lane >= o) g += t; }
        const float glast = __shfl(g, 63);
        GC[lane] = g; BETA[lane] = be; EG[lane] = __expf(g); DKS[lane] = __expf(glast - g);
        if (lane == 0) ((float*)(A.ws + WS_GL))[uidx] = __expf(glast);
    }
    __syncthreads();
    {
        const int i = tid >> 3, sub = tid & 7, c = d ? 63 - i : i;
        const int tp = ch * 64 + c;
        const bool has_prev = !(tp == 0 || tp == CTXL), has_next = !(tp == CTXL - 1 || tp == RB - 1);
        const bf16_t* xr = P + (R0 + c) * LDP + C_QKV + h * 128 + sub * 16;
        const float* cw = A.in[I_DNCONV] + (size_t)l * 3 * 3072 + h * 128 + sub * 16;
        const float be = BETA[i], eg = EG[i];
#pragma unroll
        for (int mat = 0; mat < 3; ++mat) {
            const bf16_t* xm = xr + mat * 1024; const float* wm = cw + mat * 1024;
            float y[16];
            const u32x4 z4 = (u32x4){0u, 0u, 0u, 0u};
#pragma unroll
            for (int hf = 0; hf < 2; ++hf) {
                const u32x4 xc = *(const u32x4*)(xm + hf * 8);
                const u32x4 xp = has_prev ? *(const u32x4*)(xm - LDP + hf * 8) : z4;
                const u32x4 xn = has_next ? *(const u32x4*)(xm + LDP + hf * 8) : z4;
#pragma unroll
                for (int k = 0; k < 4; ++k) { const int e = hf * 8 + 2 * k;
                    const float v0 = wm[e] * bf_lo(xp[k]) + wm[3072 + e] * bf_lo(xc[k]) + wm[6144 + e] * bf_lo(xn[k]);
                    const float v1 = wm[e + 1] * bf_hi(xp[k]) + wm[3072 + e + 1] * bf_hi(xc[k]) + wm[6144 + e + 1] * bf_hi(xn[k]);
                    y[e] = silu_f(v0); y[e + 1] = silu_f(v1); }
            }
            if (mat < 2) {
                float ss = 0.f;
#pragma unroll
                for (int e = 0; e < 16; ++e) ss += y[e] * y[e];
                ss += __shfl_xor(ss, 1); ss += __shfl_xor(ss, 2); ss += __shfl_xor(ss, 4);
                const float rn = (1.0f / sqrtf(ss + 1e-6f)) * (mat == 0 ? 0.08838834764831845f : 1.0f);
#pragma unroll
                for (int e = 0; e < 16; ++e) y[e] *= rn;
                LAS unsigned char* dst = lds + (mat == 0 ? GL_QN : GL_KN) + i * GPITCH + sub * 32;
                u32x4 w0, w1; w0.x = cvt_pk_bf16(y[0], y[1]); w0.y = cvt_pk_bf16(y[2], y[3]); w0.z = cvt_pk_bf16(y[4], y[5]); w0.w = cvt_pk_bf16(y[6], y[7]);
                w1.x = cvt_pk_bf16(y[8], y[9]); w1.y = cvt_pk_bf16(y[10], y[11]); w1.z = cvt_pk_bf16(y[12], y[13]); w1.w = cvt_pk_bf16(y[14], y[15]);
                *(LAS u32x4*)dst = w0; *(LAS u32x4*)(dst + 16) = w1;
                if (mat == 1) { const float s = be * eg;
#pragma unroll
                    for (int e = 0; e < 16; e += 4) *(LAS f32x4*)(RHS + i * 256 + 128 + sub * 16 + e) = (f32x4){y[e] * s, y[e + 1] * s, y[e + 2] * s, y[e + 3] * s}; }
            } else {
#pragma unroll
                for (int e = 0; e < 16; e += 4) *(LAS f32x4*)(RHS + i * 256 + sub * 16 + e) = (f32x4){y[e] * be, y[e + 1] * be, y[e + 2] * be, y[e + 3] * be};
            }
        }
    }
    __syncthreads();
    {
        const int mat = wave >> 2, rbk = (wave >> 1) & 1, cbk = wave & 1;
        LAS const unsigned char* Ab = lds + GL_KN + (32 * rbk + r32) * GPITCH + hi * 16;
        LAS const unsigned char* Bb = lds + (mat == 0 ? GL_KN : GL_QN) + (32 * cbk + r32) * GPITCH + hi * 16;
        f32x16 acc;
#pragma unroll
        for (int r = 0; r < 16; ++r) acc[r] = 0.f;
#pragma unroll
        for (int d0 = 0; d0 < 8; ++d0) { const bf16x8 a = *(LAS const bf16x8*)(Ab + d0 * 32), b = *(LAS const bf16x8*)(Bb + d0 * 32); acc = MFMA32(a, b, acc); }
        const int cc = 32 * cbk + r32; const float gcc = GC[cc];
        if (mat == 0) {
#pragma unroll
            for (int r = 0; r < 16; ++r) { const int i = 32 * rbk + crow(r, hi); const float v = (i > cc) ? BETA[i] * acc[r] * __expf(GC[i] - gcc) : 0.f; MM[i * 68 + cc] = v; }
        } else {
            float v[16];
#pragma unroll
            for (int r = 0; r < 16; ++r) { const int j = 32 * rbk + crow(r, hi); v[r] = (cc >= j) ? acc[r] * __expf(gcc - GC[j]) : 0.f; }
            bf16x8* at = (bf16x8*)(rec + GU_AT);
            at[(cbk * 4 + 2 * rbk + 0) * 64 + lane] = pack8(v[0], v[1], v[2], v[3], v[4], v[5], v[6], v[7]);
            at[(cbk * 4 + 2 * rbk + 1) * 64 + lane] = pack8(v[8], v[9], v[10], v[11], v[12], v[13], v[14], v[15]);
        }
    }
    __syncthreads();
    float x[64];
#define FNMA(acc, a, b) asm("v_fma_f32 %0, -%1, %2, %0" : "+v"(acc) : "v"(a), "v"(b))
    if (tid < 256) {
        LAS const float* MMv = MM; asm volatile("" : "+v"(MMv));
        LAS const float* RHv = RHS + tid; asm volatile("" : "+v"(RHv));
#pragma unroll
        for (int i = 0; i < 64; ++i) {
            float a = RHv[i * 256];
#pragma unroll
            for (int m4 = 0; m4 < i; m4 += 4) { const f32x4 mm = *(LAS const f32x4*)(MMv + i * 68 + m4);
                FNMA(a, mm[0], x[m4]); if (m4 + 1 < i) FNMA(a, mm[1], x[m4 + 1]); if (m4 + 2 < i) FNMA(a, mm[2], x[m4 + 2]); if (m4 + 3 < i) FNMA(a, mm[3], x[m4 + 3]); }
            x[i] = a; asm volatile("" ::: "memory");
        }
    } else {
        const int w4 = wave - 4;
        if (w4 < 2) {
#pragma unroll
            for (int ff = 0; ff < 8; ++ff) { const int f = w4 * 8 + ff, ib = f >> 3, rb = (f >> 1) & 3, s = f & 1; const int i = 32 * ib + r32, dk0 = 32 * rb + 16 * s + 4 * hi;
                const u32x2 a = *(LAS const u32x2*)(lds + GL_QN + i * GPITCH + dk0 * 2), b = *(LAS const u32x2*)(lds + GL_QN + i * GPITCH + (dk0 + 8) * 2); const float e = EG[i];
                ((bf16x8*)(rec + GU_QG))[f * 64 + lane] = pack8(bf_lo(a.x) * e, bf_hi(a.x) * e, bf_lo(a.y) * e, bf_hi(a.y) * e, bf_lo(b.x) * e, bf_hi(b.x) * e, bf_lo(b.y) * e, bf_hi(b.y) * e); }
        } else {
#pragma unroll
            for (int ff = 0; ff < 8; ++ff) { const int f = (w4 - 2) * 8 + ff, rb = f >> 2, ib = (f >> 1) & 1, s = f & 1; const int i0 = 32 * ib + 16 * s + 4 * hi;
                LAS const unsigned char* kp = lds + GL_KN + (i0 + ((lane & 15) >> 2)) * GPITCH + (32 * rb + 16 * ((lane >> 4) & 1) + 4 * (lane & 3)) * 2;
                const s16x4 lo = lds_tr(kp), hh = lds_tr(kp + 8 * GPITCH);
                const f32x4 s0 = *(LAS const f32x4*)(DKS + i0), s1 = *(LAS const f32x4*)(DKS + i0 + 8);
#define BFV(x) __uint_as_float(((unsigned)(unsigned short)(x)) << 16)
                ((bf16x8*)(rec + GU_KD))[f * 64 + lane] = pack8(BFV(lo[0]) * s0[0], BFV(lo[1]) * s0[1], BFV(lo[2]) * s0[2], BFV(lo[3]) * s0[3], BFV(hh[0]) * s1[0], BFV(hh[1]) * s1[1], BFV(hh[2]) * s1[2], BFV(hh[3]) * s1[3]);
#undef BFV
            }
        }
    }
    __syncthreads();
    if (tid < 128) {
        unsigned* up = (unsigned*)(rec + GU_U); const int sl = tid >> 5, dvl = tid & 31;
#pragma unroll
        for (int ib = 0; ib < 2; ++ib)
#pragma unroll
            for (int p = 0; p < 8; ++p)
#pragma unroll
                for (int hh = 0; hh < 2; ++hh) { const int i = 32 * ib + (2 * p & 3) + 8 * (2 * p >> 2) + 4 * hh; up[((ib * 4 + sl) * 8 + p) * 64 + hh * 32 + dvl] = cvt_pk_bf16(x[i], x[i + 1]); }
    } else if (tid < 256) {
        LAS bf16_t* wl = (LAS bf16_t*)(lds + GL_QN);
#pragma unroll
        for (int i = 0; i < 64; ++i) wl[i * (GPITCH / 2) + (tid - 128)] = (bf16_t)(cvt_pk_bf16(x[i], 0.f) & 0xffffu);
    }
    __syncthreads();
#pragma unroll
    for (int ff = 0; ff < 2; ++ff) { const int f = wave * 2 + ff, ib = f >> 3, rb = (f >> 1) & 3, s = f & 1; const int i = 32 * ib + r32, dk0 = 32 * rb + 16 * s + 4 * hi;
        const u32x2 a = *(LAS const u32x2*)(lds + GL_QN + i * GPITCH + dk0 * 2), b = *(LAS const u32x2*)(lds + GL_QN + i * GPITCH + (dk0 + 8) * 2);
        ((u32x4*)(rec + GU_W))[f * 64 + lane] = (u32x4){a.x, a.y, b.x, b.y}; }
    __syncthreads();
}
__device__ __forceinline__ void ph_gdn_intra(const Args& A, LAS unsigned char* lds, int l) {
    for (int u = blockIdx.x; u < HB * NCH * 8 * 2; u += gridDim.x) { const int d = u & 1, h = (u >> 1) & 7, t = u >> 4, ch = t % NCH, bl = t / NCH; gdn_intra_unit(A, lds, l, bl, ch, h, d); }
}
__device__ __forceinline__ void gdn_scan_unit(const Args& A, int bl, int h, int d) {
    const int tid_ = tid_opaque();
    const int tid = tid_, lane = tid & 63, r32 = lane & 31, hi = lane >> 5, sl = __builtin_amdgcn_readfirstlane(tid >> 6);
    if (sl >= 4) return;
    bf16_t* O = (bf16_t*)(A.ws + WS_H) + (size_t)d * HR * 1024;
    const float* GLv = (const float*)(A.ws + WS_GL);
    f32x16 S[4];
#pragma unroll
    for (int rb = 0; rb < 4; ++rb)
#pragma unroll
        for (int r = 0; r < 16; ++r) S[rb][r] = 0.f;
    for (int step = 0; step < NCH; ++step) {
        const int ch = d ? (step < 4 ? 3 - step : NCH + 3 - step) : step;
        const int uidx = ((bl * NCH + ch) * 8 + h) * 2 + d;
        const unsigned char* rec = A.ws + WS_G + (size_t)uidx * GU_BYTES;
        const bf16x8* Wf = (const bf16x8*)(rec + GU_W) + lane; const bf16x8* Qf = (const bf16x8*)(rec + GU_QG) + lane; const bf16x8* Kf = (const bf16x8*)(rec + GU_KD) + lane; const bf16x8* Af = (const bf16x8*)(rec + GU_AT) + lane;
        const unsigned* Up = (const unsigned*)(rec + GU_U) + lane;
        const float gl = GLv[uidx];
        f32x16 vn[2], o[2];
#pragma unroll
        for (int ib = 0; ib < 2; ++ib)
#pragma unroll
            for (int r = 0; r < 16; ++r) { vn[ib][r] = 0.f; o[ib][r] = 0.f; }
#pragma unroll
        for (int rb = 0; rb < 4; ++rb) {
#pragma unroll
            for (int s = 0; s < 2; ++s) {
                const bf16x8 sb = pack8(S[rb][8 * s], S[rb][8 * s + 1], S[rb][8 * s + 2], S[rb][8 * s + 3], S[rb][8 * s + 4], S[rb][8 * s + 5], S[rb][8 * s + 6], S[rb][8 * s + 7]);
#pragma unroll
                for (int ib = 0; ib < 2; ++ib) { const int f = (ib * 4 + rb) * 2 + s; vn[ib] = MFMA32(Wf[f * 64], sb, vn[ib]); o[ib] = MFMA32(Qf[f * 64], sb, o[ib]); }
            }
            asm volatile("" ::: "memory");
        }
#pragma unroll
        for (int ib = 0; ib < 2; ++ib)
#pragma unroll
            for (int p = 0; p < 8; ++p) { const unsigned w = Up[((ib * 4 + sl) * 8 + p) * 64]; vn[ib][2 * p] = bf_lo(w) - vn[ib][2 * p]; vn[ib][2 * p + 1] = bf_hi(w) - vn[ib][2 * p + 1]; }
        bf16x8 vb[2][2];
#pragma unroll
        for (int ib = 0; ib < 2; ++ib) { vb[ib][0] = pack8(vn[ib][0], vn[ib][1], vn[ib][2], vn[ib][3], vn[ib][4], vn[ib][5], vn[ib][6], vn[ib][7]);
            vb[ib][1] = pack8(vn[ib][8], vn[ib][9], vn[ib][10], vn[ib][11], vn[ib][12], vn[ib][13], vn[ib][14], vn[ib][15]); }
        asm volatile("" ::: "memory");
#pragma unroll
        for (int ib = 0; ib < 2; ++ib)
#pragma unroll
            for (int jb = 0; jb < 2; ++jb)
#pragma unroll
                for (int s = 0; s < 2; ++s) o[ib] = MFMA32(Af[(ib * 4 + 2 * jb + s) * 64], vb[jb][s], o[ib]);
        asm volatile("" ::: "memory");
#pragma unroll
        for (int rb = 0; rb < 4; ++rb) { S[rb] = S[rb] * gl;
#pragma unroll
            for (int ib = 0; ib < 2; ++ib)
#pragma unroll
                for (int s = 0; s < 2; ++s) S[rb] = MFMA32(Kf[((rb * 2 + ib) * 2 + s) * 64], vb[ib][s], S[rb]);
            asm volatile("" ::: "memory"); }
        bf16_t* orow = O + ((size_t)bl * RB + ch * 64) * 1024 + h * 128 + 32 * sl + r32;
#pragma unroll
        for (int ib = 0; ib < 2; ++ib)
#pragma unroll
            for (int r = 0; r < 16; ++r) { const int i = 32 * ib + crow(r, hi); const int c = d ? 63 - i : i; orow[(size_t)c * 1024] = (bf16_t)(cvt_pk_bf16(o[ib][r], 0.f) & 0xffffu); }
    }
}
__device__ __forceinline__ void ph_gdn_scan(const Args& A) {
    for (int u = blockIdx.x; u < HB * 8 * 2; u += gridDim.x) gdn_scan_unit(A, u >> 4, (u >> 1) & 7, u & 1);
}
__device__ __forceinline__ void ph_gdn_post(const Args& A, int l) {
    const int tid = tid_opaque(), lane = tid & 63, gw = blockIdx.x * NWAVES + (tid >> 6), NGW = gridDim.x * NWAVES;
    const bf16_t* OF = (const bf16_t*)(A.ws + WS_H); const bf16_t* OB = OF + (size_t)HR * 1024; bf16_t* P = (bf16_t*)(A.ws + WS_P);
    const float* nw = A.in[I_DNNORM] + l * 128 + (lane & 7) * 16;
    for (int r = gw; r < HR; r += NGW) {
        const u32x4 f0 = *(const u32x4*)(OF + (size_t)r * 1024 + lane * 16), f1 = *(const u32x4*)(OF + (size_t)r * 1024 + lane * 16 + 8);
        const u32x4 b0 = *(const u32x4*)(OB + (size_t)r * 1024 + lane * 16), b1 = *(const u32x4*)(OB + (size_t)r * 1024 + lane * 16 + 8);
        bf16_t* zp = P + (size_t)r * LDP + C_Z + lane * 16;
        const u32x4 z0 = *(const u32x4*)zp, z1 = *(const u32x4*)(zp + 8);
        float o[16], z[16]; float ss = 0.f;
#pragma unroll
        for (int k = 0; k < 4; ++k) { o[2 * k] = bf_lo(f0[k]) + bf_lo(b0[k]); o[2 * k + 1] = bf_hi(f0[k]) + bf_hi(b0[k]); o[8 + 2 * k] = bf_lo(f1[k]) + bf_lo(b1[k]); o[8 + 2 * k + 1] = bf_hi(f1[k]) + bf_hi(b1[k]);
            z[2 * k] = bf_lo(z0[k]); z[2 * k + 1] = bf_hi(z0[k]); z[8 + 2 * k] = bf_lo(z1[k]); z[8 + 2 * k + 1] = bf_hi(z1[k]); }
#pragma unroll
        for (int e = 0; e < 16; ++e) ss += o[e] * o[e];
        ss += __shfl_xor(ss, 1); ss += __shfl_xor(ss, 2); ss += __shfl_xor(ss, 4);
        const float rn = 1.0f / sqrtf(ss * (1.0f / 128.0f) + 1e-6f);
#pragma unroll
        for (int e = 0; e < 16; ++e) o[e] = o[e] * rn * nw[e] * silu_f(z[e]);
        u32x4 w0, w1; w0.x = cvt_pk_bf16(o[0], o[1]); w0.y = cvt_pk_bf16(o[2], o[3]); w0.z = cvt_pk_bf16(o[4], o[5]); w0.w = cvt_pk_bf16(o[6], o[7]);
        w1.x = cvt_pk_bf16(o[8], o[9]); w1.y = cvt_pk_bf16(o[10], o[11]); w1.z = cvt_pk_bf16(o[12], o[13]); w1.w = cvt_pk_bf16(o[14], o[15]);
        *(u32x4*)zp = w0; *(u32x4*)(zp + 8) = w1;
    }
}
constexpr int NPH = 1 + 14 * 4;
__host__ __device__ inline bool phase_is_noop(int id) { if (id == 0) return false; const int it = (id - 1) / 14, k = (id - 1) % 14; return k == 0 && it != 2; }
__global__ void __launch_bounds__(NTHR, 2) fwd(Args A) {
    extern __shared__ __attribute__((aligned(16))) unsigned char lds_raw[];
    LAS unsigned char* lds = (LAS unsigned char*)lds_raw;
    volatile LAS unsigned* MISC = (volatile LAS unsigned*)(lds + LDSCTL_OFF + 320);
    for (int u = threadIdx.x; u < (LDS_BYTES - LDSCTL_OFF) / 4; u += NTHR) ((LAS unsigned*)(lds + LDSCTL_OFF))[u] = 0u;
    __syncthreads();
    const int lo = A.ph_lo, hi = A.ph_hi, G = gridDim.x, bid = blockIdx.x;
    unsigned char* ws = A.ws;
    XcdBarrier bar; bar.bar = (unsigned*)(ws + WS_CTL) + CW_BAR; bar.x = 0; bar.st = nullptr;
    if (hi - lo > 1) bar = xcd_barrier_post((unsigned*)(ws + WS_CTL) + CW_BAR, MISC + 8);
#ifndef PHMASK
#define PHMASK 0x7fff
#endif
#define RUNK(k, id, ...) do { if (((PHMASK >> (k)) & 1) && lo <= (id) && (id) < hi) { __VA_ARGS__; if ((id) + 1 < hi) xcd_barrier(bar); } } while (0)
    bf16_t* H = (bf16_t*)(ws + WS_H); bf16_t* P = (bf16_t*)(ws + WS_P);
    RUNK(14, 0, { ph_prologue(A, lds); __syncthreads(); ph_weights(A, lds, 0); });
    for (int it = 0; it < 4; ++it) {
        const int l = it >> 1, half = it & 1, base = 1 + 14 * it;
        if (it == 2) RUNK(0, base + 0, { ph_weights(A, lds, 1); });
        RUNK(1, base + 1, { ph_adaln(A, l, half); });
        RUNK(2, base + 2, {
            pg8::Gemm g{H, (const bf16_t*)(ws + WS_WIN), HR, NWIN, 2048, 2048}; pg8::StaticOrder S; S.init(HR, NWIN, G, bid);
            pg8::EpiInProj E{P, LDP, (float*)(ws + WS_AB), (const float*)(ws + WS_ROPEA), (const float*)(ws + WS_ROPED), A.in[I_ALOG] + l * 16, A.in[I_DTB] + l * 16, 0.08838834764831845f * LOG2E, 0.125f * LOG2E};
            pg8::gemm_phase<pg8::EpiInProj, pg8::StaticOrder, true, true>(lds, g, S, E); });
        RUNK(3, base + 3, { ph_gdn_intra(A, lds, l); });
        RUNK(4, base + 4, { ph_gdn_scan(A); });
        RUNK(5, base + 5, { ph_gdn_post(A, l); });
        RUNK(6, base + 6, { ph_attention(A, lds, l, half); });
        RUNK(7, base + 7, {
            pg8::StaticOrder S; S.init(HR, 2048, G, bid); float* TOT = (float*)(ws + WS_TOT); bf16_t* Mo = (bf16_t*)(ws + WS_M);
            { pg8::Gemm g{P + C_QA, (const bf16_t*)(ws + WS_WPA), HR, 2048, 1024, LDP}; pg8::EpiMerge<0> E{P + C_G, LDP, TOT, Mo, 2048}; pg8::gemm_phase<pg8::EpiMerge<0>, pg8::StaticOrder, true, true>(lds, g, S, E); }
            { pg8::Gemm g{P + C_QD, (const bf16_t*)(ws + WS_WPB), HR, 2048, 1024, LDP}; pg8::EpiMerge<1> E{P + C_G + 2048, LDP, TOT, Mo, 2048}; pg8::gemm_phase<pg8::EpiMerge<1>, pg8::StaticOrder, true, true>(lds, g, S, E); }
            { pg8::Gemm g{P + C_Z, (const bf16_t*)(ws + WS_WPC), HR, 2048, 1024, LDP}; pg8::EpiMerge<2> E{P + C_G + 4096, LDP, TOT, Mo, 2048}; pg8::gemm_phase<pg8::EpiMerge<2>, pg8::StaticOrder, true, true>(lds, g, S, E); } });
        RUNK(8, base + 8, {
            pg8::Gemm g{(const bf16_t*)(ws + WS_M), (const bf16_t*)(ws + WS_WO), HR, 2048, 2048, 2048}; pg8::StaticOrder S; S.init(HR, 2048, G, bid);
            pg8::EpiF32 E{(float*)(ws + WS_OX), 2048}; pg8::gemm_phase<pg8::EpiF32, pg8::StaticOrder, true, true>(lds, g, S, E); });
        RUNK(9, base + 9, { ph_resln<true>(A, l, half, (const float*)(ws + WS_OX), 2, A.in[I_LN1G] + l * DM, A.in[I_LN1B] + l * DM); });
        RUNK(10, base + 10, {
            pg8::Gemm g{H, (const bf16_t*)(ws + WS_WUP), HR, NUP, 2048, 2048}; pg8::StaticOrder S; S.init(HR, NUP, G, bid);
            pg8::EpiBf16 E{(bf16_t*)(ws + WS_U), NUP}; pg8::gemm_phase<pg8::EpiBf16, pg8::StaticOrder, true, true>(lds, g, S, E); });
        RUNK(11, base + 11, { ph_convact(A, l); });
        RUNK(12, base + 12, {
            pg8::Gemm g{(const bf16_t*)(ws + WS_ACT), (const bf16_t*)(ws + WS_WDN), HR, 2048, DFF, DFF}; pg8::StaticOrder S; S.init(HR, 2048, G, bid);
            pg8::EpiF32 E{(float*)(ws + WS_FX), 2048}; pg8::gemm_phase<pg8::EpiF32, pg8::StaticOrder, true, true>(lds, g, S, E); });
        RUNK(13, base + 13, { ph_resln<false>(A, l, half, (const float*)(ws + WS_FX), 5, A.in[I_LN2G] + l * DM, A.in[I_LN2B] + l * DM); });
    }
#undef RUNK
}

#ifndef MK_ONE_LAUNCH
#define MK_ONE_LAUNCH 1
#endif
extern "C" void kernel_launch(void* const* d_in, const int* in_sizes, int n_in, void* d_out, int out_size, void* d_ws, size_t ws_size, hipStream_t stream) {
    static int grid = 0;
    if (grid == 0) {
        if (n_in != 29 || out_size != NBATCH * SEQ * DM || ws_size < WS_END) { fprintf(stderr, "kernel_launch: unexpected problem (n_in %d, out %d, ws %zu < %zu)\n", n_in, out_size, ws_size, (size_t)WS_END); grid = -1; return; }
        int dev = 0, cus = 0, per_cu = 0;
        if (hipGetDevice(&dev) != hipSuccess || hipDeviceGetAttribute(&cus, hipDeviceAttributeMultiprocessorCount, dev) != hipSuccess) { grid = -1; return; }
        if (hipFuncSetAttribute((const void*)fwd, hipFuncAttributeMaxDynamicSharedMemorySize, LDS_BYTES) != hipSuccess) { fprintf(stderr, "kernel_launch: hipFuncSetAttribute failed\n"); grid = -1; return; }
        if (hipOccupancyMaxActiveBlocksPerMultiprocessor(&per_cu, (const void*)fwd, NTHR, LDS_BYTES) != hipSuccess || per_cu < 1) fprintf(stderr, "kernel_launch: occupancy query reports %d\n", per_cu);
        (void)hipGetLastError();
        grid = cus > 256 ? 256 : cus;
    }
    if (grid < 0) return;
    (void)hipMemsetAsync((char*)d_ws + WS_CTL, 0, CTL_ZERO_BYTES, stream);
    Args a{};
    for (int i = 0; i < 29; ++i) a.in[i] = (const float*)d_in[i];
    a.out = (float*)d_out; a.ws = (unsigned char*)d_ws;
#if MK_ONE_LAUNCH
    a.ph_lo = 0; a.ph_hi = NPH;
    hipLaunchKernelGGL(fwd, dim3(grid), dim3(NTHR), LDS_BYTES, stream, a);
#else
    for (int id = 0; id < NPH; ++id) { if (phase_is_noop(id)) continue; a.ph_lo = id; a.ph_hi = id + 1; hipLaunchKernelGGL(fwd, dim3(grid), dim3(NTHR), LDS_BYTES, stream, a); }
#endif
}
```

```cpp
#include <hip/hip_runtime.h>
#include <cstdio>
#include <cstdint>
#include <cmath>
namespace pg8 {
#define PG8_LAS __attribute__((address_space(3)))
typedef unsigned short bf16_t;
typedef short bf16x8 __attribute__((ext_vector_type(8)));
typedef float f32x4 __attribute__((ext_vector_type(4)));
typedef unsigned u32x4 __attribute__((ext_vector_type(4)));
constexpr int BM = 256, BK = 64, HALF = 128, HTB = HALF * BK * 2  , STAGE_BYTES = 8 * HTB, NXCD = 8, WGM = 8;

__host__ __device__ __forceinline__ int lds_byte(int r, int c) { const int st = (r >> 4) * 2 + (c >> 5), rr = r & 15, cc = c & 31, ob = rr * 64 + cc * 2; return st * 1024 + (ob ^ (((ob >> 9) & 1) << 5)); }
__host__ __device__ __forceinline__ void stage_rc(int b, int& R, int& C) { const int st = b / 1024, sb = b % 1024, swz = sb ^ (((sb >> 9) & 1) << 5); R = (st >> 1) * 16 + swz / 64; C = (st & 1) * 32 + (swz % 64) / 2; }
__host__ __device__ __forceinline__ int perm32(int rho) { const int n = rho >> 4, i = rho & 15; return 8 * (i >> 2) + 4 * n + (i & 3); }

struct Unit { int pm, pn; };
struct Gemm { const bf16_t* A; const bf16_t* Bt; int M, N, K, lda; };

struct StaticOrder {
    int nM, nN, nwg, G, c;
    __host__ __device__ void init(int M, int N, int G_, int c_) { nM = M / BM; nN = N / BM; nwg = nM * nN; G = G_; c = c_; }
    __host__ __device__ bool next(int i, Unit& u) const {
        const long L = (long)i * G + c; if (L >= nwg) return false;
        int wgid = (int)L; { const int q = nwg / NXCD, r = nwg % NXCD, xcd = wgid % NXCD, off = wgid / NXCD; wgid = (xcd < r ? xcd * (q + 1) : r * (q + 1) + (xcd - r) * q) + off; }
        const int nig = WGM * nN, gid = wgid / nig, fm = gid * WGM, gsz = (nM - fm) < WGM ? (nM - fm) : WGM;
        u.pm = fm + ((wgid % nig) % gsz); u.pn = (wgid % nig) / gsz; return true;
    }
    __device__ __forceinline__ void a_ready(const Unit&) const {}
    __device__ __forceinline__ void done(const Unit&) const {}
};

__device__ __forceinline__ unsigned cvt_pk_bf16(float lo, float hi) { unsigned r; asm volatile("v_cvt_pk_bf16_f32 %0, %1, %2" : "=v"(r) : "v"(lo), "v"(hi)); return r; }
__device__ __forceinline__ float bf_lo(unsigned w) { return __uint_as_float(w << 16); }
__device__ __forceinline__ float bf_hi(unsigned w) { return __uint_as_float(w & 0xffff0000u); }
__device__ __forceinline__ float sigm(float x) { return 1.0f / (1.0f + __expf(-x)); }

struct EpiF32 {
    static constexpr bool PERM = false, AFTER_DRAIN = false;
    float* C; int ldc;
    __device__ __forceinline__ void operator()(const f32x4 (&acc)[2][2][4][2], const Unit& u, int wr, int wc, int fr, int fq) const {
        const int row0 = u.pm * BM + wr * 64 + fr, col0 = u.pn * BM + wc * 32 + 4 * fq;
#pragma unroll
        for (int ai = 0; ai < 2; ++ai)
#pragma unroll
            for (int m = 0; m < 4; ++m) { float* rowp = C + (size_t)(row0 + ai * HALF + m * 16) * ldc + col0;
#pragma unroll
                for (int bj = 0; bj < 2; ++bj)
#pragma unroll
                    for (int n = 0; n < 2; ++n) *(f32x4*)(rowp + bj * HALF + n * 16) = acc[ai][bj][m][n]; }
    }
};
struct EpiBf16 {
    static constexpr bool PERM = true, AFTER_DRAIN = false;
    bf16_t* O; int ldc;
    __device__ __forceinline__ void operator()(const f32x4 (&acc)[2][2][4][2], const Unit& u, int wr, int wc, int fr, int fq) const {
        const int row0 = u.pm * BM + wr * 64 + fr, col0 = u.pn * BM + wc * 32 + 8 * fq;
#pragma unroll
        for (int ai = 0; ai < 2; ++ai)
#pragma unroll
            for (int m = 0; m < 4; ++m) { bf16_t* rowp = O + (size_t)(row0 + ai * HALF + m * 16) * ldc + col0;
#pragma unroll
                for (int bj = 0; bj < 2; ++bj) { const f32x4 v0 = acc[ai][bj][m][0], v1 = acc[ai][bj][m][1];
                    u32x4 w; w.x = cvt_pk_bf16(v0[0], v0[1]); w.y = cvt_pk_bf16(v0[2], v0[3]); w.z = cvt_pk_bf16(v1[0], v1[1]); w.w = cvt_pk_bf16(v1[2], v1[3]);
                    *(u32x4*)(rowp + bj * HALF) = w; } }
    }
};
template <int MODE> struct EpiMerge {
    static constexpr bool PERM = true, AFTER_DRAIN = false;
    const bf16_t* G; int ldg; float* TOT; bf16_t* Mo; int ldc;
    __device__ __forceinline__ void operator()(const f32x4 (&acc)[2][2][4][2], const Unit& u, int wr, int wc, int fr, int fq) const {
        asm volatile("" : "+v"(fr), "+v"(fq));
        const int row0 = u.pm * BM + wr * 64 + fr, col0 = u.pn * BM + wc * 32 + 8 * fq;
#pragma unroll
        for (int ai = 0; ai < 2; ++ai)
#pragma unroll
            for (int m = 0; m < 4; ++m) { const size_t row = (size_t)(row0 + ai * HALF + m * 16);
#pragma unroll
                for (int bj = 0; bj < 2; ++bj) { const int col = col0 + bj * HALF;
                    const u32x4 gw = *(const u32x4*)(G + row * ldg + col);
                    f32x4 g0 = (f32x4){bf_lo(gw.x), bf_hi(gw.x), bf_lo(gw.y), bf_hi(gw.y)}, g1 = (f32x4){bf_lo(gw.z), bf_hi(gw.z), bf_lo(gw.w), bf_hi(gw.w)};
                    f32x4 v0 = acc[ai][bj][m][0] * g0, v1 = acc[ai][bj][m][1] * g1;
                    float* tp = TOT + row * ldc + col;
                    if (MODE >= 1) { v0 += *(const f32x4*)tp; v1 += *(const f32x4*)(tp + 4); }
                    if (MODE <= 1) { *(f32x4*)tp = v0; *(f32x4*)(tp + 4) = v1; }
                    else { u32x4 w; w.x = cvt_pk_bf16(v0[0], v0[1]); w.y = cvt_pk_bf16(v0[2], v0[3]); w.z = cvt_pk_bf16(v1[0], v1[1]); w.w = cvt_pk_bf16(v1[2], v1[3]);
                        *(u32x4*)(Mo + row * ldc + col) = w; } }
                asm volatile("" ::: "memory"); }
    }
};
struct EpiInProj {
    static constexpr bool PERM = true, AFTER_DRAIN = false;
    bf16_t* P; int ldp; float* AB; const float* ropeA; const float* ropeD; const float* a_log; const float* dt_bias; float sA, sD;
    __device__ __forceinline__ void operator()(const f32x4 (&acc)[2][2][4][2], const Unit& u, int wr, int wc, int fr, int fq) const {
        asm volatile("" : "+v"(fr), "+v"(fq));
        const int pn = u.pn, tib = u.pm % 33; const bool is_ctx = (tib == 0);
        const int row0 = u.pm * BM + wr * 64 + fr, t0 = tib * 256 - 256 + wr * 64 + fr, cl = wc * 32 + 8 * fq;
        int type; float scale = 1.f;
        if (pn <= 3) { type = 1; scale = sA; } else if (pn == 4) type = 1; else if (pn == 5) type = 0; else if (pn <= 9) { type = 2; scale = sD; } else if (pn <= 13) type = 2;
        else if (pn <= 33) type = 0; else if (pn <= 57) type = 3; else type = 4;
        if (type == 4) {
            if (wc == 0) {
                const int c = 8 * fq;
#pragma unroll
                for (int ai = 0; ai < 2; ++ai)
#pragma unroll
                    for (int m = 0; m < 4; ++m) { const size_t row = (size_t)(row0 + ai * HALF + m * 16); f32x4 v0 = acc[ai][0][m][0], v1 = acc[ai][0][m][1]; float o[8] = {v0[0], v0[1], v0[2], v0[3], v1[0], v1[1], v1[2], v1[3]};
#pragma unroll
                        for (int k = 0; k < 8; ++k) { if (c < 16) { const float x = o[k] + dt_bias[c + k]; const float sp = fmaxf(x, 0.f) + log1pf(__expf(-fabsf(x))); o[k] = -__expf(a_log[c + k]) * sp; } else o[k] = sigm(o[k]); }
                        *(f32x4*)(AB + row * 32 + c) = (f32x4){o[0], o[1], o[2], o[3]}; *(f32x4*)(AB + row * 32 + c + 4) = (f32x4){o[4], o[5], o[6], o[7]}; }
            }
            return;
        }
#pragma unroll
        for (int ai = 0; ai < 2; ++ai)
#pragma unroll
            for (int m = 0; m < 4; ++m) { const size_t row = (size_t)(row0 + ai * HALF + m * 16); const int t = t0 + ai * HALF + m * 16;
#pragma unroll
                for (int bj = 0; bj < 2; ++bj) { const int c = cl + bj * HALF; f32x4 v0 = acc[ai][bj][m][0], v1 = acc[ai][bj][m][1];
                    if ((type == 1 || type == 2) && !is_ctx) {
                        const float* tab;
                        if (type == 1) { const int p0 = (c & 127) >> 1; const int pos = (p0 >= 32) ? (t & 63) : (t >> 6); tab = ropeA + (pos * 32 + (p0 & 31)) * 2; }
                        else { const int p0 = (c & 63) >> 1; const int pos = (p0 >= 16) ? (t & 63) : (t >> 6); tab = ropeD + (pos * 16 + (p0 & 15)) * 2; }
                        const f32x4 cs0 = *(const f32x4*)tab, cs1 = *(const f32x4*)(tab + 4);
                        f32x4 r0, r1;
                        r0[0] = v0[0] * cs0[0] - v0[1] * cs0[1]; r0[1] = v0[1] * cs0[0] + v0[0] * cs0[1]; r0[2] = v0[2] * cs0[2] - v0[3] * cs0[3]; r0[3] = v0[3] * cs0[2] + v0[2] * cs0[3];
                        r1[0] = v1[0] * cs1[0] - v1[1] * cs1[1]; r1[1] = v1[1] * cs1[0] + v1[0] * cs1[1]; r1[2] = v1[2] * cs1[2] - v1[3] * cs1[3]; r1[3] = v1[3] * cs1[2] + v1[2] * cs1[3];
                        v0 = r0; v1 = r1;
                    }
                    if (type == 3) {
#pragma unroll
                        for (int k = 0; k < 4; ++k) { v0[k] = sigm(v0[k]); v1[k] = sigm(v1[k]); } }
                    v0 = v0 * scale; v1 = v1 * scale;
                    u32x4 w; w.x = cvt_pk_bf16(v0[0], v0[1]); w.y = cvt_pk_bf16(v0[2], v0[3]); w.z = cvt_pk_bf16(v1[0], v1[1]); w.w = cvt_pk_bf16(v1[2], v1[3]);
                    *(u32x4*)(P + row * ldp + pn * BM + c) = w; }
                asm volatile("" ::: "memory"); }
    }
};

template <class Epi, class Sched, bool ALIGN_EPI = false, bool SP2 = false>
__device__ __forceinline__ void gemm_phase(PG8_LAS unsigned char* lds, const Gemm g, const Sched& S, const Epi& E) {
    int tid_ = threadIdx.x; asm volatile("" : "+v"(tid_));
    const int tid = tid_, wid = __builtin_amdgcn_readfirstlane(tid >> 6), lane = tid & 63, wr = wid >> 2, wc = wid & 3, fr = lane & 15, fq = lane >> 4;
    const int K = g.K, nt = K / BK;
    unsigned voffA[2], voffB[2];
#pragma unroll
    for (int i = 0; i < 2; ++i) { int R, C; stage_rc(tid * 16 + i * 8192, R, C); const int Rb = Epi::PERM ? ((R & ~31) + perm32(R & 31)) : R;
        voffA[i] = (unsigned)(R * g.lda + C) * 2u; voffB[i] = (unsigned)(Rb * K + C) * 2u; }
    const size_t kstep = (size_t)(BK * 2);
    const size_t hstepB = (size_t)HALF * K * 2, hstepA = (size_t)HALF * g.lda * 2;
    const size_t tstepA = 2 * hstepA, tstepB = 2 * hstepB;
    const unsigned ldsw = (unsigned)wid * 1024u;
    const int aoff = lds_byte(wr * 64 + fr, fq * 8), boff = lds_byte(wc * 32 + fr, fq * 8);
#define PG8_SA(b, h) (((b) * 2 + (h)) * HTB)
#define PG8_SB(b, h) ((4 + (b) * 2 + (h)) * HTB)
#define PG8_STAGE(bufoff, gbase, voff) do { _Pragma("unroll") for (int _i = 0; _i < 2; ++_i) \
        __builtin_amdgcn_global_load_lds((const unsigned*)((const char*)(gbase) + (voff)[_i]), (PG8_LAS unsigned*)(lds + (bufoff) + ldsw + _i * 8192), 16, 0, 0); } while (0)
#define PG8_LDA(dst, b, h) do { _Pragma("unroll") for (int m = 0; m < 4; ++m) _Pragma("unroll") for (int k = 0; k < 2; ++k) dst[m][k] = *(const PG8_LAS bf16x8*)(lds + PG8_SA(b, h) + aoff + m * 2048 + k * 1024); } while (0)
#define PG8_LDB(dst, b, h) do { _Pragma("unroll") for (int n = 0; n < 2; ++n) _Pragma("unroll") for (int k = 0; k < 2; ++k) dst[n][k] = *(const PG8_LAS bf16x8*)(lds + PG8_SB(b, h) + boff + n * 2048 + k * 1024); } while (0)
#define PG8_MMA(ai, bj, At, Bt) do { __builtin_amdgcn_s_setprio(1); _Pragma("unroll") for (int m = 0; m < 4; ++m) _Pragma("unroll") for (int n = 0; n < 2; ++n) _Pragma("unroll") for (int k = 0; k < 2; ++k) \
        acc[ai][bj][m][n] = __builtin_amdgcn_mfma_f32_16x16x32_bf16(Bt[n][k], At[m][k], acc[ai][bj][m][n], 0, 0, 0); __builtin_amdgcn_s_setprio(0); } while (0)
#define PG8_WAIT_V(n) asm volatile("s_waitcnt vmcnt(" #n ")" ::: "memory")
#define PG8_WAIT_L(n) asm volatile("s_waitcnt lgkmcnt(" #n ")" ::: "memory")
#define PG8_BAR __builtin_amdgcn_s_barrier()
#define PG8_SCHED __builtin_amdgcn_sched_barrier(0)
    Unit cur, nxt; int ui = 0;
    if (!S.next(0, cur)) return;
    f32x4 acc[2][2][4][2];
#pragma unroll
    for (int a = 0; a < 2; ++a)
#pragma unroll
        for (int b = 0; b < 2; ++b)
#pragma unroll
            for (int m = 0; m < 4; ++m)
#pragma unroll
                for (int n = 0; n < 2; ++n) acc[a][b][m][n] = (f32x4){0.f, 0.f, 0.f, 0.f};
    bf16x8 At[4][2], B0[2][2], B1[2][2];
    const char* cA = (const char*)g.A + (size_t)cur.pm * tstepA; const char* cB = (const char*)g.Bt + (size_t)cur.pn * tstepB;
    S.a_ready(cur);
    if constexpr (SP2) {
        PG8_STAGE(PG8_SB(0, 0), cB, voffB); PG8_STAGE(PG8_SB(0, 1), cB + hstepB, voffB); PG8_STAGE(PG8_SA(0, 0), cA, voffA); PG8_STAGE(PG8_SA(0, 1), cA + hstepA, voffA);
        if (wr == 1) PG8_BAR;
        PG8_WAIT_V(2); PG8_BAR;
        PG8_STAGE(PG8_SB(1, 0), cB + kstep, voffB); PG8_STAGE(PG8_SA(1, 0), cA + kstep, voffA); PG8_STAGE(PG8_SB(1, 1), cB + hstepB + kstep, voffB);
        PG8_WAIT_V(6); PG8_BAR;
    } else {
        PG8_STAGE(PG8_SB(0, 0), cB, voffB); PG8_STAGE(PG8_SA(0, 0), cA, voffA); PG8_STAGE(PG8_SB(0, 1), cB + hstepB, voffB); PG8_STAGE(PG8_SA(0, 1), cA + hstepA, voffA);
        if (wr == 1) PG8_BAR;
        PG8_WAIT_V(4); PG8_BAR;
        PG8_STAGE(PG8_SB(1, 0), cB + kstep, voffB); PG8_STAGE(PG8_SA(1, 0), cA + kstep, voffA); PG8_STAGE(PG8_SB(1, 1), cB + hstepB + kstep, voffB);
        PG8_WAIT_V(6); PG8_BAR;
    }
    for (;;) {
        const bool has_next = S.next(ui + 1, nxt);
        const char* nA = has_next ? (const char*)g.A + (size_t)nxt.pm * tstepA : cA; const char* nB = has_next ? (const char*)g.Bt + (size_t)nxt.pn * tstepB : cB;
        for (int t = 0; t < nt; t += 2) {
            const bool last = (t == nt - 2);
            const char* a1 = cA + (size_t)(t + 1) * kstep;
            const char* a2 = last ? nA : cA + (size_t)(t + 2) * kstep; const char* b2 = last ? nB : cB + (size_t)(t + 2) * kstep;
            const char* a3 = a2 + kstep; const char* b3 = b2 + kstep;
            if (last && has_next) S.a_ready(nxt);
            if constexpr (SP2) {
            PG8_LDB(B0, 0, 0); PG8_LDB(B1, 0, 1); PG8_SCHED; PG8_LDA(At, 0, 0); PG8_STAGE(PG8_SA(1, 1), a1 + hstepA, voffA);
            PG8_WAIT_V(8); PG8_WAIT_L(0); PG8_BAR; PG8_MMA(0, 0, At, B0); PG8_MMA(0, 1, At, B1); PG8_BAR; PG8_SCHED;
            PG8_LDA(At, 0, 1); PG8_STAGE(PG8_SB(0, 0), b2, voffB); PG8_STAGE(PG8_SB(0, 1), b2 + hstepB, voffB); PG8_STAGE(PG8_SA(0, 0), a2, voffA);
            PG8_WAIT_V(8); PG8_WAIT_L(0); PG8_BAR; PG8_MMA(1, 0, At, B0); PG8_MMA(1, 1, At, B1); PG8_BAR; PG8_SCHED;
            PG8_LDB(B0, 1, 0); PG8_LDB(B1, 1, 1); PG8_SCHED; PG8_LDA(At, 1, 0); PG8_STAGE(PG8_SA(0, 1), a2 + hstepA, voffA);
            PG8_WAIT_V(8); PG8_WAIT_L(0); PG8_BAR; PG8_MMA(0, 0, At, B0); PG8_MMA(0, 1, At, B1); PG8_BAR; PG8_SCHED;
            PG8_LDA(At, 1, 1); PG8_STAGE(PG8_SB(1, 0), b3, voffB); PG8_STAGE(PG8_SB(1, 1), b3 + hstepB, voffB); PG8_STAGE(PG8_SA(1, 0), a3, voffA);
            PG8_WAIT_V(8); PG8_WAIT_L(0); PG8_BAR; PG8_MMA(1, 0, At, B0); PG8_MMA(1, 1, At, B1); PG8_BAR; PG8_SCHED;
            } else {
            PG8_LDB(B0, 0, 0); PG8_SCHED; PG8_LDA(At, 0, 0); PG8_STAGE(PG8_SA(1, 1), a1 + hstepA, voffA);
            PG8_WAIT_L(8); PG8_BAR; PG8_WAIT_L(0); PG8_MMA(0, 0, At, B0); PG8_BAR; PG8_SCHED;
            PG8_LDB(B1, 0, 1); PG8_STAGE(PG8_SB(0, 0), b2, voffB);
            PG8_BAR; PG8_WAIT_L(0); PG8_MMA(0, 1, At, B1); PG8_BAR;
            PG8_LDA(At, 0, 1); PG8_STAGE(PG8_SA(0, 0), a2, voffA);
            PG8_BAR; PG8_WAIT_L(0); PG8_MMA(1, 0, At, B0); PG8_BAR; PG8_SCHED;
            PG8_STAGE(PG8_SB(0, 1), b2 + hstepB, voffB);
            PG8_WAIT_V(6); PG8_BAR; PG8_MMA(1, 1, At, B1); PG8_BAR;
            PG8_LDB(B0, 1, 0); PG8_SCHED; PG8_LDA(At, 1, 0); PG8_STAGE(PG8_SA(0, 1), a2 + hstepA, voffA);
            PG8_WAIT_L(8); PG8_BAR; PG8_WAIT_L(0); PG8_MMA(0, 0, At, B0); PG8_BAR; PG8_SCHED;
            PG8_LDB(B1, 1, 1); PG8_STAGE(PG8_SB(1, 0), b3, voffB);
            PG8_BAR; PG8_WAIT_L(0); PG8_MMA(0, 1, At, B1); PG8_BAR;
            PG8_LDA(At, 1, 1); PG8_STAGE(PG8_SA(1, 0), a3, voffA);
            PG8_BAR; PG8_WAIT_L(0); PG8_MMA(1, 0, At, B0); PG8_BAR; PG8_SCHED;
            PG8_STAGE(PG8_SB(1, 1), b3 + hstepB, voffB);
            PG8_WAIT_V(6); PG8_BAR; PG8_MMA(1, 1, At, B1); PG8_BAR;
            }
        }
        if constexpr (ALIGN_EPI) { if (wr == 0) PG8_BAR; }
        if constexpr (!Epi::AFTER_DRAIN) { E(acc, cur, wr, wc, fr, fq); S.done(cur); }
        if (!has_next) break;
#pragma unroll
        for (int a = 0; a < 2; ++a)
#pragma unroll
            for (int b = 0; b < 2; ++b)
#pragma unroll
                for (int m = 0; m < 4; ++m)
#pragma unroll
                    for (int n = 0; n < 2; ++n) acc[a][b][m][n] = (f32x4){0.f, 0.f, 0.f, 0.f};
        cur = nxt; cA = nA; cB = nB; ++ui;
        if constexpr (ALIGN_EPI) { if (wr == 1) PG8_BAR; }
    }
    PG8_WAIT_V(0);
    if constexpr (!ALIGN_EPI) { if (wr == 0) PG8_BAR; }
    PG8_BAR;
    if constexpr (Epi::AFTER_DRAIN) { E.fused(acc, cur, wr, wc, fr, fq, lds, wid, lane); S.done(cur); }
#undef PG8_SA
#undef PG8_SB
#undef PG8_STAGE
#undef PG8_LDA
#undef PG8_LDB
#undef PG8_MMA
#undef PG8_WAIT_V
#undef PG8_WAIT_L
#undef PG8_BAR
#undef PG8_SCHED
}
}

constexpr int DM = 2048, NBATCH = 4, SEQ = 8192, CTXL = 256, RB = CTXL + SEQ  , HB = 2  , HR = HB * RB  ;
constexpr int DFF = 5632, NUP = 2 * DFF, NMOD = 6 * DM, NCH = RB / 64  ;
constexpr int LDP = 14848;
constexpr int NWIN = 15104, INW = 14880;
constexpr int C_QA = 0, C_KA = 1024, C_VA = 1280, C_QD = 1536, C_KD = 2560, C_VD = 3584, C_QKV = 4608, C_Z = 7680, C_G = 8704;
constexpr float LN_EPS = 1e-6f, DN_ALPHA = 1.41421356237f  , LOG2E = 1.4426950408889634f;
constexpr int NWAVES = 8, NTHR = 512;
constexpr size_t MiB = 1u << 20;
constexpr size_t WS_CTL = 0, CTL_ZERO_BYTES = 1 * MiB;
constexpr size_t WS_MOD = 1 * MiB;
constexpr size_t WS_ROPEA = WS_MOD + 512 * 1024, WS_ROPED = WS_ROPEA + 32768, WS_LAM = WS_ROPED + 16384;
constexpr size_t WS_CX = 2 * MiB;
constexpr size_t WS_WIN = 10 * MiB, WS_WPA = 69 * MiB, WS_WPB = 73 * MiB, WS_WPC = 77 * MiB, WS_WO = 81 * MiB, WS_WUP = 89 * MiB, WS_WDN = 133 * MiB;
constexpr size_t WS_H = 155 * MiB;
constexpr size_t WS_AB = 221 * MiB;
constexpr size_t WS_GL = WS_AB + 5 * MiB / 2;
constexpr size_t WS_P = 224 * MiB;
constexpr size_t WS_G = 703 * MiB;
constexpr size_t GU_BYTES = 73728, GU_W = 0, GU_QG = 16384, GU_KD = 32768, GU_AT = 49152, GU_U = 57344;
constexpr size_t WS_END = WS_G + 297 * MiB;
constexpr size_t WS_TOT = WS_G, WS_M = WS_G + 132 * MiB, WS_OX = WS_P, WS_U = WS_P, WS_ACT = WS_G, WS_FX = WS_P;
static_assert((size_t)HR * LDP * 2 <= 479 * MiB && (size_t)4224 * GU_BYTES <= 297 * MiB && (size_t)HR * NUP * 2 <= 479 * MiB && (size_t)HR * DFF * 2 <= 297 * MiB, "d_ws map");
constexpr size_t WS_TRASH = 512 * 1024;
constexpr int CW_BAR = 4096, CW_Q = 16384;
constexpr int RING_BYTES = 131072, LDSCTL_OFF = RING_BYTES, LDS_BYTES = 147456;

#define GAS __attribute__((address_space(1)))
#define LAS __attribute__((address_space(3)))
typedef unsigned short bf16_t;
typedef short bf16x8 __attribute__((ext_vector_type(8)));
typedef short s16x4 __attribute__((ext_vector_type(4)));
typedef float f32x4 __attribute__((ext_vector_type(4)));
typedef float f32x2 __attribute__((ext_vector_type(2)));
typedef float f32x16 __attribute__((ext_vector_type(16)));
typedef unsigned u32x4 __attribute__((ext_vector_type(4)));
typedef unsigned u32x2 __attribute__((ext_vector_type(2)));
using pg8::cvt_pk_bf16; using pg8::bf_lo; using pg8::bf_hi; using pg8::sigm;
__device__ __forceinline__ float wave_sum(float v) {
#pragma unroll
    for (int o = 1; o < 64; o <<= 1) v += __shfl_xor(v, o);
    return v;
}
__device__ __forceinline__ int tid_opaque() { int t = threadIdx.x; asm volatile("" : "+v"(t)); return t; }
__device__ __forceinline__ float silu_f(float x) { return x / (1.0f + __expf(-x)); }
__device__ __forceinline__ int crow(int r, int hi) { return (r & 3) + 8 * (r >> 2) + 4 * hi; }
__device__ __forceinline__ bf16x8 pack8(float a0, float a1, float a2, float a3, float a4, float a5, float a6, float a7) {
    u32x4 w; w.x = cvt_pk_bf16(a0, a1); w.y = cvt_pk_bf16(a2, a3); w.z = cvt_pk_bf16(a4, a5); w.w = cvt_pk_bf16(a6, a7); return __builtin_bit_cast(bf16x8, w); }
typedef short v4i16_t __attribute__((ext_vector_type(4)));
__device__ __forceinline__ s16x4 lds_tr(LAS const unsigned char* p) { return __builtin_bit_cast(s16x4, __builtin_amdgcn_ds_read_tr16_b64_v4i16((LAS v4i16_t*)p)); }
#define MFMA32(a, b, c) __builtin_amdgcn_mfma_f32_32x32x16_bf16((a), (b), (c), 0, 0, 0)

#define XB_TMO      128
#define XB_XCNT(j)  (256  + 64 * (j))
#define XB_XSUB(j)  (1280 + 64 * (j))
#define XB_XGEN(j)  (2304 + 64 * (j))
#define XB_TOP      3328
#define XB_TOPGEN   3392
#define XCD_BAR_WORDS 3456
#define XB_SPIN_CAP (1u << 18)

__device__ __forceinline__ unsigned xb_ld(unsigned* p)              { return __hip_atomic_load(p, __ATOMIC_RELAXED, __HIP_MEMORY_SCOPE_AGENT); }
__device__ __forceinline__ unsigned xb_add(unsigned* p, unsigned v) { return __hip_atomic_fetch_add(p, v, __ATOMIC_RELAXED, __HIP_MEMORY_SCOPE_AGENT); }
__device__ __forceinline__ unsigned xb_xcc_id() { return (unsigned)__builtin_amdgcn_s_getreg((3 << 11) | 20) & 0xFu; }
#define XB_SPIN(cond, bar) do { unsigned _sp = 0; while (cond) { __builtin_amdgcn_s_sleep(1); \
    if ((++_sp & 255u) == 0u) { if (xb_ld(&(bar)[XB_TMO])) break; if (_sp > XB_SPIN_CAP) { atomicAdd(&(bar)[XB_TMO], 1u); break; } } } } while (0)

struct XcdBarrier {
    unsigned* bar; unsigned x;
    volatile LAS unsigned* st;
};

__device__ __forceinline__ XcdBarrier xcd_barrier_post(unsigned* bar, volatile LAS unsigned* st) {
    XcdBarrier b; b.bar = bar; b.x = xb_xcc_id(); b.st = st;
    if (threadIdx.x == 0) (void)xb_add(&bar[XB_XCNT(b.x)], 1u);
    return b;
}
__device__ __forceinline__ void xcd_barrier_complete(unsigned* bar, unsigned x, unsigned& nloc, unsigned& nx) {
    const unsigned G = gridDim.x * gridDim.y * gridDim.z;
    unsigned sum, cnt, mine, sp = 0u;
    for (;;) {
        sum = 0u; cnt = 0u; mine = 0u;
#pragma unroll
        for (unsigned j = 0; j < 16; ++j) { const unsigned c = xb_ld(&bar[XB_XCNT(j)]); sum += c; cnt += (c > 0u) ? 1u : 0u; mine = (j == x) ? c : mine; }
        if (sum == G) break;
        __builtin_amdgcn_s_sleep(1);
        if ((++sp & 255u) == 0u) { if (xb_ld(&bar[XB_TMO])) break; if (sp > XB_SPIN_CAP) { atomicAdd(&bar[XB_TMO], 1u); break; } }
    }
    nloc = mine > 0u ? mine : 1u; nx = cnt > 0u ? cnt : 1u;
}

__device__ __forceinline__ void xcd_barrier(const XcdBarrier& b) {
    asm volatile("s_waitcnt vmcnt(0)" ::: "memory");
    __syncthreads();
    if (threadIdx.x == 0) {
        unsigned* bar = b.bar;
        __builtin_amdgcn_s_waitcnt(0);
        unsigned nloc = b.st[0], nx = b.st[1];
        if (nloc == 0u) { xcd_barrier_complete(bar, b.x, nloc, nx); b.st[0] = nloc; b.st[1] = nx; }
        const unsigned old = xb_add(&bar[XB_XSUB(b.x)], 1u);
        const unsigned gen = old / nloc;
        if (old + 1u == (gen + 1u) * nloc) {
            __builtin_amdgcn_fence(__ATOMIC_RELEASE, "agent");
            asm volatile("s_waitcnt vmcnt(0)" ::: "memory");
            const unsigned og = xb_add(&bar[XB_TOP], 1u);
            const unsigned tg = og / nx;
            if (og + 1u == (tg + 1u) * nx) xb_add(&bar[XB_TOPGEN], 1u);
            else XB_SPIN(xb_ld(&bar[XB_TOPGEN]) == tg, bar);
            __builtin_amdgcn_fence(__ATOMIC_ACQUIRE, "agent");
            xb_add(&bar[XB_XGEN(b.x)], 1u);
            asm volatile("s_waitcnt vmcnt(0)" ::: "memory");
        } else {
            XB_SPIN(xb_ld(&bar[XB_XGEN(b.x)]) == gen, bar);
            __builtin_amdgcn_fence(__ATOMIC_ACQUIRE, "agent");
            asm volatile("s_waitcnt vmcnt(0)" ::: "memory");
        }
    }
    __syncthreads();
}
struct Args { const float* in[29]; float* out; unsigned char* ws; int ph_lo, ph_hi; };
enum { I_X = 0, I_C, I_CTX, I_CCTX, I_WMOD, I_BMOD, I_WIN, I_SINK, I_LQ1, I_LK1, I_LQ2, I_LK2, I_SUBLN, I_DNCONV, I_ALOG, I_DTB, I_DNNORM, I_WPA, I_WPB, I_WPC, I_WO, I_LN1G, I_LN1B, I_WUP, I_FCW, I_FCB, I_WDN, I_LN2G, I_LN2B };

__device__ __forceinline__ void ph_prologue(const Args& A, LAS unsigned char* lds) {
    const int tid = tid_opaque(), lane = tid & 63, wave = tid >> 6, G = gridDim.x, bid = blockIdx.x;
    const int gt = bid * NTHR + tid, NT = G * NTHR;
    float* ropeA = (float*)(A.ws + WS_ROPEA); float* ropeD = (float*)(A.ws + WS_ROPED); float* LAM = (float*)(A.ws + WS_LAM); float* MOD = (float*)(A.ws + WS_MOD);
    for (int e = gt; e < 128 * 32; e += NT) { const int pos = e >> 5, f = e & 31; const float inv = powf(10000.0f, -(float)(2 * f) / 64.0f); const float ang = (float)pos * inv; ropeA[2 * e] = cosf(ang); ropeA[2 * e + 1] = sinf(ang); }
    for (int e = gt; e < 128 * 16; e += NT) { const int pos = e >> 4, f = e & 15; const float inv = powf(10000.0f, -(float)(2 * f) / 32.0f); const float ang = (float)pos * inv; ropeD[2 * e] = cosf(ang); ropeD[2 * e + 1] = sinf(ang); }
    if (gt < 2) { const int l = gt; float s1 = 0.f, s2 = 0.f;
        for (int i = 0; i < 64; ++i) { s1 += A.in[I_LQ1][l * 64 + i] * A.in[I_LK1][l * 64 + i]; s2 += A.in[I_LQ2][l * 64 + i] * A.in[I_LK2][l * 64 + i]; }
        const float lam_init = 0.8f - 0.6f * expf(-0.3f * (float)l); LAM[2 * l] = expf(s1) - expf(s2) + lam_init; LAM[2 * l + 1] = 1.0f - lam_init; }
    LAS float* sc = (LAS float*)lds;
    LAS float* red = (LAS float*)(lds + 40960);
    for (int e = tid; e < 5 * 2048; e += NTHR) { const int idx = e >> 11, k = e & 2047; const float v = (idx < 4) ? A.in[I_C][idx * 2048 + k] : A.in[I_CCTX][k]; sc[e] = silu_f(v); }
    __syncthreads();
    for (int u = bid; u < 192; u += G) {
        const int l = u / 96, n0 = (u % 96) * 128;
        const float* W = A.in[I_WMOD] + (size_t)l * 2048 * NMOD + n0 + 2 * lane;
        float acc[5][2];
#pragma unroll
        for (int i = 0; i < 5; ++i) { acc[i][0] = 0.f; acc[i][1] = 0.f; }
        const int k0 = wave * 256;
#pragma unroll 4
        for (int k = k0; k < k0 + 256; ++k) { const f32x2 w = *(const f32x2*)(W + (size_t)k * NMOD);
#pragma unroll
            for (int i = 0; i < 5; ++i) { const float s = sc[i * 2048 + k]; acc[i][0] += s * w.x; acc[i][1] += s * w.y; } }
#pragma unroll
        for (int i = 0; i < 5; ++i) { red[(wave * 5 + i) * 128 + 2 * lane] = acc[i][0]; red[(wave * 5 + i) * 128 + 2 * lane + 1] = acc[i][1]; }
        __syncthreads();
        for (int e = tid; e < 640; e += NTHR) { const int idx = e >> 7, n = e & 127; float s = 0.f;
#pragma unroll
            for (int w = 0; w < 8; ++w) s += red[(w * 5 + idx) * 128 + n];
            MOD[(size_t)(l * 5 + idx) * NMOD + n0 + n] = s + A.in[I_BMOD][l * NMOD + n0 + n]; }
        __syncthreads();
    }
}
__device__ __forceinline__ int win_src(int n) {
    if (n < 1280) { const int j = n & 127, p = j >> 1, s = j & 1; const int dim = (p < 32) ? (s * 32 + p) : (64 + s * 32 + (p - 32)); return (n & ~127) + dim; }
    if (n < 1536) return n;
    if (n < 3584) { const int j = n & 63, p = j >> 1, s = j & 1; const int dim = (p < 16) ? (s * 16 + p) : (32 + s * 16 + (p - 16)); return (n & ~63) + dim; }
    if (n < 8704) return n;
    if (n < 14848) return n + 32;
    if (n < 14880) return n - 14848 + 8704;
    return -1;
}
template <int MODE> __device__ __forceinline__ void transpose_item(const float* W, int K, int N, bf16_t* WT, LAS float* scr, int kb, int nb, int lane) {
    const int k0 = 64 * kb, n0 = 32 * nb, nn = n0 + (lane & 31);
    const int sc = (MODE == 1) ? win_src(nn) : nn;
    const float* src = W + (size_t)(k0 + (lane >> 5)) * N + (sc >= 0 ? sc : 0);
#pragma unroll 8
    for (int i = 0; i < 32; ++i) { const float v = src[(size_t)(2 * i) * N]; scr[(2 * i + (lane >> 5)) * 33 + (lane & 31)] = (sc >= 0) ? v : 0.f; }
    asm volatile("s_waitcnt lgkmcnt(0)" ::: "memory");
    const int c = lane & 7;
#pragma unroll
    for (int j = 0; j < 4; ++j) { const int n = (lane >> 3) + 8 * j; const LAS float* s = scr + (8 * c) * 33 + n;
        u32x4 o; o.x = cvt_pk_bf16(s[0 * 33], s[1 * 33]); o.y = cvt_pk_bf16(s[2 * 33], s[3 * 33]); o.z = cvt_pk_bf16(s[4 * 33], s[5 * 33]); o.w = cvt_pk_bf16(s[6 * 33], s[7 * 33]);
        *(u32x4*)(WT + (size_t)(n0 + n) * K + k0 + 8 * c) = o; }
    asm volatile("s_waitcnt lgkmcnt(0)" ::: "memory");
}
__device__ __forceinline__ void ph_weights(const Args& A, LAS unsigned char* lds, int l) {
    const int tid = tid_opaque(), lane = tid & 63, wave = tid >> 6, G = gridDim.x, bid = blockIdx.x;
    LAS float* scr = (LAS float*)(lds + wave * 8448);
    unsigned char* ws = A.ws;
    constexpr int I0 = 32 * 472, I1 = 16 * 64, I2 = 32 * 64, I3 = 32 * 352, I4 = 88 * 64, NIT = I0 + 3 * I1 + I2 + I3 + I4;
    for (int it = bid * NWAVES + wave; it < NIT; it += G * NWAVES) {
        int r = it;
        if (r < I0) { transpose_item<1>(A.in[I_WIN] + (size_t)l * 2048 * INW, 2048, INW, (bf16_t*)(ws + WS_WIN), scr, r / 472, r % 472, lane); continue; } r -= I0;
        if (r < I1) { transpose_item<0>(A.in[I_WPA] + (size_t)l * 1024 * 2048, 1024, 2048, (bf16_t*)(ws + WS_WPA), scr, r / 64, r % 64, lane); continue; } r -= I1;
        if (r < I1) { transpose_item<0>(A.in[I_WPB] + (size_t)l * 1024 * 2048, 1024, 2048, (bf16_t*)(ws + WS_WPB), scr, r / 64, r % 64, lane); continue; } r -= I1;
        if (r < I1) { transpose_item<0>(A.in[I_WPC] + (size_t)l * 1024 * 2048, 1024, 2048, (bf16_t*)(ws + WS_WPC), scr, r / 64, r % 64, lane); continue; } r -= I1;
        if (r < I2) { transpose_item<0>(A.in[I_WO] + (size_t)l * 2048 * 2048, 2048, 2048, (bf16_t*)(ws + WS_WO), scr, r / 64, r % 64, lane); continue; } r -= I2;
        if (r < I3) { transpose_item<0>(A.in[I_WUP] + (size_t)l * 2048 * NUP, 2048, NUP, (bf16_t*)(ws + WS_WUP), scr, r / 352, r % 352, lane); continue; } r -= I3;
        transpose_item<0>(A.in[I_WDN] + (size_t)l * DFF * 2048, DFF, 2048, (bf16_t*)(ws + WS_WDN), scr, r / 64, r % 64, lane);
    }
}
__device__ __forceinline__ void row_src(const Args& A, int l, int half, int r, const float*& src, float*& dst, const float*& mod, bool& is_ctx) {
    const int bl = r / RB, tp = r - bl * RB, b = half * HB + bl; is_ctx = tp < CTXL;
    float* cx = (float*)(A.ws + WS_CX);
    dst = is_ctx ? cx + (size_t)(b * CTXL + tp) * DM : A.out + (size_t)(b * SEQ + tp - CTXL) * DM;
    if (l == 0) src = is_ctx ? A.in[I_CTX] + (size_t)(b * CTXL + tp) * DM : A.in[I_X] + (size_t)(b * SEQ + tp - CTXL) * DM; else src = dst;
    mod = (const float*)(A.ws + WS_MOD) + (size_t)(l * 5 + (is_ctx ? 4 : b)) * NMOD;
}
__device__ __forceinline__ void ln_stats(const f32x4 (&v)[8], float& mean, float& rstd) {
    float s = 0.f;
#pragma unroll
    for (int j = 0; j < 8; ++j) s += (v[j].x + v[j].y) + (v[j].z + v[j].w);
    mean = wave_sum(s) * (1.0f / DM); float q = 0.f;
#pragma unroll
    for (int j = 0; j < 8; ++j) { const f32x4 d = v[j] - mean; q += (d.x * d.x + d.y * d.y) + (d.z * d.z + d.w * d.w); }
    rstd = 1.0f / sqrtf(wave_sum(q) * (1.0f / DM) + LN_EPS);
}
__device__ __forceinline__ void ada_store(const f32x4 (&v)[8], float mean, float rstd, const float* shift, const float* scale, bf16_t* hrow, int lane) {
#pragma unroll
    for (int j = 0; j < 8; ++j) { const int e = (64 * j + lane) * 4; const f32x4 sh = *(const f32x4*)(shift + e), sc = *(const f32x4*)(scale + e);
        const f32x4 y = (v[j] - mean) * rstd * (sc + 1.0f) + sh; u32x2 w; w.x = cvt_pk_bf16(y.x, y.y); w.y = cvt_pk_bf16(y.z, y.w); *(u32x2*)(hrow + e) = w; }
}
__device__ __forceinline__ void ph_adaln(const Args& A, int l, int half) {
    const int tid = tid_opaque(), lane = tid & 63, gw = blockIdx.x * NWAVES + (tid >> 6), NGW = gridDim.x * NWAVES;
    bf16_t* H = (bf16_t*)(A.ws + WS_H);
    for (int r = gw; r < HR; r += NGW) {
        const float* src; float* dst; const float* mod; bool is_ctx; row_src(A, l, half, r, src, dst, mod, is_ctx);
        f32x4 v[8];
#pragma unroll
        for (int j = 0; j < 8; ++j) v[j] = *((const f32x4*)src + 64 * j + lane);
        float mean, rstd; ln_stats(v, mean, rstd);
        ada_store(v, mean, rstd, mod, mod + DM, H + (size_t)r * DM, lane);
    }
}
template <bool WITH_H> __device__ __forceinline__ void ph_resln(const Args& A, int l, int half, const float* Y, int gate_idx, const float* lng, const float* lnb, bool dry) {
    const int tid = tid_opaque(), lane = tid & 63, gw = blockIdx.x * NWAVES + (tid >> 6), NGW = gridDim.x * NWAVES;
    bf16_t* H = (bf16_t*)(A.ws + WS_H);
    for (int r = gw; r < HR; r += NGW) {
        const float* src; float* dst; const float* mod; bool is_ctx; row_src(A, l, half, r, src, dst, mod, is_ctx);
        if (is_ctx && l == 1) continue;
        if (!WITH_H) src = dst;
        if (dry) dst = (float*)(A.ws + WS_TRASH) + (tid >> 6) * DM;
        const float* gate = mod + gate_idx * DM; const float* yrow = Y + (size_t)r * DM;
        f32x4 v[8];
#pragma unroll
        for (int j = 0; j < 8; ++j) { const int e = 64 * j + lane; v[j] = *((const f32x4*)src + e) * DN_ALPHA + *((const f32x4*)gate + e) * *((const f32x4*)yrow + e); }
        float mean, rstd; ln_stats(v, mean, rstd);
#pragma unroll
        for (int j = 0; j < 8; ++j) { const int e = 64 * j + lane; v[j] = (v[j] - mean) * rstd * *((const f32x4*)lng + e) + *((const f32x4*)lnb + e); *((f32x4*)dst + e) = v[j]; }
        if (WITH_H) { ln_stats(v, mean, rstd); ada_store(v, mean, rstd, mod + 3 * DM, mod + 4 * DM, dry ? (bf16_t*)(A.ws + WS_TRASH) + 131072 + (tid >> 6) * DM : H + (size_t)r * DM, lane); }
    }
}
__device__ __forceinline__ void ph_convact(const Args& A, int l) {
    const int gt = blockIdx.x * NTHR + tid_opaque(), NT = gridDim.x * NTHR;
    const bf16_t* U = (const bf16_t*)(A.ws + WS_U); bf16_t* ACT = (bf16_t*)(A.ws + WS_ACT);
    const float* cw = A.in[I_FCW] + (size_t)l * 3 * NUP; const float* cb = A.in[I_FCB] + (size_t)l * NUP;
    constexpr int NVC = DFF / 8, NRB = HR / 32;
    for (int idx = gt; idx < NRB * NVC; idx += NT) {
        const int rbk = idx / NVC, vc = idx - rbk * NVC, r0 = rbk * 32, tp0 = r0 % RB;
        const bool first_start = (tp0 == 0 || tp0 == CTXL), last_end = (tp0 + 31 == CTXL - 1 || tp0 + 31 == RB - 1);
        const int ca = vc * 8, cbk = DFF + vc * 8;
        float wa[3][8], wb[3][8], ba[8], bb[8];
#pragma unroll
        for (int t = 0; t < 3; ++t) {
#pragma unroll
            for (int k = 0; k < 8; ++k) { wa[t][k] = cw[t * NUP + ca + k]; wb[t][k] = cw[t * NUP + cbk + k]; } }
#pragma unroll
        for (int k = 0; k < 8; ++k) { ba[k] = cb[ca + k]; bb[k] = cb[cbk + k]; }
        const u32x4 z4 = (u32x4){0u, 0u, 0u, 0u};
        u32x4 pa = z4, pb = z4, qa, qb, na, nb;
        if (!first_start) { pa = *(const u32x4*)(U + (size_t)(r0 - 1) * NUP + ca); pb = *(const u32x4*)(U + (size_t)(r0 - 1) * NUP + cbk); }
        qa = *(const u32x4*)(U + (size_t)r0 * NUP + ca); qb = *(const u32x4*)(U + (size_t)r0 * NUP + cbk);
        for (int r = 0; r < 32; ++r) {
            if (r == 31 && last_end) { na = z4; nb = z4; } else { na = *(const u32x4*)(U + (size_t)(r0 + r + 1) * NUP + ca); nb = *(const u32x4*)(U + (size_t)(r0 + r + 1) * NUP + cbk); }
            float o[8];
#pragma unroll
            for (int k = 0; k < 4; ++k) {
                const unsigned a0 = pa[k], a1 = qa[k], a2 = na[k], b0 = pb[k], b1 = qb[k], b2 = nb[k];
                const float xa0 = wa[0][2 * k] * bf_lo(a0) + wa[1][2 * k] * bf_lo(a1) + wa[2][2 * k] * bf_lo(a2) + ba[2 * k];
                const float xa1 = wa[0][2 * k + 1] * bf_hi(a0) + wa[1][2 * k + 1] * bf_hi(a1) + wa[2][2 * k + 1] * bf_hi(a2) + ba[2 * k + 1];
                const float xb0 = wb[0][2 * k] * bf_lo(b0) + wb[1][2 * k] * bf_lo(b1) + wb[2][2 * k] * bf_lo(b2) + bb[2 * k];
                const float xb1 = wb[0][2 * k + 1] * bf_hi(b0) + wb[1][2 * k + 1] * bf_hi(b1) + wb[2][2 * k + 1] * bf_hi(b2) + bb[2 * k + 1];
                o[2 * k] = silu_f(xa0) * xb0; o[2 * k + 1] = silu_f(xa1) * xb1; }
            u32x4 w; w.x = cvt_pk_bf16(o[0], o[1]); w.y = cvt_pk_bf16(o[2], o[3]); w.z = cvt_pk_bf16(o[4], o[5]); w.w = cvt_pk_bf16(o[6], o[7]);
            *(u32x4*)(ACT + (size_t)(r0 + r) * DFF + vc * 8) = w;
            pa = qa; pb = qb; qa = na; qb = nb;
        }
    }
}
template <int DQK>
__device__ __forceinline__ void attn_core(LAS unsigned char* lds, const bf16_t* Qrow, int kc0, const bf16_t* K0, const bf16_t* V0, int n0, const bf16_t* K1, const bf16_t* V1, int n1,
                                          bool mask1, int qpos, int k1pos0, f32x16 (&oT)[4], float& mref, float& lsum) {
    const int tid = tid_opaque(), lane = tid & 63, r32 = lane & 31, hi = lane >> 5;
    bf16x8 qf[DQK / 16];
#pragma unroll
    for (int d0 = 0; d0 < DQK / 16; ++d0) qf[d0] = *(const bf16x8*)(Qrow + d0 * 16 + hi * 8);
    const int srow = tid >> 4, sch = tid & 15;
    const size_t goff0 = (size_t)srow * LDP + sch * 8, goff1 = goff0 + (size_t)32 * LDP;
    const int kl0 = sch * 1024 + ((srow ^ sch) << 4), kl1 = kl0 + 512;
    const int vl0 = ((sch >> 2) * 8 + (srow >> 3)) * 512 + (srow & 7) * 64 + (sch & 3) * 16, vl1 = vl0 + 4 * 512;
    const int nt = n0 + n1;
    const int vbase = (4 * hi + ((lane & 15) >> 2)) * 64 + ((lane >> 4) & 1) * 32 + (lane & 3) * 8;
    u32x4 sk0, sk1, sv0, sv1;
    { const bf16_t* kp = (n0 > 0) ? K0 : K1; const bf16_t* vp = (n0 > 0) ? V0 : V1;
      sk0 = *(const u32x4*)(kp + goff0); sk1 = *(const u32x4*)(kp + goff1); sv0 = *(const u32x4*)(vp + goff0); sv1 = *(const u32x4*)(vp + goff1);
      *(LAS u32x4*)(lds + kl0) = sk0; *(LAS u32x4*)(lds + kl1) = sk1; *(LAS u32x4*)(lds + 32768 + vl0) = sv0; *(LAS u32x4*)(lds + 32768 + vl1) = sv1; }
    __syncthreads();
    for (int t = 0; t < nt; ++t) {
        const int b = t & 1; const bool more = (t + 1 < nt);
        if (more) { const int tn = t + 1; const bf16_t* kp = (tn < n0) ? K0 + (size_t)tn * 64 * LDP : K1 + (size_t)(tn - n0) * 64 * LDP; const bf16_t* vp = (tn < n0) ? V0 + (size_t)tn * 64 * LDP : V1 + (size_t)(tn - n0) * 64 * LDP;
            sk0 = *(const u32x4*)(kp + goff0); sk1 = *(const u32x4*)(kp + goff1); sv0 = *(const u32x4*)(vp + goff0); sv1 = *(const u32x4*)(vp + goff1); }
        LAS const unsigned char* Kb = lds + b * 16384; LAS const unsigned char* Vb = lds + 32768 + b * 16384;
        f32x16 p0, p1;
#pragma unroll
        for (int r = 0; r < 16; ++r) { p0[r] = 0.f; p1[r] = 0.f; }
#pragma unroll
        for (int d0 = 0; d0 < DQK / 16; ++d0) { const int c = (kc0 >> 3) + 2 * d0 + hi; const int off = c * 1024 + ((r32 ^ c) << 4);
            const bf16x8 a0 = *(LAS const bf16x8*)(Kb + off), a1 = *(LAS const bf16x8*)(Kb + off + 512);
            p0 = MFMA32(a0, qf[d0], p0); p1 = MFMA32(a1, qf[d0], p1); }
        if (mask1 && t >= n0) { const int kb = k1pos0 + (t - n0) * 64 + 4 * hi - qpos;
#pragma unroll
            for (int r = 0; r < 16; ++r) { const int dl = kb + (r & 3) + 8 * (r >> 2); if (dl > 128 || dl < -128) p0[r] = -INFINITY; if (dl + 32 > 128 || dl + 32 < -128) p1[r] = -INFINITY; } }
        float tm = fmaxf(p0[0], p1[0]);
#pragma unroll
        for (int r = 1; r < 16; ++r) tm = fmaxf(tm, fmaxf(p0[r], p1[r]));
        tm = fmaxf(tm, __shfl_xor(tm, 32));
        if (__any(tm > mref + 8.0f)) { const float mn = fmaxf(mref, tm); const float al = __builtin_amdgcn_exp2f(mref - mn);
#pragma unroll
            for (int q = 0; q < 4; ++q) oT[q] = oT[q] * al;
            lsum *= al; mref = mn; }
        float rs = 0.f;
#pragma unroll
        for (int r = 0; r < 16; ++r) { p0[r] = __builtin_amdgcn_exp2f(p0[r] - mref); p1[r] = __builtin_amdgcn_exp2f(p1[r] - mref); rs += p0[r] + p1[r]; }
        lsum += rs;
        bf16x8 pw[4];
        pw[0] = pack8(p0[0], p0[1], p0[2], p0[3], p0[4], p0[5], p0[6], p0[7]); pw[1] = pack8(p0[8], p0[9], p0[10], p0[11], p0[12], p0[13], p0[14], p0[15]);
        pw[2] = pack8(p1[0], p1[1], p1[2], p1[3], p1[4], p1[5], p1[6], p1[7]); pw[3] = pack8(p1[8], p1[9], p1[10], p1[11], p1[12], p1[13], p1[14], p1[15]);
#pragma unroll
        for (int q = 0; q < 4; ++q)
#pragma unroll
            for (int ks = 0; ks < 4; ++ks) { LAS const unsigned char* vp = Vb + (q * 8 + 2 * ks) * 512 + vbase; const s16x4 lo = lds_tr(vp), hh = lds_tr(vp + 512);
                const bf16x8 vf = (bf16x8){lo[0], lo[1], lo[2], lo[3], hh[0], hh[1], hh[2], hh[3]};
                oT[q] = MFMA32(vf, pw[ks], oT[q]); }
        if (more) { LAS unsigned char* Kn = lds + (b ^ 1) * 16384; LAS unsigned char* Vn = lds + 32768 + (b ^ 1) * 16384;
            *(LAS u32x4*)(Kn + kl0) = sk0; *(LAS u32x4*)(Kn + kl1) = sk1; *(LAS u32x4*)(Vn + vl0) = sv0; *(LAS u32x4*)(Vn + vl1) = sv1; }
        __syncthreads();
    }
}
__device__ __forceinline__ void attn_store(bf16_t* orow, const f32x16 (&o)[4], int hi) {
#pragma unroll
    for (int q = 0; q < 4; ++q)
#pragma unroll
        for (int g = 0; g < 4; ++g) { u32x2 w; w.x = cvt_pk_bf16(o[q][4 * g], o[q][4 * g + 1]); w.y = cvt_pk_bf16(o[q][4 * g + 2], o[q][4 * g + 3]); *(u32x2*)(orow + 32 * q + 8 * g + 4 * hi) = w; }
}
__device__ __forceinline__ void attnA_unit(const Args& A, LAS unsigned char* lds, int l, int bl, int nb, int pr, bool ctxq, bool dry) {
    const int tid = tid_opaque(), lane = tid & 63, r32 = lane & 31, hi = lane >> 5, wave = __builtin_amdgcn_readfirstlane(tid >> 6);
    bf16_t* P = (bf16_t*)(A.ws + WS_P);
    const int head = 2 * pr + (wave >> 2), kvh = pr >> 1, qloc = nb * 128 + 32 * (wave & 3) + r32;
    const size_t brow = (size_t)bl * RB;
    const size_t qrow = brow + (ctxq ? 0 : CTXL) + qloc;
    const bf16_t* Kc = P + brow * LDP + C_KA + kvh * 128; const bf16_t* Vc = P + brow * LDP + C_VA + kvh * 128;
    int ks = 128 * (nb - 1), ke = 128 * (nb + 2); if (ks < 0) ks = 0; if (ke > SEQ) ke = SEQ;
    const int n1 = ctxq ? 0 : (ke - ks) / 64;
    f32x16 oT[4];
#pragma unroll
    for (int q = 0; q < 4; ++q)
#pragma unroll
        for (int r = 0; r < 16; ++r) oT[q][r] = 0.f;
    float mref = -INFINITY, lsum = 0.f;
    attn_core<128>(lds, P + qrow * LDP + C_QA + head * 128, 0, Kc, Vc, 4, Kc + (size_t)(CTXL + ks) * LDP, Vc + (size_t)(CTXL + ks) * LDP, n1, true, qloc, ks, oT, mref, lsum);
    const float sk = A.in[I_SINK][l * 8 + head] * LOG2E;
    const float mf = fmaxf(mref, sk), sc = __builtin_amdgcn_exp2f(mref - mf);
    lsum += __shfl_xor(lsum, 32);
    const float f = sc / (lsum * sc + __builtin_amdgcn_exp2f(sk - mf));
#pragma unroll
    for (int q = 0; q < 4; ++q) oT[q] = oT[q] * f;
    attn_store(dry ? (bf16_t*)(A.ws + WS_TRASH) + tid * 128 : P + qrow * LDP + C_QA + head * 128, oT, hi);
}
__device__ __forceinline__ void attnB_unit(const Args& A, LAS unsigned char* lds, int l, int bl, int h, int qb, bool ctxq, bool dry) {
    const int tid = tid_opaque(), lane = tid & 63, r32 = lane & 31, hi = lane >> 5, wave = __builtin_amdgcn_readfirstlane(tid >> 6);
    bf16_t* P = (bf16_t*)(A.ws + WS_P);
    const int sub = wave >> 2;
    const size_t brow = (size_t)bl * RB;
    const size_t qrow = brow + (ctxq ? 0 : CTXL) + qb * 128 + 32 * (wave & 3) + r32;
    const bf16_t* Kc = P + brow * LDP + C_KD + h * 128; const bf16_t* Vc = P + brow * LDP + C_VD + h * 128;
    f32x16 oT[4];
#pragma unroll
    for (int q = 0; q < 4; ++q)
#pragma unroll
        for (int r = 0; r < 16; ++r) oT[q][r] = 0.f;
    float mref = -INFINITY, lsum = 0.f;
    attn_core<64>(lds, P + qrow * LDP + C_QD + h * 128 + sub * 64, sub * 64, Kc, Vc, ctxq ? 4 : NCH, Kc, Vc, 0, false, 0, 0, oT, mref, lsum);
    lsum += __shfl_xor(lsum, 32);
    const float inv = 1.0f / lsum;
    LAS float* xch = (LAS float*)lds + (wave & 3) * 4096;
    if (sub == 1) {
#pragma unroll
        for (int q = 0; q < 4; ++q)
#pragma unroll
            for (int r = 0; r < 16; ++r) xch[(q * 16 + r) * 64 + lane] = oT[q][r] * inv;
    }
    __syncthreads();
    if (sub == 0) {
        const float lam = ((const float*)(A.ws + WS_LAM))[2 * l], post = ((const float*)(A.ws + WS_LAM))[2 * l + 1];
        float ss = 0.f;
#pragma unroll
        for (int q = 0; q < 4; ++q)
#pragma unroll
            for (int r = 0; r < 16; ++r) { const float v = oT[q][r] * inv - lam * xch[(q * 16 + r) * 64 + lane]; oT[q][r] = v; ss += v * v; }
        ss += __shfl_xor(ss, 32);
        const float rn = post / sqrtf(ss * (1.0f / 128.0f) + 1e-6f);
        const float* sw = A.in[I_SUBLN] + l * 128;
#pragma unroll
        for (int q = 0; q < 4; ++q)
#pragma unroll
            for (int r = 0; r < 16; ++r) oT[q][r] *= rn * sw[32 * q + 8 * (r >> 2) + 4 * hi + (r & 3)];
        attn_store(dry ? (bf16_t*)(A.ws + WS_TRASH) + tid * 128 : P + qrow * LDP + C_QD + h * 128, oT, hi);
    }
    __syncthreads();
}
__device__ __forceinline__ void ph_attention(const Args& A, LAS unsigned char* lds, int l, int half, int it, bool dry) {
    const int tid = tid_opaque();
    unsigned* ctr = (unsigned*)(A.ws + WS_CTL) + CW_Q + 64 * (2 * it + (dry ? 1 : 0));
    volatile LAS int* qw = (volatile LAS int*)(lds + LDSCTL_OFF + 64);
    constexpr int NB_ = HB * 8 * 64, NA_ = HB * 64 * 4, NBC_ = HB * 8 * 2, NAC_ = HB * 2 * 4;
    const int ntot = NB_ + NA_ + (l == 0 ? NBC_ + NAC_ : 0);
    for (;;) {
        if (tid == 0) *qw = (int)__hip_atomic_fetch_add(ctr, 1u, __ATOMIC_RELAXED, __HIP_MEMORY_SCOPE_AGENT);
        __syncthreads();
        int u = *qw;
        __syncthreads();
        if (u >= ntot) break;
        if (u < NB_) { attnB_unit(A, lds, l, u >> 9, (u >> 6) & 7, u & 63, false, dry); continue; } u -= NB_;
        if (u < NA_) { attnA_unit(A, lds, l, u >> 8, (u >> 2) & 63, u & 3, false, dry); continue; } u -= NA_;
        if (u < NBC_) { attnB_unit(A, lds, l, u >> 4, (u >> 1) & 7, u & 1, true, dry); continue; } u -= NBC_;
        attnA_unit(A, lds, l, u >> 3, (u >> 2) & 1, u & 3, true, dry);
    }
}
constexpr int GL_QN = 0, GL_KN = 17408, GL_RHS = 34816, GL_MM = 100352, GL_GC = 117760, GL_BETA = 118016, GL_EG = 118272, GL_DK = 118528, GPITCH = 272;
__device__ __forceinline__ void gdn_intra_unit(const Args& A, LAS unsigned char* lds, int l, int bl, int ch, int h, int d) {
    const int tid_ = tid_opaque();
    const int tid = tid_, lane = tid & 63, r32 = lane & 31, hi = lane >> 5, wave = __builtin_amdgcn_readfirstlane(tid >> 6);
    const bf16_t* P = (const bf16_t*)(A.ws + WS_P); const float* AB = (const float*)(A.ws + WS_AB);
    const int uidx = ((bl * NCH + ch) * 8 + h) * 2 + d;
    unsigned char* rec = A.ws + WS_G + (size_t)uidx * GU_BYTES;
    const size_t R0 = (size_t)bl * RB + ch * 64;
    LAS float* GC = (LAS float*)(lds + GL_GC); LAS float* BETA = (LAS float*)(lds + GL_BETA); LAS float* EG = (LAS float*)(lds + GL_EG); LAS float* DKS = (LAS float*)(lds + GL_DK);
    LAS float* RHS = (LAS float*)(lds + GL_RHS); LAS float* MM = (LAS float*)(lds + GL_MM);
    if (wave == 0) {
        const size_t row = R0 + (d ? 63 - lane : lane);
        float g = AB[row * 32 + d * 8 + h]; const float be = AB[row * 32 + 16 + d * 8 + h];
#pragma unroll
        for (int o = 1; o < 64; o <<= 1) { const float t = __shfl_up(g, o); if (lane >= o) g += t; }
        const float glast = __shfl(g, 63);
        GC[lane] = g; BETA[lane] = be; EG[lane] = __expf(g); DKS[lane] = __expf(glast - g);
        if (lane == 0) ((float*)(A.ws + WS_GL))[uidx] = __expf(glast);
    }
    __syncthreads();
    {
        const int i = tid >> 3, sub = tid & 7, c = d ? 63 - i : i;
        const int tp = ch * 64 + c;
        const bool has_prev = !(tp == 0 || tp == CTXL), has_next = !(tp == CTXL - 1 || tp == RB - 1);
        const bf16_t* xr = P + (R0 + c) * LDP + C_QKV + h * 128 + sub * 16;
        const float* cw = A.in[I_DNCONV] + (size_t)l * 3 * 3072 + h * 128 + sub * 16;
        const float be = BETA[i], eg = EG[i];
#pragma unroll
        for (int mat = 0; mat < 3; ++mat) {
            const bf16_t* xm = xr + mat * 1024; const float* wm = cw + mat * 1024;
            float y[16];
            const u32x4 z4 = (u32x4){0u, 0u, 0u, 0u};
#pragma unroll
            for (int hf = 0; hf < 2; ++hf) {
                const u32x4 xc = *(const u32x4*)(xm + hf * 8);
                const u32x4 xp = has_prev ? *(const u32x4*)(xm - LDP + hf * 8) : z4;
                const u32x4 xn = has_next ? *(const u32x4*)(xm + LDP + hf * 8) : z4;
#pragma unroll
                for (int k = 0; k < 4; ++k) { const int e = hf * 8 + 2 * k;
                    const float v0 = wm[e] * bf_lo(xp[k]) + wm[3072 + e] * bf_lo(xc[k]) + wm[6144 + e] * bf_lo(xn[k]);
                    const float v1 = wm[e + 1] * bf_hi(xp[k]) + wm[3072 + e + 1] * bf_hi(xc[k]) + wm[6144 + e + 1] * bf_hi(xn[k]);
                    y[e] = silu_f(v0); y[e + 1] = silu_f(v1); }
            }
            if (mat < 2) {
                float ss = 0.f;
#pragma unroll
                for (int e = 0; e < 16; ++e) ss += y[e] * y[e];
                ss += __shfl_xor(ss, 1); ss += __shfl_xor(ss, 2); ss += __shfl_xor(ss, 4);
                const float rn = (1.0f / sqrtf(ss + 1e-6f)) * (mat == 0 ? 0.08838834764831845f : 1.0f);
#pragma unroll
                for (int e = 0; e < 16; ++e) y[e] *= rn;
                LAS unsigned char* dst = lds + (mat == 0 ? GL_QN : GL_KN) + i * GPITCH + sub * 32;
                u32x4 w0, w1; w0.x = cvt_pk_bf16(y[0], y[1]); w0.y = cvt_pk_bf16(y[2], y[3]); w0.z = cvt_pk_bf16(y[4], y[5]); w0.w = cvt_pk_bf16(y[6], y[7]);
                w1.x = cvt_pk_bf16(y[8], y[9]); w1.y = cvt_pk_bf16(y[10], y[11]); w1.z = cvt_pk_bf16(y[12], y[13]); w1.w = cvt_pk_bf16(y[14], y[15]);
                *(LAS u32x4*)dst = w0; *(LAS u32x4*)(dst + 16) = w1;
                if (mat == 1) { const float s = be * eg;
#pragma unroll
                    for (int e = 0; e < 16; e += 4) *(LAS f32x4*)(RHS + i * 256 + 128 + sub * 16 + e) = (f32x4){y[e] * s, y[e + 1] * s, y[e + 2] * s, y[e + 3] * s}; }
            } else {
#pragma unroll
                for (int e = 0; e < 16; e += 4) *(LAS f32x4*)(RHS + i * 256 + sub * 16 + e) = (f32x4){y[e] * be, y[e + 1] * be, y[e + 2] * be, y[e + 3] * be};
            }
        }
    }
    __syncthreads();
    {
        const int mat = wave >> 2, rbk = (wave >> 1) & 1, cbk = wave & 1;
        LAS const unsigned char* Ab = lds + GL_KN + (32 * rbk + r32) * GPITCH + hi * 16;
        LAS const unsigned char* Bb = lds + (mat == 0 ? GL_KN : GL_QN) + (32 * cbk + r32) * GPITCH + hi * 16;
        f32x16 acc;
#pragma unroll
        for (int r = 0; r < 16; ++r) acc[r] = 0.f;
#pragma unroll
        for (int d0 = 0; d0 < 8; ++d0) { const bf16x8 a = *(LAS const bf16x8*)(Ab + d0 * 32), b = *(LAS const bf16x8*)(Bb + d0 * 32); acc = MFMA32(a, b, acc); }
        const int cc = 32 * cbk + r32; const float gcc = GC[cc];
        if (mat == 0) {
#pragma unroll
            for (int r = 0; r < 16; ++r) { const int i = 32 * rbk + crow(r, hi); const float v = (i > cc) ? BETA[i] * acc[r] * __expf(GC[i] - gcc) : 0.f; MM[i * 68 + cc] = v; }
        } else {
            float v[16];
#pragma unroll
            for (int r = 0; r < 16; ++r) { const int j = 32 * rbk + crow(r, hi); v[r] = (cc >= j) ? acc[r] * __expf(gcc - GC[j]) : 0.f; }
            bf16x8* at = (bf16x8*)(rec + GU_AT);
            at[(cbk * 4 + 2 * rbk + 0) * 64 + lane] = pack8(v[0], v[1], v[2], v[3], v[4], v[5], v[6], v[7]);
            at[(cbk * 4 + 2 * rbk + 1) * 64 + lane] = pack8(v[8], v[9], v[10], v[11], v[12], v[13], v[14], v[15]);
        }
    }
    __syncthreads();
    float x[64];
#define FNMA(acc, a, b) asm("v_fma_f32 %0, -%1, %2, %0" : "+v"(acc) : "v"(a), "v"(b))
    if (tid < 256) {
        LAS const float* MMv = MM; asm volatile("" : "+v"(MMv));
        LAS const float* RHv = RHS + tid; asm volatile("" : "+v"(RHv));
#pragma unroll
        for (int i = 0; i < 64; ++i) {
            float a = RHv[i * 256];
#pragma unroll
            for (int m4 = 0; m4 < i; m4 += 4) { const f32x4 mm = *(LAS const f32x4*)(MMv + i * 68 + m4);
                FNMA(a, mm[0], x[m4]); if (m4 + 1 < i) FNMA(a, mm[1], x[m4 + 1]); if (m4 + 2 < i) FNMA(a, mm[2], x[m4 + 2]); if (m4 + 3 < i) FNMA(a, mm[3], x[m4 + 3]); }
            x[i] = a; asm volatile("" ::: "memory");
        }
    } else {
        const int w4 = wave - 4;
        if (w4 < 2) {
#pragma unroll
            for (int ff = 0; ff < 8; ++ff) { const int f = w4 * 8 + ff, ib = f >> 3, rb = (f >> 1) & 3, s = f & 1; const int i = 32 * ib + r32, dk0 = 32 * rb + 16 * s + 4 * hi;
                const u32x2 a = *(LAS const u32x2*)(lds + GL_QN + i * GPITCH + dk0 * 2), b = *(LAS const u32x2*)(lds + GL_QN + i * GPITCH + (dk0 + 8) * 2); const float e = EG[i];
                ((bf16x8*)(rec + GU_QG))[f * 64 + lane] = pack8(bf_lo(a.x) * e, bf_hi(a.x) * e, bf_lo(a.y) * e, bf_hi(a.y) * e, bf_lo(b.x) * e, bf_hi(b.x) * e, bf_lo(b.y) * e, bf_hi(b.y) * e); }
        } else {
#pragma unroll
            for (int ff = 0; ff < 8; ++ff) { const int f = (w4 - 2) * 8 + ff, rb = f >> 2, ib = (f >> 1) & 1, s = f & 1; const int i0 = 32 * ib + 16 * s + 4 * hi;
                LAS const unsigned char* kp = lds + GL_KN + (i0 + ((lane & 15) >> 2)) * GPITCH + (32 * rb + 16 * ((lane >> 4) & 1) + 4 * (lane & 3)) * 2;
                const s16x4 lo = lds_tr(kp), hh = lds_tr(kp + 8 * GPITCH);
                const f32x4 s0 = *(LAS const f32x4*)(DKS + i0), s1 = *(LAS const f32x4*)(DKS + i0 + 8);
#define BFV(x) __uint_as_float(((unsigned)(unsigned short)(x)) << 16)
                ((bf16x8*)(rec + GU_KD))[f * 64 + lane] = pack8(BFV(lo[0]) * s0[0], BFV(lo[1]) * s0[1], BFV(lo[2]) * s0[2], BFV(lo[3]) * s0[3], BFV(hh[0]) * s1[0], BFV(hh[1]) * s1[1], BFV(hh[2]) * s1[2], BFV(hh[3]) * s1[3]);
#undef BFV
            }
        }
    }
    __syncthreads();
    if (tid < 128) {
        unsigned* up = (unsigned*)(rec + GU_U); const int sl = tid >> 5, dvl = tid & 31;
#pragma unroll
        for (int ib = 0; ib < 2; ++ib)
#pragma unroll
            for (int p = 0; p < 8; ++p)
#pragma unroll
                for (int hh = 0; hh < 2; ++hh) { const int i = 32 * ib + (2 * p & 3) + 8 * (2 * p >> 2) + 4 * hh; up[((ib * 4 + sl) * 8 + p) * 64 + hh * 32 + dvl] = cvt_pk_bf16(x[i], x[i + 1]); }
    } else if (tid < 256) {
        LAS bf16_t* wl = (LAS bf16_t*)(lds + GL_QN);
#pragma unroll
        for (int i = 0; i < 64; ++i) wl[i * (GPITCH / 2) + (tid - 128)] = (bf16_t)(cvt_pk_bf16(x[i], 0.f) & 0xffffu);
    }
    __syncthreads();
#pragma unroll
    for (int ff = 0; ff < 2; ++ff) { const int f = wave * 2 + ff, ib = f >> 3, rb = (f >> 1) & 3, s = f & 1; const int i = 32 * ib + r32, dk0 = 32 * rb + 16 * s + 4 * hi;
        const u32x2 a = *(LAS const u32x2*)(lds + GL_QN + i * GPITCH + dk0 * 2), b = *(LAS const u32x2*)(lds + GL_QN + i * GPITCH + (dk0 + 8) * 2);
        ((u32x4*)(rec + GU_W))[f * 64 + lane] = (u32x4){a.x, a.y, b.x, b.y}; }
    __syncthreads();
}
__device__ __forceinline__ void ph_gdn_intra(const Args& A, LAS unsigned char* lds, int l) {
    for (int u = blockIdx.x; u < HB * NCH * 8 * 2; u += gridDim.x) { const int d = u & 1, h = (u >> 1) & 7, t = u >> 4, ch = t % NCH, bl = t / NCH; gdn_intra_unit(A, lds, l, bl, ch, h, d); }
}
constexpr int SC_SLOT = 57344, SC_OST = 2 * SC_SLOT;
__device__ __forceinline__ void gdn_scan_unit(const Args& A, LAS unsigned char* lds, int bl, int h, int d) {
    const int tid = tid_opaque(), lane = tid & 63, r32 = lane & 31, hi = lane >> 5, wave = __builtin_amdgcn_readfirstlane(tid >> 6);
#define SC_CH(step) (d ? ((step) < 4 ? 3 - (step) : NCH + 3 - (step)) : (step))
#define SC_UIDX(step) (((bl * NCH + SC_CH(step)) * 8 + h) * 2 + d)
    if (wave >= 4) {
        const int lw = wave - 4;
#define SC_ISSUE(step, slot) do { const unsigned char* rec_ = A.ws + WS_G + (size_t)SC_UIDX(step) * GU_BYTES + lane * 16; \
        _Pragma("unroll") for (int k_ = 0; k_ < 14; ++k_) __builtin_amdgcn_global_load_lds((const unsigned*)(rec_ + (lw * 14 + k_) * 1024), (LAS unsigned*)(lds + (slot) * SC_SLOT + (lw * 14 + k_) * 1024), 16, 0, 0); } while (0)
        SC_ISSUE(0, 0);
        asm volatile("s_waitcnt vmcnt(0)" ::: "memory"); __builtin_amdgcn_s_barrier();
        for (int step = 0; step < NCH; ++step) {
            if (step + 1 < NCH) SC_ISSUE(step + 1, (step + 1) & 1);
            asm volatile("s_waitcnt vmcnt(0)" ::: "memory"); __builtin_amdgcn_s_barrier();
        }
#undef SC_ISSUE
        return;
    }
    const int sl = wave;
    bf16_t* O = (bf16_t*)(A.ws + WS_H) + (size_t)d * HR * 1024;
    const float* GLv = (const float*)(A.ws + WS_GL);
    LAS unsigned char* ost = lds + SC_OST + sl * 4096;
    f32x16 S[4];
#pragma unroll
    for (int rb = 0; rb < 4; ++rb)
#pragma unroll
        for (int r = 0; r < 16; ++r) S[rb][r] = 0.f;
    unsigned un[16]; float gln;
    { const unsigned* Up = (const unsigned*)(A.ws + WS_G + (size_t)SC_UIDX(0) * GU_BYTES + GU_U) + lane;
#pragma unroll
      for (int q = 0; q < 16; ++q) un[q] = Up[(((q >> 3) * 4 + sl) * 8 + (q & 7)) * 64];
      gln = GLv[SC_UIDX(0)]; }
    __builtin_amdgcn_s_barrier();
    for (int step = 0; step < NCH; ++step) {
        const int ch = SC_CH(step);
        LAS const unsigned char* slot = lds + (step & 1) * SC_SLOT + lane * 16;
        unsigned uc[16]; const float gl = gln;
#pragma unroll
        for (int q = 0; q < 16; ++q) uc[q] = un[q];
        if (step + 1 < NCH) { const unsigned* Up = (const unsigned*)(A.ws + WS_G + (size_t)SC_UIDX(step + 1) * GU_BYTES + GU_U) + lane;
#pragma unroll
            for (int q = 0; q < 16; ++q) un[q] = Up[(((q >> 3) * 4 + sl) * 8 + (q & 7)) * 64];
            gln = GLv[SC_UIDX(step + 1)]; }
        f32x16 vn[2], o[2];
#pragma unroll
        for (int ib = 0; ib < 2; ++ib)
#pragma unroll
            for (int r = 0; r < 16; ++r) { vn[ib][r] = 0.f; o[ib][r] = 0.f; }
#pragma unroll
        for (int rb = 0; rb < 4; ++rb)
#pragma unroll
            for (int s = 0; s < 2; ++s) {
                const bf16x8 sb = pack8(S[rb][8 * s], S[rb][8 * s + 1], S[rb][8 * s + 2], S[rb][8 * s + 3], S[rb][8 * s + 4], S[rb][8 * s + 5], S[rb][8 * s + 6], S[rb][8 * s + 7]);
#pragma unroll
                for (int ib = 0; ib < 2; ++ib) { const int f = (ib * 4 + rb) * 2 + s;
                    vn[ib] = MFMA32(*(LAS const bf16x8*)(slot + GU_W + f * 1024), sb, vn[ib]); o[ib] = MFMA32(*(LAS const bf16x8*)(slot + GU_QG + f * 1024), sb, o[ib]); }
            }
#pragma unroll
        for (int ib = 0; ib < 2; ++ib)
#pragma unroll
            for (int p = 0; p < 8; ++p) { const unsigned w = uc[ib * 8 + p]; vn[ib][2 * p] = bf_lo(w) - vn[ib][2 * p]; vn[ib][2 * p + 1] = bf_hi(w) - vn[ib][2 * p + 1]; }
        bf16x8 vb[2][2];
#pragma unroll
        for (int ib = 0; ib < 2; ++ib) { vb[ib][0] = pack8(vn[ib][0], vn[ib][1], vn[ib][2], vn[ib][3], vn[ib][4], vn[ib][5], vn[ib][6], vn[ib][7]);
            vb[ib][1] = pack8(vn[ib][8], vn[ib][9], vn[ib][10], vn[ib][11], vn[ib][12], vn[ib][13], vn[ib][14], vn[ib][15]); }
#pragma unroll
        for (int ib = 0; ib < 2; ++ib)
#pragma unroll
            for (int jb = 0; jb < 2; ++jb)
#pragma unroll
                for (int s = 0; s < 2; ++s) o[ib] = MFMA32(*(LAS const bf16x8*)(slot + GU_AT + (ib * 4 + 2 * jb + s) * 1024), vb[jb][s], o[ib]);
#pragma unroll
        for (int rb = 0; rb < 4; ++rb) { S[rb] = S[rb] * gl;
#pragma unroll
            for (int ib = 0; ib < 2; ++ib)
#pragma unroll
                for (int s = 0; s < 2; ++s) S[rb] = MFMA32(*(LAS const bf16x8*)(slot + GU_KD + ((rb * 2 + ib) * 2 + s) * 1024), vb[ib][s], S[rb]); }
#pragma unroll
        for (int ib = 0; ib < 2; ++ib)
#pragma unroll
            for (int r = 0; r < 16; ++r) { const int i = 32 * ib + crow(r, hi); const int c = d ? 63 - i : i; *(LAS bf16_t*)(ost + c * 64 + r32 * 2) = (bf16_t)(cvt_pk_bf16(o[ib][r], 0.f) & 0xffffu); }
        asm volatile("s_waitcnt lgkmcnt(0)" ::: "memory");
        bf16_t* obase = O + ((size_t)bl * RB + ch * 64) * 1024 + h * 128 + 32 * sl;
#pragma unroll
        for (int k = 0; k < 4; ++k) { const int id = k * 64 + lane; const u32x4 v = *(LAS const u32x4*)(ost + id * 16); *(u32x4*)(obase + (size_t)(id >> 2) * 1024 + (id & 3) * 8) = v; }
        asm volatile("s_waitcnt lgkmcnt(0)" ::: "memory"); __builtin_amdgcn_s_barrier();
    }
#undef SC_CH
#undef SC_UIDX
}
__device__ __forceinline__ void ph_gdn_post(const Args& A, int l, bool dry) {
    const int tid = tid_opaque(), lane = tid & 63, gw = blockIdx.x * NWAVES + (tid >> 6), NGW = gridDim.x * NWAVES;
    const bf16_t* OF = (const bf16_t*)(A.ws + WS_H); const bf16_t* OB = OF + (size_t)HR * 1024; bf16_t* P = (bf16_t*)(A.ws + WS_P);
    const float* nw = A.in[I_DNNORM] + l * 128 + (lane & 7) * 16;
    for (int r = gw; r < HR; r += NGW) {
        const u32x4 f0 = *(const u32x4*)(OF + (size_t)r * 1024 + lane * 16), f1 = *(const u32x4*)(OF + (size_t)r * 1024 + lane * 16 + 8);
        const u32x4 b0 = *(const u32x4*)(OB + (size_t)r * 1024 + lane * 16), b1 = *(const u32x4*)(OB + (size_t)r * 1024 + lane * 16 + 8);
        bf16_t* zp = P + (size_t)r * LDP + C_Z + lane * 16;
        const u32x4 z0 = *(const u32x4*)zp, z1 = *(const u32x4*)(zp + 8);
        float o[16], z[16]; float ss = 0.f;
#pragma unroll
        for (int k = 0; k < 4; ++k) { o[2 * k] = bf_lo(f0[k]) + bf_lo(b0[k]); o[2 * k + 1] = bf_hi(f0[k]) + bf_hi(b0[k]); o[8 + 2 * k] = bf_lo(f1[k]) + bf_lo(b1[k]); o[8 + 2 * k + 1] = bf_hi(f1[k]) + bf_hi(b1[k]);
            z[2 * k] = bf_lo(z0[k]); z[2 * k + 1] = bf_hi(z0[k]); z[8 + 2 * k] = bf_lo(z1[k]); z[8 + 2 * k + 1] = bf_hi(z1[k]); }
#pragma unroll
        for (int e = 0; e < 16; ++e) ss += o[e] * o[e];
        ss += __shfl_xor(ss, 1); ss += __shfl_xor(ss, 2); ss += __shfl_xor(ss, 4);
        const float rn = 1.0f / sqrtf(ss * (1.0f / 128.0f) + 1e-6f);
#pragma unroll
        for (int e = 0; e < 16; ++e) o[e] = o[e] * rn * nw[e] * silu_f(z[e]);
        u32x4 w0, w1; w0.x = cvt_pk_bf16(o[0], o[1]); w0.y = cvt_pk_bf16(o[2], o[3]); w0.z = cvt_pk_bf16(o[4], o[5]); w0.w = cvt_pk_bf16(o[6], o[7]);
        w1.x = cvt_pk_bf16(o[8], o[9]); w1.y = cvt_pk_bf16(o[10], o[11]); w1.z = cvt_pk_bf16(o[12], o[13]); w1.w = cvt_pk_bf16(o[14], o[15]);
        bf16_t* zo = dry ? (bf16_t*)(A.ws + WS_TRASH) + tid * 16 : zp;
        *(u32x4*)zo = w0; *(u32x4*)(zo + 8) = w1;
    }
}
constexpr int NPH = 1 + 14 * 4;
__host__ __device__ inline bool phase_is_noop(int id) { if (id == 0) return false; const int it = (id - 1) / 14, k = (id - 1) % 14; return (k == 0 && it != 2) || k == 6; }
__global__ void __launch_bounds__(NTHR, 2) fwd(Args A) {
    extern __shared__ __attribute__((aligned(16))) unsigned char lds_raw[];
    LAS unsigned char* lds = (LAS unsigned char*)lds_raw;
    volatile LAS unsigned* MISC = (volatile LAS unsigned*)(lds + LDSCTL_OFF + 320);
    for (int u = threadIdx.x; u < (LDS_BYTES - LDSCTL_OFF) / 4; u += NTHR) ((LAS unsigned*)(lds + LDSCTL_OFF))[u] = 0u;
    __syncthreads();
    const int lo = A.ph_lo, hi = A.ph_hi, G = gridDim.x, bid = blockIdx.x;
    unsigned char* ws = A.ws;
    XcdBarrier bar; bar.bar = (unsigned*)(ws + WS_CTL) + CW_BAR; bar.x = 0; bar.st = nullptr;
    if (hi - lo > 1) bar = xcd_barrier_post((unsigned*)(ws + WS_CTL) + CW_BAR, MISC + 8);
#ifndef PHMASK
#define PHMASK 0x7fff
#endif
#ifndef DUP_MASK
#define DUP_MASK 0
#endif
#define RUNK(k, id, ...) do { if (((PHMASK >> (k)) & 1) && lo <= (id) && (id) < hi) { \
    if ((DUP_MASK >> (k)) & 1) { dry = true; __VA_ARGS__; xcd_barrier(bar); dry = false; } \
    __VA_ARGS__; if ((id) + 1 < hi) xcd_barrier(bar); } } while (0)
    bool dry = false;
    bf16_t* H = (bf16_t*)(ws + WS_H); bf16_t* P = (bf16_t*)(ws + WS_P);
    RUNK(14, 0, { ph_prologue(A, lds); __syncthreads(); ph_weights(A, lds, 0); });
    for (int it = 0; it < 4; ++it) {
        const int l = it >> 1, half = it & 1, base = 1 + 14 * it;
        if (it == 2) RUNK(0, base + 0, { ph_weights(A, lds, 1); });
        RUNK(1, base + 1, { ph_adaln(A, l, half); });
        RUNK(2, base + 2, {
            pg8::Gemm g{H, (const bf16_t*)(ws + WS_WIN), HR, NWIN, 2048, 2048}; pg8::StaticOrder S; S.init(HR, NWIN, G, bid);
            pg8::EpiInProj E{P, LDP, (float*)(ws + WS_AB), (const float*)(ws + WS_ROPEA), (const float*)(ws + WS_ROPED), A.in[I_ALOG] + l * 16, A.in[I_DTB] + l * 16, 0.08838834764831845f * LOG2E, 0.125f * LOG2E};
            pg8::gemm_phase<pg8::EpiInProj, pg8::StaticOrder, true, true>(lds, g, S, E); });
        RUNK(3, base + 3, { ph_gdn_intra(A, lds, l); });
        RUNK(4, base + 4, { if (bid < HB * 8 * 2) gdn_scan_unit(A, lds, bid >> 4, (bid >> 1) & 7, bid & 1); ph_attention(A, lds, l, half, it, dry); });
        RUNK(5, base + 5, { ph_gdn_post(A, l, dry); });
        RUNK(7, base + 7, {
            pg8::StaticOrder S; S.init(HR, 2048, G, bid); float* TOT = (float*)(ws + WS_TOT); bf16_t* Mo = (bf16_t*)(ws + WS_M);
            { pg8::Gemm g{P + C_QA, (const bf16_t*)(ws + WS_WPA), HR, 2048, 1024, LDP}; pg8::EpiMerge<0> E{P + C_G, LDP, TOT, Mo, 2048}; pg8::gemm_phase<pg8::EpiMerge<0>, pg8::StaticOrder, true, true>(lds, g, S, E); }
            { pg8::Gemm g{P + C_QD, (const bf16_t*)(ws + WS_WPB), HR, 2048, 1024, LDP}; pg8::EpiMerge<1> E{P + C_G + 2048, LDP, TOT, Mo, 2048}; pg8::gemm_phase<pg8::EpiMerge<1>, pg8::StaticOrder, true, true>(lds, g, S, E); }
            { pg8::Gemm g{P + C_Z, (const bf16_t*)(ws + WS_WPC), HR, 2048, 1024, LDP}; pg8::EpiMerge<2> E{P + C_G + 4096, LDP, TOT, Mo, 2048}; pg8::gemm_phase<pg8::EpiMerge<2>, pg8::StaticOrder, true, true>(lds, g, S, E); } });
        RUNK(8, base + 8, {
            pg8::Gemm g{(const bf16_t*)(ws + WS_M), (const bf16_t*)(ws + WS_WO), HR, 2048, 2048, 2048}; pg8::StaticOrder S; S.init(HR, 2048, G, bid);
            pg8::EpiF32 E{(float*)(ws + WS_OX), 2048}; pg8::gemm_phase<pg8::EpiF32, pg8::StaticOrder, true, true>(lds, g, S, E); });
        RUNK(9, base + 9, { ph_resln<true>(A, l, half, (const float*)(ws + WS_OX), 2, A.in[I_LN1G] + l * DM, A.in[I_LN1B] + l * DM, dry); });
        RUNK(10, base + 10, {
            pg8::Gemm g{H, (const bf16_t*)(ws + WS_WUP), HR, NUP, 2048, 2048}; pg8::StaticOrder S; S.init(HR, NUP, G, bid);
            pg8::EpiBf16 E{(bf16_t*)(ws + WS_U), NUP}; pg8::gemm_phase<pg8::EpiBf16, pg8::StaticOrder, true, true>(lds, g, S, E); });
        RUNK(11, base + 11, { ph_convact(A, l); });
        RUNK(12, base + 12, {
            pg8::Gemm g{(const bf16_t*)(ws + WS_ACT), (const bf16_t*)(ws + WS_WDN), HR, 2048, DFF, DFF}; pg8::StaticOrder S; S.init(HR, 2048, G, bid);
            pg8::EpiF32 E{(float*)(ws + WS_FX), 2048}; pg8::gemm_phase<pg8::EpiF32, pg8::StaticOrder, true, true>(lds, g, S, E); });
        RUNK(13, base + 13, { ph_resln<false>(A, l, half, (const float*)(ws + WS_FX), 5, A.in[I_LN2G] + l * DM, A.in[I_LN2B] + l * DM, dry); });
    }
#undef RUNK
}

#ifndef MK_ONE_LAUNCH
#define MK_ONE_LAUNCH 1
#endif
extern "C" void kernel_launch(void* const* d_in, const int* in_sizes, int n_in, void* d_out, int out_size, void* d_ws, size_t ws_size, hipStream_t stream) {
    static int grid = 0;
    if (grid == 0) {
        if (n_in != 29 || out_size != NBATCH * SEQ * DM || ws_size < WS_END) { fprintf(stderr, "kernel_launch: unexpected problem (n_in %d, out %d, ws %zu < %zu)\n", n_in, out_size, ws_size, (size_t)WS_END); grid = -1; return; }
        int dev = 0, cus = 0, per_cu = 0;
        if (hipGetDevice(&dev) != hipSuccess || hipDeviceGetAttribute(&cus, hipDeviceAttributeMultiprocessorCount, dev) != hipSuccess) { grid = -1; return; }
        if (hipFuncSetAttribute((const void*)fwd, hipFuncAttributeMaxDynamicSharedMemorySize, LDS_BYTES) != hipSuccess) { fprintf(stderr, "kernel_launch: hipFuncSetAttribute failed\n"); grid = -1; return; }
        if (hipOccupancyMaxActiveBlocksPerMultiprocessor(&per_cu, (const void*)fwd, NTHR, LDS_BYTES) != hipSuccess || per_cu < 1) fprintf(stderr, "kernel_launch: occupancy query reports %d\n", per_cu);
        (void)hipGetLastError();
        grid = cus > 256 ? 256 : cus;
    }
    if (grid < 0) return;
    (void)hipMemsetAsync((char*)d_ws + WS_CTL, 0, CTL_ZERO_BYTES, stream);
    Args a{};
    for (int i = 0; i < 29; ++i) a.in[i] = (const float*)d_in[i];
    a.out = (float*)d_out; a.ws = (unsigned char*)d_ws;
#if MK_ONE_LAUNCH
    a.ph_lo = 0; a.ph_hi = NPH;
    hipLaunchKernelGGL(fwd, dim3(grid), dim3(NTHR), LDS_BYTES, stream, a);
#else
    for (int id = 0; id < NPH; ++id) { if (phase_is_noop(id)) continue; a.ph_lo = id; a.ph_hi = id + 1; hipLaunchKernelGGL(fwd, dim3(grid), dim3(NTHR), LDS_BYTES, stream, a); }
#endif
}
```

```cpp
#include <hip/hip_runtime.h>
#include <cstdio>
#include <cstdint>
#include <cmath>
namespace pg8 {
#define PG8_LAS __attribute__((address_space(3)))
typedef unsigned short bf16_t;
typedef short bf16x8 __attribute__((ext_vector_type(8)));
typedef float f32x4 __attribute__((ext_vector_type(4)));
typedef unsigned u32x4 __attribute__((ext_vector_type(4)));
constexpr int BM = 256, BK = 64, HALF = 128, HTB = HALF * BK * 2  , STAGE_BYTES = 8 * HTB, NXCD = 8, WGM = 8;

__host__ __device__ __forceinline__ int lds_byte(int r, int c) { const int st = (r >> 4) * 2 + (c >> 5), rr = r & 15, cc = c & 31, ob = rr * 64 + cc * 2; return st * 1024 + (ob ^ (((ob >> 9) & 1) << 5)); }
__host__ __device__ __forceinline__ void stage_rc(int b, int& R, int& C) { const int st = b / 1024, sb = b % 1024, swz = sb ^ (((sb >> 9) & 1) << 5); R = (st >> 1) * 16 + swz / 64; C = (st & 1) * 32 + (swz % 64) / 2; }
__host__ __device__ __forceinline__ int perm32(int rho) { const int n = rho >> 4, i = rho & 15; return 8 * (i >> 2) + 4 * n + (i & 3); }

struct Unit { int pm, pn; };
struct Gemm { const bf16_t* A; const bf16_t* Bt; int M, N, K, lda; };

struct StaticOrder {
    int nM, nN, nwg, G, c;
    __host__ __device__ void init(int M, int N, int G_, int c_) { nM = M / BM; nN = N / BM; nwg = nM * nN; G = G_; c = c_; }
    __host__ __device__ bool next(int i, Unit& u) const {
        const long L = (long)i * G + c; if (L >= nwg) return false;
        int wgid = (int)L; { const int q = nwg / NXCD, r = nwg % NXCD, xcd = wgid % NXCD, off = wgid / NXCD; wgid = (xcd < r ? xcd * (q + 1) : r * (q + 1) + (xcd - r) * q) + off; }
        const int nig = WGM * nN, gid = wgid / nig, fm = gid * WGM, gsz = (nM - fm) < WGM ? (nM - fm) : WGM;
        u.pm = fm + ((wgid % nig) % gsz); u.pn = (wgid % nig) / gsz; return true;
    }
    __device__ __forceinline__ void a_ready(const Unit&) const {}
    __device__ __forceinline__ void done(const Unit&) const {}
};
struct LatentOrder : StaticOrder {
    __host__ __device__ void init(int N, int G_, int c_) { StaticOrder::init(64 * BM, N, G_, c_); }
    __host__ __device__ bool next(int i, Unit& u) const { if (!StaticOrder::next(i, u)) return false; u.pm += 1 + (u.pm >= 32 ? 1 : 0); return true; }
};


__device__ __forceinline__ unsigned cvt_pk_bf16(float lo, float hi) { unsigned r; asm volatile("v_cvt_pk_bf16_f32 %0, %1, %2" : "=v"(r) : "v"(lo), "v"(hi)); return r; }
__device__ __forceinline__ float bf_lo(unsigned w) { return __uint_as_float(w << 16); }
__device__ __forceinline__ float bf_hi(unsigned w) { return __uint_as_float(w & 0xffff0000u); }
__device__ __forceinline__ float sigm(float x) { return 1.0f / (1.0f + __expf(-x)); }

struct EpiF32 {
    static constexpr bool PERM = false, AFTER_DRAIN = false;
    float* C; int ldc;
    __device__ __forceinline__ void operator()(const f32x4 (&acc)[2][2][4][2], const Unit& u, int wr, int wc, int fr, int fq) const {
        const int row0 = u.pm * BM + wr * 64 + fr, col0 = u.pn * BM + wc * 32 + 4 * fq;
#pragma unroll
        for (int ai = 0; ai < 2; ++ai)
#pragma unroll
            for (int m = 0; m < 4; ++m) { float* rowp = C + (size_t)(row0 + ai * HALF + m * 16) * ldc + col0;
#pragma unroll
                for (int bj = 0; bj < 2; ++bj)
#pragma unroll
                    for (int n = 0; n < 2; ++n) *(f32x4*)(rowp + bj * HALF + n * 16) = acc[ai][bj][m][n]; }
    }
};
struct EpiBf16 {
    static constexpr bool PERM = true, AFTER_DRAIN = false;
    bf16_t* O; int ldc;
    __device__ __forceinline__ void operator()(const f32x4 (&acc)[2][2][4][2], const Unit& u, int wr, int wc, int fr, int fq) const {
        const int row0 = u.pm * BM + wr * 64 + fr, col0 = u.pn * BM + wc * 32 + 8 * fq;
#pragma unroll
        for (int ai = 0; ai < 2; ++ai)
#pragma unroll
            for (int m = 0; m < 4; ++m) { bf16_t* rowp = O + (size_t)(row0 + ai * HALF + m * 16) * ldc + col0;
#pragma unroll
                for (int bj = 0; bj < 2; ++bj) { const f32x4 v0 = acc[ai][bj][m][0], v1 = acc[ai][bj][m][1];
                    u32x4 w; w.x = cvt_pk_bf16(v0[0], v0[1]); w.y = cvt_pk_bf16(v0[2], v0[3]); w.z = cvt_pk_bf16(v1[0], v1[1]); w.w = cvt_pk_bf16(v1[2], v1[3]);
                    *(u32x4*)(rowp + bj * HALF) = w; } }
    }
};
template <int MODE> struct EpiMerge {
    static constexpr bool PERM = true, AFTER_DRAIN = false;
    const bf16_t* G; int ldg; float* TOT; bf16_t* Mo; int ldc;
    __device__ __forceinline__ void operator()(const f32x4 (&acc)[2][2][4][2], const Unit& u, int wr, int wc, int fr, int fq) const {
        asm volatile("" : "+v"(fr), "+v"(fq));
        const int row0 = u.pm * BM + wr * 64 + fr, col0 = u.pn * BM + wc * 32 + 8 * fq;
#pragma unroll
        for (int ai = 0; ai < 2; ++ai)
#pragma unroll
            for (int m = 0; m < 4; ++m) { const size_t row = (size_t)(row0 + ai * HALF + m * 16);
#pragma unroll
                for (int bj = 0; bj < 2; ++bj) { const int col = col0 + bj * HALF;
                    const u32x4 gw = *(const u32x4*)(G + row * ldg + col);
                    f32x4 g0 = (f32x4){bf_lo(gw.x), bf_hi(gw.x), bf_lo(gw.y), bf_hi(gw.y)}, g1 = (f32x4){bf_lo(gw.z), bf_hi(gw.z), bf_lo(gw.w), bf_hi(gw.w)};
                    f32x4 v0 = acc[ai][bj][m][0] * g0, v1 = acc[ai][bj][m][1] * g1;
                    float* tp = TOT + row * ldc + col;
                    if (MODE >= 1) { v0 += *(const f32x4*)tp; v1 += *(const f32x4*)(tp + 4); }
                    if (MODE <= 1) { *(f32x4*)tp = v0; *(f32x4*)(tp + 4) = v1; }
                    else { u32x4 w; w.x = cvt_pk_bf16(v0[0], v0[1]); w.y = cvt_pk_bf16(v0[2], v0[3]); w.z = cvt_pk_bf16(v1[0], v1[1]); w.w = cvt_pk_bf16(v1[2], v1[3]);
                        *(u32x4*)(Mo + row * ldc + col) = w; } }
                asm volatile("" ::: "memory"); }
    }
};
struct EpiInProj {
    static constexpr bool PERM = true, AFTER_DRAIN = false;
    bf16_t* P; int ldp; float* AB; const float* ropeA; const float* ropeD; const float* a_log; const float* dt_bias; float sA, sD;
    __device__ __forceinline__ void operator()(const f32x4 (&acc)[2][2][4][2], const Unit& u, int wr, int wc, int fr, int fq) const {
        asm volatile("" : "+v"(fr), "+v"(fq));
        const int pn = u.pn, tib = u.pm % 33; const bool is_ctx = (tib == 0);
        const int row0 = u.pm * BM + wr * 64 + fr, t0 = tib * 256 - 256 + wr * 64 + fr, cl = wc * 32 + 8 * fq;
        int type; float scale = 1.f;
        if (pn <= 3) { type = 1; scale = sA; } else if (pn == 4) type = 1; else if (pn == 5) type = 0; else if (pn <= 9) { type = 2; scale = sD; } else if (pn <= 13) type = 2;
        else if (pn <= 33) type = 0; else if (pn <= 57) type = 3; else type = 4;
        if (type == 4) {
            if (wc == 0) {
                const int c = 8 * fq;
#pragma unroll
                for (int ai = 0; ai < 2; ++ai)
#pragma unroll
                    for (int m = 0; m < 4; ++m) { const size_t row = (size_t)(row0 + ai * HALF + m * 16); f32x4 v0 = acc[ai][0][m][0], v1 = acc[ai][0][m][1]; float o[8] = {v0[0], v0[1], v0[2], v0[3], v1[0], v1[1], v1[2], v1[3]};
#pragma unroll
                        for (int k = 0; k < 8; ++k) { if (c < 16) { const float x = o[k] + dt_bias[c + k]; const float sp = fmaxf(x, 0.f) + log1pf(__expf(-fabsf(x))); o[k] = -__expf(a_log[c + k]) * sp; } else o[k] = sigm(o[k]); }
                        *(f32x4*)(AB + row * 32 + c) = (f32x4){o[0], o[1], o[2], o[3]}; *(f32x4*)(AB + row * 32 + c + 4) = (f32x4){o[4], o[5], o[6], o[7]}; }
            }
            return;
        }
#pragma unroll
        for (int ai = 0; ai < 2; ++ai)
#pragma unroll
            for (int m = 0; m < 4; ++m) { const size_t row = (size_t)(row0 + ai * HALF + m * 16); const int t = t0 + ai * HALF + m * 16;
#pragma unroll
                for (int bj = 0; bj < 2; ++bj) { const int c = cl + bj * HALF; f32x4 v0 = acc[ai][bj][m][0], v1 = acc[ai][bj][m][1];
                    if ((type == 1 || type == 2) && !is_ctx) {
                        const float* tab;
                        if (type == 1) { const int p0 = (c & 127) >> 1; const int pos = (p0 >= 32) ? (t & 63) : (t >> 6); tab = ropeA + (pos * 32 + (p0 & 31)) * 2; }
                        else { const int p0 = (c & 63) >> 1; const int pos = (p0 >= 16) ? (t & 63) : (t >> 6); tab = ropeD + (pos * 16 + (p0 & 15)) * 2; }
                        const f32x4 cs0 = *(const f32x4*)tab, cs1 = *(const f32x4*)(tab + 4);
                        f32x4 r0, r1;
                        r0[0] = v0[0] * cs0[0] - v0[1] * cs0[1]; r0[1] = v0[1] * cs0[0] + v0[0] * cs0[1]; r0[2] = v0[2] * cs0[2] - v0[3] * cs0[3]; r0[3] = v0[3] * cs0[2] + v0[2] * cs0[3];
                        r1[0] = v1[0] * cs1[0] - v1[1] * cs1[1]; r1[1] = v1[1] * cs1[0] + v1[0] * cs1[1]; r1[2] = v1[2] * cs1[2] - v1[3] * cs1[3]; r1[3] = v1[3] * cs1[2] + v1[2] * cs1[3];
                        v0 = r0; v1 = r1;
                    }
                    if (type == 3) {
#pragma unroll
                        for (int k = 0; k < 4; ++k) { v0[k] = sigm(v0[k]); v1[k] = sigm(v1[k]); } }
                    v0 = v0 * scale; v1 = v1 * scale;
                    u32x4 w; w.x = cvt_pk_bf16(v0[0], v0[1]); w.y = cvt_pk_bf16(v0[2], v0[3]); w.z = cvt_pk_bf16(v1[0], v1[1]); w.w = cvt_pk_bf16(v1[2], v1[3]);
                    *(u32x4*)(P + row * ldp + pn * BM + c) = w; }
                asm volatile("" ::: "memory"); }
    }
};

template <class Epi, class Sched, bool ALIGN_EPI = false, bool SP2 = false>
__device__ __forceinline__ void gemm_phase(PG8_LAS unsigned char* lds, const Gemm g, const Sched& S, const Epi& E) {
    int tid_ = threadIdx.x; asm volatile("" : "+v"(tid_));
    const int tid = tid_, wid = __builtin_amdgcn_readfirstlane(tid >> 6), lane = tid & 63, wr = wid >> 2, wc = wid & 3, fr = lane & 15, fq = lane >> 4;
    const int K = g.K, nt = K / BK;
    unsigned voffA[2], voffB[2];
#pragma unroll
    for (int i = 0; i < 2; ++i) { int R, C; stage_rc(tid * 16 + i * 8192, R, C); const int Rb = Epi::PERM ? ((R & ~31) + perm32(R & 31)) : R;
        voffA[i] = (unsigned)(R * g.lda + C) * 2u; voffB[i] = (unsigned)(Rb * K + C) * 2u; }
    const size_t kstep = (size_t)(BK * 2);
    const size_t hstepB = (size_t)HALF * K * 2, hstepA = (size_t)HALF * g.lda * 2;
    const size_t tstepA = 2 * hstepA, tstepB = 2 * hstepB;
    const unsigned ldsw = (unsigned)wid * 1024u;
    const int aoff = lds_byte(wr * 64 + fr, fq * 8), boff = lds_byte(wc * 32 + fr, fq * 8);
#define PG8_SA(b, h) (((b) * 2 + (h)) * HTB)
#define PG8_SB(b, h) ((4 + (b) * 2 + (h)) * HTB)
#define PG8_STAGE(bufoff, gbase, voff) do { _Pragma("unroll") for (int _i = 0; _i < 2; ++_i) \
        __builtin_amdgcn_global_load_lds((const unsigned*)((const char*)(gbase) + (voff)[_i]), (PG8_LAS unsigned*)(lds + (bufoff) + ldsw + _i * 8192), 16, 0, 0); } while (0)
#define PG8_LDA(dst, b, h) do { _Pragma("unroll") for (int m = 0; m < 4; ++m) _Pragma("unroll") for (int k = 0; k < 2; ++k) dst[m][k] = *(const PG8_LAS bf16x8*)(lds + PG8_SA(b, h) + aoff + m * 2048 + k * 1024); } while (0)
#define PG8_LDB(dst, b, h) do { _Pragma("unroll") for (int n = 0; n < 2; ++n) _Pragma("unroll") for (int k = 0; k < 2; ++k) dst[n][k] = *(const PG8_LAS bf16x8*)(lds + PG8_SB(b, h) + boff + n * 2048 + k * 1024); } while (0)
#define PG8_MMA(ai, bj, At, Bt) do { __builtin_amdgcn_s_setprio(1); _Pragma("unroll") for (int m = 0; m < 4; ++m) _Pragma("unroll") for (int n = 0; n < 2; ++n) _Pragma("unroll") for (int k = 0; k < 2; ++k) \
        acc[ai][bj][m][n] = __builtin_amdgcn_mfma_f32_16x16x32_bf16(Bt[n][k], At[m][k], acc[ai][bj][m][n], 0, 0, 0); __builtin_amdgcn_s_setprio(0); } while (0)
#define PG8_WAIT_V(n) asm volatile("s_waitcnt vmcnt(" #n ")" ::: "memory")
#define PG8_WAIT_L(n) asm volatile("s_waitcnt lgkmcnt(" #n ")" ::: "memory")
#define PG8_BAR __builtin_amdgcn_s_barrier()
#define PG8_SCHED __builtin_amdgcn_sched_barrier(0)
    Unit cur, nxt; int ui = 0;
    if (!S.next(0, cur)) return;
    f32x4 acc[2][2][4][2];
#pragma unroll
    for (int a = 0; a < 2; ++a)
#pragma unroll
        for (int b = 0; b < 2; ++b)
#pragma unroll
            for (int m = 0; m < 4; ++m)
#pragma unroll
                for (int n = 0; n < 2; ++n) acc[a][b][m][n] = (f32x4){0.f, 0.f, 0.f, 0.f};
    bf16x8 At[4][2], B0[2][2], B1[2][2];
    const char* cA = (const char*)g.A + (size_t)cur.pm * tstepA; const char* cB = (const char*)g.Bt + (size_t)cur.pn * tstepB;
    S.a_ready(cur);
    if constexpr (SP2) {
        PG8_STAGE(PG8_SB(0, 0), cB, voffB); PG8_STAGE(PG8_SB(0, 1), cB + hstepB, voffB); PG8_STAGE(PG8_SA(0, 0), cA, voffA); PG8_STAGE(PG8_SA(0, 1), cA + hstepA, voffA);
        if (wr == 1) PG8_BAR;
        PG8_WAIT_V(2); PG8_BAR;
        PG8_STAGE(PG8_SB(1, 0), cB + kstep, voffB); PG8_STAGE(PG8_SA(1, 0), cA + kstep, voffA); PG8_STAGE(PG8_SB(1, 1), cB + hstepB + kstep, voffB);
        PG8_WAIT_V(6); PG8_BAR;
    } else {
        PG8_STAGE(PG8_SB(0, 0), cB, voffB); PG8_STAGE(PG8_SA(0, 0), cA, voffA); PG8_STAGE(PG8_SB(0, 1), cB + hstepB, voffB); PG8_STAGE(PG8_SA(0, 1), cA + hstepA, voffA);
        if (wr == 1) PG8_BAR;
        PG8_WAIT_V(4); PG8_BAR;
        PG8_STAGE(PG8_SB(1, 0), cB + kstep, voffB); PG8_STAGE(PG8_SA(1, 0), cA + kstep, voffA); PG8_STAGE(PG8_SB(1, 1), cB + hstepB + kstep, voffB);
        PG8_WAIT_V(6); PG8_BAR;
    }
    for (;;) {
        const bool has_next = S.next(ui + 1, nxt);
        const char* nA = has_next ? (const char*)g.A + (size_t)nxt.pm * tstepA : cA; const char* nB = has_next ? (const char*)g.Bt + (size_t)nxt.pn * tstepB : cB;
        for (int t = 0; t < nt; t += 2) {
            const bool last = (t == nt - 2);
            const char* a1 = cA + (size_t)(t + 1) * kstep;
            const char* a2 = last ? nA : cA + (size_t)(t + 2) * kstep; const char* b2 = last ? nB : cB + (size_t)(t + 2) * kstep;
            const char* a3 = a2 + kstep; const char* b3 = b2 + kstep;
            if (last && has_next) S.a_ready(nxt);
            if constexpr (SP2) {
            PG8_LDB(B0, 0, 0); PG8_LDB(B1, 0, 1); PG8_SCHED; PG8_LDA(At, 0, 0); PG8_STAGE(PG8_SA(1, 1), a1 + hstepA, voffA);
            PG8_WAIT_V(8); PG8_WAIT_L(0); PG8_BAR; PG8_MMA(0, 0, At, B0); PG8_MMA(0, 1, At, B1); PG8_BAR; PG8_SCHED;
            PG8_LDA(At, 0, 1); PG8_STAGE(PG8_SB(0, 0), b2, voffB); PG8_STAGE(PG8_SB(0, 1), b2 + hstepB, voffB); PG8_STAGE(PG8_SA(0, 0), a2, voffA);
            PG8_WAIT_V(8); PG8_WAIT_L(0); PG8_BAR; PG8_MMA(1, 0, At, B0); PG8_MMA(1, 1, At, B1); PG8_BAR; PG8_SCHED;
            PG8_LDB(B0, 1, 0); PG8_LDB(B1, 1, 1); PG8_SCHED; PG8_LDA(At, 1, 0); PG8_STAGE(PG8_SA(0, 1), a2 + hstepA, voffA);
            PG8_WAIT_V(8); PG8_WAIT_L(0); PG8_BAR; PG8_MMA(0, 0, At, B0); PG8_MMA(0, 1, At, B1); PG8_BAR; PG8_SCHED;
            PG8_LDA(At, 1, 1); PG8_STAGE(PG8_SB(1, 0), b3, voffB); PG8_STAGE(PG8_SB(1, 1), b3 + hstepB, voffB); PG8_STAGE(PG8_SA(1, 0), a3, voffA);
            PG8_WAIT_V(8); PG8_WAIT_L(0); PG8_BAR; PG8_MMA(1, 0, At, B0); PG8_MMA(1, 1, At, B1); PG8_BAR; PG8_SCHED;
            } else {
            PG8_LDB(B0, 0, 0); PG8_SCHED; PG8_LDA(At, 0, 0); PG8_STAGE(PG8_SA(1, 1), a1 + hstepA, voffA);
            PG8_WAIT_L(8); PG8_BAR; PG8_WAIT_L(0); PG8_MMA(0, 0, At, B0); PG8_BAR; PG8_SCHED;
            PG8_LDB(B1, 0, 1); PG8_STAGE(PG8_SB(0, 0), b2, voffB);
            PG8_BAR; PG8_WAIT_L(0); PG8_MMA(0, 1, At, B1); PG8_BAR;
            PG8_LDA(At, 0, 1); PG8_STAGE(PG8_SA(0, 0), a2, voffA);
            PG8_BAR; PG8_WAIT_L(0); PG8_MMA(1, 0, At, B0); PG8_BAR; PG8_SCHED;
            PG8_STAGE(PG8_SB(0, 1), b2 + hstepB, voffB);
            PG8_WAIT_V(6); PG8_BAR; PG8_MMA(1, 1, At, B1); PG8_BAR;
            PG8_LDB(B0, 1, 0); PG8_SCHED; PG8_LDA(At, 1, 0); PG8_STAGE(PG8_SA(0, 1), a2 + hstepA, voffA);
            PG8_WAIT_L(8); PG8_BAR; PG8_WAIT_L(0); PG8_MMA(0, 0, At, B0); PG8_BAR; PG8_SCHED;
            PG8_LDB(B1, 1, 1); PG8_STAGE(PG8_SB(1, 0), b3, voffB);
            PG8_BAR; PG8_WAIT_L(0); PG8_MMA(0, 1, At, B1); PG8_BAR;
            PG8_LDA(At, 1, 1); PG8_STAGE(PG8_SA(1, 0), a3, voffA);
            PG8_BAR; PG8_WAIT_L(0); PG8_MMA(1, 0, At, B0); PG8_BAR; PG8_SCHED;
            PG8_STAGE(PG8_SB(1, 1), b3 + hstepB, voffB);
            PG8_WAIT_V(6); PG8_BAR; PG8_MMA(1, 1, At, B1); PG8_BAR;
            }
        }
        if constexpr (ALIGN_EPI) { if (wr == 0) PG8_BAR; }
        if constexpr (!Epi::AFTER_DRAIN) { E(acc, cur, wr, wc, fr, fq); S.done(cur); }
        if (!has_next) break;
#pragma unroll
        for (int a = 0; a < 2; ++a)
#pragma unroll
            for (int b = 0; b < 2; ++b)
#pragma unroll
                for (int m = 0; m < 4; ++m)
#pragma unroll
                    for (int n = 0; n < 2; ++n) acc[a][b][m][n] = (f32x4){0.f, 0.f, 0.f, 0.f};
        cur = nxt; cA = nA; cB = nB; ++ui;
        if constexpr (ALIGN_EPI) { if (wr == 1) PG8_BAR; }
    }
    PG8_WAIT_V(0);
    if constexpr (!ALIGN_EPI) { if (wr == 0) PG8_BAR; }
    PG8_BAR;
    if constexpr (Epi::AFTER_DRAIN) { E.fused(acc, cur, wr, wc, fr, fq, lds, wid, lane); S.done(cur); }
#undef PG8_SA
#undef PG8_SB
#undef PG8_STAGE
#undef PG8_LDA
#undef PG8_LDB
#undef PG8_MMA
#undef PG8_WAIT_V
#undef PG8_WAIT_L
#undef PG8_BAR
#undef PG8_SCHED
}
}

constexpr int DM = 2048, NBATCH = 4, SEQ = 8192, CTXL = 256, RB = CTXL + SEQ  , HB = 2  , HR = HB * RB  ;
constexpr int DFF = 5632, NUP = 2 * DFF, NMOD = 6 * DM, NCH = RB / 64  ;
constexpr int LDP = 14848;
constexpr int NWIN = 15104, INW = 14880;
constexpr int C_QA = 0, C_KA = 1024, C_VA = 1280, C_QD = 1536, C_KD = 2560, C_VD = 3584, C_QKV = 4608, C_Z = 7680, C_G = 8704;
constexpr float LN_EPS = 1e-6f, DN_ALPHA = 1.41421356237f  , LOG2E = 1.4426950408889634f;
constexpr int NWAVES = 8, NTHR = 512;
constexpr size_t MiB = 1u << 20;
constexpr size_t WS_CTL = 0, CTL_ZERO_BYTES = 1 * MiB;
constexpr size_t WS_MOD = 1 * MiB;
constexpr size_t WS_ROPEA = WS_MOD + 512 * 1024, WS_ROPED = WS_ROPEA + 32768, WS_LAM = WS_ROPED + 16384;
constexpr size_t WS_CX = 2 * MiB;
constexpr size_t WS_WIN = 10 * MiB, WS_WPA = 69 * MiB, WS_WPB = 73 * MiB, WS_WPC = 77 * MiB, WS_WO = 81 * MiB, WS_WUP = 89 * MiB, WS_WDN = 133 * MiB;
constexpr size_t WS_H = 155 * MiB;
constexpr size_t WS_AB = 221 * MiB;
constexpr size_t WS_GL = WS_AB + 5 * MiB / 2;
constexpr size_t WS_P = 224 * MiB;
constexpr size_t WS_G = 703 * MiB;
constexpr size_t GU_BYTES = 73728, GU_W = 0, GU_QG = 16384, GU_KD = 32768, GU_AT = 49152, GU_U = 57344;
constexpr size_t WS_END = WS_G + 297 * MiB;
constexpr size_t WS_TOT = WS_G, WS_M = WS_G + 132 * MiB, WS_OX = WS_P, WS_U = WS_P, WS_ACT = WS_G, WS_FX = WS_P;
static_assert((size_t)HR * LDP * 2 <= 479 * MiB && (size_t)4224 * GU_BYTES <= 297 * MiB && (size_t)HR * NUP * 2 <= 479 * MiB && (size_t)HR * DFF * 2 <= 297 * MiB, "d_ws map");
constexpr size_t WS_TRASH = 512 * 1024;
constexpr int CW_BAR = 4096, CW_Q = 16384;
constexpr int RING_BYTES = 131072, LDSCTL_OFF = RING_BYTES, LDS_BYTES = 147456;

#define GAS __attribute__((address_space(1)))
#define LAS __attribute__((address_space(3)))
typedef unsigned short bf16_t;
typedef short bf16x8 __attribute__((ext_vector_type(8)));
typedef short s16x4 __attribute__((ext_vector_type(4)));
typedef float f32x4 __attribute__((ext_vector_type(4)));
typedef float f32x2 __attribute__((ext_vector_type(2)));
typedef float f32x16 __attribute__((ext_vector_type(16)));
typedef unsigned u32x4 __attribute__((ext_vector_type(4)));
typedef unsigned u32x2 __attribute__((ext_vector_type(2)));
using pg8::cvt_pk_bf16; using pg8::bf_lo; using pg8::bf_hi; using pg8::sigm;
__device__ __forceinline__ float wave_sum(float v) {
#pragma unroll
    for (int o = 1; o < 64; o <<= 1) v += __shfl_xor(v, o);
    return v;
}
__device__ __forceinline__ int tid_opaque() { int t = threadIdx.x; asm volatile("" : "+v"(t)); return t; }
__device__ __forceinline__ float silu_f(float x) { return x / (1.0f + __expf(-x)); }
__device__ __forceinline__ int crow(int r, int hi) { return (r & 3) + 8 * (r >> 2) + 4 * hi; }
__device__ __forceinline__ bf16x8 pack8(float a0, float a1, float a2, float a3, float a4, float a5, float a6, float a7) {
    u32x4 w; w.x = cvt_pk_bf16(a0, a1); w.y = cvt_pk_bf16(a2, a3); w.z = cvt_pk_bf16(a4, a5); w.w = cvt_pk_bf16(a6, a7); return __builtin_bit_cast(bf16x8, w); }
typedef short v4i16_t __attribute__((ext_vector_type(4)));
__device__ __forceinline__ s16x4 lds_tr(LAS const unsigned char* p) { return __builtin_bit_cast(s16x4, __builtin_amdgcn_ds_read_tr16_b64_v4i16((LAS v4i16_t*)p)); }
#define MFMA32(a, b, c) __builtin_amdgcn_mfma_f32_32x32x16_bf16((a), (b), (c), 0, 0, 0)

#define XB_TMO      128
#define XB_XCNT(j)  (256  + 64 * (j))
#define XB_XSUB(j)  (1280 + 64 * (j))
#define XB_XGEN(j)  (2304 + 64 * (j))
#define XB_TOP      3328
#define XB_TOPGEN   3392
#define XCD_BAR_WORDS 3456
#define XB_SPIN_CAP (1u << 18)

__device__ __forceinline__ unsigned xb_ld(unsigned* p)              { return __hip_atomic_load(p, __ATOMIC_RELAXED, __HIP_MEMORY_SCOPE_AGENT); }
__device__ __forceinline__ unsigned xb_add(unsigned* p, unsigned v) { return __hip_atomic_fetch_add(p, v, __ATOMIC_RELAXED, __HIP_MEMORY_SCOPE_AGENT); }
__device__ __forceinline__ unsigned xb_xcc_id() { return (unsigned)__builtin_amdgcn_s_getreg((3 << 11) | 20) & 0xFu; }
#define XB_SPIN(cond, bar) do { unsigned _sp = 0; while (cond) { __builtin_amdgcn_s_sleep(1); \
    if ((++_sp & 255u) == 0u) { if (xb_ld(&(bar)[XB_TMO])) break; if (_sp > XB_SPIN_CAP) { atomicAdd(&(bar)[XB_TMO], 1u); break; } } } } while (0)

struct XcdBarrier {
    unsigned* bar; unsigned x;
    volatile LAS unsigned* st;
};

__device__ __forceinline__ XcdBarrier xcd_barrier_post(unsigned* bar, volatile LAS unsigned* st) {
    XcdBarrier b; b.bar = bar; b.x = xb_xcc_id(); b.st = st;
    if (threadIdx.x == 0) (void)xb_add(&bar[XB_XCNT(b.x)], 1u);
    return b;
}
__device__ __forceinline__ void xcd_barrier_complete(unsigned* bar, unsigned x, unsigned& nloc, unsigned& nx) {
    const unsigned G = gridDim.x * gridDim.y * gridDim.z;
    unsigned sum, cnt, mine, sp = 0u;
    for (;;) {
        sum = 0u; cnt = 0u; mine = 0u;
#pragma unroll
        for (unsigned j = 0; j < 16; ++j) { const unsigned c = xb_ld(&bar[XB_XCNT(j)]); sum += c; cnt += (c > 0u) ? 1u : 0u; mine = (j == x) ? c : mine; }
        if (sum == G) break;
        __builtin_amdgcn_s_sleep(1);
        if ((++sp & 255u) == 0u) { if (xb_ld(&bar[XB_TMO])) break; if (sp > XB_SPIN_CAP) { atomicAdd(&bar[XB_TMO], 1u); break; } }
    }
    nloc = mine > 0u ? mine : 1u; nx = cnt > 0u ? cnt : 1u;
}

__device__ __forceinline__ void xcd_barrier(const XcdBarrier& b) {
    asm volatile("s_waitcnt vmcnt(0)" ::: "memory");
    __syncthreads();
    if (threadIdx.x == 0) {
        unsigned* bar = b.bar;
        __builtin_amdgcn_s_waitcnt(0);
        unsigned nloc = b.st[0], nx = b.st[1];
        if (nloc == 0u) { xcd_barrier_complete(bar, b.x, nloc, nx); b.st[0] = nloc; b.st[1] = nx; }
        const unsigned old = xb_add(&bar[XB_XSUB(b.x)], 1u);
        const unsigned gen = old / nloc;
        if (old + 1u == (gen + 1u) * nloc) {
            __builtin_amdgcn_fence(__ATOMIC_RELEASE, "agent");
            asm volatile("s_waitcnt vmcnt(0)" ::: "memory");
            const unsigned og = xb_add(&bar[XB_TOP], 1u);
            const unsigned tg = og / nx;
            if (og + 1u == (tg + 1u) * nx) xb_add(&bar[XB_TOPGEN], 1u);
            else XB_SPIN(xb_ld(&bar[XB_TOPGEN]) == tg, bar);
            __builtin_amdgcn_fence(__ATOMIC_ACQUIRE, "agent");
            xb_add(&bar[XB_XGEN(b.x)], 1u);
            asm volatile("s_waitcnt vmcnt(0)" ::: "memory");
        } else {
            XB_SPIN(xb_ld(&bar[XB_XGEN(b.x)]) == gen, bar);
            __builtin_amdgcn_fence(__ATOMIC_ACQUIRE, "agent");
            asm volatile("s_waitcnt vmcnt(0)" ::: "memory");
        }
    }
    __syncthreads();
}
struct Args { const float* in[29]; float* out; unsigned char* ws; int ph_lo, ph_hi; };
enum { I_X = 0, I_C, I_CTX, I_CCTX, I_WMOD, I_BMOD, I_WIN, I_SINK, I_LQ1, I_LK1, I_LQ2, I_LK2, I_SUBLN, I_DNCONV, I_ALOG, I_DTB, I_DNNORM, I_WPA, I_WPB, I_WPC, I_WO, I_LN1G, I_LN1B, I_WUP, I_FCW, I_FCB, I_WDN, I_LN2G, I_LN2B };

__device__ __forceinline__ void ph_prologue(const Args& A, LAS unsigned char* lds) {
    const int tid = tid_opaque(), lane = tid & 63, wave = tid >> 6, G = gridDim.x, bid = blockIdx.x;
    const int gt = bid * NTHR + tid, NT = G * NTHR;
    float* ropeA = (float*)(A.ws + WS_ROPEA); float* ropeD = (float*)(A.ws + WS_ROPED); float* LAM = (float*)(A.ws + WS_LAM); float* MOD = (float*)(A.ws + WS_MOD);
    for (int e = gt; e < 128 * 32; e += NT) { const int pos = e >> 5, f = e & 31; const float inv = powf(10000.0f, -(float)(2 * f) / 64.0f); const float ang = (float)pos * inv; ropeA[2 * e] = cosf(ang); ropeA[2 * e + 1] = sinf(ang); }
    for (int e = gt; e < 128 * 16; e += NT) { const int pos = e >> 4, f = e & 15; const float inv = powf(10000.0f, -(float)(2 * f) / 32.0f); const float ang = (float)pos * inv; ropeD[2 * e] = cosf(ang); ropeD[2 * e + 1] = sinf(ang); }
    if (gt < 2) { const int l = gt; float s1 = 0.f, s2 = 0.f;
        for (int i = 0; i < 64; ++i) { s1 += A.in[I_LQ1][l * 64 + i] * A.in[I_LK1][l * 64 + i]; s2 += A.in[I_LQ2][l * 64 + i] * A.in[I_LK2][l * 64 + i]; }
        const float lam_init = 0.8f - 0.6f * expf(-0.3f * (float)l); LAM[2 * l] = expf(s1) - expf(s2) + lam_init; LAM[2 * l + 1] = 1.0f - lam_init; }
    LAS float* sc = (LAS float*)lds;
    LAS float* red = (LAS float*)(lds + 40960);
    for (int e = tid; e < 5 * 2048; e += NTHR) { const int idx = e >> 11, k = e & 2047; const float v = (idx < 4) ? A.in[I_C][idx * 2048 + k] : A.in[I_CCTX][k]; sc[e] = silu_f(v); }
    __syncthreads();
    for (int u = bid; u < 192; u += G) {
        const int l = u / 96, n0 = (u % 96) * 128;
        const float* W = A.in[I_WMOD] + (size_t)l * 2048 * NMOD + n0 + 2 * lane;
        float acc[5][2];
#pragma unroll
        for (int i = 0; i < 5; ++i) { acc[i][0] = 0.f; acc[i][1] = 0.f; }
        const int k0 = wave * 256;
#pragma unroll 4
        for (int k = k0; k < k0 + 256; ++k) { const f32x2 w = *(const f32x2*)(W + (size_t)k * NMOD);
#pragma unroll
            for (int i = 0; i < 5; ++i) { const float s = sc[i * 2048 + k]; acc[i][0] += s * w.x; acc[i][1] += s * w.y; } }
#pragma unroll
        for (int i = 0; i < 5; ++i) { red[(wave * 5 + i) * 128 + 2 * lane] = acc[i][0]; red[(wave * 5 + i) * 128 + 2 * lane + 1] = acc[i][1]; }
        __syncthreads();
        for (int e = tid; e < 640; e += NTHR) { const int idx = e >> 7, n = e & 127; float s = 0.f;
#pragma unroll
            for (int w = 0; w < 8; ++w) s += red[(w * 5 + idx) * 128 + n];
            MOD[(size_t)(l * 5 + idx) * NMOD + n0 + n] = s + A.in[I_BMOD][l * NMOD + n0 + n]; }
        __syncthreads();
    }
}
__device__ __forceinline__ int win_src(int n) {
    if (n < 1280) { const int j = n & 127, p = j >> 1, s = j & 1; const int dim = (p < 32) ? (s * 32 + p) : (64 + s * 32 + (p - 32)); return (n & ~127) + dim; }
    if (n < 1536) return n;
    if (n < 3584) { const int j = n & 63, p = j >> 1, s = j & 1; const int dim = (p < 16) ? (s * 16 + p) : (32 + s * 16 + (p - 16)); return (n & ~63) + dim; }
    if (n < 8704) return n;
    if (n < 14848) return n + 32;
    if (n < 14880) return n - 14848 + 8704;
    return -1;
}
template <int MODE> __device__ __forceinline__ void transpose_item(const float* W, int K, int N, bf16_t* WT, LAS float* scr, int kb, int nb, int lane) {
    const int k0 = 64 * kb, n0 = 32 * nb, nn = n0 + (lane & 31);
    const int sc = (MODE == 1) ? win_src(nn) : nn;
    const float* src = W + (size_t)(k0 + (lane >> 5)) * N + (sc >= 0 ? sc : 0);
#pragma unroll 8
    for (int i = 0; i < 32; ++i) { const float v = src[(size_t)(2 * i) * N]; scr[(2 * i + (lane >> 5)) * 33 + (lane & 31)] = (sc >= 0) ? v : 0.f; }
    asm volatile("s_waitcnt lgkmcnt(0)" ::: "memory");
    const int c = lane & 7;
#pragma unroll
    for (int j = 0; j < 4; ++j) { const int n = (lane >> 3) + 8 * j; const LAS float* s = scr + (8 * c) * 33 + n;
        u32x4 o; o.x = cvt_pk_bf16(s[0 * 33], s[1 * 33]); o.y = cvt_pk_bf16(s[2 * 33], s[3 * 33]); o.z = cvt_pk_bf16(s[4 * 33], s[5 * 33]); o.w = cvt_pk_bf16(s[6 * 33], s[7 * 33]);
        *(u32x4*)(WT + (size_t)(n0 + n) * K + k0 + 8 * c) = o; }
    asm volatile("s_waitcnt lgkmcnt(0)" ::: "memory");
}
__device__ __forceinline__ void ph_weights(const Args& A, LAS unsigned char* lds, int l) {
    const int tid = tid_opaque(), lane = tid & 63, wave = tid >> 6, G = gridDim.x, bid = blockIdx.x;
    LAS float* scr = (LAS float*)(lds + wave * 8448);
    unsigned char* ws = A.ws;
    constexpr int I0 = 32 * 472, I1 = 16 * 64, I2 = 32 * 64, I3 = 32 * 352, I4 = 88 * 64, NIT = I0 + 3 * I1 + I2 + I3 + I4;
    for (int it = bid * NWAVES + wave; it < NIT; it += G * NWAVES) {
        int r = it;
        if (r < I0) { transpose_item<1>(A.in[I_WIN] + (size_t)l * 2048 * INW, 2048, INW, (bf16_t*)(ws + WS_WIN), scr, r / 472, r % 472, lane); continue; } r -= I0;
        if (r < I1) { transpose_item<0>(A.in[I_WPA] + (size_t)l * 1024 * 2048, 1024, 2048, (bf16_t*)(ws + WS_WPA), scr, r / 64, r % 64, lane); continue; } r -= I1;
        if (r < I1) { transpose_item<0>(A.in[I_WPB] + (size_t)l * 1024 * 2048, 1024, 2048, (bf16_t*)(ws + WS_WPB), scr, r / 64, r % 64, lane); continue; } r -= I1;
        if (r < I1) { transpose_item<0>(A.in[I_WPC] + (size_t)l * 1024 * 2048, 1024, 2048, (bf16_t*)(ws + WS_WPC), scr, r / 64, r % 64, lane); continue; } r -= I1;
        if (r < I2) { transpose_item<0>(A.in[I_WO] + (size_t)l * 2048 * 2048, 2048, 2048, (bf16_t*)(ws + WS_WO), scr, r / 64, r % 64, lane); continue; } r -= I2;
        if (r < I3) { transpose_item<0>(A.in[I_WUP] + (size_t)l * 2048 * NUP, 2048, NUP, (bf16_t*)(ws + WS_WUP), scr, r / 352, r % 352, lane); continue; } r -= I3;
        transpose_item<0>(A.in[I_WDN] + (size_t)l * DFF * 2048, DFF, 2048, (bf16_t*)(ws + WS_WDN), scr, r / 64, r % 64, lane);
    }
}
__device__ __forceinline__ void row_src(const Args& A, int l, int half, int r, const float*& src, float*& dst, const float*& mod, bool& is_ctx) {
    const int bl = r / RB, tp = r - bl * RB, b = half * HB + bl; is_ctx = tp < CTXL;
    float* cx = (float*)(A.ws + WS_CX);
    dst = is_ctx ? cx + (size_t)(b * CTXL + tp) * DM : A.out + (size_t)(b * SEQ + tp - CTXL) * DM;
    if (l == 0) src = is_ctx ? A.in[I_CTX] + (size_t)(b * CTXL + tp) * DM : A.in[I_X] + (size_t)(b * SEQ + tp - CTXL) * DM; else src = dst;
    mod = (const float*)(A.ws + WS_MOD) + (size_t)(l * 5 + (is_ctx ? 4 : b)) * NMOD;
}
__device__ __forceinline__ void ln_stats(const f32x4 (&v)[8], float& mean, float& rstd) {
    float s = 0.f;
#pragma unroll
    for (int j = 0; j < 8; ++j) s += (v[j].x + v[j].y) + (v[j].z + v[j].w);
    mean = wave_sum(s) * (1.0f / DM); float q = 0.f;
#pragma unroll
    for (int j = 0; j < 8; ++j) { const f32x4 d = v[j] - mean; q += (d.x * d.x + d.y * d.y) + (d.z * d.z + d.w * d.w); }
    rstd = 1.0f / sqrtf(wave_sum(q) * (1.0f / DM) + LN_EPS);
}
__device__ __forceinline__ void ada_store(const f32x4 (&v)[8], float mean, float rstd, const float* shift, const float* scale, bf16_t* hrow, int lane) {
#pragma unroll
    for (int j = 0; j < 8; ++j) { const int e = (64 * j + lane) * 4; const f32x4 sh = *(const f32x4*)(shift + e), sc = *(const f32x4*)(scale + e);
        const f32x4 y = (v[j] - mean) * rstd * (sc + 1.0f) + sh; u32x2 w; w.x = cvt_pk_bf16(y.x, y.y); w.y = cvt_pk_bf16(y.z, y.w); *(u32x2*)(hrow + e) = w; }
}
__device__ __forceinline__ void ph_adaln(const Args& A, int l, int half) {
    const int tid = tid_opaque(), lane = tid & 63, gw = blockIdx.x * NWAVES + (tid >> 6), NGW = gridDim.x * NWAVES;
    bf16_t* H = (bf16_t*)(A.ws + WS_H);
    for (int r = gw; r < HR; r += NGW) {
        const float* src; float* dst; const float* mod; bool is_ctx; row_src(A, l, half, r, src, dst, mod, is_ctx);
        f32x4 v[8];
#pragma unroll
        for (int j = 0; j < 8; ++j) v[j] = *((const f32x4*)src + 64 * j + lane);
        float mean, rstd; ln_stats(v, mean, rstd);
        ada_store(v, mean, rstd, mod, mod + DM, H + (size_t)r * DM, lane);
    }
}
template <bool WITH_H> __device__ __forceinline__ void ph_resln(const Args& A, int l, int half, const float* Y, int gate_idx, const float* lng, const float* lnb, bool dry) {
    const int tid = tid_opaque(), lane = tid & 63, gw = blockIdx.x * NWAVES + (tid >> 6), NGW = gridDim.x * NWAVES;
    bf16_t* H = (bf16_t*)(A.ws + WS_H);
    for (int r = gw; r < HR; r += NGW) {
        const float* src; float* dst; const float* mod; bool is_ctx; row_src(A, l, half, r, src, dst, mod, is_ctx);
        if (is_ctx && l == 1) continue;
        if (!WITH_H) src = dst;
        if (dry) dst = (float*)(A.ws + WS_TRASH) + (tid >> 6) * DM;
        const float* gate = mod + gate_idx * DM; const float* yrow = Y + (size_t)r * DM;
        f32x4 v[8];
#pragma unroll
        for (int j = 0; j < 8; ++j) { const int e = 64 * j + lane; v[j] = *((const f32x4*)src + e) * DN_ALPHA + *((const f32x4*)gate + e) * *((const f32x4*)yrow + e); }
        float mean, rstd; ln_stats(v, mean, rstd);
#pragma unroll
        for (int j = 0; j < 8; ++j) { const int e = 64 * j + lane; v[j] = (v[j] - mean) * rstd * *((const f32x4*)lng + e) + *((const f32x4*)lnb + e); *((f32x4*)dst + e) = v[j]; }
        if (WITH_H) { ln_stats(v, mean, rstd); ada_store(v, mean, rstd, mod + 3 * DM, mod + 4 * DM, dry ? (bf16_t*)(A.ws + WS_TRASH) + 131072 + (tid >> 6) * DM : H + (size_t)r * DM, lane); }
    }
}
__device__ __forceinline__ void ph_convact(const Args& A, int l) {
    const int gt = blockIdx.x * NTHR + tid_opaque(), NT = gridDim.x * NTHR;
    const bf16_t* U = (const bf16_t*)(A.ws + WS_U); bf16_t* ACT = (bf16_t*)(A.ws + WS_ACT);
    const float* cw = A.in[I_FCW] + (size_t)l * 3 * NUP; const float* cb = A.in[I_FCB] + (size_t)l * NUP;
    constexpr int NVC = DFF / 8, NRB = HR / 32;
    for (int idx = gt; idx < NRB * NVC; idx += NT) {
        const int rbk = idx / NVC, vc = idx - rbk * NVC, r0 = rbk * 32, tp0 = r0 % RB;
        const bool first_start = (tp0 == 0 || tp0 == CTXL), last_end = (tp0 + 31 == CTXL - 1 || tp0 + 31 == RB - 1);
        const int ca = vc * 8, cbk = DFF + vc * 8;
        float wa[3][8], wb[3][8], ba[8], bb[8];
#pragma unroll
        for (int t = 0; t < 3; ++t) {
#pragma unroll
            for (int k = 0; k < 8; ++k) { wa[t][k] = cw[t * NUP + ca + k]; wb[t][k] = cw[t * NUP + cbk + k]; } }
#pragma unroll
        for (int k = 0; k < 8; ++k) { ba[k] = cb[ca + k]; bb[k] = cb[cbk + k]; }
        const u32x4 z4 = (u32x4){0u, 0u, 0u, 0u};
        u32x4 pa = z4, pb = z4, qa, qb, na, nb;
        if (!first_start) { pa = *(const u32x4*)(U + (size_t)(r0 - 1) * NUP + ca); pb = *(const u32x4*)(U + (size_t)(r0 - 1) * NUP + cbk); }
        qa = *(const u32x4*)(U + (size_t)r0 * NUP + ca); qb = *(const u32x4*)(U + (size_t)r0 * NUP + cbk);
        for (int r = 0; r < 32; ++r) {
            if (r == 31 && last_end) { na = z4; nb = z4; } else { na = *(const u32x4*)(U + (size_t)(r0 + r + 1) * NUP + ca); nb = *(const u32x4*)(U + (size_t)(r0 + r + 1) * NUP + cbk); }
            float o[8];
#pragma unroll
            for (int k = 0; k < 4; ++k) {
                const unsigned a0 = pa[k], a1 = qa[k], a2 = na[k], b0 = pb[k], b1 = qb[k], b2 = nb[k];
                const float xa0 = wa[0][2 * k] * bf_lo(a0) + wa[1][2 * k] * bf_lo(a1) + wa[2][2 * k] * bf_lo(a2) + ba[2 * k];
                const float xa1 = wa[0][2 * k + 1] * bf_hi(a0) + wa[1][2 * k + 1] * bf_hi(a1) + wa[2][2 * k + 1] * bf_hi(a2) + ba[2 * k + 1];
                const float xb0 = wb[0][2 * k] * bf_lo(b0) + wb[1][2 * k] * bf_lo(b1) + wb[2][2 * k] * bf_lo(b2) + bb[2 * k];
                const float xb1 = wb[0][2 * k + 1] * bf_hi(b0) + wb[1][2 * k + 1] * bf_hi(b1) + wb[2][2 * k + 1] * bf_hi(b2) + bb[2 * k + 1];
                o[2 * k] = silu_f(xa0) * xb0; o[2 * k + 1] = silu_f(xa1) * xb1; }
            u32x4 w; w.x = cvt_pk_bf16(o[0], o[1]); w.y = cvt_pk_bf16(o[2], o[3]); w.z = cvt_pk_bf16(o[4], o[5]); w.w = cvt_pk_bf16(o[6], o[7]);
            *(u32x4*)(ACT + (size_t)(r0 + r) * DFF + vc * 8) = w;
            pa = qa; pb = qb; qa = na; qb = nb;
        }
    }
}
__device__ __forceinline__ float max3f(float a, float b, float c) { float r; asm("v_max3_f32 %0, %1, %2, %3" : "=v"(r) : "v"(a), "v"(b), "v"(c)); return r; }
__device__ __forceinline__ float xhalf_max(float m) { auto rr = __builtin_amdgcn_permlane32_swap(__float_as_uint(m), __float_as_uint(m), false, false); float r; asm("v_max_f32_e32 %0, %1, %2" : "=v"(r) : "v"(__uint_as_float(rr[0])), "v"(__uint_as_float(rr[1]))); return r; }
__device__ __forceinline__ float xhalf_sum(float m) { auto rr = __builtin_amdgcn_permlane32_swap(__float_as_uint(m), __float_as_uint(m), false, false); return __uint_as_float(rr[0]) + __uint_as_float(rr[1]); }
template <int DQK>
__device__ __forceinline__ void attn_core(LAS unsigned char* lds, const bf16_t* Qrow, int kc0, const bf16_t* K0, const bf16_t* V0, int n0, const bf16_t* K1, const bf16_t* V1, int n1,
                                          bool mask1, int qpos, int k1pos0, f32x16 (&oT)[4], float& mref, float& lsum) {
    const int tid = tid_opaque(), lane = tid & 63, r32 = lane & 31, hi = lane >> 5, wave = __builtin_amdgcn_readfirstlane(tid >> 6);
    bf16x8 qf[DQK / 16];
#pragma unroll
    for (int d0 = 0; d0 < DQK / 16; ++d0) qf[d0] = *(const bf16x8*)(Qrow + d0 * 16 + hi * 8);
    const int c0 = 2 * wave, c1 = 2 * wave + 1;
    const size_t kg0 = (size_t)(lane ^ c0) * LDP + c0 * 8, kg1 = (size_t)(lane ^ c1) * LDP + c1 * 8;
    const size_t vg0 = (size_t)(16 * (c0 & 3) + (lane >> 2)) * LDP + (4 * (c0 >> 2) + (lane & 3)) * 8, vg1 = (size_t)(16 * (c1 & 3) + (lane >> 2)) * LDP + (4 * (c1 >> 2) + (lane & 3)) * 8;
    const int vd0 = 32768 + ((c0 >> 2) * 8 + 2 * (c0 & 3)) * 512, vd1 = 32768 + ((c1 >> 2) * 8 + 2 * (c1 & 3)) * 512;
#define AT_DMA_K(t, b) do { const bf16_t* kp_ = ((t) < n0) ? K0 + (size_t)(t) * 64 * LDP : K1 + (size_t)((t) - n0) * 64 * LDP; \
        __builtin_amdgcn_global_load_lds((const unsigned*)(kp_ + kg0), (LAS unsigned*)(lds + (b) * 16384 + c0 * 1024), 16, 0, 0); \
        __builtin_amdgcn_global_load_lds((const unsigned*)(kp_ + kg1), (LAS unsigned*)(lds + (b) * 16384 + c1 * 1024), 16, 0, 0); } while (0)
#define AT_DMA_V(t, b) do { const bf16_t* vp_ = ((t) < n0) ? V0 + (size_t)(t) * 64 * LDP : V1 + (size_t)((t) - n0) * 64 * LDP; \
        __builtin_amdgcn_global_load_lds((const unsigned*)(vp_ + vg0), (LAS unsigned*)(lds + (b) * 16384 + vd0), 16, 0, 0); \
        __builtin_amdgcn_global_load_lds((const unsigned*)(vp_ + vg1), (LAS unsigned*)(lds + (b) * 16384 + vd1), 16, 0, 0); } while (0)
    const int nt = n0 + n1;
    const int vbase = 32768 + (4 * hi + ((lane & 15) >> 2)) * 64 + ((lane >> 4) & 1) * 32 + (lane & 3) * 8;
#define AT_KLD(kb) do { kbo = (kb); if (DQK == 64) { _Pragma("unroll") for (int d0 = 0; d0 < 4; ++d0) { const int c_ = (kc0 >> 3) + 2 * d0 + hi; const int off_ = kbo + c_ * 1024 + ((r32 ^ c_) << 4); \
            kf[2 * d0] = *(LAS const bf16x8*)(lds + off_); kf[2 * d0 + 1] = *(LAS const bf16x8*)(lds + off_ + 512); } } } while (0)
#define AT_QK(P0, P1) do { _Pragma("unroll") for (int r_ = 0; r_ < 16; ++r_) { P0[r_] = 0.f; P1[r_] = 0.f; } \
        if (DQK == 64) { _Pragma("unroll") for (int d0 = 0; d0 < 4; ++d0) { P0 = MFMA32(kf[2 * d0], qf[d0], P0); P1 = MFMA32(kf[2 * d0 + 1], qf[d0], P1); } } \
        else { _Pragma("unroll") for (int d0 = 0; d0 < DQK / 16; ++d0) { const int c_ = (kc0 >> 3) + 2 * d0 + hi; const int off_ = kbo + c_ * 1024 + ((r32 ^ c_) << 4); \
            const bf16x8 a0_ = *(LAS const bf16x8*)(lds + off_), a1_ = *(LAS const bf16x8*)(lds + off_ + 512); P0 = MFMA32(a0_, qf[d0], P0); P1 = MFMA32(a1_, qf[d0], P1); } } } while (0)
    bf16x8 kf[8]; int kbo = 0;
    f32x16 pc0, pc1;
    AT_DMA_K(0, 0); AT_DMA_V(0, 0); if (nt > 1) AT_DMA_K(1, 1);
    asm volatile("s_waitcnt vmcnt(0)" ::: "memory"); __syncthreads();
    AT_KLD(0); AT_QK(pc0, pc1);
    __syncthreads();
    for (int t = 0; t < nt; ++t) {
        const int b = t & 1; const bool more1 = (t + 1 < nt), more2 = (t + 2 < nt);
        if (more2) AT_DMA_K(t + 2, b);
        if (more1) AT_DMA_V(t + 1, b ^ 1);
        if (more1) { AT_KLD((b ^ 1) * 16384); }
        if (mask1 && t >= n0) { const int kb = k1pos0 + (t - n0) * 64 + 4 * hi - qpos;
#pragma unroll
            for (int r = 0; r < 16; ++r) { const int dl = kb + (r & 3) + 8 * (r >> 2); if (dl > 128 || dl < -128) pc0[r] = -INFINITY; if (dl + 32 > 128 || dl + 32 < -128) pc1[r] = -INFINITY; } }
        float tm = max3f(pc0[0], pc1[0], pc0[1]), tm2 = max3f(pc1[1], pc0[2], pc1[2]);
#pragma unroll
        for (int r = 3; r < 15; r += 2) { tm = max3f(tm, pc0[r], pc1[r]); tm2 = max3f(tm2, pc0[r + 1], pc1[r + 1]); }
        tm = max3f(tm, pc0[15], pc1[15]); tm = max3f(tm, tm2, tm2);
        tm = xhalf_max(tm);
        if (__any(tm > mref + 8.0f)) { const float mn = fmaxf(mref, tm); const float al = __builtin_amdgcn_exp2f(mref - mn);
#pragma unroll
            for (int q = 0; q < 4; ++q) oT[q] = oT[q] * al;
            lsum *= al; mref = mn; }
        float rs = 0.f;
#pragma unroll
        for (int r = 0; r < 16; ++r) { pc0[r] = __builtin_amdgcn_exp2f(pc0[r] - mref); pc1[r] = __builtin_amdgcn_exp2f(pc1[r] - mref); rs += pc0[r] + pc1[r]; }
        lsum += rs;
        bf16x8 pw[4];
        pw[0] = pack8(pc0[0], pc0[1], pc0[2], pc0[3], pc0[4], pc0[5], pc0[6], pc0[7]); pw[1] = pack8(pc0[8], pc0[9], pc0[10], pc0[11], pc0[12], pc0[13], pc0[14], pc0[15]);
        pw[2] = pack8(pc1[0], pc1[1], pc1[2], pc1[3], pc1[4], pc1[5], pc1[6], pc1[7]); pw[3] = pack8(pc1[8], pc1[9], pc1[10], pc1[11], pc1[12], pc1[13], pc1[14], pc1[15]);
        LAS const unsigned char* vt = lds + b * 16384 + vbase;
        s16x4 va[4], vc[4];
#define AT_VRD(dst, g) do { LAS const unsigned char* p_ = vt + (((g) >> 1) * 8 + 4 * ((g) & 1)) * 512; dst[0] = lds_tr(p_); dst[1] = lds_tr(p_ + 512); dst[2] = lds_tr(p_ + 1024); dst[3] = lds_tr(p_ + 1536); } while (0)
#define AT_PV(src, g) do { oT[(g) >> 1] = MFMA32(((bf16x8){src[0][0], src[0][1], src[0][2], src[0][3], src[1][0], src[1][1], src[1][2], src[1][3]}), pw[2 * ((g) & 1)], oT[(g) >> 1]); \
        oT[(g) >> 1] = MFMA32(((bf16x8){src[2][0], src[2][1], src[2][2], src[2][3], src[3][0], src[3][1], src[3][2], src[3][3]}), pw[2 * ((g) & 1) + 1], oT[(g) >> 1]); } while (0)
        AT_VRD(va, 0);
        if (more1) { AT_QK(pc0, pc1); }
        __builtin_amdgcn_sched_barrier(0);
        AT_VRD(vc, 1); __builtin_amdgcn_sched_barrier(0); AT_PV(va, 0); __builtin_amdgcn_sched_barrier(0);
        AT_VRD(va, 2); __builtin_amdgcn_sched_barrier(0); AT_PV(vc, 1); __builtin_amdgcn_sched_barrier(0);
        AT_VRD(vc, 3); __builtin_amdgcn_sched_barrier(0); AT_PV(va, 2); __builtin_amdgcn_sched_barrier(0);
        AT_VRD(va, 4); __builtin_amdgcn_sched_barrier(0); AT_PV(vc, 3); __builtin_amdgcn_sched_barrier(0);
        AT_VRD(vc, 5); __builtin_amdgcn_sched_barrier(0); AT_PV(va, 4); __builtin_amdgcn_sched_barrier(0);
        AT_VRD(va, 6); __builtin_amdgcn_sched_barrier(0); AT_PV(vc, 5); __builtin_amdgcn_sched_barrier(0);
        AT_VRD(vc, 7); __builtin_amdgcn_sched_barrier(0); AT_PV(va, 6); __builtin_amdgcn_sched_barrier(0);
        AT_PV(vc, 7);
#undef AT_VRD
#undef AT_PV
        asm volatile("s_waitcnt vmcnt(0)" ::: "memory");
        __syncthreads();
    }
#undef AT_DMA_K
#undef AT_DMA_V
#undef AT_QK
#undef AT_KLD
}
__device__ __forceinline__ void attn_store(bf16_t* orow, const f32x16 (&o)[4], int hi) {
#pragma unroll
    for (int q = 0; q < 4; ++q)
#pragma unroll
        for (int g = 0; g < 4; ++g) { u32x2 w; w.x = cvt_pk_bf16(o[q][4 * g], o[q][4 * g + 1]); w.y = cvt_pk_bf16(o[q][4 * g + 2], o[q][4 * g + 3]); *(u32x2*)(orow + 32 * q + 8 * g + 4 * hi) = w; }
}
__device__ __forceinline__ void attnA_unit(const Args& A, LAS unsigned char* lds, int l, int bl, int nb, int pr, bool ctxq, bool dry) {
    const int tid = tid_opaque(), lane = tid & 63, r32 = lane & 31, hi = lane >> 5, wave = __builtin_amdgcn_readfirstlane(tid >> 6);
    bf16_t* P = (bf16_t*)(A.ws + WS_P);
    const int head = 2 * pr + (wave >> 2), kvh = pr >> 1, qloc = nb * 128 + 32 * (wave & 3) + r32;
    const size_t brow = (size_t)bl * RB;
    const size_t qrow = brow + (ctxq ? 0 : CTXL) + qloc;
    const bf16_t* Kc = P + brow * LDP + C_KA + kvh * 128; const bf16_t* Vc = P + brow * LDP + C_VA + kvh * 128;
    int ks = 128 * (nb - 1), ke = 128 * (nb + 2); if (ks < 0) ks = 0; if (ke > SEQ) ke = SEQ;
    const int n1 = ctxq ? 0 : (ke - ks) / 64;
    f32x16 oT[4];
#pragma unroll
    for (int q = 0; q < 4; ++q)
#pragma unroll
        for (int r = 0; r < 16; ++r) oT[q][r] = 0.f;
    float mref = -INFINITY, lsum = 0.f;
    attn_core<128>(lds, P + qrow * LDP + C_QA + head * 128, 0, Kc, Vc, 4, Kc + (size_t)(CTXL + ks) * LDP, Vc + (size_t)(CTXL + ks) * LDP, n1, true, qloc, ks, oT, mref, lsum);
    const float sk = A.in[I_SINK][l * 8 + head] * LOG2E;
    const float mf = fmaxf(mref, sk), sc = __builtin_amdgcn_exp2f(mref - mf);
    lsum = xhalf_sum(lsum);
    const float f = sc / (lsum * sc + __builtin_amdgcn_exp2f(sk - mf));
#pragma unroll
    for (int q = 0; q < 4; ++q) oT[q] = oT[q] * f;
    attn_store(dry ? (bf16_t*)(A.ws + WS_TRASH) + tid * 128 : P + qrow * LDP + C_QA + head * 128, oT, hi);
}
__device__ __forceinline__ void attnB_unit(const Args& A, LAS unsigned char* lds, int l, int bl, int h, int qb, bool ctxq, bool dry) {
    const int tid = tid_opaque(), lane = tid & 63, r32 = lane & 31, hi = lane >> 5, wave = __builtin_amdgcn_readfirstlane(tid >> 6);
    bf16_t* P = (bf16_t*)(A.ws + WS_P);
    const int sub = wave >> 2;
    const size_t brow = (size_t)bl * RB;
    const size_t qrow = brow + (ctxq ? 0 : CTXL) + qb * 128 + 32 * (wave & 3) + r32;
    const bf16_t* Kc = P + brow * LDP + C_KD + h * 128; const bf16_t* Vc = P + brow * LDP + C_VD + h * 128;
    f32x16 oT[4];
#pragma unroll
    for (int q = 0; q < 4; ++q)
#pragma unroll
        for (int r = 0; r < 16; ++r) oT[q][r] = 0.f;
    float mref = -INFINITY, lsum = 0.f;
    attn_core<64>(lds, P + qrow * LDP + C_QD + h * 128 + sub * 64, sub * 64, Kc, Vc, ctxq ? 4 : NCH, Kc, Vc, 0, false, 0, 0, oT, mref, lsum);
    lsum = xhalf_sum(lsum);
    const float inv = 1.0f / lsum;
    LAS float* xch = (LAS float*)lds + (wave & 3) * 4096;
    if (sub == 1) {
#pragma unroll
        for (int q = 0; q < 4; ++q)
#pragma unroll
            for (int r = 0; r < 16; ++r) xch[(q * 16 + r) * 64 + lane] = oT[q][r] * inv;
    }
    __syncthreads();
    if (sub == 0) {
        const float lam = ((const float*)(A.ws + WS_LAM))[2 * l], post = ((const float*)(A.ws + WS_LAM))[2 * l + 1];
        float ss = 0.f;
#pragma unroll
        for (int q = 0; q < 4; ++q)
#pragma unroll
            for (int r = 0; r < 16; ++r) { const float v = oT[q][r] * inv - lam * xch[(q * 16 + r) * 64 + lane]; oT[q][r] = v; ss += v * v; }
        ss = xhalf_sum(ss);
        const float rn = post / sqrtf(ss * (1.0f / 128.0f) + 1e-6f);
        const float* sw = A.in[I_SUBLN] + l * 128;
#pragma unroll
        for (int q = 0; q < 4; ++q)
#pragma unroll
            for (int r = 0; r < 16; ++r) oT[q][r] *= rn * sw[32 * q + 8 * (r >> 2) + 4 * hi + (r & 3)];
        attn_store(dry ? (bf16_t*)(A.ws + WS_TRASH) + tid * 128 : P + qrow * LDP + C_QD + h * 128, oT, hi);
    }
    __syncthreads();
}
__device__ __forceinline__ void ph_attention(const Args& A, LAS unsigned char* lds, int l, int half, int it, bool dry) {
    const int tid = tid_opaque();
    unsigned* ctr = (unsigned*)(A.ws + WS_CTL) + CW_Q + 64 * (2 * it + (dry ? 1 : 0));
    volatile LAS int* qw = (volatile LAS int*)(lds + LDSCTL_OFF + 64);
    constexpr int NB_ = HB * 8 * 64, NA_ = HB * 64 * 4, NBC_ = HB * 8 * 2, NAC_ = HB * 2 * 4;
    const int ntot = NB_ + NA_ + (l == 0 ? NBC_ + NAC_ : 0);
    for (;;) {
        if (tid == 0) *qw = (int)__hip_atomic_fetch_add(ctr, 1u, __ATOMIC_RELAXED, __HIP_MEMORY_SCOPE_AGENT);
        __syncthreads();
        int u = *qw;
        __syncthreads();
        if (u >= ntot) break;
        if (u < NB_) { attnB_unit(A, lds, l, u >> 9, (u >> 6) & 7, u & 63, false, dry); continue; } u -= NB_;
        if (u < NA_) { attnA_unit(A, lds, l, u >> 8, (u >> 2) & 63, u & 3, false, dry); continue; } u -= NA_;
        if (u < NBC_) { attnB_unit(A, lds, l, u >> 4, (u >> 1) & 7, u & 1, true, dry); continue; } u -= NBC_;
        attnA_unit(A, lds, l, u >> 3, (u >> 2) & 1, u & 3, true, dry);
    }
}
constexpr int GL_QN = 0, GL_KN = 17408, GL_RHS = 34816, GL_MM = 100352, GL_GC = 117760, GL_BETA = 118016, GL_EG = 118272, GL_DK = 118528, GPITCH = 272;
__device__ __forceinline__ void gdn_intra_unit(const Args& A, LAS unsigned char* lds, int l, int bl, int ch, int h, int d) {
    const int tid_ = tid_opaque();
    const int tid = tid_, lane = tid & 63, r32 = lane & 31, hi = lane >> 5, wave = __builtin_amdgcn_readfirstlane(tid >> 6);
    const bf16_t* P = (const bf16_t*)(A.ws + WS_P); const float* AB = (const float*)(A.ws + WS_AB);
    const int uidx = ((bl * NCH + ch) * 8 + h) * 2 + d;
    unsigned char* rec = A.ws + WS_G + (size_t)uidx * GU_BYTES;
    const size_t R0 = (size_t)bl * RB + ch * 64;
    LAS float* GC = (LAS float*)(lds + GL_GC); LAS float* BETA = (LAS float*)(lds + GL_BETA); LAS float* EG = (LAS float*)(lds + GL_EG); LAS float* DKS = (LAS float*)(lds + GL_DK);
    LAS float* RHS = (LAS float*)(lds + GL_RHS); LAS float* MM = (LAS float*)(lds + GL_MM);
    if (wave == 0) {
        const size_t row = R0 + (d ? 63 - lane : lane);
        float g = AB[row * 32 + d * 8 + h]; const float be = AB[row * 32 + 16 + d * 8 + h];
#pragma unroll
        for (int o = 1; o < 64; o <<= 1) { const float t = __shfl_up(g, o); if (lane >= o) g += t; }
        const float glast = __shfl(g, 63);
        GC[lane] = g; BETA[lane] = be; EG[lane] = __expf(g); DKS[lane] = __expf(glast - g);
        if (lane == 0) ((float*)(A.ws + WS_GL))[uidx] = __expf(glast);
    }
    __syncthreads();
    {
        const int i = tid >> 3, sub = tid & 7, c = d ? 63 - i : i;
        const int tp = ch * 64 + c;
        const bool has_prev = !(tp == 0 || tp == CTXL), has_next = !(tp == CTXL - 1 || tp == RB - 1);
        const bf16_t* xr = P + (R0 + c) * LDP + C_QKV + h * 128 + sub * 16;
        const float* cw = A.in[I_DNCONV] + (size_t)l * 3 * 3072 + h * 128 + sub * 16;
        const float be = BETA[i], eg = EG[i];
#pragma unroll
        for (int mat = 0; mat < 3; ++mat) {
            const bf16_t* xm = xr + mat * 1024; const float* wm = cw + mat * 1024;
            float y[16];
            const u32x4 z4 = (u32x4){0u, 0u, 0u, 0u};
#pragma unroll
            for (int hf = 0; hf < 2; ++hf) {
                const u32x4 xc = *(const u32x4*)(xm + hf * 8);
                const u32x4 xp = has_prev ? *(const u32x4*)(xm - LDP + hf * 8) : z4;
                const u32x4 xn = has_next ? *(const u32x4*)(xm + LDP + hf * 8) : z4;
#pragma unroll
                for (int k = 0; k < 4; ++k) { const int e = hf * 8 + 2 * k;
                    const float v0 = wm[e] * bf_lo(xp[k]) + wm[3072 + e] * bf_lo(xc[k]) + wm[6144 + e] * bf_lo(xn[k]);
                    const float v1 = wm[e + 1] * bf_hi(xp[k]) + wm[3072 + e + 1] * bf_hi(xc[k]) + wm[6144 + e + 1] * bf_hi(xn[k]);
                    y[e] = silu_f(v0); y[e + 1] = silu_f(v1); }
            }
            if (mat < 2) {
                float ss = 0.f;
#pragma unroll
                for (int e = 0; e < 16; ++e) ss += y[e] * y[e];
                ss += __shfl_xor(ss, 1); ss += __shfl_xor(ss, 2); ss += __shfl_xor(ss, 4);
                const float rn = (1.0f / sqrtf(ss + 1e-6f)) * (mat == 0 ? 0.08838834764831845f : 1.0f);
#pragma unroll
                for (int e = 0; e < 16; ++e) y[e] *= rn;
                LAS unsigned char* dst = lds + (mat == 0 ? GL_QN : GL_KN) + i * GPITCH + sub * 32;
                u32x4 w0, w1; w0.x = cvt_pk_bf16(y[0], y[1]); w0.y = cvt_pk_bf16(y[2], y[3]); w0.z = cvt_pk_bf16(y[4], y[5]); w0.w = cvt_pk_bf16(y[6], y[7]);
                w1.x = cvt_pk_bf16(y[8], y[9]); w1.y = cvt_pk_bf16(y[10], y[11]); w1.z = cvt_pk_bf16(y[12], y[13]); w1.w = cvt_pk_bf16(y[14], y[15]);
                *(LAS u32x4*)dst = w0; *(LAS u32x4*)(dst + 16) = w1;
                if (mat == 1) { const float s = be * eg;
#pragma unroll
                    for (int e = 0; e < 16; e += 4) *(LAS f32x4*)(RHS + i * 256 + 128 + sub * 16 + e) = (f32x4){y[e] * s, y[e + 1] * s, y[e + 2] * s, y[e + 3] * s}; }
            } else {
#pragma unroll
                for (int e = 0; e < 16; e += 4) *(LAS f32x4*)(RHS + i * 256 + sub * 16 + e) = (f32x4){y[e] * be, y[e + 1] * be, y[e + 2] * be, y[e + 3] * be};
            }
        }
    }
    __syncthreads();
    {
        const int mat = wave >> 2, rbk = (wave >> 1) & 1, cbk = wave & 1;
        LAS const unsigned char* Ab = lds + GL_KN + (32 * rbk + r32) * GPITCH + hi * 16;
        LAS const unsigned char* Bb = lds + (mat == 0 ? GL_KN : GL_QN) + (32 * cbk + r32) * GPITCH + hi * 16;
        f32x16 acc;
#pragma unroll
        for (int r = 0; r < 16; ++r) acc[r] = 0.f;
#pragma unroll
        for (int d0 = 0; d0 < 8; ++d0) { const bf16x8 a = *(LAS const bf16x8*)(Ab + d0 * 32), b = *(LAS const bf16x8*)(Bb + d0 * 32); acc = MFMA32(a, b, acc); }
        const int cc = 32 * cbk + r32; const float gcc = GC[cc];
        if (mat == 0) {
#pragma unroll
            for (int r = 0; r < 16; ++r) { const int i = 32 * rbk + crow(r, hi); const float v = (i > cc) ? BETA[i] * acc[r] * __expf(GC[i] - gcc) : 0.f; MM[i * 68 + cc] = v; }
        } else {
            float v[16];
#pragma unroll
            for (int r = 0; r < 16; ++r) { const int j = 32 * rbk + crow(r, hi); v[r] = (cc >= j) ? acc[r] * __expf(gcc - GC[j]) : 0.f; }
            bf16x8* at = (bf16x8*)(rec + GU_AT);
            at[(cbk * 4 + 2 * rbk + 0) * 64 + lane] = pack8(v[0], v[1], v[2], v[3], v[4], v[5], v[6], v[7]);
            at[(cbk * 4 + 2 * rbk + 1) * 64 + lane] = pack8(v[8], v[9], v[10], v[11], v[12], v[13], v[14], v[15]);
        }
    }
    __syncthreads();
    float x[64];
#define FNMA(acc, a, b) asm("v_fma_f32 %0, -%1, %2, %0" : "+v"(acc) : "v"(a), "v"(b))
    if (tid < 256) {
        LAS const float* MMv = MM; asm volatile("" : "+v"(MMv));
        LAS const float* RHv = RHS + tid; asm volatile("" : "+v"(RHv));
#pragma unroll
        for (int i = 0; i < 64; ++i) {
            float a = RHv[i * 256];
#pragma unroll
            for (int m4 = 0; m4 < i; m4 += 4) { const f32x4 mm = *(LAS const f32x4*)(MMv + i * 68 + m4);
                FNMA(a, mm[0], x[m4]); if (m4 + 1 < i) FNMA(a, mm[1], x[m4 + 1]); if (m4 + 2 < i) FNMA(a, mm[2], x[m4 + 2]); if (m4 + 3 < i) FNMA(a, mm[3], x[m4 + 3]); }
            x[i] = a; asm volatile("" ::: "memory");
        }
    } else {
        const int w4 = wave - 4;
        if (w4 < 2) {
#pragma unroll
            for (int ff = 0; ff < 8; ++ff) { const int f = w4 * 8 + ff, ib = f >> 3, rb = (f >> 1) & 3, s = f & 1; const int i = 32 * ib + r32, dk0 = 32 * rb + 16 * s + 4 * hi;
                const u32x2 a = *(LAS const u32x2*)(lds + GL_QN + i * GPITCH + dk0 * 2), b = *(LAS const u32x2*)(lds + GL_QN + i * GPITCH + (dk0 + 8) * 2); const float e = EG[i];
                ((bf16x8*)(rec + GU_QG))[f * 64 + lane] = pack8(bf_lo(a.x) * e, bf_hi(a.x) * e, bf_lo(a.y) * e, bf_hi(a.y) * e, bf_lo(b.x) * e, bf_hi(b.x) * e, bf_lo(b.y) * e, bf_hi(b.y) * e); }
        } else {
#pragma unroll
            for (int ff = 0; ff < 8; ++ff) { const int f = (w4 - 2) * 8 + ff, rb = f >> 2, ib = (f >> 1) & 1, s = f & 1; const int i0 = 32 * ib + 16 * s + 4 * hi;
                LAS const unsigned char* kp = lds + GL_KN + (i0 + ((lane & 15) >> 2)) * GPITCH + (32 * rb + 16 * ((lane >> 4) & 1) + 4 * (lane & 3)) * 2;
                const s16x4 lo = lds_tr(kp), hh = lds_tr(kp + 8 * GPITCH);
                const f32x4 s0 = *(LAS const f32x4*)(DKS + i0), s1 = *(LAS const f32x4*)(DKS + i0 + 8);
#define BFV(x) __uint_as_float(((unsigned)(unsigned short)(x)) << 16)
                ((bf16x8*)(rec + GU_KD))[f * 64 + lane] = pack8(BFV(lo[0]) * s0[0], BFV(lo[1]) * s0[1], BFV(lo[2]) * s0[2], BFV(lo[3]) * s0[3], BFV(hh[0]) * s1[0], BFV(hh[1]) * s1[1], BFV(hh[2]) * s1[2], BFV(hh[3]) * s1[3]);
#undef BFV
            }
        }
    }
    __syncthreads();
    if (tid < 128) {
        unsigned* up = (unsigned*)(rec + GU_U); const int sl = tid >> 5, dvl = tid & 31;
#pragma unroll
        for (int ib = 0; ib < 2; ++ib)
#pragma unroll
            for (int p = 0; p < 8; ++p)
#pragma unroll
                for (int hh = 0; hh < 2; ++hh) { const int i = 32 * ib + (2 * p & 3) + 8 * (2 * p >> 2) + 4 * hh; up[((ib * 4 + sl) * 8 + p) * 64 + hh * 32 + dvl] = cvt_pk_bf16(x[i], x[i + 1]); }
    } else if (tid < 256) {
        LAS bf16_t* wl = (LAS bf16_t*)(lds + GL_QN);
#pragma unroll
        for (int i = 0; i < 64; ++i) wl[i * (GPITCH / 2) + (tid - 128)] = (bf16_t)(cvt_pk_bf16(x[i], 0.f) & 0xffffu);
    }
    __syncthreads();
#pragma unroll
    for (int ff = 0; ff < 2; ++ff) { const int f = wave * 2 + ff, ib = f >> 3, rb = (f >> 1) & 3, s = f & 1; const int i = 32 * ib + r32, dk0 = 32 * rb + 16 * s + 4 * hi;
        const u32x2 a = *(LAS const u32x2*)(lds + GL_QN + i * GPITCH + dk0 * 2), b = *(LAS const u32x2*)(lds + GL_QN + i * GPITCH + (dk0 + 8) * 2);
        ((u32x4*)(rec + GU_W))[f * 64 + lane] = (u32x4){a.x, a.y, b.x, b.y}; }
    __syncthreads();
}
__device__ __forceinline__ void ph_gdn_intra(const Args& A, LAS unsigned char* lds, int l) {
    for (int u = blockIdx.x; u < HB * NCH * 8 * 2; u += gridDim.x) { const int d = u & 1, h = (u >> 1) & 7, t = u >> 4, ch = t % NCH, bl = t / NCH; gdn_intra_unit(A, lds, l, bl, ch, h, d); }
}
constexpr int SC_SLOT = 57344, SC_OST = 2 * SC_SLOT;
__device__ __forceinline__ void gdn_scan_unit(const Args& A, LAS unsigned char* lds, int bl, int h, int d) {
    const int tid = tid_opaque(), lane = tid & 63, r32 = lane & 31, hi = lane >> 5, wave = __builtin_amdgcn_readfirstlane(tid >> 6);
#define SC_CH(step) (d ? ((step) < 4 ? 3 - (step) : NCH + 3 - (step)) : (step))
#define SC_UIDX(step) (((bl * NCH + SC_CH(step)) * 8 + h) * 2 + d)
    if (wave >= 4) {
        const int lw = wave - 4;
#define SC_ISSUE(step, slot) do { const unsigned char* rec_ = A.ws + WS_G + (size_t)SC_UIDX(step) * GU_BYTES + lane * 16; \
        _Pragma("unroll") for (int k_ = 0; k_ < 14; ++k_) __builtin_amdgcn_global_load_lds((const unsigned*)(rec_ + (lw * 14 + k_) * 1024), (LAS unsigned*)(lds + (slot) * SC_SLOT + (lw * 14 + k_) * 1024), 16, 0, 0); } while (0)
        SC_ISSUE(0, 0);
        asm volatile("s_waitcnt vmcnt(0)" ::: "memory"); __builtin_amdgcn_s_barrier();
        for (int step = 0; step < NCH; ++step) {
            if (step + 1 < NCH) SC_ISSUE(step + 1, (step + 1) & 1);
            asm volatile("s_waitcnt vmcnt(0)" ::: "memory"); __builtin_amdgcn_s_barrier();
        }
#undef SC_ISSUE
        return;
    }
    const int sl = wave;
    bf16_t* O = (bf16_t*)(A.ws + WS_H) + (size_t)d * HR * 1024;
    const float* GLv = (const float*)(A.ws + WS_GL);
    LAS unsigned char* ost = lds + SC_OST + sl * 4096;
    f32x16 S[4];
#pragma unroll
    for (int rb = 0; rb < 4; ++rb)
#pragma unroll
        for (int r = 0; r < 16; ++r) S[rb][r] = 0.f;
    unsigned un[16]; float gln;
    { const unsigned* Up = (const unsigned*)(A.ws + WS_G + (size_t)SC_UIDX(0) * GU_BYTES + GU_U) + lane;
#pragma unroll
      for (int q = 0; q < 16; ++q) un[q] = Up[(((q >> 3) * 4 + sl) * 8 + (q & 7)) * 64];
      gln = GLv[SC_UIDX(0)]; }
    __builtin_amdgcn_s_barrier();
    for (int step = 0; step < NCH; ++step) {
        const int ch = SC_CH(step);
        LAS const unsigned char* slot = lds + (step & 1) * SC_SLOT + lane * 16;
        unsigned uc[16]; const float gl = gln;
#pragma unroll
        for (int q = 0; q < 16; ++q) uc[q] = un[q];
        if (step + 1 < NCH) { const unsigned* Up = (const unsigned*)(A.ws + WS_G + (size_t)SC_UIDX(step + 1) * GU_BYTES + GU_U) + lane;
#pragma unroll
            for (int q = 0; q < 16; ++q) un[q] = Up[(((q >> 3) * 4 + sl) * 8 + (q & 7)) * 64];
            gln = GLv[SC_UIDX(step + 1)]; }
        f32x16 vn[2], o[2];
#pragma unroll
        for (int ib = 0; ib < 2; ++ib)
#pragma unroll
            for (int r = 0; r < 16; ++r) { vn[ib][r] = 0.f; o[ib][r] = 0.f; }
#pragma unroll
        for (int rb = 0; rb < 4; ++rb)
#pragma unroll
            for (int s = 0; s < 2; ++s) {
                const bf16x8 sb = pack8(S[rb][8 * s], S[rb][8 * s + 1], S[rb][8 * s + 2], S[rb][8 * s + 3], S[rb][8 * s + 4], S[rb][8 * s + 5], S[rb][8 * s + 6], S[rb][8 * s + 7]);
#pragma unroll
                for (int ib = 0; ib < 2; ++ib) { const int f = (ib * 4 + rb) * 2 + s;
                    vn[ib] = MFMA32(*(LAS const bf16x8*)(slot + GU_W + f * 1024), sb, vn[ib]); o[ib] = MFMA32(*(LAS const bf16x8*)(slot + GU_QG + f * 1024), sb, o[ib]); }
            }
#pragma unroll
        for (int ib = 0; ib < 2; ++ib)
#pragma unroll
            for (int p = 0; p < 8; ++p) { const unsigned w = uc[ib * 8 + p]; vn[ib][2 * p] = bf_lo(w) - vn[ib][2 * p]; vn[ib][2 * p + 1] = bf_hi(w) - vn[ib][2 * p + 1]; }
        bf16x8 vb[2][2];
#pragma unroll
        for (int ib = 0; ib < 2; ++ib) { vb[ib][0] = pack8(vn[ib][0], vn[ib][1], vn[ib][2], vn[ib][3], vn[ib][4], vn[ib][5], vn[ib][6], vn[ib][7]);
            vb[ib][1] = pack8(vn[ib][8], vn[ib][9], vn[ib][10], vn[ib][11], vn[ib][12], vn[ib][13], vn[ib][14], vn[ib][15]); }
#pragma unroll
        for (int ib = 0; ib < 2; ++ib)
#pragma unroll
            for (int jb = 0; jb < 2; ++jb)
#pragma unroll
                for (int s = 0; s < 2; ++s) o[ib] = MFMA32(*(LAS const bf16x8*)(slot + GU_AT + (ib * 4 + 2 * jb + s) * 1024), vb[jb][s], o[ib]);
#pragma unroll
        for (int rb = 0; rb < 4; ++rb) { S[rb] = S[rb] * gl;
#pragma unroll
            for (int ib = 0; ib < 2; ++ib)
#pragma unroll
                for (int s = 0; s < 2; ++s) S[rb] = MFMA32(*(LAS const bf16x8*)(slot + GU_KD + ((rb * 2 + ib) * 2 + s) * 1024), vb[ib][s], S[rb]); }
#pragma unroll
        for (int ib = 0; ib < 2; ++ib)
#pragma unroll
            for (int r = 0; r < 16; ++r) { const int i = 32 * ib + crow(r, hi); const int c = d ? 63 - i : i; *(LAS bf16_t*)(ost + c * 64 + r32 * 2) = (bf16_t)(cvt_pk_bf16(o[ib][r], 0.f) & 0xffffu); }
        asm volatile("s_waitcnt lgkmcnt(0)" ::: "memory");
        bf16_t* obase = O + ((size_t)bl * RB + ch * 64) * 1024 + h * 128 + 32 * sl;
#pragma unroll
        for (int k = 0; k < 4; ++k) { const int id = k * 64 + lane; const u32x4 v = *(LAS const u32x4*)(ost + id * 16); *(u32x4*)(obase + (size_t)(id >> 2) * 1024 + (id & 3) * 8) = v; }
        asm volatile("s_waitcnt lgkmcnt(0)" ::: "memory"); __builtin_amdgcn_s_barrier();
    }
#undef SC_CH
#undef SC_UIDX
}
__device__ __forceinline__ void ph_gdn_post(const Args& A, int l, bool dry) {
    const int tid = tid_opaque(), lane = tid & 63, gw = blockIdx.x * NWAVES + (tid >> 6), NGW = gridDim.x * NWAVES;
    const bf16_t* OF = (const bf16_t*)(A.ws + WS_H); const bf16_t* OB = OF + (size_t)HR * 1024; bf16_t* P = (bf16_t*)(A.ws + WS_P);
    const float* nw = A.in[I_DNNORM] + l * 128 + (lane & 7) * 16;
    for (int r = gw; r < HR; r += NGW) {
        const u32x4 f0 = *(const u32x4*)(OF + (size_t)r * 1024 + lane * 16), f1 = *(const u32x4*)(OF + (size_t)r * 1024 + lane * 16 + 8);
        const u32x4 b0 = *(const u32x4*)(OB + (size_t)r * 1024 + lane * 16), b1 = *(const u32x4*)(OB + (size_t)r * 1024 + lane * 16 + 8);
        bf16_t* zp = P + (size_t)r * LDP + C_Z + lane * 16;
        const u32x4 z0 = *(const u32x4*)zp, z1 = *(const u32x4*)(zp + 8);
        float o[16], z[16]; float ss = 0.f;
#pragma unroll
        for (int k = 0; k < 4; ++k) { o[2 * k] = bf_lo(f0[k]) + bf_lo(b0[k]); o[2 * k + 1] = bf_hi(f0[k]) + bf_hi(b0[k]); o[8 + 2 * k] = bf_lo(f1[k]) + bf_lo(b1[k]); o[8 + 2 * k + 1] = bf_hi(f1[k]) + bf_hi(b1[k]);
            z[2 * k] = bf_lo(z0[k]); z[2 * k + 1] = bf_hi(z0[k]); z[8 + 2 * k] = bf_lo(z1[k]); z[8 + 2 * k + 1] = bf_hi(z1[k]); }
#pragma unroll
        for (int e = 0; e < 16; ++e) ss += o[e] * o[e];
        ss += __shfl_xor(ss, 1); ss += __shfl_xor(ss, 2); ss += __shfl_xor(ss, 4);
        const float rn = 1.0f / sqrtf(ss * (1.0f / 128.0f) + 1e-6f);
#pragma unroll
        for (int e = 0; e < 16; ++e) o[e] = o[e] * rn * nw[e] * silu_f(z[e]);
        u32x4 w0, w1; w0.x = cvt_pk_bf16(o[0], o[1]); w0.y = cvt_pk_bf16(o[2], o[3]); w0.z = cvt_pk_bf16(o[4], o[5]); w0.w = cvt_pk_bf16(o[6], o[7]);
        w1.x = cvt_pk_bf16(o[8], o[9]); w1.y = cvt_pk_bf16(o[10], o[11]); w1.z = cvt_pk_bf16(o[12], o[13]); w1.w = cvt_pk_bf16(o[14], o[15]);
        bf16_t* zo = dry ? (bf16_t*)(A.ws + WS_TRASH) + tid * 16 : zp;
        *(u32x4*)zo = w0; *(u32x4*)(zo + 8) = w1;
    }
}
constexpr int NPH = 1 + 14 * 4;
__host__ __device__ inline bool phase_is_noop(int id) { if (id == 0) return false; const int it = (id - 1) / 14, k = (id - 1) % 14; return (k == 0 && it != 2) || k == 6; }
__global__ void __launch_bounds__(NTHR, 2) fwd(Args A) {
    extern __shared__ __attribute__((aligned(16))) unsigned char lds_raw[];
    LAS unsigned char* lds = (LAS unsigned char*)lds_raw;
    volatile LAS unsigned* MISC = (volatile LAS unsigned*)(lds + LDSCTL_OFF + 320);
    for (int u = threadIdx.x; u < (LDS_BYTES - LDSCTL_OFF) / 4; u += NTHR) ((LAS unsigned*)(lds + LDSCTL_OFF))[u] = 0u;
    __syncthreads();
    const int lo = A.ph_lo, hi = A.ph_hi, G = gridDim.x, bid = blockIdx.x;
    unsigned char* ws = A.ws;
    XcdBarrier bar; bar.bar = (unsigned*)(ws + WS_CTL) + CW_BAR; bar.x = 0; bar.st = nullptr;
    if (hi - lo > 1) bar = xcd_barrier_post((unsigned*)(ws + WS_CTL) + CW_BAR, MISC + 8);
#ifndef PHMASK
#define PHMASK 0x7fff
#endif
#ifndef DUP_MASK
#define DUP_MASK 0
#endif
#define RUNK(k, id, ...) do { if (((PHMASK >> (k)) & 1) && lo <= (id) && (id) < hi) { \
    if ((DUP_MASK >> (k)) & 1) { dry = true; __VA_ARGS__; xcd_barrier(bar); dry = false; } \
    __VA_ARGS__; if ((id) + 1 < hi) xcd_barrier(bar); } } while (0)
    bool dry = false;
    bf16_t* H = (bf16_t*)(ws + WS_H); bf16_t* P = (bf16_t*)(ws + WS_P);
    RUNK(14, 0, { ph_prologue(A, lds); __syncthreads(); ph_weights(A, lds, 0); });
    for (int it = 0; it < 4; ++it) {
        const int l = it >> 1, half = it & 1, base = 1 + 14 * it;
        if (it == 2) RUNK(0, base + 0, { ph_weights(A, lds, 1); });
        RUNK(1, base + 1, { ph_adaln(A, l, half); });
        RUNK(2, base + 2, {
            pg8::Gemm g{H, (const bf16_t*)(ws + WS_WIN), HR, NWIN, 2048, 2048}; pg8::StaticOrder S; S.init(HR, NWIN, G, bid);
            pg8::EpiInProj E{P, LDP, (float*)(ws + WS_AB), (const float*)(ws + WS_ROPEA), (const float*)(ws + WS_ROPED), A.in[I_ALOG] + l * 16, A.in[I_DTB] + l * 16, 0.08838834764831845f * LOG2E, 0.125f * LOG2E};
            pg8::gemm_phase<pg8::EpiInProj, pg8::StaticOrder, true, true>(lds, g, S, E); });
        RUNK(3, base + 3, { ph_gdn_intra(A, lds, l); });
        RUNK(4, base + 4, { if (bid < HB * 8 * 2) gdn_scan_unit(A, lds, bid >> 4, (bid >> 1) & 7, bid & 1); ph_attention(A, lds, l, half, it, dry); });
        RUNK(5, base + 5, { ph_gdn_post(A, l, dry); });
        RUNK(7, base + 7, {
            float* TOT = (float*)(ws + WS_TOT); bf16_t* Mo = (bf16_t*)(ws + WS_M);
            pg8::Gemm ga{P + C_QA, (const bf16_t*)(ws + WS_WPA), HR, 2048, 1024, LDP}; pg8::EpiMerge<0> Ea{P + C_G, LDP, TOT, Mo, 2048};
            pg8::Gemm gb{P + C_QD, (const bf16_t*)(ws + WS_WPB), HR, 2048, 1024, LDP}; pg8::EpiMerge<1> Eb{P + C_G + 2048, LDP, TOT, Mo, 2048};
            pg8::Gemm gc{P + C_Z, (const bf16_t*)(ws + WS_WPC), HR, 2048, 1024, LDP}; pg8::EpiMerge<2> Ec{P + C_G + 4096, LDP, TOT, Mo, 2048};
            if (l == 0) { pg8::StaticOrder S; S.init(HR, 2048, G, bid);
                pg8::gemm_phase<pg8::EpiMerge<0>, pg8::StaticOrder, true, true>(lds, ga, S, Ea); pg8::gemm_phase<pg8::EpiMerge<1>, pg8::StaticOrder, true, true>(lds, gb, S, Eb); pg8::gemm_phase<pg8::EpiMerge<2>, pg8::StaticOrder, true, true>(lds, gc, S, Ec); }
            else { pg8::LatentOrder S; S.init(2048, G, bid);
                pg8::gemm_phase<pg8::EpiMerge<0>, pg8::LatentOrder, true, true>(lds, ga, S, Ea); pg8::gemm_phase<pg8::EpiMerge<1>, pg8::LatentOrder, true, true>(lds, gb, S, Eb); pg8::gemm_phase<pg8::EpiMerge<2>, pg8::LatentOrder, true, true>(lds, gc, S, Ec); } });
        RUNK(8, base + 8, {
            pg8::Gemm g{(const bf16_t*)(ws + WS_M), (const bf16_t*)(ws + WS_WO), HR, 2048, 2048, 2048}; pg8::EpiF32 E{(float*)(ws + WS_OX), 2048};
            if (l == 0) { pg8::StaticOrder S; S.init(HR, 2048, G, bid); pg8::gemm_phase<pg8::EpiF32, pg8::StaticOrder, true, true>(lds, g, S, E); }
            else { pg8::LatentOrder S; S.init(2048, G, bid); pg8::gemm_phase<pg8::EpiF32, pg8::LatentOrder, true, true>(lds, g, S, E); } });
        RUNK(9, base + 9, { ph_resln<true>(A, l, half, (const float*)(ws + WS_OX), 2, A.in[I_LN1G] + l * DM, A.in[I_LN1B] + l * DM, dry); });
        RUNK(10, base + 10, {
            pg8::Gemm g{H, (const bf16_t*)(ws + WS_WUP), HR, NUP, 2048, 2048}; pg8::EpiBf16 E{(bf16_t*)(ws + WS_U), NUP};
            if (l == 0) { pg8::StaticOrder S; S.init(HR, NUP, G, bid); pg8::gemm_phase<pg8::EpiBf16, pg8::StaticOrder, true, true>(lds, g, S, E); }
            else { pg8::LatentOrder S; S.init(NUP, G, bid); pg8::gemm_phase<pg8::EpiBf16, pg8::LatentOrder, true, true>(lds, g, S, E); } });
        RUNK(11, base + 11, { ph_convact(A, l); });
        RUNK(12, base + 12, {
            pg8::Gemm g{(const bf16_t*)(ws + WS_ACT), (const bf16_t*)(ws + WS_WDN), HR, 2048, DFF, DFF}; pg8::EpiF32 E{(float*)(ws + WS_FX), 2048};
            if (l == 0) { pg8::StaticOrder S; S.init(HR, 2048, G, bid); pg8::gemm_phase<pg8::EpiF32, pg8::StaticOrder, true, true>(lds, g, S, E); }
            else { pg8::LatentOrder S; S.init(2048, G, bid); pg8::gemm_phase<pg8::EpiF32, pg8::LatentOrder, true, true>(lds, g, S, E); } });
        RUNK(13, base + 13, { ph_resln<false>(A, l, half, (const float*)(ws + WS_FX), 5, A.in[I_LN2G] + l * DM, A.in[I_LN2B] + l * DM, dry); });
    }
#undef RUNK
}

#ifndef MK_ONE_LAUNCH
#define MK_ONE_LAUNCH 1
#endif
extern "C" void kernel_launch(void* const* d_in, const int* in_sizes, int n_in, void* d_out, int out_size, void* d_ws, size_t ws_size, hipStream_t stream) {
    static int grid = 0;
    if (grid == 0) {
        if (n_in != 29 || out_size != NBATCH * SEQ * DM || ws_size < WS_END) { fprintf(stderr, "kernel_launch: unexpected problem (n_in %d, out %d, ws %zu < %zu)\n", n_in, out_size, ws_size, (size_t)WS_END); grid = -1; return; }
        int dev = 0, cus = 0, per_cu = 0;
        if (hipGetDevice(&dev) != hipSuccess || hipDeviceGetAttribute(&cus, hipDeviceAttributeMultiprocessorCount, dev) != hipSuccess) { grid = -1; return; }
        if (hipFuncSetAttribute((const void*)fwd, hipFuncAttributeMaxDynamicSharedMemorySize, LDS_BYTES) != hipSuccess) { fprintf(stderr, "kernel_launch: hipFuncSetAttribute failed\n"); grid = -1; return; }
        if (hipOccupancyMaxActiveBlocksPerMultiprocessor(&per_cu, (const void*)fwd, NTHR, LDS_BYTES) != hipSuccess || per_cu < 1) fprintf(stderr, "kernel_launch: occupancy query reports %d\n", per_cu);
        (void)hipGetLastError();
        grid = cus > 256 ? 256 : cus;
    }
    if (grid < 0) return;
    (void)hipMemsetAsync((char*)d_ws + WS_CTL, 0, CTL_ZERO_BYTES, stream);
    Args a{};
    for (int i = 0; i < 29; ++i) a.in[i] = (const float*)d_in[i];
    a.out = (float*)d_out; a.ws = (unsigned char*)d_ws;
#if MK_ONE_LAUNCH
    a.ph_lo = 0; a.ph_hi = NPH;
    hipLaunchKernelGGL(fwd, dim3(grid), dim3(NTHR), LDS_BYTES, stream, a);
#else
    for (int id = 0; id < NPH; ++id) { if (phase_is_noop(id)) continue; a.ph_lo = id; a.ph_hi = id + 1; hipLaunchKernelGGL(fwd, dim3(grid), dim3(NTHR), LDS_BYTES, stream, a); }
#endif
}
```

```cpp
#include <hip/hip_runtime.h>
#include <cstdio>
#include <cstdint>
#include <cmath>
namespace pg8 {
#define PG8_LAS __attribute__((address_space(3)))
typedef unsigned short bf16_t;
typedef short bf16x8 __attribute__((ext_vector_type(8)));
typedef float f32x4 __attribute__((ext_vector_type(4)));
typedef unsigned u32x4 __attribute__((ext_vector_type(4)));
constexpr int BM = 256, BK = 64, HALF = 128, HTB = HALF * BK * 2  , STAGE_BYTES = 8 * HTB, NXCD = 8, WGM = 8;

__host__ __device__ __forceinline__ int lds_byte(int r, int c) { const int st = (r >> 4) * 2 + (c >> 5), rr = r & 15, cc = c & 31, ob = rr * 64 + cc * 2; return st * 1024 + (ob ^ (((ob >> 9) & 1) << 5)); }
__host__ __device__ __forceinline__ void stage_rc(int b, int& R, int& C) { const int st = b / 1024, sb = b % 1024, swz = sb ^ (((sb >> 9) & 1) << 5); R = (st >> 1) * 16 + swz / 64; C = (st & 1) * 32 + (swz % 64) / 2; }
__host__ __device__ __forceinline__ int perm32(int rho) { const int n = rho >> 4, i = rho & 15; return 8 * (i >> 2) + 4 * n + (i & 3); }

struct Unit { int pm, pn; };
struct Gemm { const bf16_t* A; const bf16_t* Bt; int M, N, K, lda; };

struct StaticOrder {
    int nM, nN, nwg, G, c;
    __host__ __device__ void init(int M, int N, int G_, int c_) { nM = M / BM; nN = N / BM; nwg = nM * nN; G = G_; c = c_; }
    __host__ __device__ bool next(int i, Unit& u) const {
        const long L = (long)i * G + c; if (L >= nwg) return false;
        int wgid = (int)L; { const int q = nwg / NXCD, r = nwg % NXCD, xcd = wgid % NXCD, off = wgid / NXCD; wgid = (xcd < r ? xcd * (q + 1) : r * (q + 1) + (xcd - r) * q) + off; }
        const int nig = WGM * nN, gid = wgid / nig, fm = gid * WGM, gsz = (nM - fm) < WGM ? (nM - fm) : WGM;
        u.pm = fm + ((wgid % nig) % gsz); u.pn = (wgid % nig) / gsz; return true;
    }
    __device__ __forceinline__ void a_ready(const Unit&) const {}
    __device__ __forceinline__ void done(const Unit&) const {}
};
struct InProjLastOrder : StaticOrder {
    __host__ __device__ void init(int N, int G_, int c_) { StaticOrder::init(64 * BM, N, G_, c_); }
    __host__ __device__ bool next(int i, Unit& u) const {
        const long L = (long)i * G + c;
        if (L < nwg) { StaticOrder::next(i, u); u.pm += 1 + (u.pm >= 32 ? 1 : 0); return true; }
        const int e = (int)(L - nwg); if (e >= 46) return false;
        const int k = e % 23; u.pm = (e >= 23) ? 33 : 0; u.pn = (k < 2) ? 4 + k : (k < 22) ? 8 + k : 58; return true;
    }
};
struct LatentOrder : StaticOrder {
    __host__ __device__ void init(int N, int G_, int c_) { StaticOrder::init(64 * BM, N, G_, c_); }
    __host__ __device__ bool next(int i, Unit& u) const { if (!StaticOrder::next(i, u)) return false; u.pm += 1 + (u.pm >= 32 ? 1 : 0); return true; }
};


__device__ __forceinline__ unsigned cvt_pk_bf16(float lo, float hi) { unsigned r; asm volatile("v_cvt_pk_bf16_f32 %0, %1, %2" : "=v"(r) : "v"(lo), "v"(hi)); return r; }
__device__ __forceinline__ float bf_lo(unsigned w) { return __uint_as_float(w << 16); }
__device__ __forceinline__ float bf_hi(unsigned w) { return __uint_as_float(w & 0xffff0000u); }
__device__ __forceinline__ float sigm(float x) { return 1.0f / (1.0f + __expf(-x)); }

struct EpiF32 {
    static constexpr bool PERM = false, AFTER_DRAIN = false;
    float* C; int ldc;
    __device__ __forceinline__ void operator()(const f32x4 (&acc)[2][2][4][2], const Unit& u, int wr, int wc, int fr, int fq) const {
        const int row0 = u.pm * BM + wr * 64 + fr, col0 = u.pn * BM + wc * 32 + 4 * fq;
#pragma unroll
        for (int ai = 0; ai < 2; ++ai)
#pragma unroll
            for (int m = 0; m < 4; ++m) { float* rowp = C + (size_t)(row0 + ai * HALF + m * 16) * ldc + col0;
#pragma unroll
                for (int bj = 0; bj < 2; ++bj)
#pragma unroll
                    for (int n = 0; n < 2; ++n) *(f32x4*)(rowp + bj * HALF + n * 16) = acc[ai][bj][m][n]; }
    }
};
struct EpiBf16 {
    static constexpr bool PERM = true, AFTER_DRAIN = false;
    bf16_t* O; int ldc;
    __device__ __forceinline__ void operator()(const f32x4 (&acc)[2][2][4][2], const Unit& u, int wr, int wc, int fr, int fq) const {
        const int row0 = u.pm * BM + wr * 64 + fr, col0 = u.pn * BM + wc * 32 + 8 * fq;
#pragma unroll
        for (int ai = 0; ai < 2; ++ai)
#pragma unroll
            for (int m = 0; m < 4; ++m) { bf16_t* rowp = O + (size_t)(row0 + ai * HALF + m * 16) * ldc + col0;
#pragma unroll
                for (int bj = 0; bj < 2; ++bj) { const f32x4 v0 = acc[ai][bj][m][0], v1 = acc[ai][bj][m][1];
                    u32x4 w; w.x = cvt_pk_bf16(v0[0], v0[1]); w.y = cvt_pk_bf16(v0[2], v0[3]); w.z = cvt_pk_bf16(v1[0], v1[1]); w.w = cvt_pk_bf16(v1[2], v1[3]);
                    *(u32x4*)(rowp + bj * HALF) = w; } }
    }
};
template <int MODE> struct EpiMerge {
    static constexpr bool PERM = true, AFTER_DRAIN = false;
    const bf16_t* G; int ldg; bf16_t* T1; bf16_t* T2; bf16_t* Mo; int ldc;
    __device__ __forceinline__ void operator()(const f32x4 (&acc)[2][2][4][2], const Unit& u, int wr, int wc, int fr, int fq) const {
        asm volatile("" : "+v"(fr), "+v"(fq));
        const int row0 = u.pm * BM + wr * 64 + fr, col0 = u.pn * BM + wc * 32 + 8 * fq;
#pragma unroll
        for (int ai = 0; ai < 2; ++ai)
#pragma unroll
            for (int m = 0; m < 4; ++m) { const size_t row = (size_t)(row0 + ai * HALF + m * 16);
#pragma unroll
                for (int bj = 0; bj < 2; ++bj) { const int col = col0 + bj * HALF;
                    const u32x4 gw = *(const u32x4*)(G + row * ldg + col);
                    f32x4 g0 = (f32x4){bf_lo(gw.x), bf_hi(gw.x), bf_lo(gw.y), bf_hi(gw.y)}, g1 = (f32x4){bf_lo(gw.z), bf_hi(gw.z), bf_lo(gw.w), bf_hi(gw.w)};
                    f32x4 v0 = acc[ai][bj][m][0] * g0, v1 = acc[ai][bj][m][1] * g1;
                    if (MODE == 2) { const u32x4 a = *(const u32x4*)(T1 + row * ldc + col), b = *(const u32x4*)(T2 + row * ldc + col);
                        v0 += (f32x4){bf_lo(a.x) + bf_lo(b.x), bf_hi(a.x) + bf_hi(b.x), bf_lo(a.y) + bf_lo(b.y), bf_hi(a.y) + bf_hi(b.y)};
                        v1 += (f32x4){bf_lo(a.z) + bf_lo(b.z), bf_hi(a.z) + bf_hi(b.z), bf_lo(a.w) + bf_lo(b.w), bf_hi(a.w) + bf_hi(b.w)}; }
                    u32x4 w; w.x = cvt_pk_bf16(v0[0], v0[1]); w.y = cvt_pk_bf16(v0[2], v0[3]); w.z = cvt_pk_bf16(v1[0], v1[1]); w.w = cvt_pk_bf16(v1[2], v1[3]);
                    bf16_t* dst = (MODE == 0) ? T1 : (MODE == 1) ? T2 : Mo;
                    *(u32x4*)(dst + row * ldc + col) = w; }
                asm volatile("" ::: "memory"); }
    }
};
struct EpiInProj {
    static constexpr bool PERM = true, AFTER_DRAIN = false;
    bf16_t* P; int ldp; float* AB; const float* ropeA; const float* ropeD; const float* a_log; const float* dt_bias; float sA, sD; bool light;
    __device__ __forceinline__ void operator()(const f32x4 (&acc)[2][2][4][2], const Unit& u, int wr, int wc, int fr, int fq) const {
        asm volatile("" : "+v"(fr), "+v"(fq));
        const int pn = u.pn, tib = u.pm % 33; const bool is_ctx = (tib == 0);
        const int row0 = u.pm * BM + wr * 64 + fr, t0 = tib * 256 - 256 + wr * 64 + fr, cl = wc * 32 + 8 * fq;
        int type; float scale = 1.f;
        if (pn <= 3) { type = 1; scale = sA; } else if (pn == 4) type = 1; else if (pn == 5) type = 0; else if (pn <= 9) { type = 2; scale = sD; } else if (pn <= 13) type = 2;
        else if (pn <= 33) type = 0; else if (pn <= 57) type = 3; else type = 4;
        if (light && type != 4) type = 0;
        if (type == 4) {
            if (wc == 0) {
                const int c = 8 * fq;
#pragma unroll
                for (int ai = 0; ai < 2; ++ai)
#pragma unroll
                    for (int m = 0; m < 4; ++m) { const size_t row = (size_t)(row0 + ai * HALF + m * 16); f32x4 v0 = acc[ai][0][m][0], v1 = acc[ai][0][m][1]; float o[8] = {v0[0], v0[1], v0[2], v0[3], v1[0], v1[1], v1[2], v1[3]};
#pragma unroll
                        for (int k = 0; k < 8; ++k) { if (c < 16) { const float x = o[k] + dt_bias[c + k]; const float sp = fmaxf(x, 0.f) + log1pf(__expf(-fabsf(x))); o[k] = -__expf(a_log[c + k]) * sp; } else o[k] = sigm(o[k]); }
                        *(f32x4*)(AB + row * 32 + c) = (f32x4){o[0], o[1], o[2], o[3]}; *(f32x4*)(AB + row * 32 + c + 4) = (f32x4){o[4], o[5], o[6], o[7]}; }
            }
            return;
        }
#pragma unroll
        for (int ai = 0; ai < 2; ++ai)
#pragma unroll
            for (int m = 0; m < 4; ++m) { const size_t row = (size_t)(row0 + ai * HALF + m * 16); const int t = t0 + ai * HALF + m * 16;
#pragma unroll
                for (int bj = 0; bj < 2; ++bj) { const int c = cl + bj * HALF; f32x4 v0 = acc[ai][bj][m][0], v1 = acc[ai][bj][m][1];
                    if ((type == 1 || type == 2) && !is_ctx) {
                        const float* tab;
                        if (type == 1) { const int p0 = (c & 127) >> 1; const int pos = (p0 >= 32) ? (t & 63) : (t >> 6); tab = ropeA + (pos * 32 + (p0 & 31)) * 2; }
                        else { const int p0 = (c & 63) >> 1; const int pos = (p0 >= 16) ? (t & 63) : (t >> 6); tab = ropeD + (pos * 16 + (p0 & 15)) * 2; }
                        const f32x4 cs0 = *(const f32x4*)tab, cs1 = *(const f32x4*)(tab + 4);
                        f32x4 r0, r1;
                        r0[0] = v0[0] * cs0[0] - v0[1] * cs0[1]; r0[1] = v0[1] * cs0[0] + v0[0] * cs0[1]; r0[2] = v0[2] * cs0[2] - v0[3] * cs0[3]; r0[3] = v0[3] * cs0[2] + v0[2] * cs0[3];
                        r1[0] = v1[0] * cs1[0] - v1[1] * cs1[1]; r1[1] = v1[1] * cs1[0] + v1[0] * cs1[1]; r1[2] = v1[2] * cs1[2] - v1[3] * cs1[3]; r1[3] = v1[3] * cs1[2] + v1[2] * cs1[3];
                        v0 = r0; v1 = r1;
                    }
                    if (type == 3) {
#pragma unroll
                        for (int k = 0; k < 4; ++k) { v0[k] = sigm(v0[k]); v1[k] = sigm(v1[k]); } }
                    v0 = v0 * scale; v1 = v1 * scale;
                    u32x4 w; w.x = cvt_pk_bf16(v0[0], v0[1]); w.y = cvt_pk_bf16(v0[2], v0[3]); w.z = cvt_pk_bf16(v1[0], v1[1]); w.w = cvt_pk_bf16(v1[2], v1[3]);
                    *(u32x4*)(P + row * ldp + pn * BM + c) = w; }
                asm volatile("" ::: "memory"); }
    }
};

template <class Epi, class Sched, bool ALIGN_EPI = false, bool SP2 = false>
__device__ __forceinline__ void gemm_phase(PG8_LAS unsigned char* lds, const Gemm g, const Sched& S, const Epi& E) {
    int tid_ = threadIdx.x; asm volatile("" : "+v"(tid_));
    const int tid = tid_, wid = __builtin_amdgcn_readfirstlane(tid >> 6), lane = tid & 63, wr = wid >> 2, wc = wid & 3, fr = lane & 15, fq = lane >> 4;
    const int K = g.K, nt = K / BK;
    unsigned voffA[2], voffB[2];
#pragma unroll
    for (int i = 0; i < 2; ++i) { int R, C; stage_rc(tid * 16 + i * 8192, R, C); const int Rb = Epi::PERM ? ((R & ~31) + perm32(R & 31)) : R;
        voffA[i] = (unsigned)(R * g.lda + C) * 2u; voffB[i] = (unsigned)(Rb * K + C) * 2u; }
    const size_t kstep = (size_t)(BK * 2);
    const size_t hstepB = (size_t)HALF * K * 2, hstepA = (size_t)HALF * g.lda * 2;
    const size_t tstepA = 2 * hstepA, tstepB = 2 * hstepB;
    const unsigned ldsw = (unsigned)wid * 1024u;
    const int aoff = lds_byte(wr * 64 + fr, fq * 8), boff = lds_byte(wc * 32 + fr, fq * 8);
#define PG8_SA(b, h) (((b) * 2 + (h)) * HTB)
#define PG8_SB(b, h) ((4 + (b) * 2 + (h)) * HTB)
#define PG8_STAGE(bufoff, gbase, voff) do { _Pragma("unroll") for (int _i = 0; _i < 2; ++_i) \
        __builtin_amdgcn_global_load_lds((const unsigned*)((const char*)(gbase) + (voff)[_i]), (PG8_LAS unsigned*)(lds + (bufoff) + ldsw + _i * 8192), 16, 0, 0); } while (0)
#define PG8_LDA(dst, b, h) do { _Pragma("unroll") for (int m = 0; m < 4; ++m) _Pragma("unroll") for (int k = 0; k < 2; ++k) dst[m][k] = *(const PG8_LAS bf16x8*)(lds + PG8_SA(b, h) + aoff + m * 2048 + k * 1024); } while (0)
#define PG8_LDB(dst, b, h) do { _Pragma("unroll") for (int n = 0; n < 2; ++n) _Pragma("unroll") for (int k = 0; k < 2; ++k) dst[n][k] = *(const PG8_LAS bf16x8*)(lds + PG8_SB(b, h) + boff + n * 2048 + k * 1024); } while (0)
#define PG8_MMA(ai, bj, At, Bt) do { __builtin_amdgcn_s_setprio(1); _Pragma("unroll") for (int m = 0; m < 4; ++m) _Pragma("unroll") for (int n = 0; n < 2; ++n) _Pragma("unroll") for (int k = 0; k < 2; ++k) \
        acc[ai][bj][m][n] = __builtin_amdgcn_mfma_f32_16x16x32_bf16(Bt[n][k], At[m][k], acc[ai][bj][m][n], 0, 0, 0); __builtin_amdgcn_s_setprio(0); } while (0)
#define PG8_WAIT_V(n) asm volatile("s_waitcnt vmcnt(" #n ")" ::: "memory")
#define PG8_WAIT_L(n) asm volatile("s_waitcnt lgkmcnt(" #n ")" ::: "memory")
#define PG8_BAR __builtin_amdgcn_s_barrier()
#define PG8_SCHED __builtin_amdgcn_sched_barrier(0)
    Unit cur, nxt; int ui = 0;
    if (!S.next(0, cur)) return;
    f32x4 acc[2][2][4][2];
#pragma unroll
    for (int a = 0; a < 2; ++a)
#pragma unroll
        for (int b = 0; b < 2; ++b)
#pragma unroll
            for (int m = 0; m < 4; ++m)
#pragma unroll
                for (int n = 0; n < 2; ++n) acc[a][b][m][n] = (f32x4){0.f, 0.f, 0.f, 0.f};
    bf16x8 At[4][2], B0[2][2], B1[2][2];
    const char* cA = (const char*)g.A + (size_t)cur.pm * tstepA; const char* cB = (const char*)g.Bt + (size_t)cur.pn * tstepB;
    S.a_ready(cur);
    if constexpr (SP2) {
        PG8_STAGE(PG8_SB(0, 0), cB, voffB); PG8_STAGE(PG8_SB(0, 1), cB + hstepB, voffB); PG8_STAGE(PG8_SA(0, 0), cA, voffA); PG8_STAGE(PG8_SA(0, 1), cA + hstepA, voffA);
        if (wr == 1) PG8_BAR;
        PG8_WAIT_V(2); PG8_BAR;
        PG8_STAGE(PG8_SB(1, 0), cB + kstep, voffB); PG8_STAGE(PG8_SA(1, 0), cA + kstep, voffA); PG8_STAGE(PG8_SB(1, 1), cB + hstepB + kstep, voffB);
        PG8_WAIT_V(6); PG8_BAR;
    } else {
        PG8_STAGE(PG8_SB(0, 0), cB, voffB); PG8_STAGE(PG8_SA(0, 0), cA, voffA); PG8_STAGE(PG8_SB(0, 1), cB + hstepB, voffB); PG8_STAGE(PG8_SA(0, 1), cA + hstepA, voffA);
        if (wr == 1) PG8_BAR;
        PG8_WAIT_V(4); PG8_BAR;
        PG8_STAGE(PG8_SB(1, 0), cB + kstep, voffB); PG8_STAGE(PG8_SA(1, 0), cA + kstep, voffA); PG8_STAGE(PG8_SB(1, 1), cB + hstepB + kstep, voffB);
        PG8_WAIT_V(6); PG8_BAR;
    }
    for (;;) {
        const bool has_next = S.next(ui + 1, nxt);
        const char* nA = has_next ? (const char*)g.A + (size_t)nxt.pm * tstepA : cA; const char* nB = has_next ? (const char*)g.Bt + (size_t)nxt.pn * tstepB : cB;
        for (int t = 0; t < nt; t += 2) {
            const bool last = (t == nt - 2);
            const char* a1 = cA + (size_t)(t + 1) * kstep;
            const char* a2 = last ? nA : cA + (size_t)(t + 2) * kstep; const char* b2 = last ? nB : cB + (size_t)(t + 2) * kstep;
            const char* a3 = a2 + kstep; const char* b3 = b2 + kstep;
            if (last && has_next) S.a_ready(nxt);
            if constexpr (SP2) {
            PG8_LDB(B0, 0, 0); PG8_LDB(B1, 0, 1); PG8_SCHED; PG8_LDA(At, 0, 0); PG8_STAGE(PG8_SA(1, 1), a1 + hstepA, voffA);
            PG8_WAIT_V(8); PG8_WAIT_L(0); PG8_BAR; PG8_MMA(0, 0, At, B0); PG8_MMA(0, 1, At, B1); PG8_BAR; PG8_SCHED;
            PG8_LDA(At, 0, 1); PG8_STAGE(PG8_SB(0, 0), b2, voffB); PG8_STAGE(PG8_SB(0, 1), b2 + hstepB, voffB); PG8_STAGE(PG8_SA(0, 0), a2, voffA);
            PG8_WAIT_V(8); PG8_WAIT_L(0); PG8_BAR; PG8_MMA(1, 0, At, B0); PG8_MMA(1, 1, At, B1); PG8_BAR; PG8_SCHED;
            PG8_LDB(B0, 1, 0); PG8_LDB(B1, 1, 1); PG8_SCHED; PG8_LDA(At, 1, 0); PG8_STAGE(PG8_SA(0, 1), a2 + hstepA, voffA);
            PG8_WAIT_V(8); PG8_WAIT_L(0); PG8_BAR; PG8_MMA(0, 0, At, B0); PG8_MMA(0, 1, At, B1); PG8_BAR; PG8_SCHED;
            PG8_LDA(At, 1, 1); PG8_STAGE(PG8_SB(1, 0), b3, voffB); PG8_STAGE(PG8_SB(1, 1), b3 + hstepB, voffB); PG8_STAGE(PG8_SA(1, 0), a3, voffA);
            PG8_WAIT_V(8); PG8_WAIT_L(0); PG8_BAR; PG8_MMA(1, 0, At, B0); PG8_MMA(1, 1, At, B1); PG8_BAR; PG8_SCHED;
            } else {
            PG8_LDB(B0, 0, 0); PG8_SCHED; PG8_LDA(At, 0, 0); PG8_STAGE(PG8_SA(1, 1), a1 + hstepA, voffA);
            PG8_WAIT_L(8); PG8_BAR; PG8_WAIT_L(0); PG8_MMA(0, 0, At, B0); PG8_BAR; PG8_SCHED;
            PG8_LDB(B1, 0, 1); PG8_STAGE(PG8_SB(0, 0), b2, voffB);
            PG8_BAR; PG8_WAIT_L(0); PG8_MMA(0, 1, At, B1); PG8_BAR;
            PG8_LDA(At, 0, 1); PG8_STAGE(PG8_SA(0, 0), a2, voffA);
            PG8_BAR; PG8_WAIT_L(0); PG8_MMA(1, 0, At, B0); PG8_BAR; PG8_SCHED;
            PG8_STAGE(PG8_SB(0, 1), b2 + hstepB, voffB);
            PG8_WAIT_V(6); PG8_BAR; PG8_MMA(1, 1, At, B1); PG8_BAR;
            PG8_LDB(B0, 1, 0); PG8_SCHED; PG8_LDA(At, 1, 0); PG8_STAGE(PG8_SA(0, 1), a2 + hstepA, voffA);
            PG8_WAIT_L(8); PG8_BAR; PG8_WAIT_L(0); PG8_MMA(0, 0, At, B0); PG8_BAR; PG8_SCHED;
            PG8_LDB(B1, 1, 1); PG8_STAGE(PG8_SB(1, 0), b3, voffB);
            PG8_BAR; PG8_WAIT_L(0); PG8_MMA(0, 1, At, B1); PG8_BAR;
            PG8_LDA(At, 1, 1); PG8_STAGE(PG8_SA(1, 0), a3, voffA);
            PG8_BAR; PG8_WAIT_L(0); PG8_MMA(1, 0, At, B0); PG8_BAR; PG8_SCHED;
            PG8_STAGE(PG8_SB(1, 1), b3 + hstepB, voffB);
            PG8_WAIT_V(6); PG8_BAR; PG8_MMA(1, 1, At, B1); PG8_BAR;
            }
        }
        if constexpr (ALIGN_EPI) { if (wr == 0) PG8_BAR; }
        if constexpr (!Epi::AFTER_DRAIN) { E(acc, cur, wr, wc, fr, fq); S.done(cur); }
        if (!has_next) break;
#pragma unroll
        for (int a = 0; a < 2; ++a)
#pragma unroll
            for (int b = 0; b < 2; ++b)
#pragma unroll
                for (int m = 0; m < 4; ++m)
#pragma unroll
                    for (int n = 0; n < 2; ++n) acc[a][b][m][n] = (f32x4){0.f, 0.f, 0.f, 0.f};
        cur = nxt; cA = nA; cB = nB; ++ui;
        if constexpr (ALIGN_EPI) { if (wr == 1) PG8_BAR; }
    }
    PG8_WAIT_V(0);
    if constexpr (!ALIGN_EPI) { if (wr == 0) PG8_BAR; }
    PG8_BAR;
    if constexpr (Epi::AFTER_DRAIN) { E.fused(acc, cur, wr, wc, fr, fq, lds, wid, lane); S.done(cur); }
#undef PG8_SA
#undef PG8_SB
#undef PG8_STAGE
#undef PG8_LDA
#undef PG8_LDB
#undef PG8_MMA
#undef PG8_WAIT_V
#undef PG8_WAIT_L
#undef PG8_BAR
#undef PG8_SCHED
}
}

constexpr int DM = 2048, NBATCH = 4, SEQ = 8192, CTXL = 256, RB = CTXL + SEQ  , HB = 2  , HR = HB * RB  ;
constexpr int DFF = 5632, NUP = 2 * DFF, NMOD = 6 * DM, NCH = RB / 64  ;
constexpr int LDP = 14848;
constexpr int NWIN = 15104, INW = 14880;
constexpr int C_QA = 0, C_KA = 1024, C_VA = 1280, C_QD = 1536, C_KD = 2560, C_VD = 3584, C_QKV = 4608, C_Z = 7680, C_G = 8704;
constexpr float LN_EPS = 1e-6f, DN_ALPHA = 1.41421356237f  , LOG2E = 1.4426950408889634f;
constexpr int NWAVES = 8, NTHR = 512;
constexpr size_t MiB = 1u << 20;
constexpr size_t WS_CTL = 0, CTL_ZERO_BYTES = 1 * MiB;
constexpr size_t WS_MOD = 1 * MiB;
constexpr size_t WS_ROPEA = WS_MOD + 512 * 1024, WS_ROPED = WS_ROPEA + 32768, WS_LAM = WS_ROPED + 16384;
constexpr size_t WS_CX = 2 * MiB;
constexpr size_t WS_WIN = 10 * MiB, WS_WPA = 69 * MiB, WS_WPB = 73 * MiB, WS_WPC = 77 * MiB, WS_WO = 81 * MiB, WS_WUP = 89 * MiB, WS_WDN = 133 * MiB;
constexpr size_t WS_H = 155 * MiB;
constexpr size_t WS_AB = 221 * MiB;
constexpr size_t WS_GL = WS_AB + 5 * MiB / 2;
constexpr size_t WS_P = 224 * MiB;
constexpr size_t WS_G = 703 * MiB;
constexpr size_t GU_BYTES = 73728, GU_W = 0, GU_QG = 16384, GU_KD = 32768, GU_AT = 49152, GU_U = 57344;
constexpr size_t WS_END = WS_G + 297 * MiB;
constexpr size_t WS_TOT = WS_G, WS_M = WS_G + 132 * MiB, WS_OX = WS_P, WS_U = WS_P, WS_ACT = WS_G, WS_FX = WS_P;
static_assert((size_t)HR * LDP * 2 <= 479 * MiB && (size_t)4224 * GU_BYTES <= 297 * MiB && (size_t)HR * NUP * 2 <= 479 * MiB && (size_t)HR * DFF * 2 <= 297 * MiB, "d_ws map");
constexpr size_t WS_TRASH = 512 * 1024;
constexpr int CW_BAR = 4096, CW_Q = 16384;
constexpr int RING_BYTES = 131072, LDS_BYTES = 147456, LDSCTL_OFF = LDS_BYTES - 1024;

#define GAS __attribute__((address_space(1)))
#define LAS __attribute__((address_space(3)))
typedef unsigned short bf16_t;
typedef short bf16x8 __attribute__((ext_vector_type(8)));
typedef short s16x4 __attribute__((ext_vector_type(4)));
typedef float f32x4 __attribute__((ext_vector_type(4)));
typedef float f32x2 __attribute__((ext_vector_type(2)));
typedef float f32x16 __attribute__((ext_vector_type(16)));
typedef unsigned u32x4 __attribute__((ext_vector_type(4)));
typedef unsigned u32x2 __attribute__((ext_vector_type(2)));
using pg8::cvt_pk_bf16; using pg8::bf_lo; using pg8::bf_hi; using pg8::sigm;
__device__ __forceinline__ float wave_sum(float v) {
#pragma unroll
    for (int o = 1; o < 64; o <<= 1) v += __shfl_xor(v, o);
    return v;
}
__device__ __forceinline__ int tid_opaque() { int t = threadIdx.x; asm volatile("" : "+v"(t)); return t; }
__device__ __forceinline__ int opaque_s(int v) { asm volatile("" : "+s"(v)); return v; }
__device__ __forceinline__ float silu_f(float x) { return x / (1.0f + __expf(-x)); }
__device__ __forceinline__ int crow(int r, int hi) { return (r & 3) + 8 * (r >> 2) + 4 * hi; }
__device__ __forceinline__ bf16x8 pack8(float a0, float a1, float a2, float a3, float a4, float a5, float a6, float a7) {
    u32x4 w; w.x = cvt_pk_bf16(a0, a1); w.y = cvt_pk_bf16(a2, a3); w.z = cvt_pk_bf16(a4, a5); w.w = cvt_pk_bf16(a6, a7); return __builtin_bit_cast(bf16x8, w); }
typedef short v4i16_t __attribute__((ext_vector_type(4)));
__device__ __forceinline__ s16x4 lds_tr(LAS const unsigned char* p) { return __builtin_bit_cast(s16x4, __builtin_amdgcn_ds_read_tr16_b64_v4i16((LAS v4i16_t*)p)); }
#define MFMA32(a, b, c) __builtin_amdgcn_mfma_f32_32x32x16_bf16((a), (b), (c), 0, 0, 0)

#define XB_TMO      128
#define XB_XCNT(j)  (256  + 64 * (j))
#define XB_XSUB(j)  (1280 + 64 * (j))
#define XB_XGEN(j)  (2304 + 64 * (j))
#define XB_TOP      3328
#define XB_TOPGEN   3392
#define XCD_BAR_WORDS 3456
#define XB_SPIN_CAP (1u << 18)

__device__ __forceinline__ unsigned xb_ld(unsigned* p)              { return __hip_atomic_load(p, __ATOMIC_RELAXED, __HIP_MEMORY_SCOPE_AGENT); }
__device__ __forceinline__ unsigned xb_add(unsigned* p, unsigned v) { return __hip_atomic_fetch_add(p, v, __ATOMIC_RELAXED, __HIP_MEMORY_SCOPE_AGENT); }
__device__ __forceinline__ unsigned xb_xcc_id() { return (unsigned)__builtin_amdgcn_s_getreg((3 << 11) | 20) & 0xFu; }
#define XB_SPIN(cond, bar) do { unsigned _sp = 0; while (cond) { __builtin_amdgcn_s_sleep(1); \
    if ((++_sp & 255u) == 0u) { if (xb_ld(&(bar)[XB_TMO])) break; if (_sp > XB_SPIN_CAP) { atomicAdd(&(bar)[XB_TMO], 1u); break; } } } } while (0)

struct XcdBarrier {
    unsigned* bar; unsigned x;
    volatile LAS unsigned* st;
};

__device__ __forceinline__ XcdBarrier xcd_barrier_post(unsigned* bar, volatile LAS unsigned* st) {
    XcdBarrier b; b.bar = bar; b.x = xb_xcc_id(); b.st = st;
    if (threadIdx.x == 0) (void)xb_add(&bar[XB_XCNT(b.x)], 1u);
    return b;
}
__device__ __forceinline__ void xcd_barrier_complete(unsigned* bar, unsigned x, unsigned& nloc, unsigned& nx) {
    const unsigned G = gridDim.x * gridDim.y * gridDim.z;
    unsigned sum, cnt, mine, sp = 0u;
    for (;;) {
        sum = 0u; cnt = 0u; mine = 0u;
#pragma unroll
        for (unsigned j = 0; j < 16; ++j) { const unsigned c = xb_ld(&bar[XB_XCNT(j)]); sum += c; cnt += (c > 0u) ? 1u : 0u; mine = (j == x) ? c : mine; }
        if (sum == G) break;
        __builtin_amdgcn_s_sleep(1);
        if ((++sp & 255u) == 0u) { if (xb_ld(&bar[XB_TMO])) break; if (sp > XB_SPIN_CAP) { atomicAdd(&bar[XB_TMO], 1u); break; } }
    }
    nloc = mine > 0u ? mine : 1u; nx = cnt > 0u ? cnt : 1u;
}

__device__ __forceinline__ void xcd_barrier(const XcdBarrier& b) {
    asm volatile("s_waitcnt vmcnt(0)" ::: "memory");
    __syncthreads();
    if (threadIdx.x == 0) {
        unsigned* bar = b.bar;
        __builtin_amdgcn_s_waitcnt(0);
        unsigned nloc = b.st[0], nx = b.st[1];
        if (nloc == 0u) { xcd_barrier_complete(bar, b.x, nloc, nx); b.st[0] = nloc; b.st[1] = nx; }
        const unsigned old = xb_add(&bar[XB_XSUB(b.x)], 1u);
        const unsigned gen = old / nloc;
        if (old + 1u == (gen + 1u) * nloc) {
            __builtin_amdgcn_fence(__ATOMIC_RELEASE, "agent");
            asm volatile("s_waitcnt vmcnt(0)" ::: "memory");
            const unsigned og = xb_add(&bar[XB_TOP], 1u);
            const unsigned tg = og / nx;
            if (og + 1u == (tg + 1u) * nx) xb_add(&bar[XB_TOPGEN], 1u);
            else XB_SPIN(xb_ld(&bar[XB_TOPGEN]) == tg, bar);
            __builtin_amdgcn_fence(__ATOMIC_ACQUIRE, "agent");
            xb_add(&bar[XB_XGEN(b.x)], 1u);
            asm volatile("s_waitcnt vmcnt(0)" ::: "memory");
        } else {
            XB_SPIN(xb_ld(&bar[XB_XGEN(b.x)]) == gen, bar);
            __builtin_amdgcn_fence(__ATOMIC_ACQUIRE, "agent");
            asm volatile("s_waitcnt vmcnt(0)" ::: "memory");
        }
    }
    __syncthreads();
}
struct Args { const float* in[29]; float* out; unsigned char* ws; int ph_lo, ph_hi; };
enum { I_X = 0, I_C, I_CTX, I_CCTX, I_WMOD, I_BMOD, I_WIN, I_SINK, I_LQ1, I_LK1, I_LQ2, I_LK2, I_SUBLN, I_DNCONV, I_ALOG, I_DTB, I_DNNORM, I_WPA, I_WPB, I_WPC, I_WO, I_LN1G, I_LN1B, I_WUP, I_FCW, I_FCB, I_WDN, I_LN2G, I_LN2B };

__device__ __forceinline__ void ph_prologue(const Args& A, LAS unsigned char* lds) {
    const int tid = tid_opaque(), lane = tid & 63, wave = tid >> 6, G = gridDim.x, bid = blockIdx.x;
    const int gt = bid * NTHR + tid, NT = G * NTHR;
    float* ropeA = (float*)(A.ws + WS_ROPEA); float* ropeD = (float*)(A.ws + WS_ROPED); float* LAM = (float*)(A.ws + WS_LAM); float* MOD = (float*)(A.ws + WS_MOD);
    for (int e = gt; e < 128 * 32; e += NT) { const int pos = e >> 5, f = e & 31; const float inv = powf(10000.0f, -(float)(2 * f) / 64.0f); const float ang = (float)pos * inv; ropeA[2 * e] = cosf(ang); ropeA[2 * e + 1] = sinf(ang); }
    for (int e = gt; e < 128 * 16; e += NT) { const int pos = e >> 4, f = e & 15; const float inv = powf(10000.0f, -(float)(2 * f) / 32.0f); const float ang = (float)pos * inv; ropeD[2 * e] = cosf(ang); ropeD[2 * e + 1] = sinf(ang); }
    if (gt < 2) { const int l = gt; float s1 = 0.f, s2 = 0.f;
        for (int i = 0; i < 64; ++i) { s1 += A.in[I_LQ1][l * 64 + i] * A.in[I_LK1][l * 64 + i]; s2 += A.in[I_LQ2][l * 64 + i] * A.in[I_LK2][l * 64 + i]; }
        const float lam_init = 0.8f - 0.6f * expf(-0.3f * (float)l); LAM[2 * l] = expf(s1) - expf(s2) + lam_init; LAM[2 * l + 1] = 1.0f - lam_init; }
    LAS float* sc = (LAS float*)lds;
    LAS float* red = (LAS float*)(lds + 40960);
    for (int e = tid; e < 5 * 2048; e += NTHR) { const int idx = e >> 11, k = e & 2047; const float v = (idx < 4) ? A.in[I_C][idx * 2048 + k] : A.in[I_CCTX][k]; sc[e] = silu_f(v); }
    __syncthreads();
    for (int u = bid; u < 192; u += G) {
        const int l = u / 96, n0 = (u % 96) * 128;
        const float* W = A.in[I_WMOD] + (size_t)l * 2048 * NMOD + n0 + 2 * lane;
        float acc[5][2];
#pragma unroll
        for (int i = 0; i < 5; ++i) { acc[i][0] = 0.f; acc[i][1] = 0.f; }
        const int k0 = wave * 256;
#pragma unroll 4
        for (int k = k0; k < k0 + 256; ++k) { const f32x2 w = *(const f32x2*)(W + (size_t)k * NMOD);
#pragma unroll
            for (int i = 0; i < 5; ++i) { const float s = sc[i * 2048 + k]; acc[i][0] += s * w.x; acc[i][1] += s * w.y; } }
#pragma unroll
        for (int i = 0; i < 5; ++i) { red[(wave * 5 + i) * 128 + 2 * lane] = acc[i][0]; red[(wave * 5 + i) * 128 + 2 * lane + 1] = acc[i][1]; }
        __syncthreads();
        for (int e = tid; e < 640; e += NTHR) { const int idx = e >> 7, n = e & 127; float s = 0.f;
#pragma unroll
            for (int w = 0; w < 8; ++w) s += red[(w * 5 + idx) * 128 + n];
            MOD[(size_t)(l * 5 + idx) * NMOD + n0 + n] = s + A.in[I_BMOD][l * NMOD + n0 + n]; }
        __syncthreads();
    }
}
__device__ __forceinline__ int win_src(int n) {
    if (n < 1280) { const int j = n & 127, p = j >> 1, s = j & 1; const int dim = (p < 32) ? (s * 32 + p) : (64 + s * 32 + (p - 32)); return (n & ~127) + dim; }
    if (n < 1536) return n;
    if (n < 3584) { const int j = n & 63, p = j >> 1, s = j & 1; const int dim = (p < 16) ? (s * 16 + p) : (32 + s * 16 + (p - 16)); return (n & ~63) + dim; }
    if (n < 8704) return n;
    if (n < 14848) return n + 32;
    if (n < 14880) return n - 14848 + 8704;
    return -1;
}
template <int MODE> __device__ __forceinline__ void transpose_item(const float* W, int K, int N, bf16_t* WT, LAS float* scr, int kb, int nb, int lane) {
    const int k0 = 64 * kb, n0 = 32 * nb, nn = n0 + (lane & 31);
    const int sc = (MODE == 1) ? win_src(nn) : nn;
    const float* src = W + (size_t)(k0 + (lane >> 5)) * N + (sc >= 0 ? sc : 0);
#pragma unroll 8
    for (int i = 0; i < 32; ++i) { const float v = src[(size_t)(2 * i) * N]; scr[(2 * i + (lane >> 5)) * 33 + (lane & 31)] = (sc >= 0) ? v : 0.f; }
    asm volatile("s_waitcnt lgkmcnt(0)" ::: "memory");
    const int c = lane & 7;
#pragma unroll
    for (int j = 0; j < 4; ++j) { const int n = (lane >> 3) + 8 * j; const LAS float* s = scr + (8 * c) * 33 + n;
        u32x4 o; o.x = cvt_pk_bf16(s[0 * 33], s[1 * 33]); o.y = cvt_pk_bf16(s[2 * 33], s[3 * 33]); o.z = cvt_pk_bf16(s[4 * 33], s[5 * 33]); o.w = cvt_pk_bf16(s[6 * 33], s[7 * 33]);
        *(u32x4*)(WT + (size_t)(n0 + n) * K + k0 + 8 * c) = o; }
    asm volatile("s_waitcnt lgkmcnt(0)" ::: "memory");
}
__device__ __forceinline__ void ph_weights(const Args& A, LAS unsigned char* lds, int l) {
    const int tid = tid_opaque(), lane = tid & 63, wave = tid >> 6, G = gridDim.x, bid = blockIdx.x;
    LAS float* scr = (LAS float*)(lds + wave * 8448);
    unsigned char* ws = A.ws;
    constexpr int I0 = 32 * 472, I1 = 16 * 64, I2 = 32 * 64, I3 = 32 * 352, I4 = 88 * 64, NIT = I0 + 3 * I1 + I2 + I3 + I4;
    for (int it = bid * NWAVES + wave; it < NIT; it += G * NWAVES) {
        int r = it;
        if (r < I0) { transpose_item<1>(A.in[I_WIN] + (size_t)l * 2048 * INW, 2048, INW, (bf16_t*)(ws + WS_WIN), scr, r / 472, r % 472, lane); continue; } r -= I0;
        if (r < I1) { transpose_item<0>(A.in[I_WPA] + (size_t)l * 1024 * 2048, 1024, 2048, (bf16_t*)(ws + WS_WPA), scr, r / 64, r % 64, lane); continue; } r -= I1;
        if (r < I1) { transpose_item<0>(A.in[I_WPB] + (size_t)l * 1024 * 2048, 1024, 2048, (bf16_t*)(ws + WS_WPB), scr, r / 64, r % 64, lane); continue; } r -= I1;
        if (r < I1) { transpose_item<0>(A.in[I_WPC] + (size_t)l * 1024 * 2048, 1024, 2048, (bf16_t*)(ws + WS_WPC), scr, r / 64, r % 64, lane); continue; } r -= I1;
        if (r < I2) { transpose_item<0>(A.in[I_WO] + (size_t)l * 2048 * 2048, 2048, 2048, (bf16_t*)(ws + WS_WO), scr, r / 64, r % 64, lane); continue; } r -= I2;
        if (r < I3) { transpose_item<0>(A.in[I_WUP] + (size_t)l * 2048 * NUP, 2048, NUP, (bf16_t*)(ws + WS_WUP), scr, r / 352, r % 352, lane); continue; } r -= I3;
        transpose_item<0>(A.in[I_WDN] + (size_t)l * DFF * 2048, DFF, 2048, (bf16_t*)(ws + WS_WDN), scr, r / 64, r % 64, lane);
    }
}
__device__ __forceinline__ void row_src(const Args& A, int l, int half, int r, const float*& src, float*& dst, const float*& mod, bool& is_ctx) {
    const int bl = r / RB, tp = r - bl * RB, b = opaque_s(half) * HB + bl; is_ctx = tp < CTXL;
    float* cx = (float*)(A.ws + WS_CX);
    dst = is_ctx ? cx + (size_t)(b * CTXL + tp) * DM : A.out + (size_t)(b * SEQ + tp - CTXL) * DM;
    if (l == 0) src = is_ctx ? A.in[I_CTX] + (size_t)(b * CTXL + tp) * DM : A.in[I_X] + (size_t)(b * SEQ + tp - CTXL) * DM; else src = dst;
    mod = (const float*)(A.ws + WS_MOD) + (size_t)(l * 5 + (is_ctx ? 4 : b)) * NMOD;
}
__device__ __forceinline__ void ln_stats(const f32x4 (&v)[8], float& mean, float& rstd) {
    float s = 0.f;
#pragma unroll
    for (int j = 0; j < 8; ++j) s += (v[j].x + v[j].y) + (v[j].z + v[j].w);
    mean = wave_sum(s) * (1.0f / DM); float q = 0.f;
#pragma unroll
    for (int j = 0; j < 8; ++j) { const f32x4 d = v[j] - mean; q += (d.x * d.x + d.y * d.y) + (d.z * d.z + d.w * d.w); }
    rstd = 1.0f / sqrtf(wave_sum(q) * (1.0f / DM) + LN_EPS);
}
__device__ __forceinline__ void ada_store(const f32x4 (&v)[8], float mean, float rstd, const float* shift, const float* scale, bf16_t* hrow, int lane) {
#pragma unroll
    for (int j = 0; j < 8; ++j) { const int e = (64 * j + lane) * 4; const f32x4 sh = *(const f32x4*)(shift + e), sc = *(const f32x4*)(scale + e);
        const f32x4 y = (v[j] - mean) * rstd * (sc + 1.0f) + sh; u32x2 w; w.x = cvt_pk_bf16(y.x, y.y); w.y = cvt_pk_bf16(y.z, y.w); *(u32x2*)(hrow + e) = w; }
}
__device__ __forceinline__ void ph_adaln(const Args& A, int l, int half) {
    const int tid = tid_opaque(), lane = tid & 63, gw = blockIdx.x * NWAVES + (tid >> 6), NGW = gridDim.x * NWAVES;
    bf16_t* H = (bf16_t*)(A.ws + WS_H);
    for (int r = gw; r < HR; r += NGW) {
        const float* src; float* dst; const float* mod; bool is_ctx; row_src(A, l, half, r, src, dst, mod, is_ctx);
        f32x4 v[8];
#pragma unroll
        for (int j = 0; j < 8; ++j) v[j] = *((const f32x4*)src + 64 * j + lane);
        float mean, rstd; ln_stats(v, mean, rstd);
        ada_store(v, mean, rstd, mod, mod + DM, H + (size_t)r * DM, lane);
    }
}
template <bool WITH_H> __device__ __forceinline__ void ph_resln(const Args& A, int l, int half, const bf16_t* Y, int gate_idx, const float* lng, const float* lnb, bool dry) {
    const int tid = tid_opaque(), lane = tid & 63, gw = blockIdx.x * NWAVES + (tid >> 6), NGW = gridDim.x * NWAVES;
    bf16_t* H = (bf16_t*)(A.ws + WS_H);
    for (int r = gw; r < HR; r += NGW) {
        const float* src; float* dst; const float* mod; bool is_ctx; row_src(A, l, half, r, src, dst, mod, is_ctx);
        if (is_ctx && l == 1) continue;
        if (!WITH_H) src = dst;
        if (dry) dst = (float*)(A.ws + WS_TRASH) + (tid >> 6) * DM;
        const float* gate = mod + gate_idx * DM; const bf16_t* yrow = Y + (size_t)r * DM;
        f32x4 v[8];
#pragma unroll
        for (int j = 0; j < 8; ++j) { const int e = 64 * j + lane; const u32x2 yw = *((const u32x2*)yrow + e); const f32x4 yv = (f32x4){bf_lo(yw.x), bf_hi(yw.x), bf_lo(yw.y), bf_hi(yw.y)};
            v[j] = *((const f32x4*)src + e) * DN_ALPHA + *((const f32x4*)gate + e) * yv; }
        float mean, rstd; ln_stats(v, mean, rstd);
#pragma unroll
        for (int j = 0; j < 8; ++j) { const int e = 64 * j + lane; v[j] = (v[j] - mean) * rstd * *((const f32x4*)lng + e) + *((const f32x4*)lnb + e); *((f32x4*)dst + e) = v[j]; }
        if (WITH_H) { ln_stats(v, mean, rstd); ada_store(v, mean, rstd, mod + 3 * DM, mod + 4 * DM, dry ? (bf16_t*)(A.ws + WS_TRASH) + 131072 + (tid >> 6) * DM : H + (size_t)r * DM, lane); }
    }
}
__device__ __forceinline__ void ph_convact(const Args& A, int l_) {
    const int l = opaque_s(l_);
    const int gt = blockIdx.x * NTHR + tid_opaque(), NT = gridDim.x * NTHR;
    const bf16_t* U = (const bf16_t*)(A.ws + WS_U); bf16_t* ACT = (bf16_t*)(A.ws + WS_ACT);
    const float* cw = A.in[I_FCW] + (size_t)l * 3 * NUP; const float* cb = A.in[I_FCB] + (size_t)l * NUP;
    constexpr int NVC = DFF / 8, NRB = HR / 32;
    for (int idx = gt; idx < NRB * NVC; idx += NT) {
        const int rbk = idx / NVC, vc = idx - rbk * NVC, r0 = rbk * 32, tp0 = r0 % RB;
        const bool first_start = (tp0 == 0 || tp0 == CTXL), last_end = (tp0 + 31 == CTXL - 1 || tp0 + 31 == RB - 1);
        const int ca = vc * 8, cbk = DFF + vc * 8;
        float wa[3][8], wb[3][8], ba[8], bb[8];
#pragma unroll
        for (int t = 0; t < 3; ++t) {
#pragma unroll
            for (int k = 0; k < 8; ++k) { wa[t][k] = cw[t * NUP + ca + k]; wb[t][k] = cw[t * NUP + cbk + k]; } }
#pragma unroll
        for (int k = 0; k < 8; ++k) { ba[k] = cb[ca + k]; bb[k] = cb[cbk + k]; }
        const u32x4 z4 = (u32x4){0u, 0u, 0u, 0u};
        u32x4 pa = z4, pb = z4, qa, qb, na, nb;
        if (!first_start) { pa = *(const u32x4*)(U + (size_t)(r0 - 1) * NUP + ca); pb = *(const u32x4*)(U + (size_t)(r0 - 1) * NUP + cbk); }
        qa = *(const u32x4*)(U + (size_t)r0 * NUP + ca); qb = *(const u32x4*)(U + (size_t)r0 * NUP + cbk);
        for (int r = 0; r < 32; ++r) {
            if (r == 31 && last_end) { na = z4; nb = z4; } else { na = *(const u32x4*)(U + (size_t)(r0 + r + 1) * NUP + ca); nb = *(const u32x4*)(U + (size_t)(r0 + r + 1) * NUP + cbk); }
            float o[8];
#pragma unroll
            for (int k = 0; k < 4; ++k) {
                const unsigned a0 = pa[k], a1 = qa[k], a2 = na[k], b0 = pb[k], b1 = qb[k], b2 = nb[k];
                const float xa0 = wa[0][2 * k] * bf_lo(a0) + wa[1][2 * k] * bf_lo(a1) + wa[2][2 * k] * bf_lo(a2) + ba[2 * k];
                const float xa1 = wa[0][2 * k + 1] * bf_hi(a0) + wa[1][2 * k + 1] * bf_hi(a1) + wa[2][2 * k + 1] * bf_hi(a2) + ba[2 * k + 1];
                const float xb0 = wb[0][2 * k] * bf_lo(b0) + wb[1][2 * k] * bf_lo(b1) + wb[2][2 * k] * bf_lo(b2) + bb[2 * k];
                const float xb1 = wb[0][2 * k + 1] * bf_hi(b0) + wb[1][2 * k + 1] * bf_hi(b1) + wb[2][2 * k + 1] * bf_hi(b2) + bb[2 * k + 1];
                o[2 * k] = silu_f(xa0) * xb0; o[2 * k + 1] = silu_f(xa1) * xb1; }
            u32x4 w; w.x = cvt_pk_bf16(o[0], o[1]); w.y = cvt_pk_bf16(o[2], o[3]); w.z = cvt_pk_bf16(o[4], o[5]); w.w = cvt_pk_bf16(o[6], o[7]);
            *(u32x4*)(ACT + (size_t)(r0 + r) * DFF + vc * 8) = w;
            pa = qa; pb = qb; qa = na; qb = nb;
        }
    }
}
__device__ __forceinline__ float max3f(float a, float b, float c) { float r; asm("v_max3_f32 %0, %1, %2, %3" : "=v"(r) : "v"(a), "v"(b), "v"(c)); return r; }
__device__ __forceinline__ float xhalf_max(float m) { auto rr = __builtin_amdgcn_permlane32_swap(__float_as_uint(m), __float_as_uint(m), false, false); float r; asm("v_max_f32_e32 %0, %1, %2" : "=v"(r) : "v"(__uint_as_float(rr[0])), "v"(__uint_as_float(rr[1]))); return r; }
__device__ __forceinline__ float xhalf_sum(float m) { auto rr = __builtin_amdgcn_permlane32_swap(__float_as_uint(m), __float_as_uint(m), false, false); return __uint_as_float(rr[0]) + __uint_as_float(rr[1]); }
#ifndef ATT_EXP
#define ATT_EXP 0
#endif
template <int DQK>
__device__ __forceinline__ void attn_core(LAS unsigned char* lds, const bf16_t* Qrow, int kc0, const bf16_t* K0, const bf16_t* V0, int n0, const bf16_t* K1, const bf16_t* V1, int n1,
                                          bool mask1, int qpos, int k1pos0, f32x16 (&oT)[4], float& mref, float& lsum, bool dryx = false) {
    const int tid = tid_opaque(), lane = tid & 63, r32 = lane & 31, hi = lane >> 5, wave = __builtin_amdgcn_readfirstlane(tid >> 6);
    bf16x8 qf[DQK / 16];
#pragma unroll
    for (int d0 = 0; d0 < DQK / 16; ++d0) qf[d0] = *(const bf16x8*)(Qrow + d0 * 16 + hi * 8);
    const int c0 = 2 * wave, c1 = 2 * wave + 1;
    const unsigned kg0 = (unsigned)((lane ^ c0) * LDP + c0 * 8), kg1 = (unsigned)((lane ^ c1) * LDP + c1 * 8);
    const unsigned vg0 = (unsigned)((16 * (c0 & 3) + (lane >> 2)) * LDP + (4 * (c0 >> 2) + (lane & 3)) * 8), vg1 = (unsigned)((16 * (c1 & 3) + (lane >> 2)) * LDP + (4 * (c1 >> 2) + (lane & 3)) * 8);
    const int vd0 = 49152 + ((c0 >> 2) * 8 + 2 * (c0 & 3)) * 512, vd1 = 49152 + ((c1 >> 2) * 8 + 2 * (c1 & 3)) * 512;
#define AT_DMA_K(t, s) do { const bf16_t* kp_ = ((t) < n0) ? K0 + (size_t)(t) * 64 * LDP : K1 + (size_t)((t) - n0) * 64 * LDP; \
        __builtin_amdgcn_global_load_lds((const unsigned*)(kp_ + kg0), (LAS unsigned*)(lds + (s) * 16384 + c0 * 1024), 16, 0, 0); \
        __builtin_amdgcn_global_load_lds((const unsigned*)(kp_ + kg1), (LAS unsigned*)(lds + (s) * 16384 + c1 * 1024), 16, 0, 0); } while (0)
#define AT_DMA_V(t, s) do { const bf16_t* vp_ = ((t) < n0) ? V0 + (size_t)(t) * 64 * LDP : V1 + (size_t)((t) - n0) * 64 * LDP; \
        __builtin_amdgcn_global_load_lds((const unsigned*)(vp_ + vg0), (LAS unsigned*)(lds + (s) * 16384 + vd0), 16, 0, 0); \
        __builtin_amdgcn_global_load_lds((const unsigned*)(vp_ + vg1), (LAS unsigned*)(lds + (s) * 16384 + vd1), 16, 0, 0); } while (0)
    const int nt = n0 + n1;
    const int vbase = 49152 + (4 * hi + ((lane & 15) >> 2)) * 64 + ((lane >> 4) & 1) * 32 + (lane & 3) * 8;
#define AT_KLD(kb) do { kbo = (kb); if (DQK == 64) { _Pragma("unroll") for (int d0 = 0; d0 < 2; ++d0) { const int c_ = (kc0 >> 3) + 2 * d0 + hi; const int off_ = kbo + c_ * 1024 + ((r32 ^ c_) << 4); \
            kf[2 * d0] = *(LAS const bf16x8*)(lds + off_); kf[2 * d0 + 1] = *(LAS const bf16x8*)(lds + off_ + 512); } } } while (0)
#define AT_QK(P0, P1) do { _Pragma("unroll") for (int r_ = 0; r_ < 16; ++r_) { P0[r_] = 0.f; P1[r_] = 0.f; } \
        if (DQK == 64) { bf16x8 kg[4]; _Pragma("unroll") for (int d0 = 2; d0 < 4; ++d0) { const int c_ = (kc0 >> 3) + 2 * d0 + hi; const int off_ = kbo + c_ * 1024 + ((r32 ^ c_) << 4); \
                kg[2 * d0 - 4] = *(LAS const bf16x8*)(lds + off_); kg[2 * d0 - 3] = *(LAS const bf16x8*)(lds + off_ + 512); } \
            _Pragma("unroll") for (int d0 = 0; d0 < 2; ++d0) { P0 = MFMA32(kf[2 * d0], qf[d0], P0); P1 = MFMA32(kf[2 * d0 + 1], qf[d0], P1); } \
            _Pragma("unroll") for (int d0 = 2; d0 < 4; ++d0) { P0 = MFMA32(kg[2 * d0 - 4], qf[d0], P0); P1 = MFMA32(kg[2 * d0 - 3], qf[d0], P1); } } \
        else { _Pragma("unroll") for (int d0 = 0; d0 < DQK / 16; ++d0) { const int c_ = (kc0 >> 3) + 2 * d0 + hi; const int off_ = kbo + c_ * 1024 + ((r32 ^ c_) << 4); \
            const bf16x8 a0_ = *(LAS const bf16x8*)(lds + off_), a1_ = *(LAS const bf16x8*)(lds + off_ + 512); P0 = MFMA32(a0_, qf[d0], P0); P1 = MFMA32(a1_, qf[d0], P1); } } } while (0)
    bf16x8 kf[4]; int kbo = 0;
    f32x16 pc0, pc1;
    AT_DMA_K(0, 0); AT_DMA_V(0, 0); if (nt > 1) { AT_DMA_K(1, 1); AT_DMA_V(1, 1); } if (nt > 2) AT_DMA_K(2, 2);
    asm volatile("s_waitcnt vmcnt(0)" ::: "memory"); __syncthreads();
    AT_KLD(0); AT_QK(pc0, pc1);
    __syncthreads();
    int s0 = 0, s1 = 1, s2 = 2;
    for (int t = 0; t < nt; ++t) {
        const bool more1 = (t + 1 < nt), more2 = (t + 2 < nt), more3 = (t + 3 < nt);
        if (!(ATT_EXP == 7 && dryx)) {
        if (more3) AT_DMA_K(t + 3, s0);
        if (more2) AT_DMA_V(t + 2, s2);
        }
        if (more1) { AT_KLD(s1 * 16384); }
        if (mask1 && t >= n0) { const int kb = k1pos0 + (t - n0) * 64 + 4 * hi - qpos;
#pragma unroll
            for (int r = 0; r < 16; ++r) { const int dl = kb + (r & 3) + 8 * (r >> 2); if (dl > 128 || dl < -128) pc0[r] = -INFINITY; if (dl + 32 > 128 || dl + 32 < -128) pc1[r] = -INFINITY; } }
        if (!(ATT_EXP == 1 && dryx)) {
        float tm = max3f(pc0[0], pc1[0], pc0[1]), tm2 = max3f(pc1[1], pc0[2], pc1[2]);
#pragma unroll
        for (int r = 3; r < 15; r += 2) { tm = max3f(tm, pc0[r], pc1[r]); tm2 = max3f(tm2, pc0[r + 1], pc1[r + 1]); }
        tm = max3f(tm, pc0[15], pc1[15]); tm = max3f(tm, tm2, tm2);
        tm = xhalf_max(tm);
        if (__any(tm > mref + 8.0f)) { const float mn = fmaxf(mref, tm); const float al = __builtin_amdgcn_exp2f(mref - mn);
#pragma unroll
            for (int q = 0; q < 4; ++q) oT[q] = oT[q] * al;
            lsum *= al; mref = mn; }
        float rs = 0.f;
#pragma unroll
        for (int r = 0; r < 16; ++r) { pc0[r] = __builtin_amdgcn_exp2f(pc0[r] - mref); pc1[r] = __builtin_amdgcn_exp2f(pc1[r] - mref); rs += pc0[r] + pc1[r]; }
        lsum += rs;
        }
        bf16x8 pw[4];
        pw[0] = pack8(pc0[0], pc0[1], pc0[2], pc0[3], pc0[4], pc0[5], pc0[6], pc0[7]); pw[1] = pack8(pc0[8], pc0[9], pc0[10], pc0[11], pc0[12], pc0[13], pc0[14], pc0[15]);
        pw[2] = pack8(pc1[0], pc1[1], pc1[2], pc1[3], pc1[4], pc1[5], pc1[6], pc1[7]); pw[3] = pack8(pc1[8], pc1[9], pc1[10], pc1[11], pc1[12], pc1[13], pc1[14], pc1[15]);
        const unsigned vt = (unsigned)(uintptr_t)(lds + s0 * 16384 + vbase);
        s16x4 va[4], vc[4];
#define AT_TR(dst, off) asm volatile("ds_read_b64_tr_b16 %0, %1 offset:%2" : "=&v"(dst) : "v"(vt), "n"(off) : "memory")
#define AT_VRD(dst, g) do { AT_TR(dst[0], (((g) >> 1) * 8 + 4 * ((g) & 1)) * 512); AT_TR(dst[1], (((g) >> 1) * 8 + 4 * ((g) & 1)) * 512 + 512); \
        AT_TR(dst[2], (((g) >> 1) * 8 + 4 * ((g) & 1)) * 512 + 1024); AT_TR(dst[3], (((g) >> 1) * 8 + 4 * ((g) & 1)) * 512 + 1536); } while (0)
#define AT_LW(n) asm volatile("s_waitcnt lgkmcnt(" #n ")" ::: "memory")
#define AT_PV(src, g) do { oT[(g) >> 1] = MFMA32(((bf16x8){src[0][0], src[0][1], src[0][2], src[0][3], src[1][0], src[1][1], src[1][2], src[1][3]}), pw[2 * ((g) & 1)], oT[(g) >> 1]); \
        oT[(g) >> 1] = MFMA32(((bf16x8){src[2][0], src[2][1], src[2][2], src[2][3], src[3][0], src[3][1], src[3][2], src[3][3]}), pw[2 * ((g) & 1) + 1], oT[(g) >> 1]); } while (0)
        if (ATT_EXP == 2 && dryx) { if (more1) { AT_QK(pc0, pc1); } } else {
        AT_VRD(va, 0);
        if (more1 && !(ATT_EXP == 3 && dryx)) { AT_QK(pc0, pc1); }
        __builtin_amdgcn_sched_barrier(0);
        AT_VRD(vc, 1); AT_LW(4); __builtin_amdgcn_sched_barrier(0); AT_PV(va, 0); __builtin_amdgcn_sched_barrier(0);
        AT_VRD(va, 2); AT_LW(4); __builtin_amdgcn_sched_barrier(0); AT_PV(vc, 1); __builtin_amdgcn_sched_barrier(0);
        AT_VRD(vc, 3); AT_LW(4); __builtin_amdgcn_sched_barrier(0); AT_PV(va, 2); __builtin_amdgcn_sched_barrier(0);
        AT_VRD(va, 4); AT_LW(4); __builtin_amdgcn_sched_barrier(0); AT_PV(vc, 3); __builtin_amdgcn_sched_barrier(0);
        AT_VRD(vc, 5); AT_LW(4); __builtin_amdgcn_sched_barrier(0); AT_PV(va, 4); __builtin_amdgcn_sched_barrier(0);
        AT_VRD(va, 6); AT_LW(4); __builtin_amdgcn_sched_barrier(0); AT_PV(vc, 5); __builtin_amdgcn_sched_barrier(0);
        AT_VRD(vc, 7); AT_LW(4); __builtin_amdgcn_sched_barrier(0); AT_PV(va, 6); __builtin_amdgcn_sched_barrier(0);
        AT_LW(0); __builtin_amdgcn_sched_barrier(0);
        AT_PV(vc, 7);
        }
#undef AT_VRD
#undef AT_PV
#undef AT_TR
#undef AT_LW
        if (more3) { asm volatile("s_waitcnt vmcnt(4)" ::: "memory"); } else if (more2) { asm volatile("s_waitcnt vmcnt(2)" ::: "memory"); } else { asm volatile("s_waitcnt vmcnt(0)" ::: "memory"); }
        asm volatile("s_waitcnt lgkmcnt(0)" ::: "memory"); if (!(ATT_EXP == 6 && dryx)) __builtin_amdgcn_s_barrier();
        { const int tmp = s0; s0 = s1; s1 = s2; s2 = tmp; }
    }
    __syncthreads();
#undef AT_DMA_K
#undef AT_DMA_V
#undef AT_QK
#undef AT_KLD
}
__device__ __forceinline__ void attn_store(bf16_t* orow, const f32x16 (&o)[4], int hi) {
#pragma unroll
    for (int q = 0; q < 4; ++q)
#pragma unroll
        for (int g = 0; g < 4; ++g) { u32x2 w; w.x = cvt_pk_bf16(o[q][4 * g], o[q][4 * g + 1]); w.y = cvt_pk_bf16(o[q][4 * g + 2], o[q][4 * g + 3]); *(u32x2*)(orow + 32 * q + 8 * g + 4 * hi) = w; }
}
__device__ __forceinline__ void attnA_unit(const Args& A, LAS unsigned char* lds, int l_, int bl, int nb, int pr, bool ctxq, bool dry) {
    const int l = opaque_s(l_);
    const int tid = tid_opaque(), lane = tid & 63, r32 = lane & 31, hi = lane >> 5, wave = __builtin_amdgcn_readfirstlane(tid >> 6);
    bf16_t* P = (bf16_t*)(A.ws + WS_P);
    const int head = 2 * pr + (wave >> 2), kvh = pr >> 1, qloc = nb * 128 + 32 * (wave & 3) + r32;
    const size_t brow = (size_t)bl * RB;
    const size_t qrow = brow + (ctxq ? 0 : CTXL) + qloc;
    const bf16_t* Kc = P + brow * LDP + C_KA + kvh * 128; const bf16_t* Vc = P + brow * LDP + C_VA + kvh * 128;
    int ks = 128 * (nb - 1), ke = 128 * (nb + 2); if (ks < 0) ks = 0; if (ke > SEQ) ke = SEQ;
    const int n1 = ctxq ? 0 : (ke - ks) / 64;
    f32x16 oT[4];
#pragma unroll
    for (int q = 0; q < 4; ++q)
#pragma unroll
        for (int r = 0; r < 16; ++r) oT[q][r] = 0.f;
    float mref = -INFINITY, lsum = 0.f;
    attn_core<128>(lds, P + qrow * LDP + C_QA + head * 128, 0, Kc, Vc, 4, Kc + (size_t)(CTXL + ks) * LDP, Vc + (size_t)(CTXL + ks) * LDP, n1, true, qloc, ks, oT, mref, lsum, dry);
    const float sk = A.in[I_SINK][l * 8 + head] * LOG2E;
    const float mf = fmaxf(mref, sk), sc = __builtin_amdgcn_exp2f(mref - mf);
    lsum = xhalf_sum(lsum);
    const float f = sc / (lsum * sc + __builtin_amdgcn_exp2f(sk - mf));
#pragma unroll
    for (int q = 0; q < 4; ++q) oT[q] = oT[q] * f;
    attn_store(dry ? (bf16_t*)(A.ws + WS_TRASH) + tid * 128 : P + qrow * LDP + C_QA + head * 128, oT, hi);
}
__device__ __forceinline__ void attnB_unit(const Args& A, LAS unsigned char* lds, int l_, int bl, int h, int qb, bool ctxq, bool dry) {
    const int l = opaque_s(l_);
    const int tid = tid_opaque(), lane = tid & 63, r32 = lane & 31, hi = lane >> 5, wave = __builtin_amdgcn_readfirstlane(tid >> 6);
    bf16_t* P = (bf16_t*)(A.ws + WS_P);
    const int sub = wave >> 2;
    const size_t brow = (size_t)bl * RB;
    const size_t qrow = brow + (ctxq ? 0 : CTXL) + qb * 128 + 32 * (wave & 3) + r32;
    const bf16_t* Kc = P + brow * LDP + C_KD + h * 128; const bf16_t* Vc = P + brow * LDP + C_VD + h * 128;
    f32x16 oT[4];
#pragma unroll
    for (int q = 0; q < 4; ++q)
#pragma unroll
        for (int r = 0; r < 16; ++r) oT[q][r] = 0.f;
    float mref = -INFINITY, lsum = 0.f;
    attn_core<64>(lds, P + qrow * LDP + C_QD + h * 128 + sub * 64, sub * 64, Kc, Vc, ctxq ? 4 : NCH, Kc, Vc, 0, false, 0, 0, oT, mref, lsum, dry);
    lsum = xhalf_sum(lsum);
    const float inv = 1.0f / lsum;
    LAS float* xch = (LAS float*)lds + (wave & 3) * 4096;
    if (sub == 1) {
#pragma unroll
        for (int q = 0; q < 4; ++q)
#pragma unroll
            for (int r = 0; r < 16; ++r) xch[(q * 16 + r) * 64 + lane] = oT[q][r] * inv;
    }
    __syncthreads();
    if (sub == 0) {
        const float lam = ((const float*)(A.ws + WS_LAM))[2 * l], post = ((const float*)(A.ws + WS_LAM))[2 * l + 1];
        float ss = 0.f;
#pragma unroll
        for (int q = 0; q < 4; ++q)
#pragma unroll
            for (int r = 0; r < 16; ++r) { const float v = oT[q][r] * inv - lam * xch[(q * 16 + r) * 64 + lane]; oT[q][r] = v; ss += v * v; }
        ss = xhalf_sum(ss);
        const float rn = post / sqrtf(ss * (1.0f / 128.0f) + 1e-6f);
        const float* sw = A.in[I_SUBLN] + l * 128;
#pragma unroll
        for (int q = 0; q < 4; ++q)
#pragma unroll
            for (int r = 0; r < 16; ++r) oT[q][r] *= rn * sw[32 * q + 8 * (r >> 2) + 4 * hi + (r & 3)];
        attn_store(dry ? (bf16_t*)(A.ws + WS_TRASH) + tid * 128 : P + qrow * LDP + C_QD + h * 128, oT, hi);
    }
    __syncthreads();
}
__device__ __forceinline__ void ph_attention(const Args& A, LAS unsigned char* lds, int l, int half, int it, bool dry) {
    const int tid = tid_opaque();
    unsigned* ctr = (unsigned*)(A.ws + WS_CTL) + CW_Q + 64 * 8 * (2 * it + (dry ? 1 : 0));
    volatile LAS int* qw = (volatile LAS int*)(lds + LDSCTL_OFF + 64);
    const int nq = 128 + 64 + (l == 0 ? 6 : 0);
    const int x0 = (int)(xb_xcc_id() & 7u);
    for (int k = 0; k < 8; ++k) {
        const int x = (x0 + k) & 7;
        for (;;) {
            if (tid == 0) *qw = (int)__hip_atomic_fetch_add(ctr + 64 * x, 1u, __ATOMIC_RELAXED, __HIP_MEMORY_SCOPE_AGENT);
            __syncthreads();
            int j = *qw;
            __syncthreads();
            if (j >= nq) break;
            if (j < 128) { const int s = x + 8 * (j >> 6); attnB_unit(A, lds, l, s >> 3, s & 7, j & 63, false, dry); continue; } j -= 128;
            if (j < 64) { const int u = x * 64 + j; attnA_unit(A, lds, l, u >> 8, (u >> 2) & 63, u & 3, false, dry); continue; } j -= 64;
            if (j < 4) { const int u = x * 4 + j; attnB_unit(A, lds, l, u >> 4, (u >> 1) & 7, u & 1, true, dry); continue; } j -= 4;
            { const int u = x * 2 + j; attnA_unit(A, lds, l, u >> 3, (u >> 2) & 1, u & 3, true, dry); }
        }
    }
}
constexpr int GL_QN = 0, GL_KN = 17408, GL_VK = 34816, GL_MM = 100352, GL_TB = 135168, GPITCH = 272;
#define FNMA(acc, a, b) asm("v_fma_f32 %0, -%1, %2, %0" : "+v"(acc) : "v"(a), "v"(b))
#define BFV(x) __uint_as_float(((unsigned)(unsigned short)(x)) << 16)
__device__ __forceinline__ void gdn_intra_unit(const Args& A, LAS unsigned char* lds, int l_, int bl, int ch, int h) {
    const int l = opaque_s(l_);
    const int tid = tid_opaque(), lane = tid & 63, r32 = lane & 31, hi = lane >> 5, wave = __builtin_amdgcn_readfirstlane(tid >> 6);
    const bf16_t* P = (const bf16_t*)(A.ws + WS_P); const float* AB = (const float*)(A.ws + WS_AB);
    const int uidx0 = ((bl * NCH + ch) * 8 + h) * 2;
    const size_t R0 = (size_t)bl * RB + ch * 64;
    LAS float* VK = (LAS float*)(lds + GL_VK);
    if (wave < 2) {
        const int d = wave; LAS float* TB = (LAS float*)(lds + GL_TB + d * 1024); LAS float* MMd = (LAS float*)(lds + GL_MM + d * 17408);
        const size_t row = R0 + (d ? 63 - lane : lane);
        float g = AB[row * 32 + d * 8 + h]; const float be = AB[row * 32 + 16 + d * 8 + h];
#pragma unroll
        for (int o = 1; o < 64; o <<= 1) { const float t = __shfl_up(g, o); if (lane >= o) g += t; }
        const float glast = __shfl(g, 63); const float eg = __expf(g);
        TB[lane] = g; TB[64 + lane] = be; TB[128 + lane] = eg; TB[192 + lane] = __expf(glast - g);
        MMd[lane * 68 + 64] = be; MMd[lane * 68 + 65] = be * eg;
        if (lane == 0) ((float*)(A.ws + WS_GL))[uidx0 + d] = __expf(glast);
    }
    {
        const int c = tid >> 3, sub = tid & 7;
        const int tp = ch * 64 + c;
        const bool has_prev = !(tp == 0 || tp == CTXL), has_next = !(tp == CTXL - 1 || tp == RB - 1);
        const bf16_t* xr = P + (R0 + c) * LDP + C_QKV + h * 128 + sub * 16;
        const float* cw = A.in[I_DNCONV] + (size_t)l * 3 * 3072 + h * 128 + sub * 16;
#pragma unroll
        for (int mat = 0; mat < 3; ++mat) {
            const bf16_t* xm = xr + mat * 1024; const float* wm = cw + mat * 1024;
            float y[16];
            const u32x4 z4 = (u32x4){0u, 0u, 0u, 0u};
#pragma unroll
            for (int hf = 0; hf < 2; ++hf) {
                const u32x4 xc = *(const u32x4*)(xm + hf * 8);
                const u32x4 xp = has_prev ? *(const u32x4*)(xm - LDP + hf * 8) : z4;
                const u32x4 xn = has_next ? *(const u32x4*)(xm + LDP + hf * 8) : z4;
#pragma unroll
                for (int k = 0; k < 4; ++k) { const int e = hf * 8 + 2 * k;
                    const float v0 = wm[e] * bf_lo(xp[k]) + wm[3072 + e] * bf_lo(xc[k]) + wm[6144 + e] * bf_lo(xn[k]);
                    const float v1 = wm[e + 1] * bf_hi(xp[k]) + wm[3072 + e + 1] * bf_hi(xc[k]) + wm[6144 + e + 1] * bf_hi(xn[k]);
                    y[e] = silu_f(v0); y[e + 1] = silu_f(v1); }
            }
            if (mat < 2) {
                float ss = 0.f;
#pragma unroll
                for (int e = 0; e < 16; ++e) ss += y[e] * y[e];
                ss += __shfl_xor(ss, 1); ss += __shfl_xor(ss, 2); ss += __shfl_xor(ss, 4);
                const float rn = (1.0f / sqrtf(ss + 1e-6f)) * (mat == 0 ? 0.08838834764831845f : 1.0f);
#pragma unroll
                for (int e = 0; e < 16; ++e) y[e] *= rn;
                LAS unsigned char* dst = lds + (mat == 0 ? GL_QN : GL_KN) + c * GPITCH + sub * 32;
                u32x4 w0, w1; w0.x = cvt_pk_bf16(y[0], y[1]); w0.y = cvt_pk_bf16(y[2], y[3]); w0.z = cvt_pk_bf16(y[4], y[5]); w0.w = cvt_pk_bf16(y[6], y[7]);
                w1.x = cvt_pk_bf16(y[8], y[9]); w1.y = cvt_pk_bf16(y[10], y[11]); w1.z = cvt_pk_bf16(y[12], y[13]); w1.w = cvt_pk_bf16(y[14], y[15]);
                *(LAS u32x4*)dst = w0; *(LAS u32x4*)(dst + 16) = w1;
            }
            if (mat >= 1) { LAS float* vk = VK + c * 256 + (mat == 1 ? 128 : 0) + sub * 16;
#pragma unroll
                for (int e = 0; e < 16; e += 4) *(LAS f32x4*)(vk + e) = (f32x4){y[e], y[e + 1], y[e + 2], y[e + 3]}; }
        }
    }
    __syncthreads();
#pragma unroll 1
    for (int d = 0; d < 2; ++d) {
        const int mat = wave >> 2, rbk = (wave >> 1) & 1, cbk = wave & 1;
        LAS const float* GC = (LAS const float*)(lds + GL_TB + d * 1024); LAS const float* BETA = GC + 64; LAS float* MM = (LAS float*)(lds + GL_MM + d * 17408);
        const int ra = 32 * rbk + r32, rb_ = 32 * cbk + r32;
        LAS const unsigned char* Ab = lds + GL_KN + (d ? 63 - ra : ra) * GPITCH + hi * 16;
        LAS const unsigned char* Bb = lds + (mat == 0 ? GL_KN : GL_QN) + (d ? 63 - rb_ : rb_) * GPITCH + hi * 16;
        f32x16 acc;
#pragma unroll
        for (int r = 0; r < 16; ++r) acc[r] = 0.f;
#pragma unroll
        for (int d0 = 0; d0 < 8; ++d0) { const bf16x8 a = *(LAS const bf16x8*)(Ab + d0 * 32), b = *(LAS const bf16x8*)(Bb + d0 * 32); acc = MFMA32(a, b, acc); }
        const int cc = 32 * cbk + r32; const float gcc = GC[cc];
        if (mat == 0) {
#pragma unroll
            for (int r = 0; r < 16; ++r) { const int i = 32 * rbk + crow(r, hi); const float v = (i > cc) ? BETA[i] * acc[r] * __expf(GC[i] - gcc) : 0.f; MM[i * 68 + cc] = v; }
        } else {
            float v[16];
#pragma unroll
            for (int r = 0; r < 16; ++r) { const int j = 32 * rbk + crow(r, hi); v[r] = (cc >= j) ? acc[r] * __expf(gcc - GC[j]) : 0.f; }
            bf16x8* at = (bf16x8*)(A.ws + WS_G + (size_t)(uidx0 + d) * GU_BYTES + GU_AT);
            at[(cbk * 4 + 2 * rbk + 0) * 64 + lane] = pack8(v[0], v[1], v[2], v[3], v[4], v[5], v[6], v[7]);
            at[(cbk * 4 + 2 * rbk + 1) * 64 + lane] = pack8(v[8], v[9], v[10], v[11], v[12], v[13], v[14], v[15]);
        }
    }
    {
        const int d = wave >> 2, w4 = wave & 3;
        LAS const float* EG = (LAS const float*)(lds + GL_TB + d * 1024 + 512); LAS const float* DKS = EG + 64;
        unsigned char* rec = A.ws + WS_G + (size_t)(uidx0 + d) * GU_BYTES;
        if (w4 < 2) {
#pragma unroll
            for (int ff = 0; ff < 8; ++ff) { const int f = w4 * 8 + ff, ib = f >> 3, rb = (f >> 1) & 3, s = f & 1; const int i = 32 * ib + r32, dk0 = 32 * rb + 16 * s + 4 * hi; const int row = d ? 63 - i : i;
                const u32x2 a = *(LAS const u32x2*)(lds + GL_QN + row * GPITCH + dk0 * 2), b = *(LAS const u32x2*)(lds + GL_QN + row * GPITCH + (dk0 + 8) * 2); const float e = EG[i];
                ((bf16x8*)(rec + GU_QG))[f * 64 + lane] = pack8(bf_lo(a.x) * e, bf_hi(a.x) * e, bf_lo(a.y) * e, bf_hi(a.y) * e, bf_lo(b.x) * e, bf_hi(b.x) * e, bf_lo(b.y) * e, bf_hi(b.y) * e); }
        } else {
#pragma unroll
            for (int ff = 0; ff < 8; ++ff) { const int f = (w4 - 2) * 8 + ff, rb = f >> 2, ib = (f >> 1) & 1, s = f & 1; const int i0 = 32 * ib + 16 * s + 4 * hi; const int ia = i0 + ((lane & 15) >> 2);
                LAS const unsigned char* kp = lds + GL_KN + (d ? 63 - ia : ia) * GPITCH + (32 * rb + 16 * ((lane >> 4) & 1) + 4 * (lane & 3)) * 2;
                const s16x4 lo = lds_tr(kp), hh = lds_tr(d ? kp - 8 * GPITCH : kp + 8 * GPITCH);
                const f32x4 s0 = *(LAS const f32x4*)(DKS + i0), s1 = *(LAS const f32x4*)(DKS + i0 + 8);
                ((bf16x8*)(rec + GU_KD))[f * 64 + lane] = pack8(BFV(lo[0]) * s0[0], BFV(lo[1]) * s0[1], BFV(lo[2]) * s0[2], BFV(lo[3]) * s0[3], BFV(hh[0]) * s1[0], BFV(hh[1]) * s1[1], BFV(hh[2]) * s1[2], BFV(hh[3]) * s1[3]);
            }
        }
    }
    __syncthreads();
    float x[64];
    const int dD = opaque_s(wave >> 2), col = tid & 255;
    {
        LAS const float* MMv = (LAS const float*)(lds + GL_MM + dD * 17408); asm volatile("" : "+v"(MMv));
        LAS const float* RHv = VK + col + (dD ? 63 * 256 : 0); asm volatile("" : "+v"(RHv));
        const int colhalf = (col >> 7), strd = dD ? -256 : 256;
#pragma unroll
        for (int i = 0; i < 64; ++i) {
            const f32x2 sc2 = *(LAS const f32x2*)(MMv + i * 68 + 64);
            float a = RHv[i * strd] * (colhalf ? sc2.y : sc2.x), a1 = 0.f, a2 = 0.f, a3 = 0.f;
#pragma unroll
            for (int m4 = 0; m4 < i; m4 += 4) { const f32x4 mm = *(LAS const f32x4*)(MMv + i * 68 + m4);
                FNMA(a, mm[0], x[m4]); if (m4 + 1 < i) FNMA(a1, mm[1], x[m4 + 1]); if (m4 + 2 < i) FNMA(a2, mm[2], x[m4 + 2]); if (m4 + 3 < i) FNMA(a3, mm[3], x[m4 + 3]); }
            x[i] = (a + a1) + (a2 + a3); asm volatile("" ::: "memory");
        }
    }
    __syncthreads();
    {
        unsigned char* rec = A.ws + WS_G + (size_t)(uidx0 + dD) * GU_BYTES;
        if (col < 128) {
            unsigned* up = (unsigned*)(rec + GU_U); const int sl = col >> 5, dvl = col & 31;
#pragma unroll
            for (int ib = 0; ib < 2; ++ib)
#pragma unroll
                for (int p = 0; p < 8; ++p)
#pragma unroll
                    for (int hh = 0; hh < 2; ++hh) { const int i = 32 * ib + (2 * p & 3) + 8 * (2 * p >> 2) + 4 * hh; up[((ib * 4 + sl) * 8 + p) * 64 + hh * 32 + dvl] = cvt_pk_bf16(x[i], x[i + 1]); }
        } else {
            LAS bf16_t* wl = (LAS bf16_t*)(lds + (dD ? GL_KN : GL_QN));
#pragma unroll
            for (int i = 0; i < 64; ++i) wl[i * (GPITCH / 2) + (col - 128)] = (bf16_t)(cvt_pk_bf16(x[i], 0.f) & 0xffffu);
        }
    }
    __syncthreads();
    {
        unsigned char* rec = A.ws + WS_G + (size_t)(uidx0 + dD) * GU_BYTES; const int wl0 = dD ? GL_KN : GL_QN;
#pragma unroll
        for (int ff = 0; ff < 4; ++ff) { const int f = (wave & 3) * 4 + ff, ib = f >> 3, rb = (f >> 1) & 3, s = f & 1; const int i = 32 * ib + r32, dk0 = 32 * rb + 16 * s + 4 * hi;
            const u32x2 a = *(LAS const u32x2*)(lds + wl0 + i * GPITCH + dk0 * 2), b = *(LAS const u32x2*)(lds + wl0 + i * GPITCH + (dk0 + 8) * 2);
            ((u32x4*)(rec + GU_W))[f * 64 + lane] = (u32x4){a.x, a.y, b.x, b.y}; }
    }
    __syncthreads();
}
#undef FNMA
#undef BFV
__device__ __forceinline__ void ph_gdn_intra(const Args& A, LAS unsigned char* lds, int l) {
    for (int u = blockIdx.x; u < HB * NCH * 8; u += gridDim.x) { const int h = u & 7, t = u >> 3, ch = t % NCH, bl = t / NCH; gdn_intra_unit(A, lds, l, bl, ch, h); }
}
constexpr int SC_SLOT = 57344, SC_OST = 2 * SC_SLOT;
__device__ __forceinline__ void gdn_scan_unit(const Args& A, LAS unsigned char* lds, int bl, int h, int d) {
    const int tid = tid_opaque(), lane = tid & 63, r32 = lane & 31, hi = lane >> 5, wave = __builtin_amdgcn_readfirstlane(tid >> 6);
#define SC_CH(step) (d ? ((step) < 4 ? 3 - (step) : NCH + 3 - (step)) : (step))
#define SC_UIDX(step) (((bl * NCH + SC_CH(step)) * 8 + h) * 2 + d)
    if (wave >= 4) {
        const int lw = wave - 4;
#define SC_ISSUE(step, slot) do { const unsigned char* rec_ = A.ws + WS_G + (size_t)SC_UIDX(step) * GU_BYTES + lane * 16; \
        _Pragma("unroll") for (int k_ = 0; k_ < 14; ++k_) __builtin_amdgcn_global_load_lds((const unsigned*)(rec_ + (lw * 14 + k_) * 1024), (LAS unsigned*)(lds + (slot) * SC_SLOT + (lw * 14 + k_) * 1024), 16, 0, 0); } while (0)
        SC_ISSUE(0, 0);
        asm volatile("s_waitcnt vmcnt(0)" ::: "memory"); __builtin_amdgcn_s_barrier();
        for (int step = 0; step < NCH; ++step) {
            if (step + 1 < NCH) SC_ISSUE(step + 1, (step + 1) & 1);
            asm volatile("s_waitcnt vmcnt(0)" ::: "memory"); __builtin_amdgcn_s_barrier();
        }
#undef SC_ISSUE
        return;
    }
    const int sl = wave;
    bf16_t* O = (bf16_t*)(A.ws + WS_H) + (size_t)d * HR * 1024;
    const float* GLv = (const float*)(A.ws + WS_GL);
    LAS unsigned char* ost = lds + SC_OST + sl * 4096;
    f32x16 S[4];
#pragma unroll
    for (int rb = 0; rb < 4; ++rb)
#pragma unroll
        for (int r = 0; r < 16; ++r) S[rb][r] = 0.f;
    unsigned un[16]; float gln;
    { const unsigned* Up = (const unsigned*)(A.ws + WS_G + (size_t)SC_UIDX(0) * GU_BYTES + GU_U) + lane;
#pragma unroll
      for (int q = 0; q < 16; ++q) un[q] = Up[(((q >> 3) * 4 + sl) * 8 + (q & 7)) * 64];
      gln = GLv[SC_UIDX(0)]; }
    __builtin_amdgcn_s_barrier();
    for (int step = 0; step < NCH; ++step) {
        const int ch = SC_CH(step);
        LAS const unsigned char* slot = lds + (step & 1) * SC_SLOT + lane * 16;
        unsigned uc[16]; const float gl = gln;
#pragma unroll
        for (int q = 0; q < 16; ++q) uc[q] = un[q];
        if (step + 1 < NCH) { const unsigned* Up = (const unsigned*)(A.ws + WS_G + (size_t)SC_UIDX(step + 1) * GU_BYTES + GU_U) + lane;
#pragma unroll
            for (int q = 0; q < 16; ++q) un[q] = Up[(((q >> 3) * 4 + sl) * 8 + (q & 7)) * 64];
            gln = GLv[SC_UIDX(step + 1)]; }
        f32x16 vn[2], o[2];
#pragma unroll
        for (int ib = 0; ib < 2; ++ib)
#pragma unroll
            for (int r = 0; r < 16; ++r) { vn[ib][r] = 0.f; o[ib][r] = 0.f; }
#pragma unroll
        for (int rb = 0; rb < 4; ++rb)
#pragma unroll
            for (int s = 0; s < 2; ++s) {
                const bf16x8 sb = pack8(S[rb][8 * s], S[rb][8 * s + 1], S[rb][8 * s + 2], S[rb][8 * s + 3], S[rb][8 * s + 4], S[rb][8 * s + 5], S[rb][8 * s + 6], S[rb][8 * s + 7]);
#pragma unroll
                for (int ib = 0; ib < 2; ++ib) { const int f = (ib * 4 + rb) * 2 + s;
                    vn[ib] = MFMA32(*(LAS const bf16x8*)(slot + GU_W + f * 1024), sb, vn[ib]); o[ib] = MFMA32(*(LAS const bf16x8*)(slot + GU_QG + f * 1024), sb, o[ib]); }
            }
#pragma unroll
        for (int ib = 0; ib < 2; ++ib)
#pragma unroll
            for (int p = 0; p < 8; ++p) { const unsigned w = uc[ib * 8 + p]; vn[ib][2 * p] = bf_lo(w) - vn[ib][2 * p]; vn[ib][2 * p + 1] = bf_hi(w) - vn[ib][2 * p + 1]; }
        bf16x8 vb[2][2];
#pragma unroll
        for (int ib = 0; ib < 2; ++ib) { vb[ib][0] = pack8(vn[ib][0], vn[ib][1], vn[ib][2], vn[ib][3], vn[ib][4], vn[ib][5], vn[ib][6], vn[ib][7]);
            vb[ib][1] = pack8(vn[ib][8], vn[ib][9], vn[ib][10], vn[ib][11], vn[ib][12], vn[ib][13], vn[ib][14], vn[ib][15]); }
#pragma unroll
        for (int ib = 0; ib < 2; ++ib)
#pragma unroll
            for (int jb = 0; jb < 2; ++jb)
#pragma unroll
                for (int s = 0; s < 2; ++s) o[ib] = MFMA32(*(LAS const bf16x8*)(slot + GU_AT + (ib * 4 + 2 * jb + s) * 1024), vb[jb][s], o[ib]);
#pragma unroll
        for (int rb = 0; rb < 4; ++rb) { S[rb] = S[rb] * gl;
#pragma unroll
            for (int ib = 0; ib < 2; ++ib)
#pragma unroll
                for (int s = 0; s < 2; ++s) S[rb] = MFMA32(*(LAS const bf16x8*)(slot + GU_KD + ((rb * 2 + ib) * 2 + s) * 1024), vb[ib][s], S[rb]); }
#pragma unroll
        for (int ib = 0; ib < 2; ++ib)
#pragma unroll
            for (int r = 0; r < 16; ++r) { const int i = 32 * ib + crow(r, hi); const int c = d ? 63 - i : i; *(LAS bf16_t*)(ost + c * 64 + r32 * 2) = (bf16_t)(cvt_pk_bf16(o[ib][r], 0.f) & 0xffffu); }
        asm volatile("s_waitcnt lgkmcnt(0)" ::: "memory");
        bf16_t* obase = O + ((size_t)bl * RB + ch * 64) * 1024 + h * 128 + 32 * sl;
#pragma unroll
        for (int k = 0; k < 4; ++k) { const int id = k * 64 + lane; const u32x4 v = *(LAS const u32x4*)(ost + id * 16); *(u32x4*)(obase + (size_t)(id >> 2) * 1024 + (id & 3) * 8) = v; }
        asm volatile("s_waitcnt lgkmcnt(0)" ::: "memory"); __builtin_amdgcn_s_barrier();
    }
#undef SC_CH
#undef SC_UIDX
}
__device__ __forceinline__ void ph_gdn_post(const Args& A, int l_, bool dry) {
    const int l = opaque_s(l_);
    const int tid = tid_opaque(), lane = tid & 63, gw = blockIdx.x * NWAVES + (tid >> 6), NGW = gridDim.x * NWAVES;
    const bf16_t* OF = (const bf16_t*)(A.ws + WS_H); const bf16_t* OB = OF + (size_t)HR * 1024; bf16_t* P = (bf16_t*)(A.ws + WS_P);
    const float* nw = A.in[I_DNNORM] + l * 128 + (lane & 7) * 16;
    for (int r = gw; r < HR; r += NGW) {
        const u32x4 f0 = *(const u32x4*)(OF + (size_t)r * 1024 + lane * 16), f1 = *(const u32x4*)(OF + (size_t)r * 1024 + lane * 16 + 8);
        const u32x4 b0 = *(const u32x4*)(OB + (size_t)r * 1024 + lane * 16), b1 = *(const u32x4*)(OB + (size_t)r * 1024 + lane * 16 + 8);
        bf16_t* zp = P + (size_t)r * LDP + C_Z + lane * 16;
        const u32x4 z0 = *(const u32x4*)zp, z1 = *(const u32x4*)(zp + 8);
        float o[16], z[16]; float ss = 0.f;
#pragma unroll
        for (int k = 0; k < 4; ++k) { o[2 * k] = bf_lo(f0[k]) + bf_lo(b0[k]); o[2 * k + 1] = bf_hi(f0[k]) + bf_hi(b0[k]); o[8 + 2 * k] = bf_lo(f1[k]) + bf_lo(b1[k]); o[8 + 2 * k + 1] = bf_hi(f1[k]) + bf_hi(b1[k]);
            z[2 * k] = bf_lo(z0[k]); z[2 * k + 1] = bf_hi(z0[k]); z[8 + 2 * k] = bf_lo(z1[k]); z[8 + 2 * k + 1] = bf_hi(z1[k]); }
#pragma unroll
        for (int e = 0; e < 16; ++e) ss += o[e] * o[e];
        ss += __shfl_xor(ss, 1); ss += __shfl_xor(ss, 2); ss += __shfl_xor(ss, 4);
        const float rn = 1.0f / sqrtf(ss * (1.0f / 128.0f) + 1e-6f);
#pragma unroll
        for (int e = 0; e < 16; ++e) o[e] = o[e] * rn * nw[e] * silu_f(z[e]);
        u32x4 w0, w1; w0.x = cvt_pk_bf16(o[0], o[1]); w0.y = cvt_pk_bf16(o[2], o[3]); w0.z = cvt_pk_bf16(o[4], o[5]); w0.w = cvt_pk_bf16(o[6], o[7]);
        w1.x = cvt_pk_bf16(o[8], o[9]); w1.y = cvt_pk_bf16(o[10], o[11]); w1.z = cvt_pk_bf16(o[12], o[13]); w1.w = cvt_pk_bf16(o[14], o[15]);
        bf16_t* zo = dry ? (bf16_t*)(A.ws + WS_TRASH) + tid * 16 : zp;
        *(u32x4*)zo = w0; *(u32x4*)(zo + 8) = w1;
    }
}
constexpr int NPH = 1 + 14 * 4;
__host__ __device__ inline bool phase_is_noop(int id) { if (id == 0) return false; const int it = (id - 1) / 14, k = (id - 1) % 14; return (k == 0 && it != 2) || k == 6; }
__global__ void __launch_bounds__(NTHR, 2) fwd(Args A0) {
    extern __shared__ __attribute__((aligned(16))) unsigned char lds_raw[];
    LAS unsigned char* lds = (LAS unsigned char*)lds_raw;
    volatile LAS unsigned* MISC = (volatile LAS unsigned*)(lds + LDSCTL_OFF + 320);
    for (int u = threadIdx.x; u < (LDS_BYTES - LDSCTL_OFF) / 4; u += NTHR) ((LAS unsigned*)(lds + LDSCTL_OFF))[u] = 0u;
    __syncthreads();
    const int lo = A0.ph_lo, hi = A0.ph_hi, G = gridDim.x, bid = blockIdx.x;
    unsigned char* ws0 = A0.ws;
    XcdBarrier bar; bar.bar = (unsigned*)(ws0 + WS_CTL) + CW_BAR; bar.x = 0; bar.st = nullptr;
    if (hi - lo > 1) bar = xcd_barrier_post((unsigned*)(ws0 + WS_CTL) + CW_BAR, MISC + 8);
#ifndef PHMASK
#define PHMASK 0x7fff
#endif
#ifndef DUP_MASK
#define DUP_MASK 0
#endif
#define EXTRA_BAR 0
#define GA_ true
#define GS_ true
#define RUNK(k, id, ...) do { if (((PHMASK >> (k)) & 1) && lo <= (id) && (id) < hi) { \
    KA_T ap_ = (KA_T)__builtin_amdgcn_kernarg_segment_ptr(); asm volatile("" : "+s"(ap_)); const Args& A = *(const Args*)ap_; unsigned char* ws = A.ws; \
    bf16_t* H = (bf16_t*)(ws + WS_H); bf16_t* P = (bf16_t*)(ws + WS_P); (void)H; (void)P; \
    if ((DUP_MASK >> (k)) & 1) { dry = true; __VA_ARGS__; xcd_barrier(bar); dry = false; } \
    __VA_ARGS__; if ((id) + 1 < hi) { xcd_barrier(bar); if (EXTRA_BAR) { xcd_barrier(bar); xcd_barrier(bar); } } } } while (0)
    typedef const __attribute__((address_space(4))) Args* KA_T;
    bool dry = false;
    RUNK(14, 0, { ph_prologue(A, lds); __syncthreads(); ph_weights(A, lds, 0); });
    for (int it = 0; it < 4; ++it) {
        const int l = it >> 1, half = it & 1, base = 1 + 14 * it;
        if (it == 2) RUNK(0, base + 0, { ph_weights(A, lds, 1); });
        RUNK(1, base + 1, { ph_adaln(A, l, half); });
        RUNK(2, base + 2, {
            pg8::Gemm g{H, (const bf16_t*)(ws + WS_WIN), HR, NWIN, 2048, 2048};
            pg8::EpiInProj E{P, LDP, (float*)(ws + WS_AB), (const float*)(ws + WS_ROPEA), (const float*)(ws + WS_ROPED), A.in[I_ALOG] + l * 16, A.in[I_DTB] + l * 16, 0.08838834764831845f * LOG2E, 0.125f * LOG2E, dry};
            if (l == 0) { pg8::StaticOrder S; S.init(HR, NWIN, G, bid); pg8::gemm_phase<pg8::EpiInProj, pg8::StaticOrder, GA_, GS_>(lds, g, S, E); }
            else { pg8::InProjLastOrder S; S.init(NWIN, G, bid); pg8::gemm_phase<pg8::EpiInProj, pg8::InProjLastOrder, GA_, GS_>(lds, g, S, E); } });
        RUNK(3, base + 3, { ph_gdn_intra(A, lds, l); });
        RUNK(4, base + 4, { if (bid < HB * 8 * 2 && !(dry && ATT_EXP >= 5)) gdn_scan_unit(A, lds, bid >> 4, (bid >> 1) & 7, bid & 1); if (!(dry && ATT_EXP == 4)) ph_attention(A, lds, l, half, it, dry); });
        RUNK(5, base + 5, { ph_gdn_post(A, l, dry); });
        RUNK(7, base + 7, {
            bf16_t* T1 = (bf16_t*)(ws + WS_TOT); bf16_t* T2 = T1 + (size_t)HR * 2048; bf16_t* Mo = (bf16_t*)(ws + WS_M);
            pg8::Gemm ga{P + C_QA, (const bf16_t*)(ws + WS_WPA), HR, 2048, 1024, LDP}; pg8::EpiMerge<0> Ea{P + C_G, LDP, T1, T2, Mo, 2048};
            pg8::Gemm gb{P + C_QD, (const bf16_t*)(ws + WS_WPB), HR, 2048, 1024, LDP}; pg8::EpiMerge<1> Eb{P + C_G + 2048, LDP, T1, T2, Mo, 2048};
            pg8::Gemm gc{P + C_Z, (const bf16_t*)(ws + WS_WPC), HR, 2048, 1024, LDP}; pg8::EpiMerge<2> Ec{P + C_G + 4096, LDP, T1, T2, Mo, 2048};
            if (l == 0) { pg8::StaticOrder S; S.init(HR, 2048, G, bid);
                pg8::gemm_phase<pg8::EpiMerge<0>, pg8::StaticOrder, GA_, GS_>(lds, ga, S, Ea); pg8::gemm_phase<pg8::EpiMerge<1>, pg8::StaticOrder, GA_, GS_>(lds, gb, S, Eb); pg8::gemm_phase<pg8::EpiMerge<2>, pg8::StaticOrder, GA_, GS_>(lds, gc, S, Ec); }
            else { pg8::LatentOrder S; S.init(2048, G, bid);
                pg8::gemm_phase<pg8::EpiMerge<0>, pg8::LatentOrder, GA_, GS_>(lds, ga, S, Ea); pg8::gemm_phase<pg8::EpiMerge<1>, pg8::LatentOrder, GA_, GS_>(lds, gb, S, Eb); pg8::gemm_phase<pg8::EpiMerge<2>, pg8::LatentOrder, GA_, GS_>(lds, gc, S, Ec); } });
        RUNK(8, base + 8, {
            pg8::Gemm g{(const bf16_t*)(ws + WS_M), (const bf16_t*)(ws + WS_WO), HR, 2048, 2048, 2048}; pg8::EpiBf16 E{(bf16_t*)(ws + WS_OX), 2048};
            if (l == 0) { pg8::StaticOrder S; S.init(HR, 2048, G, bid); pg8::gemm_phase<pg8::EpiBf16, pg8::StaticOrder, GA_, GS_>(lds, g, S, E); }
            else { pg8::LatentOrder S; S.init(2048, G, bid); pg8::gemm_phase<pg8::EpiBf16, pg8::LatentOrder, GA_, GS_>(lds, g, S, E); } });
        RUNK(9, base + 9, { ph_resln<true>(A, l, half, (const bf16_t*)(ws + WS_OX), 2, A.in[I_LN1G] + l * DM, A.in[I_LN1B] + l * DM, dry); });
        RUNK(10, base + 10, {
            pg8::Gemm g{H, (const bf16_t*)(ws + WS_WUP), HR, NUP, 2048, 2048}; pg8::EpiBf16 E{(bf16_t*)(ws + WS_U), NUP};
            if (l == 0) { pg8::StaticOrder S; S.init(HR, NUP, G, bid); pg8::gemm_phase<pg8::EpiBf16, pg8::StaticOrder, GA_, GS_>(lds, g, S, E); }
            else { pg8::LatentOrder S; S.init(NUP, G, bid); pg8::gemm_phase<pg8::EpiBf16, pg8::LatentOrder, GA_, GS_>(lds, g, S, E); } });
        RUNK(11, base + 11, { ph_convact(A, l); });
        RUNK(12, base + 12, {
            pg8::Gemm g{(const bf16_t*)(ws + WS_ACT), (const bf16_t*)(ws + WS_WDN), HR, 2048, DFF, DFF}; pg8::EpiBf16 E{(bf16_t*)(ws + WS_FX), 2048};
            if (l == 0) { pg8::StaticOrder S; S.init(HR, 2048, G, bid); pg8::gemm_phase<pg8::EpiBf16, pg8::StaticOrder, GA_, GS_>(lds, g, S, E); }
            else { pg8::LatentOrder S; S.init(2048, G, bid); pg8::gemm_phase<pg8::EpiBf16, pg8::LatentOrder, GA_, GS_>(lds, g, S, E); } });
        RUNK(13, base + 13, { ph_resln<false>(A, l, half, (const bf16_t*)(ws + WS_FX), 5, A.in[I_LN2G] + l * DM, A.in[I_LN2B] + l * DM, dry); });
    }
#undef RUNK
}

#ifndef MK_ONE_LAUNCH
#define MK_ONE_LAUNCH 1
#endif
extern "C" void kernel_launch(void* const* d_in, const int* in_sizes, int n_in, void* d_out, int out_size, void* d_ws, size_t ws_size, hipStream_t stream) {
    static int grid = 0;
    if (grid == 0) {
        if (n_in != 29 || out_size != NBATCH * SEQ * DM || ws_size < WS_END) { fprintf(stderr, "kernel_launch: unexpected problem (n_in %d, out %d, ws %zu < %zu)\n", n_in, out_size, ws_size, (size_t)WS_END); grid = -1; return; }
        int dev = 0, cus = 0, per_cu = 0;
        if (hipGetDevice(&dev) != hipSuccess || hipDeviceGetAttribute(&cus, hipDeviceAttributeMultiprocessorCount, dev) != hipSuccess) { grid = -1; return; }
        if (hipFuncSetAttribute((const void*)fwd, hipFuncAttributeMaxDynamicSharedMemorySize, LDS_BYTES) != hipSuccess) { fprintf(stderr, "kernel_launch: hipFuncSetAttribute failed\n"); grid = -1; return; }
        if (hipOccupancyMaxActiveBlocksPerMultiprocessor(&per_cu, (const void*)fwd, NTHR, LDS_BYTES) != hipSuccess || per_cu < 1) fprintf(stderr, "kernel_launch: occupancy query reports %d\n", per_cu);
        (void)hipGetLastError();
        grid = cus > 256 ? 256 : cus;
    }
    if (grid < 0) return;
    (void)hipMemsetAsync((char*)d_ws + WS_CTL, 0, CTL_ZERO_BYTES, stream);
    Args a{};
    for (int i = 0; i < 29; ++i) a.in[i] = (const float*)d_in[i];
    a.out = (float*)d_out; a.ws = (unsigned char*)d_ws;
#if MK_ONE_LAUNCH
    a.ph_lo = 0; a.ph_hi = NPH;
    hipLaunchKernelGGL(fwd, dim3(grid), dim3(NTHR), LDS_BYTES, stream, a);
#else
    for (int id = 0; id < NPH; ++id) { if (phase_is_noop(id)) continue; a.ph_lo = id; a.ph_hi = id + 1; hipLaunchKernelGGL(fwd, dim3(grid), dim3(NTHR), LDS_BYTES, stream, a); }
#endif
}
```

```cpp
#include <hip/hip_runtime.h>
#include <cstdio>
#include <cstdint>
#include <cmath>
namespace pg8 {
#define PG8_LAS __attribute__((address_space(3)))
typedef unsigned short bf16_t;
typedef short bf16x8 __attribute__((ext_vector_type(8)));
typedef float f32x4 __attribute__((ext_vector_type(4)));
typedef unsigned u32x4 __attribute__((ext_vector_type(4)));
constexpr int BM = 256, BK = 64, HALF = 128, HTB = HALF * BK * 2  , STAGE_BYTES = 8 * HTB, NXCD = 8, WGM = 4;

__host__ __device__ __forceinline__ int lds_byte(int r, int c) { const int st = (r >> 4) * 2 + (c >> 5), rr = r & 15, cc = c & 31, ob = rr * 64 + cc * 2; return st * 1024 + (ob ^ (((ob >> 9) & 1) << 5)); }
__host__ __device__ __forceinline__ void stage_rc(int b, int& R, int& C) { const int st = b / 1024, sb = b % 1024, swz = sb ^ (((sb >> 9) & 1) << 5); R = (st >> 1) * 16 + swz / 64; C = (st & 1) * 32 + (swz % 64) / 2; }
__host__ __device__ __forceinline__ int perm32(int rho) { const int n = rho >> 4, i = rho & 15; return 8 * (i >> 2) + 4 * n + (i & 3); }

struct Unit { int pm, pn; };
struct Gemm { const bf16_t* A; const bf16_t* Bt; int M, N, K, lda; };

struct StaticOrder {
    int nM, nN, nwg, G, c;
    __host__ __device__ void init(int M, int N, int G_, int c_) { nM = M / BM; nN = N / BM; nwg = nM * nN; G = G_; c = c_; }
    __host__ __device__ bool next(int i, Unit& u) const {
        const long L = (long)i * G + c; if (L >= nwg) return false;
        int wgid = (int)L; { const int q = nwg / NXCD, r = nwg % NXCD, xcd = wgid % NXCD, off = wgid / NXCD; wgid = (xcd < r ? xcd * (q + 1) : r * (q + 1) + (xcd - r) * q) + off; }
        const int nig = WGM * nN, gid = wgid / nig, fm = gid * WGM, gsz = (nM - fm) < WGM ? (nM - fm) : WGM;
        u.pm = fm + ((wgid % nig) % gsz); u.pn = (wgid % nig) / gsz; return true;
    }
    __device__ __forceinline__ void a_ready(const Unit&) const {}
    __device__ __forceinline__ void done(const Unit&) const {}
};
struct InProjLastOrder : StaticOrder {
    __host__ __device__ void init(int N, int G_, int c_) { StaticOrder::init(64 * BM, N, G_, c_); }
    __host__ __device__ bool next(int i, Unit& u) const {
        const long L = (long)i * G + c;
        if (L < nwg) { StaticOrder::next(i, u); u.pm += 1 + (u.pm >= 32 ? 1 : 0); return true; }
        const int e = (int)(L - nwg); if (e >= 46) return false;
        const int k = e % 23; u.pm = (e >= 23) ? 33 : 0; u.pn = (k < 2) ? 4 + k : (k < 22) ? 8 + k : 58; return true;
    }
};
struct LatentOrder : StaticOrder {
    __host__ __device__ void init(int N, int G_, int c_) { StaticOrder::init(64 * BM, N, G_, c_); }
    __host__ __device__ bool next(int i, Unit& u) const { if (!StaticOrder::next(i, u)) return false; u.pm += 1 + (u.pm >= 32 ? 1 : 0); return true; }
};


__device__ __forceinline__ unsigned cvt_pk_bf16(float lo, float hi) { unsigned r; asm volatile("v_cvt_pk_bf16_f32 %0, %1, %2" : "=v"(r) : "v"(lo), "v"(hi)); return r; }
__device__ __forceinline__ float bf_lo(unsigned w) { return __uint_as_float(w << 16); }
__device__ __forceinline__ float bf_hi(unsigned w) { return __uint_as_float(w & 0xffff0000u); }
__device__ __forceinline__ float sigm(float x) { return __builtin_amdgcn_rcpf(1.0f + __builtin_amdgcn_exp2f(x * -1.4426950408889634f)); }

struct EpiF32 {
    static constexpr bool PERM = false, AFTER_DRAIN = false;
    float* C; int ldc;
    __device__ __forceinline__ void operator()(const f32x4 (&acc)[2][2][4][2], const Unit& u, int wr, int wc, int fr, int fq) const {
        const int row0 = u.pm * BM + wr * 64 + fr, col0 = u.pn * BM + wc * 32 + 4 * fq;
#pragma unroll
        for (int ai = 0; ai < 2; ++ai)
#pragma unroll
            for (int m = 0; m < 4; ++m) { float* rowp = C + (size_t)(row0 + ai * HALF + m * 16) * ldc + col0;
#pragma unroll
                for (int bj = 0; bj < 2; ++bj)
#pragma unroll
                    for (int n = 0; n < 2; ++n) *(f32x4*)(rowp + bj * HALF + n * 16) = acc[ai][bj][m][n]; }
    }
};
struct EpiBf16 {
    static constexpr bool PERM = true, AFTER_DRAIN = false;
    bf16_t* O; int ldc;
    __device__ __forceinline__ void operator()(const f32x4 (&acc)[2][2][4][2], const Unit& u, int wr, int wc, int fr, int fq) const {
        const int row0 = u.pm * BM + wr * 64 + fr, col0 = u.pn * BM + wc * 32 + 8 * fq;
#pragma unroll
        for (int ai = 0; ai < 2; ++ai)
#pragma unroll
            for (int m = 0; m < 4; ++m) { bf16_t* rowp = O + (size_t)(row0 + ai * HALF + m * 16) * ldc + col0;
#pragma unroll
                for (int bj = 0; bj < 2; ++bj) { const f32x4 v0 = acc[ai][bj][m][0], v1 = acc[ai][bj][m][1];
                    u32x4 w; w.x = cvt_pk_bf16(v0[0], v0[1]); w.y = cvt_pk_bf16(v0[2], v0[3]); w.z = cvt_pk_bf16(v1[0], v1[1]); w.w = cvt_pk_bf16(v1[2], v1[3]);
                    *(u32x4*)(rowp + bj * HALF) = w; } }
    }
};
template <int MODE> struct EpiMerge {
    static constexpr bool PERM = true, AFTER_DRAIN = false;
    const bf16_t* G; int ldg; bf16_t* T1; bf16_t* T2; bf16_t* Mo; int ldc;
    __device__ __forceinline__ void operator()(const f32x4 (&acc)[2][2][4][2], const Unit& u, int wr, int wc, int fr, int fq) const {
        asm volatile("" : "+v"(fr), "+v"(fq));
        const int row0 = u.pm * BM + wr * 64 + fr, col0 = u.pn * BM + wc * 32 + 8 * fq;
#pragma unroll
        for (int ai = 0; ai < 2; ++ai)
#pragma unroll
            for (int m = 0; m < 4; ++m) { const size_t row = (size_t)(row0 + ai * HALF + m * 16);
#pragma unroll
                for (int bj = 0; bj < 2; ++bj) { const int col = col0 + bj * HALF;
                    const u32x4 gw = *(const u32x4*)(G + row * ldg + col);
                    f32x4 g0 = (f32x4){bf_lo(gw.x), bf_hi(gw.x), bf_lo(gw.y), bf_hi(gw.y)}, g1 = (f32x4){bf_lo(gw.z), bf_hi(gw.z), bf_lo(gw.w), bf_hi(gw.w)};
                    f32x4 v0 = acc[ai][bj][m][0] * g0, v1 = acc[ai][bj][m][1] * g1;
                    if (MODE == 2) { const u32x4 a = *(const u32x4*)(T1 + row * ldc + col), b = *(const u32x4*)(T2 + row * ldc + col);
                        v0 += (f32x4){bf_lo(a.x) + bf_lo(b.x), bf_hi(a.x) + bf_hi(b.x), bf_lo(a.y) + bf_lo(b.y), bf_hi(a.y) + bf_hi(b.y)};
                        v1 += (f32x4){bf_lo(a.z) + bf_lo(b.z), bf_hi(a.z) + bf_hi(b.z), bf_lo(a.w) + bf_lo(b.w), bf_hi(a.w) + bf_hi(b.w)}; }
                    u32x4 w; w.x = cvt_pk_bf16(v0[0], v0[1]); w.y = cvt_pk_bf16(v0[2], v0[3]); w.z = cvt_pk_bf16(v1[0], v1[1]); w.w = cvt_pk_bf16(v1[2], v1[3]);
                    bf16_t* dst = (MODE == 0) ? T1 : (MODE == 1) ? T2 : Mo;
                    *(u32x4*)(dst + row * ldc + col) = w; }
                asm volatile("" ::: "memory"); }
    }
};
struct EpiInProj {
    static constexpr bool PERM = true, AFTER_DRAIN = false;
    bf16_t* P; int ldp; float* AB; const float* ropeA; const float* ropeD; const float* a_log; const float* dt_bias; float sA, sD; bool light;
    __device__ __forceinline__ void operator()(const f32x4 (&acc)[2][2][4][2], const Unit& u, int wr, int wc, int fr, int fq) const {
        asm volatile("" : "+v"(fr), "+v"(fq));
        const int pn = u.pn, tib = u.pm % 33; const bool is_ctx = (tib == 0);
        const int row0 = u.pm * BM + wr * 64 + fr, t0 = tib * 256 - 256 + wr * 64 + fr, cl = wc * 32 + 8 * fq;
        int type; float scale = 1.f;
        if (pn <= 3) { type = 1; scale = sA; } else if (pn == 4) type = 1; else if (pn == 5) type = 0; else if (pn <= 9) { type = 2; scale = sD; } else if (pn <= 13) type = 2;
        else if (pn <= 33) type = 0; else if (pn <= 57) type = 3; else type = 4;
        if (light && type != 4) type = 0;
        if (type == 4) {
            if (wc == 0) {
                const int c = 8 * fq;
#pragma unroll
                for (int ai = 0; ai < 2; ++ai)
#pragma unroll
                    for (int m = 0; m < 4; ++m) { const size_t row = (size_t)(row0 + ai * HALF + m * 16); f32x4 v0 = acc[ai][0][m][0], v1 = acc[ai][0][m][1]; float o[8] = {v0[0], v0[1], v0[2], v0[3], v1[0], v1[1], v1[2], v1[3]};
#pragma unroll
                        for (int k = 0; k < 8; ++k) { if (c < 16) { const float x = o[k] + dt_bias[c + k]; const float sp = fmaxf(x, 0.f) + log1pf(__expf(-fabsf(x))); o[k] = -__expf(a_log[c + k]) * sp; } else o[k] = sigm(o[k]); }
                        *(f32x4*)(AB + row * 32 + c) = (f32x4){o[0], o[1], o[2], o[3]}; *(f32x4*)(AB + row * 32 + c + 4) = (f32x4){o[4], o[5], o[6], o[7]}; }
            }
            return;
        }
#pragma unroll
        for (int ai = 0; ai < 2; ++ai)
#pragma unroll
            for (int m = 0; m < 4; ++m) { const size_t row = (size_t)(row0 + ai * HALF + m * 16); const int t = t0 + ai * HALF + m * 16;
#pragma unroll
                for (int bj = 0; bj < 2; ++bj) { const int c = cl + bj * HALF; f32x4 v0 = acc[ai][bj][m][0], v1 = acc[ai][bj][m][1];
                    if ((type == 1 || type == 2) && !is_ctx) {
                        const float* tab;
                        if (type == 1) { const int p0 = (c & 127) >> 1; const int pos = (p0 >= 32) ? (t & 63) : (t >> 6); tab = ropeA + (pos * 32 + (p0 & 31)) * 2; }
                        else { const int p0 = (c & 63) >> 1; const int pos = (p0 >= 16) ? (t & 63) : (t >> 6); tab = ropeD + (pos * 16 + (p0 & 15)) * 2; }
                        const f32x4 cs0 = *(const f32x4*)tab, cs1 = *(const f32x4*)(tab + 4);
                        f32x4 r0, r1;
                        r0[0] = v0[0] * cs0[0] - v0[1] * cs0[1]; r0[1] = v0[1] * cs0[0] + v0[0] * cs0[1]; r0[2] = v0[2] * cs0[2] - v0[3] * cs0[3]; r0[3] = v0[3] * cs0[2] + v0[2] * cs0[3];
                        r1[0] = v1[0] * cs1[0] - v1[1] * cs1[1]; r1[1] = v1[1] * cs1[0] + v1[0] * cs1[1]; r1[2] = v1[2] * cs1[2] - v1[3] * cs1[3]; r1[3] = v1[3] * cs1[2] + v1[2] * cs1[3];
                        v0 = r0; v1 = r1;
                    }
                    if (type == 3) {
#pragma unroll
                        for (int k = 0; k < 4; ++k) { v0[k] = sigm(v0[k]); v1[k] = sigm(v1[k]); } }
                    v0 = v0 * scale; v1 = v1 * scale;
                    u32x4 w; w.x = cvt_pk_bf16(v0[0], v0[1]); w.y = cvt_pk_bf16(v0[2], v0[3]); w.z = cvt_pk_bf16(v1[0], v1[1]); w.w = cvt_pk_bf16(v1[2], v1[3]);
                    *(u32x4*)(P + row * ldp + pn * BM + c) = w; }
                asm volatile("" ::: "memory"); }
    }
};

template <class Epi, class Sched, bool ALIGN_EPI = false, bool SP2 = false>
__device__ __forceinline__ void gemm_phase(PG8_LAS unsigned char* lds, const Gemm g, const Sched& S, const Epi& E) {
    int tid_ = threadIdx.x; asm volatile("" : "+v"(tid_));
    const int tid = tid_, wid = __builtin_amdgcn_readfirstlane(tid >> 6), lane = tid & 63, wr = wid >> 2, wc = wid & 3, fr = lane & 15, fq = lane >> 4;
    const int K = g.K, nt = K / BK;
    unsigned voffA[2], voffB[2];
#pragma unroll
    for (int i = 0; i < 2; ++i) { int R, C; stage_rc(tid * 16 + i * 8192, R, C); const int Rb = Epi::PERM ? ((R & ~31) + perm32(R & 31)) : R;
        voffA[i] = (unsigned)(R * g.lda + C) * 2u; voffB[i] = (unsigned)(Rb * K + C) * 2u; }
    const size_t kstep = (size_t)(BK * 2);
    const size_t hstepB = (size_t)HALF * K * 2, hstepA = (size_t)HALF * g.lda * 2;
    const size_t tstepA = 2 * hstepA, tstepB = 2 * hstepB;
    const unsigned ldsw = (unsigned)wid * 1024u;
    const int aoff = lds_byte(wr * 64 + fr, fq * 8), boff = lds_byte(wc * 32 + fr, fq * 8);
#define PG8_SA(b, h) (((b) * 2 + (h)) * HTB)
#define PG8_SB(b, h) ((4 + (b) * 2 + (h)) * HTB)
#define PG8_STAGE(bufoff, gbase, voff) do { _Pragma("unroll") for (int _i = 0; _i < 2; ++_i) \
        __builtin_amdgcn_global_load_lds((const unsigned*)((const char*)(gbase) + (voff)[_i]), (PG8_LAS unsigned*)(lds + (bufoff) + ldsw + _i * 8192), 16, 0, 0); } while (0)
#define PG8_LDA(dst, b, h) do { _Pragma("unroll") for (int m = 0; m < 4; ++m) _Pragma("unroll") for (int k = 0; k < 2; ++k) dst[m][k] = *(const PG8_LAS bf16x8*)(lds + PG8_SA(b, h) + aoff + m * 2048 + k * 1024); } while (0)
#define PG8_LDB(dst, b, h) do { _Pragma("unroll") for (int n = 0; n < 2; ++n) _Pragma("unroll") for (int k = 0; k < 2; ++k) dst[n][k] = *(const PG8_LAS bf16x8*)(lds + PG8_SB(b, h) + boff + n * 2048 + k * 1024); } while (0)
#define PG8_MMA(ai, bj, At, Bt) do { __builtin_amdgcn_s_setprio(1); _Pragma("unroll") for (int m = 0; m < 4; ++m) _Pragma("unroll") for (int n = 0; n < 2; ++n) _Pragma("unroll") for (int k = 0; k < 2; ++k) \
        acc[ai][bj][m][n] = __builtin_amdgcn_mfma_f32_16x16x32_bf16(Bt[n][k], At[m][k], acc[ai][bj][m][n], 0, 0, 0); __builtin_amdgcn_s_setprio(0); } while (0)
#define PG8_WAIT_V(n) asm volatile("s_waitcnt vmcnt(" #n ")" ::: "memory")
#define PG8_WAIT_L(n) asm volatile("s_waitcnt lgkmcnt(" #n ")" ::: "memory")
#define PG8_BAR __builtin_amdgcn_s_barrier()
#define PG8_SCHED __builtin_amdgcn_sched_barrier(0)
    Unit cur, nxt; int ui = 0;
    if (!S.next(0, cur)) return;
    f32x4 acc[2][2][4][2];
#pragma unroll
    for (int a = 0; a < 2; ++a)
#pragma unroll
        for (int b = 0; b < 2; ++b)
#pragma unroll
            for (int m = 0; m < 4; ++m)
#pragma unroll
                for (int n = 0; n < 2; ++n) acc[a][b][m][n] = (f32x4){0.f, 0.f, 0.f, 0.f};
    bf16x8 At[4][2], B0[2][2], B1[2][2];
    const char* cA = (const char*)g.A + (size_t)cur.pm * tstepA; const char* cB = (const char*)g.Bt + (size_t)cur.pn * tstepB;
    S.a_ready(cur);
    if constexpr (SP2) {
        PG8_STAGE(PG8_SB(0, 0), cB, voffB); PG8_STAGE(PG8_SB(0, 1), cB + hstepB, voffB); PG8_STAGE(PG8_SA(0, 0), cA, voffA); PG8_STAGE(PG8_SA(0, 1), cA + hstepA, voffA);
        if (wr == 1) PG8_BAR;
        PG8_WAIT_V(2); PG8_BAR;
        PG8_STAGE(PG8_SB(1, 0), cB + kstep, voffB); PG8_STAGE(PG8_SA(1, 0), cA + kstep, voffA); PG8_STAGE(PG8_SB(1, 1), cB + hstepB + kstep, voffB);
        PG8_WAIT_V(6); PG8_BAR;
    } else {
        PG8_STAGE(PG8_SB(0, 0), cB, voffB); PG8_STAGE(PG8_SA(0, 0), cA, voffA); PG8_STAGE(PG8_SB(0, 1), cB + hstepB, voffB); PG8_STAGE(PG8_SA(0, 1), cA + hstepA, voffA);
        if (wr == 1) PG8_BAR;
        PG8_WAIT_V(4); PG8_BAR;
        PG8_STAGE(PG8_SB(1, 0), cB + kstep, voffB); PG8_STAGE(PG8_SA(1, 0), cA + kstep, voffA); PG8_STAGE(PG8_SB(1, 1), cB + hstepB + kstep, voffB);
        PG8_WAIT_V(6); PG8_BAR;
    }
    for (;;) {
        const bool has_next = S.next(ui + 1, nxt);
        const char* nA = has_next ? (const char*)g.A + (size_t)nxt.pm * tstepA : cA; const char* nB = has_next ? (const char*)g.Bt + (size_t)nxt.pn * tstepB : cB;
        for (int t = 0; t < nt; t += 2) {
            const bool last = (t == nt - 2);
            const char* a1 = cA + (size_t)(t + 1) * kstep;
            const char* a2 = last ? nA : cA + (size_t)(t + 2) * kstep; const char* b2 = last ? nB : cB + (size_t)(t + 2) * kstep;
            const char* a3 = a2 + kstep; const char* b3 = b2 + kstep;
            if (last && has_next) S.a_ready(nxt);
            if constexpr (SP2) {
            PG8_LDB(B0, 0, 0); PG8_LDB(B1, 0, 1); PG8_SCHED; PG8_LDA(At, 0, 0); PG8_STAGE(PG8_SA(1, 1), a1 + hstepA, voffA);
            PG8_WAIT_V(8); PG8_WAIT_L(0); PG8_BAR; PG8_MMA(0, 0, At, B0); PG8_MMA(0, 1, At, B1); PG8_BAR; PG8_SCHED;
            PG8_LDA(At, 0, 1); PG8_STAGE(PG8_SB(0, 0), b2, voffB); PG8_STAGE(PG8_SB(0, 1), b2 + hstepB, voffB); PG8_STAGE(PG8_SA(0, 0), a2, voffA);
            PG8_WAIT_V(8); PG8_WAIT_L(0); PG8_BAR; PG8_MMA(1, 0, At, B0); PG8_MMA(1, 1, At, B1); PG8_BAR; PG8_SCHED;
            PG8_LDB(B0, 1, 0); PG8_LDB(B1, 1, 1); PG8_SCHED; PG8_LDA(At, 1, 0); PG8_STAGE(PG8_SA(0, 1), a2 + hstepA, voffA);
            PG8_WAIT_V(8); PG8_WAIT_L(0); PG8_BAR; PG8_MMA(0, 0, At, B0); PG8_MMA(0, 1, At, B1); PG8_BAR; PG8_SCHED;
            PG8_LDA(At, 1, 1); PG8_STAGE(PG8_SB(1, 0), b3, voffB); PG8_STAGE(PG8_SB(1, 1), b3 + hstepB, voffB); PG8_STAGE(PG8_SA(1, 0), a3, voffA);
            PG8_WAIT_V(8); PG8_WAIT_L(0); PG8_BAR; PG8_MMA(1, 0, At, B0); PG8_MMA(1, 1, At, B1); PG8_BAR; PG8_SCHED;
            } else {
            PG8_LDB(B0, 0, 0); PG8_SCHED; PG8_LDA(At, 0, 0); PG8_STAGE(PG8_SA(1, 1), a1 + hstepA, voffA);
            PG8_WAIT_L(8); PG8_BAR; PG8_WAIT_L(0); PG8_MMA(0, 0, At, B0); PG8_BAR; PG8_SCHED;
            PG8_LDB(B1, 0, 1); PG8_STAGE(PG8_SB(0, 0), b2, voffB);
            PG8_BAR; PG8_WAIT_L(0); PG8_MMA(0, 1, At, B1); PG8_BAR;
            PG8_LDA(At, 0, 1); PG8_STAGE(PG8_SA(0, 0), a2, voffA);
            PG8_BAR; PG8_WAIT_L(0); PG8_MMA(1, 0, At, B0); PG8_BAR; PG8_SCHED;
            PG8_STAGE(PG8_SB(0, 1), b2 + hstepB, voffB);
            PG8_WAIT_V(6); PG8_BAR; PG8_MMA(1, 1, At, B1); PG8_BAR;
            PG8_LDB(B0, 1, 0); PG8_SCHED; PG8_LDA(At, 1, 0); PG8_STAGE(PG8_SA(0, 1), a2 + hstepA, voffA);
            PG8_WAIT_L(8); PG8_BAR; PG8_WAIT_L(0); PG8_MMA(0, 0, At, B0); PG8_BAR; PG8_SCHED;
            PG8_LDB(B1, 1, 1); PG8_STAGE(PG8_SB(1, 0), b3, voffB);
            PG8_BAR; PG8_WAIT_L(0); PG8_MMA(0, 1, At, B1); PG8_BAR;
            PG8_LDA(At, 1, 1); PG8_STAGE(PG8_SA(1, 0), a3, voffA);
            PG8_BAR; PG8_WAIT_L(0); PG8_MMA(1, 0, At, B0); PG8_BAR; PG8_SCHED;
            PG8_STAGE(PG8_SB(1, 1), b3 + hstepB, voffB);
            PG8_WAIT_V(6); PG8_BAR; PG8_MMA(1, 1, At, B1); PG8_BAR;
            }
        }
        if constexpr (ALIGN_EPI) { if (wr == 0) PG8_BAR; }
        if constexpr (!Epi::AFTER_DRAIN) { E(acc, cur, wr, wc, fr, fq); S.done(cur); }
        if (!has_next) break;
#pragma unroll
        for (int a = 0; a < 2; ++a)
#pragma unroll
            for (int b = 0; b < 2; ++b)
#pragma unroll
                for (int m = 0; m < 4; ++m)
#pragma unroll
                    for (int n = 0; n < 2; ++n) acc[a][b][m][n] = (f32x4){0.f, 0.f, 0.f, 0.f};
        cur = nxt; cA = nA; cB = nB; ++ui;
        if constexpr (ALIGN_EPI) { if (wr == 1) PG8_BAR; }
    }
    PG8_WAIT_V(0);
    if constexpr (!ALIGN_EPI) { if (wr == 0) PG8_BAR; }
    PG8_BAR;
    if constexpr (Epi::AFTER_DRAIN) { E.fused(acc, cur, wr, wc, fr, fq, lds, wid, lane); S.done(cur); }
#undef PG8_SA
#undef PG8_SB
#undef PG8_STAGE
#undef PG8_LDA
#undef PG8_LDB
#undef PG8_MMA
#undef PG8_WAIT_V
#undef PG8_WAIT_L
#undef PG8_BAR
#undef PG8_SCHED
}
}

constexpr int DM = 2048, NBATCH = 4, SEQ = 8192, CTXL = 256, RB = CTXL + SEQ  , HB = 2  , HR = HB * RB  ;
constexpr int DFF = 5632, NUP = 2 * DFF, NMOD = 6 * DM, NCH = RB / 64  ;
constexpr int LDP = 14848;
constexpr int NWIN = 15104, INW = 14880;
constexpr int C_QA = 0, C_KA = 1024, C_VA = 1280, C_QD = 1536, C_KD = 2560, C_VD = 3584, C_QKV = 4608, C_Z = 7680, C_G = 8704;
constexpr float LN_EPS = 1e-6f, DN_ALPHA = 1.41421356237f  , LOG2E = 1.4426950408889634f;
constexpr int NWAVES = 8, NTHR = 512;
constexpr size_t MiB = 1u << 20;
constexpr size_t WS_CTL = 0, CTL_ZERO_BYTES = 1 * MiB;
constexpr size_t WS_MOD = 1 * MiB;
constexpr size_t WS_ROPEA = WS_MOD + 512 * 1024, WS_ROPED = WS_ROPEA + 32768, WS_LAM = WS_ROPED + 16384;
constexpr size_t WS_CX = 2 * MiB;
constexpr size_t WS_WIN = 10 * MiB, WS_WPA = 69 * MiB, WS_WPB = 73 * MiB, WS_WPC = 77 * MiB, WS_WO = 81 * MiB, WS_WUP = 89 * MiB, WS_WDN = 133 * MiB;
constexpr size_t WS_H = 155 * MiB;
constexpr size_t WS_AB = 221 * MiB;
constexpr size_t WS_GL = WS_AB + 5 * MiB / 2;
constexpr size_t WS_P = 224 * MiB;
constexpr size_t WS_G = 703 * MiB;
constexpr size_t GU_BYTES = 73728, GU_W = 0, GU_QG = 16384, GU_KD = 32768, GU_AT = 49152, GU_U = 57344;
constexpr size_t WS_END = WS_G + 297 * MiB;
constexpr size_t WS_TOT = WS_G, WS_M = WS_G + 132 * MiB, WS_OX = WS_P, WS_U = WS_P, WS_ACT = WS_G, WS_FX = WS_P;
static_assert((size_t)HR * LDP * 2 <= 479 * MiB && (size_t)4224 * GU_BYTES <= 297 * MiB && (size_t)HR * NUP * 2 <= 479 * MiB && (size_t)HR * DFF * 2 <= 297 * MiB, "d_ws map");
constexpr size_t WS_TRASH = 512 * 1024;
constexpr int CW_BAR = 4096, CW_Q = 16384;
constexpr int RING_BYTES = 131072, LDS_BYTES = 147456, LDSCTL_OFF = LDS_BYTES - 1024;

#define GAS __attribute__((address_space(1)))
#define LAS __attribute__((address_space(3)))
typedef unsigned short bf16_t;
typedef short bf16x8 __attribute__((ext_vector_type(8)));
typedef short s16x4 __attribute__((ext_vector_type(4)));
typedef float f32x4 __attribute__((ext_vector_type(4)));
typedef float f32x2 __attribute__((ext_vector_type(2)));
typedef float f32x16 __attribute__((ext_vector_type(16)));
typedef unsigned u32x4 __attribute__((ext_vector_type(4)));
typedef unsigned u32x2 __attribute__((ext_vector_type(2)));
using pg8::cvt_pk_bf16; using pg8::bf_lo; using pg8::bf_hi; using pg8::sigm;
__device__ __forceinline__ float wave_sum(float v) {
#pragma unroll
    for (int o = 1; o < 64; o <<= 1) v += __shfl_xor(v, o);
    return v;
}
__device__ __forceinline__ int tid_opaque() { int t = threadIdx.x; asm volatile("" : "+v"(t)); return t; }
__device__ __forceinline__ int opaque_s(int v) { asm volatile("" : "+s"(v)); return v; }
__device__ __forceinline__ float silu_f(float x) { return x * sigm(x); }
__device__ __forceinline__ int crow(int r, int hi) { return (r & 3) + 8 * (r >> 2) + 4 * hi; }
__device__ __forceinline__ bf16x8 pack8(float a0, float a1, float a2, float a3, float a4, float a5, float a6, float a7) {
    u32x4 w; w.x = cvt_pk_bf16(a0, a1); w.y = cvt_pk_bf16(a2, a3); w.z = cvt_pk_bf16(a4, a5); w.w = cvt_pk_bf16(a6, a7); return __builtin_bit_cast(bf16x8, w); }
typedef short v4i16_t __attribute__((ext_vector_type(4)));
__device__ __forceinline__ s16x4 lds_tr(LAS const unsigned char* p) { return __builtin_bit_cast(s16x4, __builtin_amdgcn_ds_read_tr16_b64_v4i16((LAS v4i16_t*)p)); }
#define MFMA32(a, b, c) __builtin_amdgcn_mfma_f32_32x32x16_bf16((a), (b), (c), 0, 0, 0)

#define XB_TMO      128
#define XB_XCNT(j)  (256  + 64 * (j))
#define XB_XSUB(j)  (1280 + 64 * (j))
#define XB_XGEN(j)  (2304 + 64 * (j))
#define XB_TOP      3328
#define XB_TOPGEN   3392
#define XCD_BAR_WORDS 3456
#define XB_SPIN_CAP (1u << 18)

__device__ __forceinline__ unsigned xb_ld(unsigned* p)              { return __hip_atomic_load(p, __ATOMIC_RELAXED, __HIP_MEMORY_SCOPE_AGENT); }
__device__ __forceinline__ unsigned xb_add(unsigned* p, unsigned v) { return __hip_atomic_fetch_add(p, v, __ATOMIC_RELAXED, __HIP_MEMORY_SCOPE_AGENT); }
__device__ __forceinline__ unsigned xb_xcc_id() { return (unsigned)__builtin_amdgcn_s_getreg((3 << 11) | 20) & 0xFu; }
#define XB_SPIN(cond, bar) do { unsigned _sp = 0; while (cond) { __builtin_amdgcn_s_sleep(1); \
    if ((++_sp & 255u) == 0u) { if (xb_ld(&(bar)[XB_TMO])) break; if (_sp > XB_SPIN_CAP) { atomicAdd(&(bar)[XB_TMO], 1u); break; } } } } while (0)

struct XcdBarrier {
    unsigned* bar; unsigned x;
    volatile LAS unsigned* st;
};

__device__ __forceinline__ XcdBarrier xcd_barrier_post(unsigned* bar, volatile LAS unsigned* st) {
    XcdBarrier b; b.bar = bar; b.x = xb_xcc_id(); b.st = st;
    if (threadIdx.x == 0) (void)xb_add(&bar[XB_XCNT(b.x)], 1u);
    return b;
}
__device__ __forceinline__ void xcd_barrier_complete(unsigned* bar, unsigned x, unsigned& nloc, unsigned& nx) {
    const unsigned G = gridDim.x * gridDim.y * gridDim.z;
    unsigned sum, cnt, mine, sp = 0u;
    for (;;) {
        sum = 0u; cnt = 0u; mine = 0u;
#pragma unroll
        for (unsigned j = 0; j < 16; ++j) { const unsigned c = xb_ld(&bar[XB_XCNT(j)]); sum += c; cnt += (c > 0u) ? 1u : 0u; mine = (j == x) ? c : mine; }
        if (sum == G) break;
        __builtin_amdgcn_s_sleep(1);
        if ((++sp & 255u) == 0u) { if (xb_ld(&bar[XB_TMO])) break; if (sp > XB_SPIN_CAP) { atomicAdd(&bar[XB_TMO], 1u); break; } }
    }
    nloc = mine > 0u ? mine : 1u; nx = cnt > 0u ? cnt : 1u;
}

__device__ __forceinline__ void xcd_barrier(const XcdBarrier& b) {
    asm volatile("s_waitcnt vmcnt(0)" ::: "memory");
    __syncthreads();
    if (threadIdx.x == 0) {
        unsigned* bar = b.bar;
        __builtin_amdgcn_s_waitcnt(0);
        unsigned nloc = b.st[0], nx = b.st[1];
        if (nloc == 0u) { xcd_barrier_complete(bar, b.x, nloc, nx); b.st[0] = nloc; b.st[1] = nx; }
        const unsigned old = xb_add(&bar[XB_XSUB(b.x)], 1u);
        const unsigned gen = old / nloc;
        if (old + 1u == (gen + 1u) * nloc) {
            __builtin_amdgcn_fence(__ATOMIC_RELEASE, "agent");
            asm volatile("s_waitcnt vmcnt(0)" ::: "memory");
            const unsigned og = xb_add(&bar[XB_TOP], 1u);
            const unsigned tg = og / nx;
            if (og + 1u == (tg + 1u) * nx) xb_add(&bar[XB_TOPGEN], 1u);
            else XB_SPIN(xb_ld(&bar[XB_TOPGEN]) == tg, bar);
            __builtin_amdgcn_fence(__ATOMIC_ACQUIRE, "agent");
            xb_add(&bar[XB_XGEN(b.x)], 1u);
            asm volatile("s_waitcnt vmcnt(0)" ::: "memory");
        } else {
            XB_SPIN(xb_ld(&bar[XB_XGEN(b.x)]) == gen, bar);
            __builtin_amdgcn_fence(__ATOMIC_ACQUIRE, "agent");
            asm volatile("s_waitcnt vmcnt(0)" ::: "memory");
        }
    }
    __syncthreads();
}
struct Args { const float* in[29]; float* out; unsigned char* ws; int ph_lo, ph_hi; };
enum { I_X = 0, I_C, I_CTX, I_CCTX, I_WMOD, I_BMOD, I_WIN, I_SINK, I_LQ1, I_LK1, I_LQ2, I_LK2, I_SUBLN, I_DNCONV, I_ALOG, I_DTB, I_DNNORM, I_WPA, I_WPB, I_WPC, I_WO, I_LN1G, I_LN1B, I_WUP, I_FCW, I_FCB, I_WDN, I_LN2G, I_LN2B };

__device__ __forceinline__ void ph_prologue(const Args& A, LAS unsigned char* lds) {
    const int tid = tid_opaque(), lane = tid & 63, wave = tid >> 6, G = gridDim.x, bid = blockIdx.x;
    const int gt = bid * NTHR + tid, NT = G * NTHR;
    float* ropeA = (float*)(A.ws + WS_ROPEA); float* ropeD = (float*)(A.ws + WS_ROPED); float* LAM = (float*)(A.ws + WS_LAM); float* MOD = (float*)(A.ws + WS_MOD);
    for (int e = gt; e < 128 * 32; e += NT) { const int pos = e >> 5, f = e & 31; const float inv = powf(10000.0f, -(float)(2 * f) / 64.0f); const float ang = (float)pos * inv; ropeA[2 * e] = cosf(ang); ropeA[2 * e + 1] = sinf(ang); }
    for (int e = gt; e < 128 * 16; e += NT) { const int pos = e >> 4, f = e & 15; const float inv = powf(10000.0f, -(float)(2 * f) / 32.0f); const float ang = (float)pos * inv; ropeD[2 * e] = cosf(ang); ropeD[2 * e + 1] = sinf(ang); }
    if (gt < 2) { const int l = gt; float s1 = 0.f, s2 = 0.f;
        for (int i = 0; i < 64; ++i) { s1 += A.in[I_LQ1][l * 64 + i] * A.in[I_LK1][l * 64 + i]; s2 += A.in[I_LQ2][l * 64 + i] * A.in[I_LK2][l * 64 + i]; }
        const float lam_init = 0.8f - 0.6f * expf(-0.3f * (float)l); LAM[2 * l] = expf(s1) - expf(s2) + lam_init; LAM[2 * l + 1] = 1.0f - lam_init; }
    LAS float* sc = (LAS float*)lds;
    LAS float* red = (LAS float*)(lds + 40960);
    for (int e = tid; e < 5 * 2048; e += NTHR) { const int idx = e >> 11, k = e & 2047; const float v = (idx < 4) ? A.in[I_C][idx * 2048 + k] : A.in[I_CCTX][k]; sc[e] = silu_f(v); }
    __syncthreads();
    for (int u = bid; u < 192; u += G) {
        const int l = u / 96, n0 = (u % 96) * 128;
        const float* W = A.in[I_WMOD] + (size_t)l * 2048 * NMOD + n0 + 2 * lane;
        float acc[5][2];
#pragma unroll
        for (int i = 0; i < 5; ++i) { acc[i][0] = 0.f; acc[i][1] = 0.f; }
        const int k0 = wave * 256;
#pragma unroll 4
        for (int k = k0; k < k0 + 256; ++k) { const f32x2 w = *(const f32x2*)(W + (size_t)k * NMOD);
#pragma unroll
            for (int i = 0; i < 5; ++i) { const float s = sc[i * 2048 + k]; acc[i][0] += s * w.x; acc[i][1] += s * w.y; } }
#pragma unroll
        for (int i = 0; i < 5; ++i) { red[(wave * 5 + i) * 128 + 2 * lane] = acc[i][0]; red[(wave * 5 + i) * 128 + 2 * lane + 1] = acc[i][1]; }
        __syncthreads();
        for (int e = tid; e < 640; e += NTHR) { const int idx = e >> 7, n = e & 127; float s = 0.f;
#pragma unroll
            for (int w = 0; w < 8; ++w) s += red[(w * 5 + idx) * 128 + n];
            MOD[(size_t)(l * 5 + idx) * NMOD + n0 + n] = s + A.in[I_BMOD][l * NMOD + n0 + n]; }
        __syncthreads();
    }
}
__device__ __forceinline__ int win_src(int n) {
    if (n < 1280) { const int j = n & 127, p = j >> 1, s = j & 1; const int dim = (p < 32) ? (s * 32 + p) : (64 + s * 32 + (p - 32)); return (n & ~127) + dim; }
    if (n < 1536) return n;
    if (n < 3584) { const int j = n & 63, p = j >> 1, s = j & 1; const int dim = (p < 16) ? (s * 16 + p) : (32 + s * 16 + (p - 16)); return (n & ~63) + dim; }
    if (n < 8704) return n;
    if (n < 14848) return n + 32;
    if (n < 14880) return n - 14848 + 8704;
    return -1;
}
template <int MODE> __device__ __forceinline__ void transpose_item(const float* W, int K, int N, bf16_t* WT, LAS float* scr, int kb, int nb, int lane) {
    const int k0 = 64 * kb, n0 = 32 * nb, nn = n0 + (lane & 31);
    const int sc = (MODE == 1) ? win_src(nn) : nn;
    const float* src = W + (size_t)(k0 + (lane >> 5)) * N + (sc >= 0 ? sc : 0);
#pragma unroll 8
    for (int i = 0; i < 32; ++i) { const float v = src[(size_t)(2 * i) * N]; scr[(2 * i + (lane >> 5)) * 33 + (lane & 31)] = (sc >= 0) ? v : 0.f; }
    asm volatile("s_waitcnt lgkmcnt(0)" ::: "memory");
    const int c = lane & 7;
#pragma unroll
    for (int j = 0; j < 4; ++j) { const int n = (lane >> 3) + 8 * j; const LAS float* s = scr + (8 * c) * 33 + n;
        u32x4 o; o.x = cvt_pk_bf16(s[0 * 33], s[1 * 33]); o.y = cvt_pk_bf16(s[2 * 33], s[3 * 33]); o.z = cvt_pk_bf16(s[4 * 33], s[5 * 33]); o.w = cvt_pk_bf16(s[6 * 33], s[7 * 33]);
        *(u32x4*)(WT + (size_t)(n0 + n) * K + k0 + 8 * c) = o; }
    asm volatile("s_waitcnt lgkmcnt(0)" ::: "memory");
}
__device__ __forceinline__ void ph_weights(const Args& A, LAS unsigned char* lds, int l) {
    const int tid = tid_opaque(), lane = tid & 63, wave = tid >> 6, G = gridDim.x, bid = blockIdx.x;
    LAS float* scr = (LAS float*)(lds + wave * 8448);
    unsigned char* ws = A.ws;
    constexpr int I0 = 32 * 472, I1 = 16 * 64, I2 = 32 * 64, I3 = 32 * 352, I4 = 88 * 64, NIT = I0 + 3 * I1 + I2 + I3 + I4;
    for (int it = bid * NWAVES + wave; it < NIT; it += G * NWAVES) {
        int r = it;
        if (r < I0) { transpose_item<1>(A.in[I_WIN] + (size_t)l * 2048 * INW, 2048, INW, (bf16_t*)(ws + WS_WIN), scr, r / 472, r % 472, lane); continue; } r -= I0;
        if (r < I1) { transpose_item<0>(A.in[I_WPA] + (size_t)l * 1024 * 2048, 1024, 2048, (bf16_t*)(ws + WS_WPA), scr, r / 64, r % 64, lane); continue; } r -= I1;
        if (r < I1) { transpose_item<0>(A.in[I_WPB] + (size_t)l * 1024 * 2048, 1024, 2048, (bf16_t*)(ws + WS_WPB), scr, r / 64, r % 64, lane); continue; } r -= I1;
        if (r < I1) { transpose_item<0>(A.in[I_WPC] + (size_t)l * 1024 * 2048, 1024, 2048, (bf16_t*)(ws + WS_WPC), scr, r / 64, r % 64, lane); continue; } r -= I1;
        if (r < I2) { transpose_item<0>(A.in[I_WO] + (size_t)l * 2048 * 2048, 2048, 2048, (bf16_t*)(ws + WS_WO), scr, r / 64, r % 64, lane); continue; } r -= I2;
        if (r < I3) { transpose_item<0>(A.in[I_WUP] + (size_t)l * 2048 * NUP, 2048, NUP, (bf16_t*)(ws + WS_WUP), scr, r / 352, r % 352, lane); continue; } r -= I3;
        transpose_item<0>(A.in[I_WDN] + (size_t)l * DFF * 2048, DFF, 2048, (bf16_t*)(ws + WS_WDN), scr, r / 64, r % 64, lane);
    }
}
__device__ __forceinline__ void row_src(const Args& A, int l, int half, int r, const float*& src, float*& dst, const float*& mod, bool& is_ctx) {
    const int bl = r / RB, tp = r - bl * RB, b = opaque_s(half) * HB + bl; is_ctx = tp < CTXL;
    float* cx = (float*)(A.ws + WS_CX);
    dst = is_ctx ? cx + (size_t)(b * CTXL + tp) * DM : A.out + (size_t)(b * SEQ + tp - CTXL) * DM;
    if (l == 0) src = is_ctx ? A.in[I_CTX] + (size_t)(b * CTXL + tp) * DM : A.in[I_X] + (size_t)(b * SEQ + tp - CTXL) * DM; else src = dst;
    mod = (const float*)(A.ws + WS_MOD) + (size_t)(l * 5 + (is_ctx ? 4 : b)) * NMOD;
}
__device__ __forceinline__ void ln_stats(const f32x4 (&v)[8], float& mean, float& rstd) {
    float s = 0.f;
#pragma unroll
    for (int j = 0; j < 8; ++j) s += (v[j].x + v[j].y) + (v[j].z + v[j].w);
    mean = wave_sum(s) * (1.0f / DM); float q = 0.f;
#pragma unroll
    for (int j = 0; j < 8; ++j) { const f32x4 d = v[j] - mean; q += (d.x * d.x + d.y * d.y) + (d.z * d.z + d.w * d.w); }
    rstd = 1.0f / sqrtf(wave_sum(q) * (1.0f / DM) + LN_EPS);
}
__device__ __forceinline__ void ada_store(const f32x4 (&v)[8], float mean, float rstd, const float* shift, const float* scale, bf16_t* hrow, int lane) {
#pragma unroll
    for (int j = 0; j < 8; ++j) { const int e = (64 * j + lane) * 4; const f32x4 sh = *(const f32x4*)(shift + e), sc = *(const f32x4*)(scale + e);
        const f32x4 y = (v[j] - mean) * rstd * (sc + 1.0f) + sh; u32x2 w; w.x = cvt_pk_bf16(y.x, y.y); w.y = cvt_pk_bf16(y.z, y.w); *(u32x2*)(hrow + e) = w; }
}
__device__ __forceinline__ void ph_adaln(const Args& A, int l, int half) {
    const int tid = tid_opaque(), lane = tid & 63, gw = blockIdx.x * NWAVES + (tid >> 6), NGW = gridDim.x * NWAVES;
    bf16_t* H = (bf16_t*)(A.ws + WS_H);
    for (int r = gw; r < HR; r += NGW) {
        const float* src; float* dst; const float* mod; bool is_ctx; row_src(A, l, half, r, src, dst, mod, is_ctx);
        f32x4 v[8];
#pragma unroll
        for (int j = 0; j < 8; ++j) v[j] = *((const f32x4*)src + 64 * j + lane);
        float mean, rstd; ln_stats(v, mean, rstd);
        ada_store(v, mean, rstd, mod, mod + DM, H + (size_t)r * DM, lane);
    }
}
template <bool WITH_H> __device__ __forceinline__ void ph_resln(const Args& A, int l, int half, const bf16_t* Y, int gate_idx, const float* lng, const float* lnb, bool dry) {
    const int tid = tid_opaque(), lane = tid & 63, gw = blockIdx.x * NWAVES + (tid >> 6), NGW = gridDim.x * NWAVES;
    bf16_t* H = (bf16_t*)(A.ws + WS_H);
    for (int r = gw; r < HR; r += NGW) {
        const float* src; float* dst; const float* mod; bool is_ctx; row_src(A, l, half, r, src, dst, mod, is_ctx);
        if (is_ctx && l == 1) continue;
        if (!WITH_H) src = dst;
        if (dry) dst = (float*)(A.ws + WS_TRASH) + (tid >> 6) * DM;
        const float* gate = mod + gate_idx * DM; const bf16_t* yrow = Y + (size_t)r * DM;
        f32x4 v[8];
#pragma unroll
        for (int j = 0; j < 8; ++j) { const int e = 64 * j + lane; const u32x2 yw = *((const u32x2*)yrow + e); const f32x4 yv = (f32x4){bf_lo(yw.x), bf_hi(yw.x), bf_lo(yw.y), bf_hi(yw.y)};
            v[j] = *((const f32x4*)src + e) * DN_ALPHA + *((const f32x4*)gate + e) * yv; }
        float mean, rstd; ln_stats(v, mean, rstd);
#pragma unroll
        for (int j = 0; j < 8; ++j) { const int e = 64 * j + lane; v[j] = (v[j] - mean) * rstd * *((const f32x4*)lng + e) + *((const f32x4*)lnb + e); *((f32x4*)dst + e) = v[j]; }
        if (WITH_H) { ln_stats(v, mean, rstd); ada_store(v, mean, rstd, mod + 3 * DM, mod + 4 * DM, dry ? (bf16_t*)(A.ws + WS_TRASH) + 131072 + (tid >> 6) * DM : H + (size_t)r * DM, lane); }
    }
}
__device__ __forceinline__ void ph_convact(const Args& A, int l_) {
    const int l = opaque_s(l_);
    const int gt = blockIdx.x * NTHR + tid_opaque(), NT = gridDim.x * NTHR;
    const bf16_t* U = (const bf16_t*)(A.ws + WS_U); bf16_t* ACT = (bf16_t*)(A.ws + WS_ACT);
    const float* cw = A.in[I_FCW] + (size_t)l * 3 * NUP; const float* cb = A.in[I_FCB] + (size_t)l * NUP;
    constexpr int NVC = DFF / 8, NRB = HR / 32;
    for (int idx = gt; idx < NRB * NVC; idx += NT) {
        const int rbk = idx / NVC, vc = idx - rbk * NVC, r0 = rbk * 32, tp0 = r0 % RB;
        const bool first_start = (tp0 == 0 || tp0 == CTXL), last_end = (tp0 + 31 == CTXL - 1 || tp0 + 31 == RB - 1);
        const int ca = vc * 8, cbk = DFF + vc * 8;
        float wa[3][8], wb[3][8], ba[8], bb[8];
#pragma unroll
        for (int t = 0; t < 3; ++t) {
#pragma unroll
            for (int k = 0; k < 8; ++k) { wa[t][k] = cw[t * NUP + ca + k]; wb[t][k] = cw[t * NUP + cbk + k]; } }
#pragma unroll
        for (int k = 0; k < 8; ++k) { ba[k] = cb[ca + k]; bb[k] = cb[cbk + k]; }
        const u32x4 z4 = (u32x4){0u, 0u, 0u, 0u};
        u32x4 pa = z4, pb = z4, qa, qb;
        if (!first_start) { pa = *(const u32x4*)(U + (size_t)(r0 - 1) * NUP + ca); pb = *(const u32x4*)(U + (size_t)(r0 - 1) * NUP + cbk); }
        qa = *(const u32x4*)(U + (size_t)r0 * NUP + ca); qb = *(const u32x4*)(U + (size_t)r0 * NUP + cbk);
        for (int rq = 0; rq < 32; rq += 4) {
            u32x4 na[4], nb[4];
#pragma unroll
            for (int k4 = 0; k4 < 4; ++k4) { const int r = rq + k4;
                if (r == 31 && last_end) { na[k4] = z4; nb[k4] = z4; } else { na[k4] = *(const u32x4*)(U + (size_t)(r0 + r + 1) * NUP + ca); nb[k4] = *(const u32x4*)(U + (size_t)(r0 + r + 1) * NUP + cbk); } }
#pragma unroll
            for (int k4 = 0; k4 < 4; ++k4) { const int r = rq + k4;
                float o[8];
#pragma unroll
                for (int k = 0; k < 4; ++k) {
                    const unsigned a0 = pa[k], a1 = qa[k], a2 = na[k4][k], b0 = pb[k], b1 = qb[k], b2 = nb[k4][k];
                    const float xa0 = wa[0][2 * k] * bf_lo(a0) + wa[1][2 * k] * bf_lo(a1) + wa[2][2 * k] * bf_lo(a2) + ba[2 * k];
                    const float xa1 = wa[0][2 * k + 1] * bf_hi(a0) + wa[1][2 * k + 1] * bf_hi(a1) + wa[2][2 * k + 1] * bf_hi(a2) + ba[2 * k + 1];
                    const float xb0 = wb[0][2 * k] * bf_lo(b0) + wb[1][2 * k] * bf_lo(b1) + wb[2][2 * k] * bf_lo(b2) + bb[2 * k];
                    const float xb1 = wb[0][2 * k + 1] * bf_hi(b0) + wb[1][2 * k + 1] * bf_hi(b1) + wb[2][2 * k + 1] * bf_hi(b2) + bb[2 * k + 1];
                    o[2 * k] = silu_f(xa0) * xb0; o[2 * k + 1] = silu_f(xa1) * xb1; }
                u32x4 w; w.x = cvt_pk_bf16(o[0], o[1]); w.y = cvt_pk_bf16(o[2], o[3]); w.z = cvt_pk_bf16(o[4], o[5]); w.w = cvt_pk_bf16(o[6], o[7]);
                *(u32x4*)(ACT + (size_t)(r0 + r) * DFF + vc * 8) = w;
                pa = qa; pb = qb; qa = na[k4]; qb = nb[k4];
            }
        }
    }
}
__device__ __forceinline__ float max3f(float a, float b, float c) { float r; asm("v_max3_f32 %0, %1, %2, %3" : "=v"(r) : "v"(a), "v"(b), "v"(c)); return r; }
__device__ __forceinline__ float xhalf_max(float m) { auto rr = __builtin_amdgcn_permlane32_swap(__float_as_uint(m), __float_as_uint(m), false, false); float r; asm("v_max_f32_e32 %0, %1, %2" : "=v"(r) : "v"(__uint_as_float(rr[0])), "v"(__uint_as_float(rr[1]))); return r; }
__device__ __forceinline__ float xhalf_sum(float m) { auto rr = __builtin_amdgcn_permlane32_swap(__float_as_uint(m), __float_as_uint(m), false, false); return __uint_as_float(rr[0]) + __uint_as_float(rr[1]); }
#ifndef ATT_EXP
#define ATT_EXP 0
#endif
template <int DQK>
__device__ __forceinline__ void attn_core(LAS unsigned char* lds, const bf16_t* Qrow, int kc0, const bf16_t* K0, const bf16_t* V0, int n0, const bf16_t* K1, const bf16_t* V1, int n1,
                                          bool mask1, int qpos, int k1pos0, f32x16 (&oT)[4], float& mref, float& lsum, bool dryx = false) {
    const int tid = tid_opaque(), lane = tid & 63, r32 = lane & 31, hi = lane >> 5, wave = __builtin_amdgcn_readfirstlane(tid >> 6);
    bf16x8 qf[DQK / 16];
#pragma unroll
    for (int d0 = 0; d0 < DQK / 16; ++d0) qf[d0] = *(const bf16x8*)(Qrow + d0 * 16 + hi * 8);
    const int c0 = 2 * wave, c1 = 2 * wave + 1;
    const unsigned kg0 = (unsigned)((lane ^ c0) * LDP + c0 * 8), kg1 = (unsigned)((lane ^ c1) * LDP + c1 * 8);
    const unsigned vg0 = (unsigned)((16 * (c0 & 3) + (lane >> 2)) * LDP + (4 * (c0 >> 2) + (lane & 3)) * 8), vg1 = (unsigned)((16 * (c1 & 3) + (lane >> 2)) * LDP + (4 * (c1 >> 2) + (lane & 3)) * 8);
    const int vd0 = 49152 + ((c0 >> 2) * 8 + 2 * (c0 & 3)) * 512, vd1 = 49152 + ((c1 >> 2) * 8 + 2 * (c1 & 3)) * 512;
#define AT_DMA_K(t, s) do { const bf16_t* kp_ = ((t) < n0) ? K0 + (size_t)(t) * 64 * LDP : K1 + (size_t)((t) - n0) * 64 * LDP; \
        __builtin_amdgcn_global_load_lds((const unsigned*)(kp_ + kg0), (LAS unsigned*)(lds + (s) * 16384 + c0 * 1024), 16, 0, 0); \
        __builtin_amdgcn_global_load_lds((const unsigned*)(kp_ + kg1), (LAS unsigned*)(lds + (s) * 16384 + c1 * 1024), 16, 0, 0); } while (0)
#define AT_DMA_V(t, s) do { const bf16_t* vp_ = ((t) < n0) ? V0 + (size_t)(t) * 64 * LDP : V1 + (size_t)((t) - n0) * 64 * LDP; \
        __builtin_amdgcn_global_load_lds((const unsigned*)(vp_ + vg0), (LAS unsigned*)(lds + (s) * 16384 + vd0), 16, 0, 0); \
        __builtin_amdgcn_global_load_lds((const unsigned*)(vp_ + vg1), (LAS unsigned*)(lds + (s) * 16384 + vd1), 16, 0, 0); } while (0)
    const int nt = n0 + n1;
    const int vbase = 49152 + (4 * hi + ((lane & 15) >> 2)) * 64 + ((lane >> 4) & 1) * 32 + (lane & 3) * 8;
#define AT_KLD(kb) do { kbo = (kb); if (DQK == 64) { _Pragma("unroll") for (int d0 = 0; d0 < 2; ++d0) { const int c_ = (kc0 >> 3) + 2 * d0 + hi; const int off_ = kbo + c_ * 1024 + ((r32 ^ c_) << 4); \
            kf[2 * d0] = *(LAS const bf16x8*)(lds + off_); kf[2 * d0 + 1] = *(LAS const bf16x8*)(lds + off_ + 512); } } } while (0)
#define AT_QK(P0, P1) do { _Pragma("unroll") for (int r_ = 0; r_ < 16; ++r_) { P0[r_] = 0.f; P1[r_] = 0.f; } \
        if (DQK == 64) { bf16x8 kg[4]; _Pragma("unroll") for (int d0 = 2; d0 < 4; ++d0) { const int c_ = (kc0 >> 3) + 2 * d0 + hi; const int off_ = kbo + c_ * 1024 + ((r32 ^ c_) << 4); \
                kg[2 * d0 - 4] = *(LAS const bf16x8*)(lds + off_); kg[2 * d0 - 3] = *(LAS const bf16x8*)(lds + off_ + 512); } \
            _Pragma("unroll") for (int d0 = 0; d0 < 2; ++d0) { P0 = MFMA32(kf[2 * d0], qf[d0], P0); P1 = MFMA32(kf[2 * d0 + 1], qf[d0], P1); } \
            _Pragma("unroll") for (int d0 = 2; d0 < 4; ++d0) { P0 = MFMA32(kg[2 * d0 - 4], qf[d0], P0); P1 = MFMA32(kg[2 * d0 - 3], qf[d0], P1); } } \
        else { _Pragma("unroll") for (int d0 = 0; d0 < DQK / 16; ++d0) { const int c_ = (kc0 >> 3) + 2 * d0 + hi; const int off_ = kbo + c_ * 1024 + ((r32 ^ c_) << 4); \
            const bf16x8 a0_ = *(LAS const bf16x8*)(lds + off_), a1_ = *(LAS const bf16x8*)(lds + off_ + 512); P0 = MFMA32(a0_, qf[d0], P0); P1 = MFMA32(a1_, qf[d0], P1); } } } while (0)
    bf16x8 kf[4]; int kbo = 0;
    f32x16 pc0, pc1;
    AT_DMA_K(0, 0); AT_DMA_V(0, 0); if (nt > 1) { AT_DMA_K(1, 1); AT_DMA_V(1, 1); } if (nt > 2) AT_DMA_K(2, 2);
    asm volatile("s_waitcnt vmcnt(0)" ::: "memory"); __syncthreads();
    AT_KLD(0); AT_QK(pc0, pc1);
    __syncthreads();
    int s0 = 0, s1 = 1, s2 = 2;
    for (int t = 0; t < nt; ++t) {
        const bool more1 = (t + 1 < nt), more2 = (t + 2 < nt), more3 = (t + 3 < nt);
        if (!(ATT_EXP == 7 && dryx)) {
        if (more3) AT_DMA_K(t + 3, s0);
        if (more2) AT_DMA_V(t + 2, s2);
        }
        if (more1) { AT_KLD(s1 * 16384); }
        if (mask1 && t >= n0) { const int kb = k1pos0 + (t - n0) * 64 + 4 * hi - qpos;
#pragma unroll
            for (int r = 0; r < 16; ++r) { const int dl = kb + (r & 3) + 8 * (r >> 2); if (dl > 128 || dl < -128) pc0[r] = -INFINITY; if (dl + 32 > 128 || dl + 32 < -128) pc1[r] = -INFINITY; } }
        if (!(ATT_EXP == 1 && dryx)) {
        float tm = max3f(pc0[0], pc1[0], pc0[1]), tm2 = max3f(pc1[1], pc0[2], pc1[2]);
#pragma unroll
        for (int r = 3; r < 15; r += 2) { tm = max3f(tm, pc0[r], pc1[r]); tm2 = max3f(tm2, pc0[r + 1], pc1[r + 1]); }
        tm = max3f(tm, pc0[15], pc1[15]); tm = max3f(tm, tm2, tm2);
        tm = xhalf_max(tm);
        if (__any(tm > mref + 8.0f)) { const float mn = fmaxf(mref, tm); const float al = __builtin_amdgcn_exp2f(mref - mn);
#pragma unroll
            for (int q = 0; q < 4; ++q) oT[q] = oT[q] * al;
            lsum *= al; mref = mn; }
        float rs = 0.f;
#pragma unroll
        for (int r = 0; r < 16; ++r) { pc0[r] = __builtin_amdgcn_exp2f(pc0[r] - mref); pc1[r] = __builtin_amdgcn_exp2f(pc1[r] - mref); rs += pc0[r] + pc1[r]; }
        lsum += rs;
        }
        bf16x8 pw[4];
        pw[0] = pack8(pc0[0], pc0[1], pc0[2], pc0[3], pc0[4], pc0[5], pc0[6], pc0[7]); pw[1] = pack8(pc0[8], pc0[9], pc0[10], pc0[11], pc0[12], pc0[13], pc0[14], pc0[15]);
        pw[2] = pack8(pc1[0], pc1[1], pc1[2], pc1[3], pc1[4], pc1[5], pc1[6], pc1[7]); pw[3] = pack8(pc1[8], pc1[9], pc1[10], pc1[11], pc1[12], pc1[13], pc1[14], pc1[15]);
        const unsigned vt = (unsigned)(uintptr_t)(lds + s0 * 16384 + vbase);
        s16x4 va[4], vc[4];
#define AT_TR(dst, off) asm volatile("ds_read_b64_tr_b16 %0, %1 offset:%2" : "=&v"(dst) : "v"(vt), "n"(off) : "memory")
#define AT_VRD(dst, g) do { AT_TR(dst[0], (((g) >> 1) * 8 + 4 * ((g) & 1)) * 512); AT_TR(dst[1], (((g) >> 1) * 8 + 4 * ((g) & 1)) * 512 + 512); \
        AT_TR(dst[2], (((g) >> 1) * 8 + 4 * ((g) & 1)) * 512 + 1024); AT_TR(dst[3], (((g) >> 1) * 8 + 4 * ((g) & 1)) * 512 + 1536); } while (0)
#define AT_LW(n) asm volatile("s_waitcnt lgkmcnt(" #n ")" ::: "memory")
#define AT_PV(src, g) do { oT[(g) >> 1] = MFMA32(((bf16x8){src[0][0], src[0][1], src[0][2], src[0][3], src[1][0], src[1][1], src[1][2], src[1][3]}), pw[2 * ((g) & 1)], oT[(g) >> 1]); \
        oT[(g) >> 1] = MFMA32(((bf16x8){src[2][0], src[2][1], src[2][2], src[2][3], src[3][0], src[3][1], src[3][2], src[3][3]}), pw[2 * ((g) & 1) + 1], oT[(g) >> 1]); } while (0)
        if (ATT_EXP == 2 && dryx) { if (more1) { AT_QK(pc0, pc1); } } else {
        AT_VRD(va, 0);
        if (more1 && !(ATT_EXP == 3 && dryx)) { AT_QK(pc0, pc1); }
        __builtin_amdgcn_sched_barrier(0);
        AT_VRD(vc, 1); AT_LW(4); __builtin_amdgcn_sched_barrier(0); AT_PV(va, 0); __builtin_amdgcn_sched_barrier(0);
        AT_VRD(va, 2); AT_LW(4); __builtin_amdgcn_sched_barrier(0); AT_PV(vc, 1); __builtin_amdgcn_sched_barrier(0);
        AT_VRD(vc, 3); AT_LW(4); __builtin_amdgcn_sched_barrier(0); AT_PV(va, 2); __builtin_amdgcn_sched_barrier(0);
        AT_VRD(va, 4); AT_LW(4); __builtin_amdgcn_sched_barrier(0); AT_PV(vc, 3); __builtin_amdgcn_sched_barrier(0);
        AT_VRD(vc, 5); AT_LW(4); __builtin_amdgcn_sched_barrier(0); AT_PV(va, 4); __builtin_amdgcn_sched_barrier(0);
        AT_VRD(va, 6); AT_LW(4); __builtin_amdgcn_sched_barrier(0); AT_PV(vc, 5); __builtin_amdgcn_sched_barrier(0);
        AT_VRD(vc, 7); AT_LW(4); __builtin_amdgcn_sched_barrier(0); AT_PV(va, 6); __builtin_amdgcn_sched_barrier(0);
        AT_LW(0); __builtin_amdgcn_sched_barrier(0);
        AT_PV(vc, 7);
        }
#undef AT_VRD
#undef AT_PV
#undef AT_TR
#undef AT_LW
        if (more3) { asm volatile("s_waitcnt vmcnt(4)" ::: "memory"); } else if (more2) { asm volatile("s_waitcnt vmcnt(2)" ::: "memory"); } else { asm volatile("s_waitcnt vmcnt(0)" ::: "memory"); }
        asm volatile("s_waitcnt lgkmcnt(0)" ::: "memory"); if (!(ATT_EXP == 6 && dryx)) __builtin_amdgcn_s_barrier();
        { const int tmp = s0; s0 = s1; s1 = s2; s2 = tmp; }
    }
    __syncthreads();
#undef AT_DMA_K
#undef AT_DMA_V
#undef AT_QK
#undef AT_KLD
}
__device__ __forceinline__ void attn_store(bf16_t* orow, const f32x16 (&o)[4], int hi) {
#pragma unroll
    for (int q = 0; q < 4; ++q)
#pragma unroll
        for (int g = 0; g < 4; ++g) { u32x2 w; w.x = cvt_pk_bf16(o[q][4 * g], o[q][4 * g + 1]); w.y = cvt_pk_bf16(o[q][4 * g + 2], o[q][4 * g + 3]); *(u32x2*)(orow + 32 * q + 8 * g + 4 * hi) = w; }
}
__device__ __forceinline__ void attnA_unit(const Args& A, LAS unsigned char* lds, int l_, int bl, int nb, int pr, bool ctxq, bool dry) {
    const int l = opaque_s(l_);
    const int tid = tid_opaque(), lane = tid & 63, r32 = lane & 31, hi = lane >> 5, wave = __builtin_amdgcn_readfirstlane(tid >> 6);
    bf16_t* P = (bf16_t*)(A.ws + WS_P);
    const int head = 2 * pr + (wave >> 2), kvh = pr >> 1, qloc = nb * 128 + 32 * (wave & 3) + r32;
    const size_t brow = (size_t)bl * RB;
    const size_t qrow = brow + (ctxq ? 0 : CTXL) + qloc;
    const bf16_t* Kc = P + brow * LDP + C_KA + kvh * 128; const bf16_t* Vc = P + brow * LDP + C_VA + kvh * 128;
    int ks = 128 * (nb - 1), ke = 128 * (nb + 2); if (ks < 0) ks = 0; if (ke > SEQ) ke = SEQ;
    const int n1 = ctxq ? 0 : (ke - ks) / 64;
    f32x16 oT[4];
#pragma unroll
    for (int q = 0; q < 4; ++q)
#pragma unroll
        for (int r = 0; r < 16; ++r) oT[q][r] = 0.f;
    float mref = -INFINITY, lsum = 0.f;
    attn_core<128>(lds, P + qrow * LDP + C_QA + head * 128, 0, Kc, Vc, 4, Kc + (size_t)(CTXL + ks) * LDP, Vc + (size_t)(CTXL + ks) * LDP, n1, true, qloc, ks, oT, mref, lsum, dry);
    const float sk = A.in[I_SINK][l * 8 + head] * LOG2E;
    const float mf = fmaxf(mref, sk), sc = __builtin_amdgcn_exp2f(mref - mf);
    lsum = xhalf_sum(lsum);
    const float f = sc / (lsum * sc + __builtin_amdgcn_exp2f(sk - mf));
#pragma unroll
    for (int q = 0; q < 4; ++q) oT[q] = oT[q] * f;
    attn_store(dry ? (bf16_t*)(A.ws + WS_TRASH) + tid * 128 : P + qrow * LDP + C_QA + head * 128, oT, hi);
}
__device__ __forceinline__ void attnB_unit(const Args& A, LAS unsigned char* lds, int l_, int bl, int h, int qb, bool ctxq, bool dry) {
    const int l = opaque_s(l_);
    const int tid = tid_opaque(), lane = tid & 63, r32 = lane & 31, hi = lane >> 5, wave = __builtin_amdgcn_readfirstlane(tid >> 6);
    bf16_t* P = (bf16_t*)(A.ws + WS_P);
    const int sub = wave >> 2;
    const size_t brow = (size_t)bl * RB;
    const size_t qrow = brow + (ctxq ? 0 : CTXL) + qb * 128 + 32 * (wave & 3) + r32;
    const bf16_t* Kc = P + brow * LDP + C_KD + h * 128; const bf16_t* Vc = P + brow * LDP + C_VD + h * 128;
    f32x16 oT[4];
#pragma unroll
    for (int q = 0; q < 4; ++q)
#pragma unroll
        for (int r = 0; r < 16; ++r) oT[q][r] = 0.f;
    float mref = -INFINITY, lsum = 0.f;
    attn_core<64>(lds, P + qrow * LDP + C_QD + h * 128 + sub * 64, sub * 64, Kc, Vc, ctxq ? 4 : NCH, Kc, Vc, 0, false, 0, 0, oT, mref, lsum, dry);
    lsum = xhalf_sum(lsum);
    const float inv = 1.0f / lsum;
    LAS float* xch = (LAS float*)lds + (wave & 3) * 4096;
    if (sub == 1) {
#pragma unroll
        for (int q = 0; q < 4; ++q)
#pragma unroll
            for (int r = 0; r < 16; ++r) xch[(q * 16 + r) * 64 + lane] = oT[q][r] * inv;
    }
    __syncthreads();
    if (sub == 0) {
        const float lam = ((const float*)(A.ws + WS_LAM))[2 * l], post = ((const float*)(A.ws + WS_LAM))[2 * l + 1];
        float ss = 0.f;
#pragma unroll
        for (int q = 0; q < 4; ++q)
#pragma unroll
            for (int r = 0; r < 16; ++r) { const float v = oT[q][r] * inv - lam * xch[(q * 16 + r) * 64 + lane]; oT[q][r] = v; ss += v * v; }
        ss = xhalf_sum(ss);
        const float rn = post / sqrtf(ss * (1.0f / 128.0f) + 1e-6f);
        const float* sw = A.in[I_SUBLN] + l * 128;
#pragma unroll
        for (int q = 0; q < 4; ++q)
#pragma unroll
            for (int r = 0; r < 16; ++r) oT[q][r] *= rn * sw[32 * q + 8 * (r >> 2) + 4 * hi + (r & 3)];
        attn_store(dry ? (bf16_t*)(A.ws + WS_TRASH) + tid * 128 : P + qrow * LDP + C_QD + h * 128, oT, hi);
    }
    __syncthreads();
}
__device__ __forceinline__ void ph_attention(const Args& A, LAS unsigned char* lds, int l, int half, int it, bool dry) {
    const int tid = tid_opaque();
    unsigned* ctr = (unsigned*)(A.ws + WS_CTL) + CW_Q + 64 * 8 * (2 * it + (dry ? 1 : 0));
    volatile LAS int* qw = (volatile LAS int*)(lds + LDSCTL_OFF + 64);
    const int nq = 128 + 64 + (l == 0 ? 6 : 0);
    const int x0 = (int)(xb_xcc_id() & 7u);
    for (int k = 0; k < 8; ++k) {
        const int x = (x0 + k) & 7;
        for (;;) {
            if (tid == 0) *qw = (int)__hip_atomic_fetch_add(ctr + 64 * x, 1u, __ATOMIC_RELAXED, __HIP_MEMORY_SCOPE_AGENT);
            __syncthreads();
            int j = *qw;
            __syncthreads();
            if (j >= nq) break;
            if (j < 128) { const int s = x + 8 * (j >> 6); attnB_unit(A, lds, l, s >> 3, s & 7, j & 63, false, dry); continue; } j -= 128;
            if (j < 64) { const int u = x * 64 + j; attnA_unit(A, lds, l, u >> 8, (u >> 2) & 63, u & 3, false, dry); continue; } j -= 64;
            if (j < 4) { const int u = x * 4 + j; attnB_unit(A, lds, l, u >> 4, (u >> 1) & 7, u & 1, true, dry); continue; } j -= 4;
            { const int u = x * 2 + j; attnA_unit(A, lds, l, u >> 3, (u >> 2) & 1, u & 3, true, dry); }
        }
    }
}
constexpr int GL_QN = 0, GL_KN = 17408, GL_VK = 34816, GL_MM = 100352, GL_TB = 135168, GPITCH = 272;
#define FNMA(acc, a, b) asm("v_fma_f32 %0, -%1, %2, %0" : "+v"(acc) : "v"(a), "v"(b))
#define FNMS(acc, a, b) asm("v_fma_f32 %0, -%1, %2, %0" : "+v"(acc) : "s"(a), "v"(b))
#define BFV(x) __uint_as_float(((unsigned)(unsigned short)(x)) << 16)
__device__ __forceinline__ void gdn_intra_unit(const Args& A, LAS unsigned char* lds, int l_, int bl, int ch, int h) {
    const int l = opaque_s(l_);
    const int tid = tid_opaque(), lane = tid & 63, r32 = lane & 31, hi = lane >> 5, wave = __builtin_amdgcn_readfirstlane(tid >> 6);
    const bf16_t* P = (const bf16_t*)(A.ws + WS_P); const float* AB = (const float*)(A.ws + WS_AB);
    const int uidx0 = ((bl * NCH + ch) * 8 + h) * 2;
    const size_t R0 = (size_t)bl * RB + ch * 64;
    LAS float* VK = (LAS float*)(lds + GL_VK);
    if (wave < 2) {
        const int d = wave; LAS float* TB = (LAS float*)(lds + GL_TB + d * 1024); LAS float* MMd = (LAS float*)(lds + GL_MM + d * 17408);
        const size_t row = R0 + (d ? 63 - lane : lane);
        float g = AB[row * 32 + d * 8 + h]; const float be = AB[row * 32 + 16 + d * 8 + h];
#pragma unroll
        for (int o = 1; o < 64; o <<= 1) { const float t = __shfl_up(g, o); if (lane >= o) g += t; }
        const float glast = __shfl(g, 63); const float eg = __expf(g);
        TB[lane] = g; TB[64 + lane] = be; TB[128 + lane] = eg; TB[192 + lane] = __expf(glast - g);
        MMd[lane * 68 + 64] = be; MMd[lane * 68 + 65] = be * eg;
        if (lane == 0) ((float*)(A.ws + WS_GL))[uidx0 + d] = __expf(glast);
    }
    {
        const int c = tid >> 3, sub = tid & 7;
        const int tp = ch * 64 + c;
        const bool has_prev = !(tp == 0 || tp == CTXL), has_next = !(tp == CTXL - 1 || tp == RB - 1);
        const bf16_t* xr = P + (R0 + c) * LDP + C_QKV + h * 128 + sub * 16;
        const float* cw = A.in[I_DNCONV] + (size_t)l * 3 * 3072 + h * 128 + sub * 16;
#pragma unroll
        for (int mat = 0; mat < 3; ++mat) {
            const bf16_t* xm = xr + mat * 1024; const float* wm = cw + mat * 1024;
            float y[16];
            const u32x4 z4 = (u32x4){0u, 0u, 0u, 0u};
#pragma unroll
            for (int hf = 0; hf < 2; ++hf) {
                const u32x4 xc = *(const u32x4*)(xm + hf * 8);
                const u32x4 xp = has_prev ? *(const u32x4*)(xm - LDP + hf * 8) : z4;
                const u32x4 xn = has_next ? *(const u32x4*)(xm + LDP + hf * 8) : z4;
#pragma unroll
                for (int k = 0; k < 4; ++k) { const int e = hf * 8 + 2 * k;
                    const float v0 = wm[e] * bf_lo(xp[k]) + wm[3072 + e] * bf_lo(xc[k]) + wm[6144 + e] * bf_lo(xn[k]);
                    const float v1 = wm[e + 1] * bf_hi(xp[k]) + wm[3072 + e + 1] * bf_hi(xc[k]) + wm[6144 + e + 1] * bf_hi(xn[k]);
                    y[e] = silu_f(v0); y[e + 1] = silu_f(v1); }
            }
            if (mat < 2) {
                float ss = 0.f;
#pragma unroll
                for (int e = 0; e < 16; ++e) ss += y[e] * y[e];
                ss += __shfl_xor(ss, 1); ss += __shfl_xor(ss, 2); ss += __shfl_xor(ss, 4);
                const float rn = (1.0f / sqrtf(ss + 1e-6f)) * (mat == 0 ? 0.08838834764831845f : 1.0f);
#pragma unroll
                for (int e = 0; e < 16; ++e) y[e] *= rn;
                LAS unsigned char* dst = lds + (mat == 0 ? GL_QN : GL_KN) + c * GPITCH + sub * 32;
                u32x4 w0, w1; w0.x = cvt_pk_bf16(y[0], y[1]); w0.y = cvt_pk_bf16(y[2], y[3]); w0.z = cvt_pk_bf16(y[4], y[5]); w0.w = cvt_pk_bf16(y[6], y[7]);
                w1.x = cvt_pk_bf16(y[8], y[9]); w1.y = cvt_pk_bf16(y[10], y[11]); w1.z = cvt_pk_bf16(y[12], y[13]); w1.w = cvt_pk_bf16(y[14], y[15]);
                *(LAS u32x4*)dst = w0; *(LAS u32x4*)(dst + 16) = w1;
            }
            if (mat >= 1) { LAS float* vk = VK + c * 256 + (mat == 1 ? 128 : 0) + sub * 16;
#pragma unroll
                for (int e = 0; e < 16; e += 4) *(LAS f32x4*)(vk + e) = (f32x4){y[e], y[e + 1], y[e + 2], y[e + 3]}; }
        }
    }
    __syncthreads();
#pragma unroll 1
    for (int d = 0; d < 2; ++d) {
        const int mat = wave >> 2, rbk = (wave >> 1) & 1, cbk = wave & 1;
        LAS const float* GC = (LAS const float*)(lds + GL_TB + d * 1024); LAS const float* BETA = GC + 64; LAS float* MM = (LAS float*)(lds + GL_MM + d * 17408);
        const int ra = 32 * rbk + r32, rb_ = 32 * cbk + r32;
        LAS const unsigned char* Ab = lds + GL_KN + (d ? 63 - ra : ra) * GPITCH + hi * 16;
        LAS const unsigned char* Bb = lds + (mat == 0 ? GL_KN : GL_QN) + (d ? 63 - rb_ : rb_) * GPITCH + hi * 16;
        f32x16 acc;
#pragma unroll
        for (int r = 0; r < 16; ++r) acc[r] = 0.f;
#pragma unroll
        for (int d0 = 0; d0 < 8; ++d0) { const bf16x8 a = *(LAS const bf16x8*)(Ab + d0 * 32), b = *(LAS const bf16x8*)(Bb + d0 * 32); acc = MFMA32(a, b, acc); }
        const int cc = 32 * cbk + r32; const float gcc = GC[cc];
        if (mat == 0) {
#pragma unroll
            for (int r = 0; r < 16; ++r) { const int i = 32 * rbk + crow(r, hi); const float v = (i > cc) ? BETA[i] * acc[r] * __expf(GC[i] - gcc) : 0.f; MM[i * 68 + cc] = v; }
        } else {
            float v[16];
#pragma unroll
            for (int r = 0; r < 16; ++r) { const int j = 32 * rbk + crow(r, hi); v[r] = (cc >= j) ? acc[r] * __expf(gcc - GC[j]) : 0.f; }
            bf16x8* at = (bf16x8*)(A.ws + WS_G + (size_t)(uidx0 + d) * GU_BYTES + GU_AT);
            at[(cbk * 4 + 2 * rbk + 0) * 64 + lane] = pack8(v[0], v[1], v[2], v[3], v[4], v[5], v[6], v[7]);
            at[(cbk * 4 + 2 * rbk + 1) * 64 + lane] = pack8(v[8], v[9], v[10], v[11], v[12], v[13], v[14], v[15]);
        }
    }
    {
        const int d = wave >> 2, w4 = wave & 3;
        LAS const float* EG = (LAS const float*)(lds + GL_TB + d * 1024 + 512); LAS const float* DKS = EG + 64;
        unsigned char* rec = A.ws + WS_G + (size_t)(uidx0 + d) * GU_BYTES;
        if (w4 < 2) {
#pragma unroll
            for (int ff = 0; ff < 8; ++ff) { const int f = w4 * 8 + ff, ib = f >> 3, rb = (f >> 1) & 3, s = f & 1; const int i = 32 * ib + r32, dk0 = 32 * rb + 16 * s + 4 * hi; const int row = d ? 63 - i : i;
                const u32x2 a = *(LAS const u32x2*)(lds + GL_QN + row * GPITCH + dk0 * 2), b = *(LAS const u32x2*)(lds + GL_QN + row * GPITCH + (dk0 + 8) * 2); const float e = EG[i];
                ((bf16x8*)(rec + GU_QG))[f * 64 + lane] = pack8(bf_lo(a.x) * e, bf_hi(a.x) * e, bf_lo(a.y) * e, bf_hi(a.y) * e, bf_lo(b.x) * e, bf_hi(b.x) * e, bf_lo(b.y) * e, bf_hi(b.y) * e); }
        } else {
#pragma unroll
            for (int ff = 0; ff < 8; ++ff) { const int f = (w4 - 2) * 8 + ff, rb = f >> 2, ib = (f >> 1) & 1, s = f & 1; const int i0 = 32 * ib + 16 * s + 4 * hi; const int ia = i0 + ((lane & 15) >> 2);
                LAS const unsigned char* kp = lds + GL_KN + (d ? 63 - ia : ia) * GPITCH + (32 * rb + 16 * ((lane >> 4) & 1) + 4 * (lane & 3)) * 2;
                const s16x4 lo = lds_tr(kp), hh = lds_tr(d ? kp - 8 * GPITCH : kp + 8 * GPITCH);
                const f32x4 s0 = *(LAS const f32x4*)(DKS + i0), s1 = *(LAS const f32x4*)(DKS + i0 + 8);
                ((bf16x8*)(rec + GU_KD))[f * 64 + lane] = pack8(BFV(lo[0]) * s0[0], BFV(lo[1]) * s0[1], BFV(lo[2]) * s0[2], BFV(lo[3]) * s0[3], BFV(hh[0]) * s1[0], BFV(hh[1]) * s1[1], BFV(hh[2]) * s1[2], BFV(hh[3]) * s1[3]);
            }
        }
    }
    __syncthreads();
    float x[64];
    const int dD = opaque_s(wave >> 2), col = tid & 255;
    {
        LAS const float* MMv = (LAS const float*)(lds + GL_MM + dD * 17408) + lane; asm volatile("" : "+v"(MMv));
        LAS const float* RHv = VK + col + (dD ? 63 * 256 : 0); asm volatile("" : "+v"(RHv));
        const int colhalf = (col >> 7), strd = dD ? -256 : 256;
#pragma unroll
        for (int i = 0; i < 64; ++i) {
            const int rowv = __float_as_int(MMv[i * 68]);
            const f32x2 sc2 = *(LAS const f32x2*)(MMv - lane + i * 68 + 64);
            float a = RHv[i * strd] * (colhalf ? sc2.y : sc2.x), a1 = 0.f, a2 = 0.f, a3 = 0.f;
#pragma unroll
            for (int m = 0; m < i; ++m) { const float s = __int_as_float(__builtin_amdgcn_readlane(rowv, m));
                if ((m & 3) == 0) FNMS(a, s, x[m]); else if ((m & 3) == 1) FNMS(a1, s, x[m]); else if ((m & 3) == 2) FNMS(a2, s, x[m]); else FNMS(a3, s, x[m]); }
            x[i] = (a + a1) + (a2 + a3); asm volatile("" ::: "memory");
        }
    }
    __syncthreads();
    {
        unsigned char* rec = A.ws + WS_G + (size_t)(uidx0 + dD) * GU_BYTES;
        if (col < 128) {
            unsigned* up = (unsigned*)(rec + GU_U); const int sl = col >> 5, dvl = col & 31;
#pragma unroll
            for (int ib = 0; ib < 2; ++ib)
#pragma unroll
                for (int p = 0; p < 8; ++p)
#pragma unroll
                    for (int hh = 0; hh < 2; ++hh) { const int i = 32 * ib + (2 * p & 3) + 8 * (2 * p >> 2) + 4 * hh; up[((ib * 4 + sl) * 8 + p) * 64 + hh * 32 + dvl] = cvt_pk_bf16(x[i], x[i + 1]); }
        } else {
            LAS bf16_t* wl = (LAS bf16_t*)(lds + (dD ? GL_KN : GL_QN));
#pragma unroll
            for (int i = 0; i < 64; ++i) wl[i * (GPITCH / 2) + (col - 128)] = (bf16_t)(cvt_pk_bf16(x[i], 0.f) & 0xffffu);
        }
    }
    __syncthreads();
    {
        unsigned char* rec = A.ws + WS_G + (size_t)(uidx0 + dD) * GU_BYTES; const int wl0 = dD ? GL_KN : GL_QN;
#pragma unroll
        for (int ff = 0; ff < 4; ++ff) { const int f = (wave & 3) * 4 + ff, ib = f >> 3, rb = (f >> 1) & 3, s = f & 1; const int i = 32 * ib + r32, dk0 = 32 * rb + 16 * s + 4 * hi;
            const u32x2 a = *(LAS const u32x2*)(lds + wl0 + i * GPITCH + dk0 * 2), b = *(LAS const u32x2*)(lds + wl0 + i * GPITCH + (dk0 + 8) * 2);
            ((u32x4*)(rec + GU_W))[f * 64 + lane] = (u32x4){a.x, a.y, b.x, b.y}; }
    }
    __syncthreads();
}
#undef FNMA
#undef FNMS
#undef BFV
__device__ __forceinline__ void ph_gdn_intra(const Args& A, LAS unsigned char* lds, int l) {
    for (int u = blockIdx.x; u < HB * NCH * 8; u += gridDim.x) { const int h = u & 7, t = u >> 3, ch = t % NCH, bl = t / NCH; gdn_intra_unit(A, lds, l, bl, ch, h); }
}
constexpr int SC_SLOT = 57344, SC_OST = 2 * SC_SLOT;
__device__ __forceinline__ void gdn_scan_unit(const Args& A, LAS unsigned char* lds, int bl, int h, int d) {
    const int tid = tid_opaque(), lane = tid & 63, r32 = lane & 31, hi = lane >> 5, wave = __builtin_amdgcn_readfirstlane(tid >> 6);
#define SC_CH(step) (d ? ((step) < 4 ? 3 - (step) : NCH + 3 - (step)) : (step))
#define SC_UIDX(step) (((bl * NCH + SC_CH(step)) * 8 + h) * 2 + d)
    if (wave >= 4) {
        const int lw = wave - 4;
#define SC_ISSUE(step, slot) do { const unsigned char* rec_ = A.ws + WS_G + (size_t)SC_UIDX(step) * GU_BYTES + lane * 16; \
        _Pragma("unroll") for (int k_ = 0; k_ < 14; ++k_) __builtin_amdgcn_global_load_lds((const unsigned*)(rec_ + (lw * 14 + k_) * 1024), (LAS unsigned*)(lds + (slot) * SC_SLOT + (lw * 14 + k_) * 1024), 16, 0, 0); } while (0)
        SC_ISSUE(0, 0);
        asm volatile("s_waitcnt vmcnt(0)" ::: "memory"); __builtin_amdgcn_s_barrier();
        for (int step = 0; step < NCH; ++step) {
            if (step + 1 < NCH) SC_ISSUE(step + 1, (step + 1) & 1);
            asm volatile("s_waitcnt vmcnt(0)" ::: "memory"); __builtin_amdgcn_s_barrier();
        }
#undef SC_ISSUE
        return;
    }
    const int sl = wave;
    bf16_t* O = (bf16_t*)(A.ws + WS_H) + (size_t)d * HR * 1024;
    const float* GLv = (const float*)(A.ws + WS_GL);
    LAS unsigned char* ost = lds + SC_OST + sl * 4096;
    f32x16 S[4];
#pragma unroll
    for (int rb = 0; rb < 4; ++rb)
#pragma unroll
        for (int r = 0; r < 16; ++r) S[rb][r] = 0.f;
    unsigned un[16]; float gln;
    { const unsigned* Up = (const unsigned*)(A.ws + WS_G + (size_t)SC_UIDX(0) * GU_BYTES + GU_U) + lane;
#pragma unroll
      for (int q = 0; q < 16; ++q) un[q] = Up[(((q >> 3) * 4 + sl) * 8 + (q & 7)) * 64];
      gln = GLv[SC_UIDX(0)]; }
    __builtin_amdgcn_s_barrier();
    for (int step = 0; step < NCH; ++step) {
        const int ch = SC_CH(step);
        LAS const unsigned char* slot = lds + (step & 1) * SC_SLOT + lane * 16;
        unsigned uc[16]; const float gl = gln;
#pragma unroll
        for (int q = 0; q < 16; ++q) uc[q] = un[q];
        if (step + 1 < NCH) { const unsigned* Up = (const unsigned*)(A.ws + WS_G + (size_t)SC_UIDX(step + 1) * GU_BYTES + GU_U) + lane;
#pragma unroll
            for (int q = 0; q < 16; ++q) un[q] = Up[(((q >> 3) * 4 + sl) * 8 + (q & 7)) * 64];
            gln = GLv[SC_UIDX(step + 1)]; }
        f32x16 vn[2], o[2];
#pragma unroll
        for (int ib = 0; ib < 2; ++ib)
#pragma unroll
            for (int r = 0; r < 16; ++r) { vn[ib][r] = 0.f; o[ib][r] = 0.f; }
#pragma unroll
        for (int rb = 0; rb < 4; ++rb)
#pragma unroll
            for (int s = 0; s < 2; ++s) {
                const bf16x8 sb = pack8(S[rb][8 * s], S[rb][8 * s + 1], S[rb][8 * s + 2], S[rb][8 * s + 3], S[rb][8 * s + 4], S[rb][8 * s + 5], S[rb][8 * s + 6], S[rb][8 * s + 7]);
#pragma unroll
                for (int ib = 0; ib < 2; ++ib) { const int f = (ib * 4 + rb) * 2 + s;
                    vn[ib] = MFMA32(*(LAS const bf16x8*)(slot + GU_W + f * 1024), sb, vn[ib]); o[ib] = MFMA32(*(LAS const bf16x8*)(slot + GU_QG + f * 1024), sb, o[ib]); }
            }
#pragma unroll
        for (int ib = 0; ib < 2; ++ib)
#pragma unroll
            for (int p = 0; p < 8; ++p) { const unsigned w = uc[ib * 8 + p]; vn[ib][2 * p] = bf_lo(w) - vn[ib][2 * p]; vn[ib][2 * p + 1] = bf_hi(w) - vn[ib][2 * p + 1]; }
        bf16x8 vb[2][2];
#pragma unroll
        for (int ib = 0; ib < 2; ++ib) { vb[ib][0] = pack8(vn[ib][0], vn[ib][1], vn[ib][2], vn[ib][3], vn[ib][4], vn[ib][5], vn[ib][6], vn[ib][7]);
            vb[ib][1] = pack8(vn[ib][8], vn[ib][9], vn[ib][10], vn[ib][11], vn[ib][12], vn[ib][13], vn[ib][14], vn[ib][15]); }
#pragma unroll
        for (int ib = 0; ib < 2; ++ib)
#pragma unroll
            for (int jb = 0; jb < 2; ++jb)
#pragma unroll
                for (int s = 0; s < 2; ++s) o[ib] = MFMA32(*(LAS const bf16x8*)(slot + GU_AT + (ib * 4 + 2 * jb + s) * 1024), vb[jb][s], o[ib]);
#pragma unroll
        for (int rb = 0; rb < 4; ++rb) { S[rb] = S[rb] * gl;
#pragma unroll
            for (int ib = 0; ib < 2; ++ib)
#pragma unroll
                for (int s = 0; s < 2; ++s) S[rb] = MFMA32(*(LAS const bf16x8*)(slot + GU_KD + ((rb * 2 + ib) * 2 + s) * 1024), vb[ib][s], S[rb]); }
#pragma unroll
        for (int ib = 0; ib < 2; ++ib)
#pragma unroll
            for (int r = 0; r < 16; ++r) { const int i = 32 * ib + crow(r, hi); const int c = d ? 63 - i : i; *(LAS bf16_t*)(ost + c * 64 + r32 * 2) = (bf16_t)(cvt_pk_bf16(o[ib][r], 0.f) & 0xffffu); }
        asm volatile("s_waitcnt lgkmcnt(0)" ::: "memory");
        bf16_t* obase = O + ((size_t)bl * RB + ch * 64) * 1024 + h * 128 + 32 * sl;
#pragma unroll
        for (int k = 0; k < 4; ++k) { const int id = k * 64 + lane; const u32x4 v = *(LAS const u32x4*)(ost + id * 16); *(u32x4*)(obase + (size_t)(id >> 2) * 1024 + (id & 3) * 8) = v; }
        asm volatile("s_waitcnt lgkmcnt(0)" ::: "memory"); __builtin_amdgcn_s_barrier();
    }
#undef SC_CH
#undef SC_UIDX
}
__device__ __forceinline__ void ph_gdn_post(const Args& A, int l_, bool dry) {
    const int l = opaque_s(l_);
    const int tid = tid_opaque(), lane = tid & 63, gw = blockIdx.x * NWAVES + (tid >> 6), NGW = gridDim.x * NWAVES;
    const bf16_t* OF = (const bf16_t*)(A.ws + WS_H); const bf16_t* OB = OF + (size_t)HR * 1024; bf16_t* P = (bf16_t*)(A.ws + WS_P);
    const float* nw = A.in[I_DNNORM] + l * 128 + (lane & 7) * 16;
    for (int r0 = 2 * gw; r0 < HR; r0 += 2 * NGW) {
        u32x4 f0[2], f1[2], b0[2], b1[2], z0[2], z1[2];
#pragma unroll
        for (int k = 0; k < 2; ++k) { const size_t r = (size_t)(r0 + k);
            f0[k] = *(const u32x4*)(OF + r * 1024 + lane * 16); f1[k] = *(const u32x4*)(OF + r * 1024 + lane * 16 + 8);
            b0[k] = *(const u32x4*)(OB + r * 1024 + lane * 16); b1[k] = *(const u32x4*)(OB + r * 1024 + lane * 16 + 8);
            const bf16_t* zq = P + r * LDP + C_Z + lane * 16; z0[k] = *(const u32x4*)zq; z1[k] = *(const u32x4*)(zq + 8); }
#pragma unroll
        for (int k = 0; k < 2; ++k) { const size_t r = (size_t)(r0 + k);
            bf16_t* zp = P + r * LDP + C_Z + lane * 16;
            float o[16], z[16]; float ss = 0.f;
#pragma unroll
            for (int q = 0; q < 4; ++q) { o[2 * q] = bf_lo(f0[k][q]) + bf_lo(b0[k][q]); o[2 * q + 1] = bf_hi(f0[k][q]) + bf_hi(b0[k][q]); o[8 + 2 * q] = bf_lo(f1[k][q]) + bf_lo(b1[k][q]); o[8 + 2 * q + 1] = bf_hi(f1[k][q]) + bf_hi(b1[k][q]);
                z[2 * q] = bf_lo(z0[k][q]); z[2 * q + 1] = bf_hi(z0[k][q]); z[8 + 2 * q] = bf_lo(z1[k][q]); z[8 + 2 * q + 1] = bf_hi(z1[k][q]); }
#pragma unroll
            for (int e = 0; e < 16; ++e) ss += o[e] * o[e];
            ss += __shfl_xor(ss, 1); ss += __shfl_xor(ss, 2); ss += __shfl_xor(ss, 4);
            const float rn = 1.0f / sqrtf(ss * (1.0f / 128.0f) + 1e-6f);
#pragma unroll
            for (int e = 0; e < 16; ++e) o[e] = o[e] * rn * nw[e] * silu_f(z[e]);
            u32x4 w0, w1; w0.x = cvt_pk_bf16(o[0], o[1]); w0.y = cvt_pk_bf16(o[2], o[3]); w0.z = cvt_pk_bf16(o[4], o[5]); w0.w = cvt_pk_bf16(o[6], o[7]);
            w1.x = cvt_pk_bf16(o[8], o[9]); w1.y = cvt_pk_bf16(o[10], o[11]); w1.z = cvt_pk_bf16(o[12], o[13]); w1.w = cvt_pk_bf16(o[14], o[15]);
            bf16_t* zo = dry ? (bf16_t*)(A.ws + WS_TRASH) + tid * 16 : zp;
            *(u32x4*)zo = w0; *(u32x4*)(zo + 8) = w1;
        }
    }
}
constexpr int NPH = 1 + 14 * 4;
__host__ __device__ inline bool phase_is_noop(int id) { if (id == 0) return false; const int it = (id - 1) / 14, k = (id - 1) % 14; return (k == 0 && it != 2) || k == 6; }
__global__ void __launch_bounds__(NTHR, 2) fwd(Args A0) {
    extern __shared__ __attribute__((aligned(16))) unsigned char lds_raw[];
    LAS unsigned char* lds = (LAS unsigned char*)lds_raw;
    volatile LAS unsigned* MISC = (volatile LAS unsigned*)(lds + LDSCTL_OFF + 320);
    for (int u = threadIdx.x; u < (LDS_BYTES - LDSCTL_OFF) / 4; u += NTHR) ((LAS unsigned*)(lds + LDSCTL_OFF))[u] = 0u;
    __syncthreads();
    const int lo = A0.ph_lo, hi = A0.ph_hi, G = gridDim.x, bid = blockIdx.x;
    unsigned char* ws0 = A0.ws;
    XcdBarrier bar; bar.bar = (unsigned*)(ws0 + WS_CTL) + CW_BAR; bar.x = 0; bar.st = nullptr;
    if (hi - lo > 1) bar = xcd_barrier_post((unsigned*)(ws0 + WS_CTL) + CW_BAR, MISC + 8);
#ifndef PHMASK
#define PHMASK 0x7fff
#endif
#ifndef DUP_MASK
#define DUP_MASK 0
#endif
#define EXTRA_BAR 0
#define GA_ true
#define GS_ true
#define RUNK(k, id, ...) do { if (((PHMASK >> (k)) & 1) && lo <= (id) && (id) < hi) { \
    KA_T ap_ = (KA_T)__builtin_amdgcn_kernarg_segment_ptr(); asm volatile("" : "+s"(ap_)); const Args& A = *(const Args*)ap_; unsigned char* ws = A.ws; \
    bf16_t* H = (bf16_t*)(ws + WS_H); bf16_t* P = (bf16_t*)(ws + WS_P); (void)H; (void)P; \
    if ((DUP_MASK >> (k)) & 1) { dry = true; __VA_ARGS__; xcd_barrier(bar); dry = false; } \
    __VA_ARGS__; if ((id) + 1 < hi) { xcd_barrier(bar); if (EXTRA_BAR) { xcd_barrier(bar); xcd_barrier(bar); } } } } while (0)
    typedef const __attribute__((address_space(4))) Args* KA_T;
    bool dry = false;
    RUNK(14, 0, { ph_prologue(A, lds); __syncthreads(); ph_weights(A, lds, 0); });
    for (int it = 0; it < 4; ++it) {
        const int l = it >> 1, half = it & 1, base = 1 + 14 * it;
        if (it == 2) RUNK(0, base + 0, { ph_weights(A, lds, 1); });
        RUNK(1, base + 1, { ph_adaln(A, l, half); });
        RUNK(2, base + 2, {
            pg8::Gemm g{H, (const bf16_t*)(ws + WS_WIN), HR, NWIN, 2048, 2048};
            pg8::EpiInProj E{P, LDP, (float*)(ws + WS_AB), (const float*)(ws + WS_ROPEA), (const float*)(ws + WS_ROPED), A.in[I_ALOG] + l * 16, A.in[I_DTB] + l * 16, 0.08838834764831845f * LOG2E, 0.125f * LOG2E, dry};
            if (l == 0) { pg8::StaticOrder S; S.init(HR, NWIN, G, bid); pg8::gemm_phase<pg8::EpiInProj, pg8::StaticOrder, GA_, GS_>(lds, g, S, E); }
            else { pg8::InProjLastOrder S; S.init(NWIN, G, bid); pg8::gemm_phase<pg8::EpiInProj, pg8::InProjLastOrder, GA_, GS_>(lds, g, S, E); } });
        RUNK(3, base + 3, { ph_gdn_intra(A, lds, l); });
        RUNK(4, base + 4, { if (bid < HB * 8 * 2 && !(dry && ATT_EXP >= 5)) gdn_scan_unit(A, lds, bid >> 4, (bid >> 1) & 7, bid & 1); if (!(dry && ATT_EXP == 4)) ph_attention(A, lds, l, half, it, dry); });
        RUNK(5, base + 5, { ph_gdn_post(A, l, dry); });
        RUNK(7, base + 7, {
            bf16_t* T1 = (bf16_t*)(ws + WS_TOT); bf16_t* T2 = T1 + (size_t)HR * 2048; bf16_t* Mo = (bf16_t*)(ws + WS_M);
            pg8::Gemm ga{P + C_QA, (const bf16_t*)(ws + WS_WPA), HR, 2048, 1024, LDP}; pg8::EpiMerge<0> Ea{P + C_G, LDP, T1, T2, Mo, 2048};
            pg8::Gemm gb{P + C_QD, (const bf16_t*)(ws + WS_WPB), HR, 2048, 1024, LDP}; pg8::EpiMerge<1> Eb{P + C_G + 2048, LDP, T1, T2, Mo, 2048};
            pg8::Gemm gc{P + C_Z, (const bf16_t*)(ws + WS_WPC), HR, 2048, 1024, LDP}; pg8::EpiMerge<2> Ec{P + C_G + 4096, LDP, T1, T2, Mo, 2048};
            if (l == 0) { pg8::StaticOrder S; S.init(HR, 2048, G, bid);
                pg8::gemm_phase<pg8::EpiMerge<0>, pg8::StaticOrder, GA_, GS_>(lds, ga, S, Ea); pg8::gemm_phase<pg8::EpiMerge<1>, pg8::StaticOrder, GA_, GS_>(lds, gb, S, Eb); pg8::gemm_phase<pg8::EpiMerge<2>, pg8::StaticOrder, GA_, GS_>(lds, gc, S, Ec); }
            else { pg8::LatentOrder S; S.init(2048, G, bid);
                pg8::gemm_phase<pg8::EpiMerge<0>, pg8::LatentOrder, GA_, GS_>(lds, ga, S, Ea); pg8::gemm_phase<pg8::EpiMerge<1>, pg8::LatentOrder, GA_, GS_>(lds, gb, S, Eb); pg8::gemm_phase<pg8::EpiMerge<2>, pg8::LatentOrder, GA_, GS_>(lds, gc, S, Ec); } });
        RUNK(8, base + 8, {
            pg8::Gemm g{(const bf16_t*)(ws + WS_M), (const bf16_t*)(ws + WS_WO), HR, 2048, 2048, 2048}; pg8::EpiBf16 E{(bf16_t*)(ws + WS_OX), 2048};
            if (l == 0) { pg8::StaticOrder S; S.init(HR, 2048, G, bid); pg8::gemm_phase<pg8::EpiBf16, pg8::StaticOrder, GA_, GS_>(lds, g, S, E); }
            else { pg8::LatentOrder S; S.init(2048, G, bid); pg8::gemm_phase<pg8::EpiBf16, pg8::LatentOrder, GA_, GS_>(lds, g, S, E); } });
        RUNK(9, base + 9, { ph_resln<true>(A, l, half, (const bf16_t*)(ws + WS_OX), 2, A.in[I_LN1G] + l * DM, A.in[I_LN1B] + l * DM, dry); });
        RUNK(10, base + 10, {
            pg8::Gemm g{H, (const bf16_t*)(ws + WS_WUP), HR, NUP, 2048, 2048}; pg8::EpiBf16 E{(bf16_t*)(ws + WS_U), NUP};
            if (l == 0) { pg8::StaticOrder S; S.init(HR, NUP, G, bid); pg8::gemm_phase<pg8::EpiBf16, pg8::StaticOrder, GA_, GS_>(lds, g, S, E); }
            else { pg8::LatentOrder S; S.init(NUP, G, bid); pg8::gemm_phase<pg8::EpiBf16, pg8::LatentOrder, GA_, GS_>(lds, g, S, E); } });
        RUNK(11, base + 11, { ph_convact(A, l); });
        RUNK(12, base + 12, {
            pg8::Gemm g{(const bf16_t*)(ws + WS_ACT), (const bf16_t*)(ws + WS_WDN), HR, 2048, DFF, DFF}; pg8::EpiBf16 E{(bf16_t*)(ws + WS_FX), 2048};
            if (l == 0) { pg8::StaticOrder S; S.init(HR, 2048, G, bid); pg8::gemm_phase<pg8::EpiBf16, pg8::StaticOrder, GA_, GS_>(lds, g, S, E); }
            else { pg8::LatentOrder S; S.init(2048, G, bid); pg8::gemm_phase<pg8::EpiBf16, pg8::LatentOrder, GA_, GS_>(lds, g, S, E); } });
        RUNK(13, base + 13, { ph_resln<false>(A, l, half, (const bf16_t*)(ws + WS_FX), 5, A.in[I_LN2G] + l * DM, A.in[I_LN2B] + l * DM, dry); });
    }
#undef RUNK
}

#ifndef MK_ONE_LAUNCH
#define MK_ONE_LAUNCH 1
#endif
extern "C" void kernel_launch(void* const* d_in, const int* in_sizes, int n_in, void* d_out, int out_size, void* d_ws, size_t ws_size, hipStream_t stream) {
    static int grid = 0;
    if (grid == 0) {
        if (n_in != 29 || out_size != NBATCH * SEQ * DM || ws_size < WS_END) { fprintf(stderr, "kernel_launch: unexpected problem (n_in %d, out %d, ws %zu < %zu)\n", n_in, out_size, ws_size, (size_t)WS_END); grid = -1; return; }
        int dev = 0, cus = 0, per_cu = 0;
        if (hipGetDevice(&dev) != hipSuccess || hipDeviceGetAttribute(&cus, hipDeviceAttributeMultiprocessorCount, dev) != hipSuccess) { grid = -1; return; }
        if (hipFuncSetAttribute((const void*)fwd, hipFuncAttributeMaxDynamicSharedMemorySize, LDS_BYTES) != hipSuccess) { fprintf(stderr, "kernel_launch: hipFuncSetAttribute failed\n"); grid = -1; return; }
        if (hipOccupancyMaxActiveBlocksPerMultiprocessor(&per_cu, (const void*)fwd, NTHR, LDS_BYTES) != hipSuccess || per_cu < 1) fprintf(stderr, "kernel_launch: occupancy query reports %d\n", per_cu);
        (void)hipGetLastError();
        grid = cus > 256 ? 256 : cus;
    }
    if (grid < 0) return;
    (void)hipMemsetAsync((char*)d_ws + WS_CTL, 0, CTL_ZERO_BYTES, stream);
    Args a{};
    for (int i = 0; i < 29; ++i) a.in[i] = (const float*)d_in[i];
    a.out = (float*)d_out; a.ws = (unsigned char*)d_ws;
#if MK_ONE_LAUNCH
    a.ph_lo = 0; a.ph_hi = NPH;
    hipLaunchKernelGGL(fwd, dim3(grid), dim3(NTHR), LDS_BYTES, stream, a);
#else
    for (int id = 0; id < NPH; ++id) { if (phase_is_noop(id)) continue; a.ph_lo = id; a.ph_hi = id + 1; hipLaunchKernelGGL(fwd, dim3(grid), dim3(NTHR), LDS_BYTES, stream, a); }
#endif
}
```

```cpp
#include <hip/hip_runtime.h>
#include <cstdio>
#include <cstdint>
#include <cmath>
namespace pg8 {
#define PG8_LAS __attribute__((address_space(3)))
typedef unsigned short bf16_t;
typedef short bf16x8 __attribute__((ext_vector_type(8)));
typedef float f32x4 __attribute__((ext_vector_type(4)));
typedef unsigned u32x4 __attribute__((ext_vector_type(4)));
constexpr int BM = 256, BK = 64, HALF = 128, HTB = HALF * BK * 2  , STAGE_BYTES = 8 * HTB, NXCD = 8, WGM = 4;

__host__ __device__ __forceinline__ int lds_byte(int r, int c) { const int st = (r >> 4) * 2 + (c >> 5), rr = r & 15, cc = c & 31, ob = rr * 64 + cc * 2; return st * 1024 + (ob ^ (((ob >> 9) & 1) << 5)); }
__host__ __device__ __forceinline__ void stage_rc(int b, int& R, int& C) { const int st = b / 1024, sb = b % 1024, swz = sb ^ (((sb >> 9) & 1) << 5); R = (st >> 1) * 16 + swz / 64; C = (st & 1) * 32 + (swz % 64) / 2; }
__host__ __device__ __forceinline__ int perm32(int rho) { const int n = rho >> 4, i = rho & 15; return 8 * (i >> 2) + 4 * n + (i & 3); }

struct Unit { int pm, pn, kofs, bofs, ks, keep; };
struct Gemm { const bf16_t* A; const bf16_t* Bt; int M, N, K, lda, ldb; };

struct StaticOrder {
    int nM, nN, nwg, G, c;
    __host__ __device__ void init(int M, int N, int G_, int c_) { nM = M / BM; nN = N / BM; nwg = nM * nN; G = G_; c = c_; }
    __host__ __device__ bool next(int i, Unit& u) const {
        const long L = (long)i * G + c; if (L >= nwg) return false;
        int wgid = (int)L; { const int q = nwg / NXCD, r = nwg % NXCD, xcd = wgid % NXCD, off = wgid / NXCD; wgid = (xcd < r ? xcd * (q + 1) : r * (q + 1) + (xcd - r) * q) + off; }
        const int nig = WGM * nN, gid = wgid / nig, fm = gid * WGM, gsz = (nM - fm) < WGM ? (nM - fm) : WGM;
        u.pm = fm + ((wgid % nig) % gsz); u.pn = (wgid % nig) / gsz; u.kofs = 0; u.bofs = 0; u.ks = 0; u.keep = 0; return true;
    }
    __device__ __forceinline__ void a_ready(const Unit&) const {}
    __device__ __forceinline__ void done(const Unit&) const {}
};
struct InProjLastOrder : StaticOrder {
    __host__ __device__ void init(int N, int G_, int c_) { StaticOrder::init(64 * BM, N, G_, c_); }
    __host__ __device__ bool next(int i, Unit& u) const {
        const long L = (long)i * G + c;
        if (L < nwg) { StaticOrder::next(i, u); u.pm += 1 + (u.pm >= 32 ? 1 : 0); return true; }
        const int e = (int)(L - nwg); if (e >= 46) return false;
        const int k = e % 23; u.pm = (e >= 23) ? 33 : 0; u.pn = (k < 2) ? 4 + k : (k < 22) ? 8 + k : 58; u.kofs = 0; u.bofs = 0; u.ks = 0; u.keep = 0; return true;
    }
};
#define DEFER_TAIL 12
struct InProjFirstOrder : StaticOrder {
    __host__ __device__ void init(int G_, int c_) { StaticOrder::init(66 * BM, 58 * BM, G_, c_); }
    __host__ __device__ bool next(int i, Unit& u) const {
        const long L = (long)i * G + c;
        if (L < nwg) { StaticOrder::next(i, u); if (u.pn >= 57) u.pn = 58; return true; }
        const int e = (int)(L - nwg); if (e >= DEFER_TAIL) return false;
        u.pm = 66 - DEFER_TAIL + e; u.pn = 57; u.kofs = 0; u.bofs = 0; u.ks = 0; u.keep = 0; return true;
    }
};
struct InProjDeferOrder {
    int G, c;
    __host__ __device__ void init(int G_, int bid) { G = G_; c = (G_ > 48) ? (bid >= 48 ? bid - 48 : bid + G_ - 48) : bid; }
    __device__ bool next(int i, Unit& u) const { const long L = (long)i * G + c; if (L >= 66 - DEFER_TAIL) return false; int pn_ = 57; asm volatile("" : "+s"(pn_)); u.pm = (int)L; u.pn = pn_; u.kofs = 0; u.bofs = 0; u.ks = 0; u.keep = 0; return true; }
    __device__ __forceinline__ void a_ready(const Unit&) const {}
    __device__ __forceinline__ void done(const Unit&) const {}
};
struct CtxSplitOrder {
    int S, ksub, G, c;
    __host__ __device__ void init(int S_, int ksub_, int G_, int c_) { S = S_; ksub = ksub_; G = G_; c = c_; }
    __host__ __device__ bool next(int i, Unit& u) const { const long L = (long)i * G + c; if (L >= 16 * S) return false; const int e = (int)L, ks = e % S, t = e / S; u.pn = t & 7; u.pm = (t >> 3) ? 33 : 0; u.kofs = ks * ksub; u.bofs = u.kofs; u.ks = ks; u.keep = 0; return true; }
    __device__ __forceinline__ void a_ready(const Unit&) const {}
    __device__ __forceinline__ void done(const Unit&) const {}
};
struct CtxBranchOrder {
    int aofs1, aofs2, bstride, G, c;
    __host__ __device__ bool next(int i, Unit& u) const { const long L = (long)i * G + c; if (L >= 48) return false; const int e = (int)L, br = e % 3, t = e / 3; u.pn = t & 7; u.pm = (t >> 3) ? 33 : 0;
        u.kofs = (br == 0) ? 0 : (br == 1) ? aofs1 : aofs2; u.bofs = br * bstride; u.ks = br; u.keep = 0; return true; }
    __device__ __forceinline__ void a_ready(const Unit&) const {}
    __device__ __forceinline__ void done(const Unit&) const {}
};
struct CtxSplit3Order {
    int G, c;
    __host__ __device__ bool next(int i, Unit& u) const { const long L = (long)i * G + c; if (L >= 192) return false; const int e = (int)L, s = e % 12, t = e / 12, br = s >> 2, kq = s & 3; u.pn = t & 7; u.pm = t >> 3;
        u.kofs = br * 512 * 2048 + kq * 512; u.bofs = kq * 512; u.ks = s; u.keep = 0; return true; }
    __device__ __forceinline__ void a_ready(const Unit&) const {}
    __device__ __forceinline__ void done(const Unit&) const {}
};
struct LatentOrder : StaticOrder {
    __host__ __device__ void init(int N, int G_, int c_) { StaticOrder::init(64 * BM, N, G_, c_); }
    __host__ __device__ bool next(int i, Unit& u) const { if (!StaticOrder::next(i, u)) return false; u.pm += 1 + (u.pm >= 32 ? 1 : 0); return true; }
};


__device__ __forceinline__ unsigned cvt_pk_bf16(float lo, float hi) { unsigned r; asm volatile("v_cvt_pk_bf16_f32 %0, %1, %2" : "=v"(r) : "v"(lo), "v"(hi)); return r; }
__device__ __forceinline__ float bf_lo(unsigned w) { return __uint_as_float(w << 16); }
__device__ __forceinline__ float bf_hi(unsigned w) { return __uint_as_float(w & 0xffff0000u); }
__device__ __forceinline__ float sigm(float x) { return __builtin_amdgcn_rcpf(1.0f + __builtin_amdgcn_exp2f(x * -1.4426950408889634f)); }

struct EpiF32 {
    static constexpr bool PERM = false, AFTER_DRAIN = false;
    float* C; int ldc;
    __device__ __forceinline__ void operator()(const f32x4 (&acc)[2][2][4][2], const Unit& u, int wr, int wc, int fr, int fq) const {
        const int row0 = u.pm * BM + wr * 64 + fr, col0 = u.pn * BM + wc * 32 + 4 * fq;
#pragma unroll
        for (int ai = 0; ai < 2; ++ai)
#pragma unroll
            for (int m = 0; m < 4; ++m) { float* rowp = C + (size_t)(row0 + ai * HALF + m * 16) * ldc + col0;
#pragma unroll
                for (int bj = 0; bj < 2; ++bj)
#pragma unroll
                    for (int n = 0; n < 2; ++n) *(f32x4*)(rowp + bj * HALF + n * 16) = acc[ai][bj][m][n]; }
    }
};
struct EpiBf16 {
    static constexpr bool PERM = true, AFTER_DRAIN = false;
    bf16_t* O; int ldc;
    __device__ __forceinline__ void operator()(const f32x4 (&acc)[2][2][4][2], const Unit& u, int wr, int wc, int fr, int fq) const {
        const int row0 = u.pm * BM + wr * 64 + fr, col0 = u.pn * BM + wc * 32 + 8 * fq;
#pragma unroll
        for (int ai = 0; ai < 2; ++ai)
#pragma unroll
            for (int m = 0; m < 4; ++m) { bf16_t* rowp = O + (size_t)(row0 + ai * HALF + m * 16) * ldc + col0;
#pragma unroll
                for (int bj = 0; bj < 2; ++bj) { const f32x4 v0 = acc[ai][bj][m][0], v1 = acc[ai][bj][m][1];
                    u32x4 w; w.x = cvt_pk_bf16(v0[0], v0[1]); w.y = cvt_pk_bf16(v0[2], v0[3]); w.z = cvt_pk_bf16(v1[0], v1[1]); w.w = cvt_pk_bf16(v1[2], v1[3]);
                    *(u32x4*)(rowp + bj * HALF) = w; } }
    }
};
struct EpiBf16Part {
    static constexpr bool PERM = true, AFTER_DRAIN = false;
    bf16_t* O;
    __device__ __forceinline__ void operator()(const f32x4 (&acc)[2][2][4][2], const Unit& u, int wr, int wc, int fr, int fq) const {
        asm volatile("" : "+v"(fr), "+v"(fq));
        const int row0 = (u.pm ? 256 : 0) + wr * 64 + fr, col0 = u.pn * BM + wc * 32 + 8 * fq;
        bf16_t* base = O + (size_t)u.ks * 512 * 2048;
#pragma unroll
        for (int ai = 0; ai < 2; ++ai)
#pragma unroll
            for (int m = 0; m < 4; ++m) { bf16_t* rowp = base + (size_t)(row0 + ai * HALF + m * 16) * 2048 + col0;
#pragma unroll
                for (int bj = 0; bj < 2; ++bj) { const f32x4 v0 = acc[ai][bj][m][0], v1 = acc[ai][bj][m][1];
                    u32x4 w; w.x = cvt_pk_bf16(v0[0], v0[1]); w.y = cvt_pk_bf16(v0[2], v0[3]); w.z = cvt_pk_bf16(v1[0], v1[1]); w.w = cvt_pk_bf16(v1[2], v1[3]);
                    *(u32x4*)(rowp + bj * HALF) = w; } }
    }
};
template <int MODE> struct EpiMerge {
    static constexpr bool PERM = true, AFTER_DRAIN = false;
    const bf16_t* G; int ldg; bf16_t* T1; bf16_t* T2; bf16_t* Mo; int ldc;
    __device__ __forceinline__ void operator()(const f32x4 (&acc)[2][2][4][2], const Unit& u, int wr, int wc, int fr, int fq) const {
        asm volatile("" : "+v"(fr), "+v"(fq));
        const int row0 = u.pm * BM + wr * 64 + fr, col0 = u.pn * BM + wc * 32 + 8 * fq;
#pragma unroll
        for (int ai = 0; ai < 2; ++ai)
#pragma unroll
            for (int m = 0; m < 4; ++m) { const size_t row = (size_t)(row0 + ai * HALF + m * 16);
#pragma unroll
                for (int bj = 0; bj < 2; ++bj) { const int col = col0 + bj * HALF;
                    const u32x4 gw = *(const u32x4*)(G + row * ldg + col);
                    f32x4 g0 = (f32x4){bf_lo(gw.x), bf_hi(gw.x), bf_lo(gw.y), bf_hi(gw.y)}, g1 = (f32x4){bf_lo(gw.z), bf_hi(gw.z), bf_lo(gw.w), bf_hi(gw.w)};
                    f32x4 v0 = acc[ai][bj][m][0] * g0, v1 = acc[ai][bj][m][1] * g1;
                    if (MODE == 2) { const u32x4 a = *(const u32x4*)(T1 + row * ldc + col), b = *(const u32x4*)(T2 + row * ldc + col);
                        v0 += (f32x4){bf_lo(a.x) + bf_lo(b.x), bf_hi(a.x) + bf_hi(b.x), bf_lo(a.y) + bf_lo(b.y), bf_hi(a.y) + bf_hi(b.y)};
                        v1 += (f32x4){bf_lo(a.z) + bf_lo(b.z), bf_hi(a.z) + bf_hi(b.z), bf_lo(a.w) + bf_lo(b.w), bf_hi(a.w) + bf_hi(b.w)}; }
                    u32x4 w; w.x = cvt_pk_bf16(v0[0], v0[1]); w.y = cvt_pk_bf16(v0[2], v0[3]); w.z = cvt_pk_bf16(v1[0], v1[1]); w.w = cvt_pk_bf16(v1[2], v1[3]);
                    bf16_t* dst = (MODE == 0) ? T1 : (MODE == 1) ? T2 : Mo;
                    *(u32x4*)(dst + row * ldc + col) = w; }
                asm volatile("" ::: "memory"); }
    }
};
struct UpCtxOrder {
    int G, c;
    __host__ __device__ bool next(int i, Unit& u) const { const long L = (long)i * G + c; if (L >= 176) return false; const int e = (int)L, ks = e & 1, t = e >> 1; u.pn = t % 44; u.pm = (t / 44) ? 33 : 0;
        u.kofs = ks * 1024; u.bofs = ks * 1024; u.ks = ks; u.keep = 0; return true; }
    __device__ __forceinline__ void a_ready(const Unit&) const {}
    __device__ __forceinline__ void done(const Unit&) const {}
};
struct EpiUpCtx {
    static constexpr bool PERM = true, AFTER_DRAIN = false;
    bf16_t* O; bf16_t* O2; int ldc;
    __device__ __forceinline__ void operator()(const f32x4 (&acc)[2][2][4][2], const Unit& u, int wr, int wc, int fr, int fq) const {
        asm volatile("" : "+v"(fr), "+v"(fq));
        const int row0 = wr * 64 + fr, col0 = u.pn * BM + wc * 32 + 8 * fq;
        bf16_t* base = u.ks ? O2 + (size_t)(u.pm ? 256 : 0) * ldc : O + (size_t)u.pm * BM * ldc;
#pragma unroll
        for (int ai = 0; ai < 2; ++ai)
#pragma unroll
            for (int m = 0; m < 4; ++m) { bf16_t* rowp = base + (size_t)(row0 + ai * HALF + m * 16) * ldc + col0;
#pragma unroll
                for (int bj = 0; bj < 2; ++bj) { const f32x4 v0 = acc[ai][bj][m][0], v1 = acc[ai][bj][m][1];
                    u32x4 w; w.x = cvt_pk_bf16(v0[0], v0[1]); w.y = cvt_pk_bf16(v0[2], v0[3]); w.z = cvt_pk_bf16(v1[0], v1[1]); w.w = cvt_pk_bf16(v1[2], v1[3]);
                    *(u32x4*)(rowp + bj * HALF) = w; } }
    }
};
template <class Base> struct Merge3Order {
    Base base; int aofs1, aofs2, bstride;
    __host__ __device__ bool next(int i, Unit& u) const { const int t = i / 3, br = i - 3 * t; if (!base.next(t, u)) return false;
        u.kofs = (br == 0) ? 0 : (br == 1) ? aofs1 : aofs2; u.bofs = br * bstride; u.ks = br; u.keep = (br < 2) ? 1 : 0; return true; }
    __device__ __forceinline__ void a_ready(const Unit&) const {}
    __device__ __forceinline__ void done(const Unit&) const {}
};
struct EpiMerge3 {
    static constexpr bool PERM = true, AFTER_DRAIN = false;
    const bf16_t* G; int ldg; bf16_t* Mo; int ldc;
    __device__ __forceinline__ void operator()(f32x4 (&acc)[2][2][4][2], const Unit& u, int wr, int wc, int fr, int fq) const {
        asm volatile("" : "+v"(fr), "+v"(fq));
        const int row0 = u.pm * BM + wr * 64 + fr, col0 = u.pn * BM + wc * 32 + 8 * fq, br = u.ks;
#pragma unroll
        for (int ai = 0; ai < 2; ++ai)
#pragma unroll
            for (int m = 0; m < 4; ++m) { const size_t row = (size_t)(row0 + ai * HALF + m * 16);
#pragma unroll
                for (int bj = 0; bj < 2; ++bj) { const int col = col0 + bj * HALF;
                    const u32x4 gw = *(const u32x4*)(G + row * ldg + br * 2048 + col);
                    f32x4 g0 = (f32x4){bf_lo(gw.x), bf_hi(gw.x), bf_lo(gw.y), bf_hi(gw.y)}, g1 = (f32x4){bf_lo(gw.z), bf_hi(gw.z), bf_lo(gw.w), bf_hi(gw.w)};
                    if (br < 2) { const u32x4 hw = *(const u32x4*)(G + row * ldg + (br + 1) * 2048 + col);
#pragma unroll
                        for (int k = 0; k < 4; ++k) { const unsigned hv = k < 2 ? (k == 0 ? hw.x : hw.y) : (k == 2 ? hw.z : hw.w);
                            const float d0 = fmaxf(bf_lo(hv), 1e-30f), d1 = fmaxf(bf_hi(hv), 1e-30f);
                            if (k < 2) { g0[2 * k] *= __builtin_amdgcn_rcpf(d0); g0[2 * k + 1] *= __builtin_amdgcn_rcpf(d1); } else { g1[2 * k - 4] *= __builtin_amdgcn_rcpf(d0); g1[2 * k - 3] *= __builtin_amdgcn_rcpf(d1); } }
                        acc[ai][bj][m][0] = acc[ai][bj][m][0] * g0; acc[ai][bj][m][1] = acc[ai][bj][m][1] * g1;
                    } else { const f32x4 v0 = acc[ai][bj][m][0] * g0, v1 = acc[ai][bj][m][1] * g1;
                        u32x4 w; w.x = cvt_pk_bf16(v0[0], v0[1]); w.y = cvt_pk_bf16(v0[2], v0[3]); w.z = cvt_pk_bf16(v1[0], v1[1]); w.w = cvt_pk_bf16(v1[2], v1[3]);
                        *(u32x4*)(Mo + row * ldc + col) = w; } }
                asm volatile("" ::: "memory"); }
    }
};
struct EpiMergeCtx {
    static constexpr bool PERM = true, AFTER_DRAIN = false;
    const bf16_t* G; int ldg; bf16_t* O;
    __device__ __forceinline__ void operator()(const f32x4 (&acc)[2][2][4][2], const Unit& u, int wr, int wc, int fr, int fq) const {
        asm volatile("" : "+v"(fr), "+v"(fq));
        const int rl0 = wr * 64 + fr, col0 = u.pn * BM + wc * 32 + 8 * fq, br = u.ks;
        const bf16_t* Gp = G + (size_t)u.pm * BM * ldg + br * 2048; bf16_t* Op = O + ((size_t)br * 512 + (u.pm ? 256 : 0)) * 2048;
#pragma unroll
        for (int ai = 0; ai < 2; ++ai)
#pragma unroll
            for (int m = 0; m < 4; ++m) { const size_t r = (size_t)(rl0 + ai * HALF + m * 16);
#pragma unroll
                for (int bj = 0; bj < 2; ++bj) { const int col = col0 + bj * HALF;
                    const u32x4 gw = *(const u32x4*)(Gp + r * ldg + col);
                    const f32x4 g0 = (f32x4){bf_lo(gw.x), bf_hi(gw.x), bf_lo(gw.y), bf_hi(gw.y)}, g1 = (f32x4){bf_lo(gw.z), bf_hi(gw.z), bf_lo(gw.w), bf_hi(gw.w)};
                    const f32x4 v0 = acc[ai][bj][m][0] * g0, v1 = acc[ai][bj][m][1] * g1;
                    u32x4 w; w.x = cvt_pk_bf16(v0[0], v0[1]); w.y = cvt_pk_bf16(v0[2], v0[3]); w.z = cvt_pk_bf16(v1[0], v1[1]); w.w = cvt_pk_bf16(v1[2], v1[3]);
                    *(u32x4*)(Op + r * 2048 + col) = w; }
                asm volatile("" ::: "memory"); }
    }
};
struct EpiInProj {
    static constexpr bool PERM = true, AFTER_DRAIN = false;
    bf16_t* P; int ldp; float* AB; const float* ropeA; const float* ropeD; const float* a_log; const float* dt_bias; float sA, sD; bool light;
    __device__ __forceinline__ void operator()(const f32x4 (&acc)[2][2][4][2], const Unit& u, int wr, int wc, int fr, int fq) const {
        asm volatile("" : "+v"(fr), "+v"(fq));
        const int pn = u.pn, tib = u.pm % 33; const bool is_ctx = (tib == 0);
        const int row0 = u.pm * BM + wr * 64 + fr, t0 = tib * 256 - 256 + wr * 64 + fr, cl = wc * 32 + 8 * fq;
        int type; float scale = 1.f;
        if (pn <= 3) { type = 1; scale = sA; } else if (pn == 4) type = 1; else if (pn == 5) type = 0; else if (pn <= 9) { type = 2; scale = sD; } else if (pn <= 13) type = 2;
        else if (pn <= 33) type = 0; else if (pn <= 57) type = 3; else type = 4;
        if (light && type != 4) type = 0;
        if (type == 4) {
            if (wc == 0) {
                const int c = 8 * fq;
#pragma unroll
                for (int ai = 0; ai < 2; ++ai)
#pragma unroll
                    for (int m = 0; m < 4; ++m) { const size_t row = (size_t)(row0 + ai * HALF + m * 16); f32x4 v0 = acc[ai][0][m][0], v1 = acc[ai][0][m][1]; float o[8] = {v0[0], v0[1], v0[2], v0[3], v1[0], v1[1], v1[2], v1[3]};
#pragma unroll
                        for (int k = 0; k < 8; ++k) { if (c < 16) { const float x = o[k] + dt_bias[c + k]; const float sp = fmaxf(x, 0.f) + log1pf(__expf(-fabsf(x))); o[k] = -__expf(a_log[c + k]) * sp; } else o[k] = sigm(o[k]); }
                        *(f32x4*)(AB + row * 32 + c) = (f32x4){o[0], o[1], o[2], o[3]}; *(f32x4*)(AB + row * 32 + c + 4) = (f32x4){o[4], o[5], o[6], o[7]}; }
            }
            return;
        }
#pragma unroll
        for (int ai = 0; ai < 2; ++ai)
#pragma unroll
            for (int m = 0; m < 4; ++m) { const size_t row = (size_t)(row0 + ai * HALF + m * 16); const int t = t0 + ai * HALF + m * 16;
#pragma unroll
                for (int bj = 0; bj < 2; ++bj) { const int c = cl + bj * HALF; f32x4 v0 = acc[ai][bj][m][0], v1 = acc[ai][bj][m][1];
                    if ((type == 1 || type == 2) && !is_ctx) {
                        const float* tab;
                        if (type == 1) { const int p0 = (c & 127) >> 1; const int pos = (p0 >= 32) ? (t & 63) : (t >> 6); tab = ropeA + (pos * 32 + (p0 & 31)) * 2; }
                        else { const int p0 = (c & 63) >> 1; const int pos = (p0 >= 16) ? (t & 63) : (t >> 6); tab = ropeD + (pos * 16 + (p0 & 15)) * 2; }
                        const f32x4 cs0 = *(const f32x4*)tab, cs1 = *(const f32x4*)(tab + 4);
                        f32x4 r0, r1;
                        r0[0] = v0[0] * cs0[0] - v0[1] * cs0[1]; r0[1] = v0[1] * cs0[0] + v0[0] * cs0[1]; r0[2] = v0[2] * cs0[2] - v0[3] * cs0[3]; r0[3] = v0[3] * cs0[2] + v0[2] * cs0[3];
                        r1[0] = v1[0] * cs1[0] - v1[1] * cs1[1]; r1[1] = v1[1] * cs1[0] + v1[0] * cs1[1]; r1[2] = v1[2] * cs1[2] - v1[3] * cs1[3]; r1[3] = v1[3] * cs1[2] + v1[2] * cs1[3];
                        v0 = r0; v1 = r1;
                    }
                    if (type == 3) {
#pragma unroll
                        for (int k = 0; k < 4; ++k) { v0[k] = sigm(v0[k]); v1[k] = sigm(v1[k]); } }
                    v0 = v0 * scale; v1 = v1 * scale;
                    u32x4 w; w.x = cvt_pk_bf16(v0[0], v0[1]); w.y = cvt_pk_bf16(v0[2], v0[3]); w.z = cvt_pk_bf16(v1[0], v1[1]); w.w = cvt_pk_bf16(v1[2], v1[3]);
                    *(u32x4*)(P + row * ldp + pn * BM + c) = w; }
                asm volatile("" ::: "memory"); }
    }
};

template <class Epi, class Sched, bool ALIGN_EPI = false, bool SP2 = false>
__device__ __forceinline__ void gemm_phase(PG8_LAS unsigned char* lds, const Gemm g, const Sched& S, const Epi& E) {
    int tid_ = threadIdx.x; asm volatile("" : "+v"(tid_));
    const int tid = tid_, wid = __builtin_amdgcn_readfirstlane(tid >> 6), lane = tid & 63, wr = wid >> 2, wc = wid & 3, fr = lane & 15, fq = lane >> 4;
    const int K = g.K, nt = K / BK;
    unsigned voffA[2], voffB[2];
#pragma unroll
    for (int i = 0; i < 2; ++i) { int R, C; stage_rc(tid * 16 + i * 8192, R, C); const int Rb = Epi::PERM ? ((R & ~31) + perm32(R & 31)) : R;
        voffA[i] = (unsigned)(R * g.lda + C) * 2u; voffB[i] = (unsigned)(Rb * g.ldb + C) * 2u; }
    const size_t kstep = (size_t)(BK * 2);
    const size_t hstepB = (size_t)HALF * g.ldb * 2, hstepA = (size_t)HALF * g.lda * 2;
    const size_t tstepA = 2 * hstepA, tstepB = 2 * hstepB;
    const unsigned ldsw = (unsigned)wid * 1024u;
    const int aoff = lds_byte(wr * 64 + fr, fq * 8), boff = lds_byte(wc * 32 + fr, fq * 8);
#define PG8_SA(b, h) (((b) * 2 + (h)) * HTB)
#define PG8_SB(b, h) ((4 + (b) * 2 + (h)) * HTB)
#define PG8_STAGE(bufoff, gbase, voff) do { _Pragma("unroll") for (int _i = 0; _i < 2; ++_i) \
        __builtin_amdgcn_global_load_lds((const unsigned*)((const char*)(gbase) + (voff)[_i]), (PG8_LAS unsigned*)(lds + (bufoff) + ldsw + _i * 8192), 16, 0, 0); } while (0)
#define PG8_LDA(dst, b, h) do { _Pragma("unroll") for (int m = 0; m < 4; ++m) _Pragma("unroll") for (int k = 0; k < 2; ++k) dst[m][k] = *(const PG8_LAS bf16x8*)(lds + PG8_SA(b, h) + aoff + m * 2048 + k * 1024); } while (0)
#define PG8_LDB(dst, b, h) do { _Pragma("unroll") for (int n = 0; n < 2; ++n) _Pragma("unroll") for (int k = 0; k < 2; ++k) dst[n][k] = *(const PG8_LAS bf16x8*)(lds + PG8_SB(b, h) + boff + n * 2048 + k * 1024); } while (0)
#define PG8_MMA(ai, bj, At, Bt) do { __builtin_amdgcn_s_setprio(1); _Pragma("unroll") for (int m = 0; m < 4; ++m) _Pragma("unroll") for (int n = 0; n < 2; ++n) _Pragma("unroll") for (int k = 0; k < 2; ++k) \
        acc[ai][bj][m][n] = __builtin_amdgcn_mfma_f32_16x16x32_bf16(Bt[n][k], At[m][k], acc[ai][bj][m][n], 0, 0, 0); __builtin_amdgcn_s_setprio(0); } while (0)
#define PG8_WAIT_V(n) asm volatile("s_waitcnt vmcnt(" #n ")" ::: "memory")
#define PG8_WAIT_L(n) asm volatile("s_waitcnt lgkmcnt(" #n ")" ::: "memory")
#define PG8_BAR __builtin_amdgcn_s_barrier()
#define PG8_SCHED __builtin_amdgcn_sched_barrier(0)
    Unit cur, nxt; int ui = 0;
    if (!S.next(0, cur)) return;
    f32x4 acc[2][2][4][2];
#pragma unroll
    for (int a = 0; a < 2; ++a)
#pragma unroll
        for (int b = 0; b < 2; ++b)
#pragma unroll
            for (int m = 0; m < 4; ++m)
#pragma unroll
                for (int n = 0; n < 2; ++n) acc[a][b][m][n] = (f32x4){0.f, 0.f, 0.f, 0.f};
    bf16x8 At[4][2], B0[2][2], B1[2][2];
    const char* cA = (const char*)g.A + (size_t)cur.pm * tstepA + (size_t)cur.kofs * 2; const char* cB = (const char*)g.Bt + (size_t)cur.pn * tstepB + (size_t)cur.bofs * 2;
    S.a_ready(cur);
    if constexpr (SP2) {
        PG8_STAGE(PG8_SB(0, 0), cB, voffB); PG8_STAGE(PG8_SB(0, 1), cB + hstepB, voffB); PG8_STAGE(PG8_SA(0, 0), cA, voffA); PG8_STAGE(PG8_SA(0, 1), cA + hstepA, voffA);
        if (wr == 1) PG8_BAR;
        PG8_WAIT_V(2); PG8_BAR;
        PG8_STAGE(PG8_SB(1, 0), cB + kstep, voffB); PG8_STAGE(PG8_SA(1, 0), cA + kstep, voffA); PG8_STAGE(PG8_SB(1, 1), cB + hstepB + kstep, voffB);
        PG8_WAIT_V(6); PG8_BAR;
    } else {
        PG8_STAGE(PG8_SB(0, 0), cB, voffB); PG8_STAGE(PG8_SA(0, 0), cA, voffA); PG8_STAGE(PG8_SB(0, 1), cB + hstepB, voffB); PG8_STAGE(PG8_SA(0, 1), cA + hstepA, voffA);
        if (wr == 1) PG8_BAR;
        PG8_WAIT_V(4); PG8_BAR;
        PG8_STAGE(PG8_SB(1, 0), cB + kstep, voffB); PG8_STAGE(PG8_SA(1, 0), cA + kstep, voffA); PG8_STAGE(PG8_SB(1, 1), cB + hstepB + kstep, voffB);
        PG8_WAIT_V(6); PG8_BAR;
    }
    for (;;) {
        const bool has_next = S.next(ui + 1, nxt);
        const char* nA = has_next ? (const char*)g.A + (size_t)nxt.pm * tstepA + (size_t)nxt.kofs * 2 : cA; const char* nB = has_next ? (const char*)g.Bt + (size_t)nxt.pn * tstepB + (size_t)nxt.bofs * 2 : cB;
        for (int t = 0; t < nt; t += 2) {
            const bool last = (t == nt - 2);
            const char* a1 = cA + (size_t)(t + 1) * kstep;
            const char* a2 = last ? nA : cA + (size_t)(t + 2) * kstep; const char* b2 = last ? nB : cB + (size_t)(t + 2) * kstep;
            const char* a3 = a2 + kstep; const char* b3 = b2 + kstep;
            if (last && has_next) S.a_ready(nxt);
            if constexpr (SP2) {
            PG8_LDB(B0, 0, 0); PG8_LDB(B1, 0, 1); PG8_SCHED; PG8_LDA(At, 0, 0); PG8_STAGE(PG8_SA(1, 1), a1 + hstepA, voffA);
            PG8_WAIT_V(8); PG8_WAIT_L(0); PG8_BAR; PG8_MMA(0, 0, At, B0); PG8_MMA(0, 1, At, B1); PG8_BAR; PG8_SCHED;
            PG8_LDA(At, 0, 1); PG8_STAGE(PG8_SB(0, 0), b2, voffB); PG8_STAGE(PG8_SB(0, 1), b2 + hstepB, voffB); PG8_STAGE(PG8_SA(0, 0), a2, voffA);
            PG8_WAIT_V(8); PG8_WAIT_L(0); PG8_BAR; PG8_MMA(1, 0, At, B0); PG8_MMA(1, 1, At, B1); PG8_BAR; PG8_SCHED;
            PG8_LDB(B0, 1, 0); PG8_LDB(B1, 1, 1); PG8_SCHED; PG8_LDA(At, 1, 0); PG8_STAGE(PG8_SA(0, 1), a2 + hstepA, voffA);
            PG8_WAIT_V(8); PG8_WAIT_L(0); PG8_BAR; PG8_MMA(0, 0, At, B0); PG8_MMA(0, 1, At, B1); PG8_BAR; PG8_SCHED;
            PG8_LDA(At, 1, 1); PG8_STAGE(PG8_SB(1, 0), b3, voffB); PG8_STAGE(PG8_SB(1, 1), b3 + hstepB, voffB); PG8_STAGE(PG8_SA(1, 0), a3, voffA);
            PG8_WAIT_V(8); PG8_WAIT_L(0); PG8_BAR; PG8_MMA(1, 0, At, B0); PG8_MMA(1, 1, At, B1); PG8_BAR; PG8_SCHED;
            } else {
            PG8_LDB(B0, 0, 0); PG8_SCHED; PG8_LDA(At, 0, 0); PG8_STAGE(PG8_SA(1, 1), a1 + hstepA, voffA);
            PG8_WAIT_L(8); PG8_BAR; PG8_WAIT_L(0); PG8_MMA(0, 0, At, B0); PG8_BAR; PG8_SCHED;
            PG8_LDB(B1, 0, 1); PG8_STAGE(PG8_SB(0, 0), b2, voffB);
            PG8_BAR; PG8_WAIT_L(0); PG8_MMA(0, 1, At, B1); PG8_BAR;
            PG8_LDA(At, 0, 1); PG8_STAGE(PG8_SA(0, 0), a2, voffA);
            PG8_BAR; PG8_WAIT_L(0); PG8_MMA(1, 0, At, B0); PG8_BAR; PG8_SCHED;
            PG8_STAGE(PG8_SB(0, 1), b2 + hstepB, voffB);
            PG8_WAIT_V(6); PG8_BAR; PG8_MMA(1, 1, At, B1); PG8_BAR;
            PG8_LDB(B0, 1, 0); PG8_SCHED; PG8_LDA(At, 1, 0); PG8_STAGE(PG8_SA(0, 1), a2 + hstepA, voffA);
            PG8_WAIT_L(8); PG8_BAR; PG8_WAIT_L(0); PG8_MMA(0, 0, At, B0); PG8_BAR; PG8_SCHED;
            PG8_LDB(B1, 1, 1); PG8_STAGE(PG8_SB(1, 0), b3, voffB);
            PG8_BAR; PG8_WAIT_L(0); PG8_MMA(0, 1, At, B1); PG8_BAR;
            PG8_LDA(At, 1, 1); PG8_STAGE(PG8_SA(1, 0), a3, voffA);
            PG8_BAR; PG8_WAIT_L(0); PG8_MMA(1, 0, At, B0); PG8_BAR; PG8_SCHED;
            PG8_STAGE(PG8_SB(1, 1), b3 + hstepB, voffB);
            PG8_WAIT_V(6); PG8_BAR; PG8_MMA(1, 1, At, B1); PG8_BAR;
            }
        }
        if constexpr (ALIGN_EPI) { if (wr == 0) PG8_BAR; }
        if constexpr (!Epi::AFTER_DRAIN) { E(acc, cur, wr, wc, fr, fq); S.done(cur); }
        if (!has_next) break;
        if (!cur.keep) {
#pragma unroll
        for (int a = 0; a < 2; ++a)
#pragma unroll
            for (int b = 0; b < 2; ++b)
#pragma unroll
                for (int m = 0; m < 4; ++m)
#pragma unroll
                    for (int n = 0; n < 2; ++n) acc[a][b][m][n] = (f32x4){0.f, 0.f, 0.f, 0.f};
        }
        cur = nxt; cA = nA; cB = nB; ++ui;
        if constexpr (ALIGN_EPI) { if (wr == 1) PG8_BAR; }
    }
    PG8_WAIT_V(0);
    if constexpr (!ALIGN_EPI) { if (wr == 0) PG8_BAR; }
    PG8_BAR;
    if constexpr (Epi::AFTER_DRAIN) { E.fused(acc, cur, wr, wc, fr, fq, lds, wid, lane); S.done(cur); }
#undef PG8_SA
#undef PG8_SB
#undef PG8_STAGE
#undef PG8_LDA
#undef PG8_LDB
#undef PG8_MMA
#undef PG8_WAIT_V
#undef PG8_WAIT_L
#undef PG8_BAR
#undef PG8_SCHED
}
}

constexpr int DM = 2048, NBATCH = 4, SEQ = 8192, CTXL = 256, RB = CTXL + SEQ  , HB = 2  , HR = HB * RB  ;
constexpr int DFF = 5632, NUP = 2 * DFF, NMOD = 6 * DM, NCH = RB / 64  ;
constexpr int LDP = 14848;
constexpr int NWIN = 15104, INW = 14880;
constexpr int C_QA = 0, C_KA = 1024, C_VA = 1280, C_QD = 1536, C_KD = 2560, C_VD = 3584, C_QKV = 4608, C_Z = 7680, C_G = 8704;
constexpr float LN_EPS = 1e-6f, DN_ALPHA = 1.41421356237f  , LOG2E = 1.4426950408889634f;
constexpr int NWAVES = 8, NTHR = 512;
constexpr size_t MiB = 1u << 20;
constexpr size_t WS_CTL = 0, CTL_ZERO_BYTES = 1 * MiB;
constexpr size_t WS_MOD = 1 * MiB;
constexpr size_t WS_ROPEA = WS_MOD + 512 * 1024, WS_ROPED = WS_ROPEA + 32768, WS_LAM = WS_ROPED + 16384;
constexpr size_t WS_CX = 2 * MiB;
constexpr size_t WS_WIN = 10 * MiB, WS_WPA = 69 * MiB, WS_WPB = 73 * MiB, WS_WPC = 77 * MiB, WS_WO = 81 * MiB, WS_WUP = 89 * MiB, WS_WDN = 133 * MiB;
constexpr size_t WS_H = 155 * MiB;
constexpr size_t WS_AB = 221 * MiB;
constexpr size_t WS_GL = WS_AB + 5 * MiB / 2;
constexpr size_t WS_P = 224 * MiB;
constexpr size_t WS_G = 703 * MiB;
constexpr size_t GU_BYTES = 73728, GU_W = 0, GU_QG = 16384, GU_KD = 32768, GU_AT = 49152, GU_U = 57344;
constexpr size_t WS_PART = WS_G + 297 * MiB;
constexpr size_t WS_MC = WS_PART + 24 * MiB;
constexpr size_t WS_END = WS_MC + 6 * MiB;
constexpr size_t WS_TOT = WS_G, WS_M = WS_G + 132 * MiB, WS_OX = WS_P, WS_U = WS_P, WS_ACT = WS_G, WS_FX = WS_P;
static_assert((size_t)HR * LDP * 2 <= 479 * MiB && (size_t)4224 * GU_BYTES <= 297 * MiB && (size_t)HR * NUP * 2 <= 479 * MiB && (size_t)HR * DFF * 2 <= 297 * MiB, "d_ws map");
constexpr size_t WS_TRASH = 512 * 1024;
constexpr int CW_BAR = 4096, CW_Q = 16384;
constexpr int RING_BYTES = 131072, LDS_BYTES = 147456, LDSCTL_OFF = LDS_BYTES - 1024;

#define GAS __attribute__((address_space(1)))
#define LAS __attribute__((address_space(3)))
typedef unsigned short bf16_t;
typedef short bf16x8 __attribute__((ext_vector_type(8)));
typedef short s16x4 __attribute__((ext_vector_type(4)));
typedef float f32x4 __attribute__((ext_vector_type(4)));
typedef float f32x2 __attribute__((ext_vector_type(2)));
typedef float f32x16 __attribute__((ext_vector_type(16)));
typedef unsigned u32x4 __attribute__((ext_vector_type(4)));
typedef unsigned u32x2 __attribute__((ext_vector_type(2)));
using pg8::cvt_pk_bf16; using pg8::bf_lo; using pg8::bf_hi; using pg8::sigm;
__device__ __forceinline__ float wave_sum(float v) {
#pragma unroll
    for (int o = 1; o < 64; o <<= 1) v += __shfl_xor(v, o);
    return v;
}
__device__ __forceinline__ int tid_opaque() { int t = threadIdx.x; asm volatile("" : "+v"(t)); return t; }
__device__ __forceinline__ int opaque_s(int v) { asm volatile("" : "+s"(v)); return v; }
__device__ __forceinline__ float silu_f(float x) { return x * sigm(x); }
__device__ __forceinline__ int crow(int r, int hi) { return (r & 3) + 8 * (r >> 2) + 4 * hi; }
__device__ __forceinline__ bf16x8 pack8(float a0, float a1, float a2, float a3, float a4, float a5, float a6, float a7) {
    u32x4 w; w.x = cvt_pk_bf16(a0, a1); w.y = cvt_pk_bf16(a2, a3); w.z = cvt_pk_bf16(a4, a5); w.w = cvt_pk_bf16(a6, a7); return __builtin_bit_cast(bf16x8, w); }
typedef short v4i16_t __attribute__((ext_vector_type(4)));
__device__ __forceinline__ s16x4 lds_tr(LAS const unsigned char* p) { return __builtin_bit_cast(s16x4, __builtin_amdgcn_ds_read_tr16_b64_v4i16((LAS v4i16_t*)p)); }
#define MFMA32(a, b, c) __builtin_amdgcn_mfma_f32_32x32x16_bf16((a), (b), (c), 0, 0, 0)

#define XB_TMO      128
#define XB_XCNT(j)  (256  + 64 * (j))
#define XB_XSUB(j)  (1280 + 64 * (j))
#define XB_XGEN(j)  (2304 + 64 * (j))
#define XB_TOP      3328
#define XB_TOPGEN   3392
#define XCD_BAR_WORDS 3456
#define XB_SPIN_CAP (1u << 18)

__device__ __forceinline__ unsigned xb_ld(unsigned* p)              { return __hip_atomic_load(p, __ATOMIC_RELAXED, __HIP_MEMORY_SCOPE_AGENT); }
__device__ __forceinline__ unsigned xb_add(unsigned* p, unsigned v) { return __hip_atomic_fetch_add(p, v, __ATOMIC_RELAXED, __HIP_MEMORY_SCOPE_AGENT); }
__device__ __forceinline__ unsigned xb_xcc_id() { return (unsigned)__builtin_amdgcn_s_getreg((3 << 11) | 20) & 0xFu; }
#define XB_SPIN(cond, bar) do { unsigned _sp = 0; while (cond) { __builtin_amdgcn_s_sleep(1); \
    if ((++_sp & 255u) == 0u) { if (xb_ld(&(bar)[XB_TMO])) break; if (_sp > XB_SPIN_CAP) { atomicAdd(&(bar)[XB_TMO], 1u); break; } } } } while (0)

struct XcdBarrier {
    unsigned* bar; unsigned x;
    volatile LAS unsigned* st;
};

__device__ __forceinline__ XcdBarrier xcd_barrier_post(unsigned* bar, volatile LAS unsigned* st) {
    XcdBarrier b; b.bar = bar; b.x = xb_xcc_id(); b.st = st;
    if (threadIdx.x == 0) (void)xb_add(&bar[XB_XCNT(b.x)], 1u);
    return b;
}
__device__ __forceinline__ void xcd_barrier_complete(unsigned* bar, unsigned x, unsigned& nloc, unsigned& nx) {
    const unsigned G = gridDim.x * gridDim.y * gridDim.z;
    unsigned sum, cnt, mine, sp = 0u;
    for (;;) {
        sum = 0u; cnt = 0u; mine = 0u;
#pragma unroll
        for (unsigned j = 0; j < 16; ++j) { const unsigned c = xb_ld(&bar[XB_XCNT(j)]); sum += c; cnt += (c > 0u) ? 1u : 0u; mine = (j == x) ? c : mine; }
        if (sum == G) break;
        __builtin_amdgcn_s_sleep(1);
        if ((++sp & 255u) == 0u) { if (xb_ld(&bar[XB_TMO])) break; if (sp > XB_SPIN_CAP) { atomicAdd(&bar[XB_TMO], 1u); break; } }
    }
    nloc = mine > 0u ? mine : 1u; nx = cnt > 0u ? cnt : 1u;
}

__device__ __forceinline__ void xcd_barrier(const XcdBarrier& b) {
    asm volatile("s_waitcnt vmcnt(0)" ::: "memory");
    __syncthreads();
    if (threadIdx.x == 0) {
        unsigned* bar = b.bar;
        __builtin_amdgcn_s_waitcnt(0);
        unsigned nloc = b.st[0], nx = b.st[1];
        if (nloc == 0u) { xcd_barrier_complete(bar, b.x, nloc, nx); b.st[0] = nloc; b.st[1] = nx; }
        const unsigned old = xb_add(&bar[XB_XSUB(b.x)], 1u);
        const unsigned gen = old / nloc;
        if (old + 1u == (gen + 1u) * nloc) {
            __builtin_amdgcn_fence(__ATOMIC_RELEASE, "agent");
            asm volatile("s_waitcnt vmcnt(0)" ::: "memory");
            const unsigned og = xb_add(&bar[XB_TOP], 1u);
            const unsigned tg = og / nx;
            if (og + 1u == (tg + 1u) * nx) xb_add(&bar[XB_TOPGEN], 1u);
            else XB_SPIN(xb_ld(&bar[XB_TOPGEN]) == tg, bar);
            __builtin_amdgcn_fence(__ATOMIC_ACQUIRE, "agent");
            xb_add(&bar[XB_XGEN(b.x)], 1u);
            asm volatile("s_waitcnt vmcnt(0)" ::: "memory");
        } else {
            XB_SPIN(xb_ld(&bar[XB_XGEN(b.x)]) == gen, bar);
            __builtin_amdgcn_fence(__ATOMIC_ACQUIRE, "agent");
            asm volatile("s_waitcnt vmcnt(0)" ::: "memory");
        }
    }
    __syncthreads();
}
struct Args { const float* in[29]; float* out; unsigned char* ws; int ph_lo, ph_hi; };
enum { I_X = 0, I_C, I_CTX, I_CCTX, I_WMOD, I_BMOD, I_WIN, I_SINK, I_LQ1, I_LK1, I_LQ2, I_LK2, I_SUBLN, I_DNCONV, I_ALOG, I_DTB, I_DNNORM, I_WPA, I_WPB, I_WPC, I_WO, I_LN1G, I_LN1B, I_WUP, I_FCW, I_FCB, I_WDN, I_LN2G, I_LN2B };

__device__ __forceinline__ void ph_prologue(const Args& A, LAS unsigned char* lds) {
    const int tid = tid_opaque(), lane = tid & 63, wave = tid >> 6, G = gridDim.x, bid = blockIdx.x;
    const int gt = bid * NTHR + tid, NT = G * NTHR;
    float* ropeA = (float*)(A.ws + WS_ROPEA); float* ropeD = (float*)(A.ws + WS_ROPED); float* LAM = (float*)(A.ws + WS_LAM); float* MOD = (float*)(A.ws + WS_MOD);
    for (int e = gt; e < 128 * 32; e += NT) { const int pos = e >> 5, f = e & 31; const float inv = powf(10000.0f, -(float)(2 * f) / 64.0f); const float ang = (float)pos * inv; ropeA[2 * e] = cosf(ang); ropeA[2 * e + 1] = sinf(ang); }
    for (int e = gt; e < 128 * 16; e += NT) { const int pos = e >> 4, f = e & 15; const float inv = powf(10000.0f, -(float)(2 * f) / 32.0f); const float ang = (float)pos * inv; ropeD[2 * e] = cosf(ang); ropeD[2 * e + 1] = sinf(ang); }
    if (gt < 2) { const int l = gt; float s1 = 0.f, s2 = 0.f;
        for (int i = 0; i < 64; ++i) { s1 += A.in[I_LQ1][l * 64 + i] * A.in[I_LK1][l * 64 + i]; s2 += A.in[I_LQ2][l * 64 + i] * A.in[I_LK2][l * 64 + i]; }
        const float lam_init = 0.8f - 0.6f * expf(-0.3f * (float)l); LAM[2 * l] = expf(s1) - expf(s2) + lam_init; LAM[2 * l + 1] = 1.0f - lam_init; }
    LAS float* sc = (LAS float*)lds;
    LAS float* red = (LAS float*)(lds + 40960);
    for (int e = tid; e < 5 * 2048; e += NTHR) { const int idx = e >> 11, k = e & 2047; const float v = (idx < 4) ? A.in[I_C][idx * 2048 + k] : A.in[I_CCTX][k]; sc[e] = silu_f(v); }
    __syncthreads();
    for (int u = bid; u < 192; u += G) {
        const int l = u / 96, n0 = (u % 96) * 128;
        const float* W = A.in[I_WMOD] + (size_t)l * 2048 * NMOD + n0 + 2 * lane;
        float acc[5][2];
#pragma unroll
        for (int i = 0; i < 5; ++i) { acc[i][0] = 0.f; acc[i][1] = 0.f; }
        const int k0 = wave * 256;
#pragma unroll 4
        for (int k = k0; k < k0 + 256; ++k) { const f32x2 w = *(const f32x2*)(W + (size_t)k * NMOD);
#pragma unroll
            for (int i = 0; i < 5; ++i) { const float s = sc[i * 2048 + k]; acc[i][0] += s * w.x; acc[i][1] += s * w.y; } }
#pragma unroll
        for (int i = 0; i < 5; ++i) { red[(wave * 5 + i) * 128 + 2 * lane] = acc[i][0]; red[(wave * 5 + i) * 128 + 2 * lane + 1] = acc[i][1]; }
        __syncthreads();
        for (int e = tid; e < 640; e += NTHR) { const int idx = e >> 7, n = e & 127; float s = 0.f;
#pragma unroll
            for (int w = 0; w < 8; ++w) s += red[(w * 5 + idx) * 128 + n];
            MOD[(size_t)(l * 5 + idx) * NMOD + n0 + n] = s + A.in[I_BMOD][l * NMOD + n0 + n]; }
        __syncthreads();
    }
}
__device__ __forceinline__ int win_src(int n) {
    if (n < 1280) { const int j = n & 127, p = j >> 1, s = j & 1; const int dim = (p < 32) ? (s * 32 + p) : (64 + s * 32 + (p - 32)); return (n & ~127) + dim; }
    if (n < 1536) return n;
    if (n < 3584) { const int j = n & 63, p = j >> 1, s = j & 1; const int dim = (p < 16) ? (s * 16 + p) : (32 + s * 16 + (p - 16)); return (n & ~63) + dim; }
    if (n < 8704) return n;
    if (n < 14848) return n + 32;
    if (n < 14880) return n - 14848 + 8704;
    return -1;
}
template <int MODE> __device__ __forceinline__ void transpose_item(const float* W, int K, int N, bf16_t* WT, LAS float* scr, int kb, int nb, int lane) {
    const int k0 = 64 * kb, n0 = 32 * nb, nn = n0 + (lane & 31);
    const int sc = (MODE == 1) ? win_src(nn) : nn;
    const float* src = W + (size_t)(k0 + (lane >> 5)) * N + (sc >= 0 ? sc : 0);
#pragma unroll 8
    for (int i = 0; i < 32; ++i) { const float v = src[(size_t)(2 * i) * N]; scr[(2 * i + (lane >> 5)) * 33 + (lane & 31)] = (sc >= 0) ? v : 0.f; }
    asm volatile("s_waitcnt lgkmcnt(0)" ::: "memory");
    const int c = lane & 7;
#pragma unroll
    for (int j = 0; j < 4; ++j) { const int n = (lane >> 3) + 8 * j; const LAS float* s = scr + (8 * c) * 33 + n;
        u32x4 o; o.x = cvt_pk_bf16(s[0 * 33], s[1 * 33]); o.y = cvt_pk_bf16(s[2 * 33], s[3 * 33]); o.z = cvt_pk_bf16(s[4 * 33], s[5 * 33]); o.w = cvt_pk_bf16(s[6 * 33], s[7 * 33]);
        *(u32x4*)(WT + (size_t)(n0 + n) * K + k0 + 8 * c) = o; }
    asm volatile("s_waitcnt lgkmcnt(0)" ::: "memory");
}
__device__ __forceinline__ void ph_weights(const Args& A, LAS unsigned char* lds, int l) {
    const int tid = tid_opaque(), lane = tid & 63, wave = tid >> 6, G = gridDim.x, bid = blockIdx.x;
    LAS float* scr = (LAS float*)(lds + wave * 8448);
    unsigned char* ws = A.ws;
    constexpr int I0 = 32 * 472, I1 = 16 * 64, I2 = 32 * 64, I3 = 32 * 352, I4 = 88 * 64, NIT = I0 + 3 * I1 + I2 + I3 + I4;
    for (int it = bid * NWAVES + wave; it < NIT; it += G * NWAVES) {
        int r = it;
        if (r < I0) { transpose_item<1>(A.in[I_WIN] + (size_t)l * 2048 * INW, 2048, INW, (bf16_t*)(ws + WS_WIN), scr, r / 472, r % 472, lane); continue; } r -= I0;
        if (r < I1) { transpose_item<0>(A.in[I_WPA] + (size_t)l * 1024 * 2048, 1024, 2048, (bf16_t*)(ws + WS_WPA), scr, r / 64, r % 64, lane); continue; } r -= I1;
        if (r < I1) { transpose_item<0>(A.in[I_WPB] + (size_t)l * 1024 * 2048, 1024, 2048, (bf16_t*)(ws + WS_WPB), scr, r / 64, r % 64, lane); continue; } r -= I1;
        if (r < I1) { transpose_item<0>(A.in[I_WPC] + (size_t)l * 1024 * 2048, 1024, 2048, (bf16_t*)(ws + WS_WPC), scr, r / 64, r % 64, lane); continue; } r -= I1;
        if (r < I2) { transpose_item<0>(A.in[I_WO] + (size_t)l * 2048 * 2048, 2048, 2048, (bf16_t*)(ws + WS_WO), scr, r / 64, r % 64, lane); continue; } r -= I2;
        if (r < I3) { transpose_item<0>(A.in[I_WUP] + (size_t)l * 2048 * NUP, 2048, NUP, (bf16_t*)(ws + WS_WUP), scr, r / 352, r % 352, lane); continue; } r -= I3;
        transpose_item<0>(A.in[I_WDN] + (size_t)l * DFF * 2048, DFF, 2048, (bf16_t*)(ws + WS_WDN), scr, r / 64, r % 64, lane);
    }
}
__device__ __forceinline__ void row_src(const Args& A, int l, int half, int r, const float*& src, float*& dst, const float*& mod, bool& is_ctx) {
    const int bl = r / RB, tp = r - bl * RB, b = opaque_s(half) * HB + bl; is_ctx = tp < CTXL;
    float* cx = (float*)(A.ws + WS_CX);
    dst = is_ctx ? cx + (size_t)(b * CTXL + tp) * DM : A.out + (size_t)(b * SEQ + tp - CTXL) * DM;
    if (l == 0) src = is_ctx ? A.in[I_CTX] + (size_t)(b * CTXL + tp) * DM : A.in[I_X] + (size_t)(b * SEQ + tp - CTXL) * DM; else src = dst;
    mod = (const float*)(A.ws + WS_MOD) + (size_t)(l * 5 + (is_ctx ? 4 : b)) * NMOD;
}
__device__ __forceinline__ void ln_stats(const f32x4 (&v)[8], float& mean, float& rstd) {
    float s = 0.f;
#pragma unroll
    for (int j = 0; j < 8; ++j) s += (v[j].x + v[j].y) + (v[j].z + v[j].w);
    mean = wave_sum(s) * (1.0f / DM); float q = 0.f;
#pragma unroll
    for (int j = 0; j < 8; ++j) { const f32x4 d = v[j] - mean; q += (d.x * d.x + d.y * d.y) + (d.z * d.z + d.w * d.w); }
    rstd = 1.0f / sqrtf(wave_sum(q) * (1.0f / DM) + LN_EPS);
}
__device__ __forceinline__ void ada_store(const f32x4 (&v)[8], float mean, float rstd, const float* shift, const float* scale, bf16_t* hrow, int lane) {
#pragma unroll
    for (int j = 0; j < 8; ++j) { const int e = (64 * j + lane) * 4; const f32x4 sh = *(const f32x4*)(shift + e), sc = *(const f32x4*)(scale + e);
        const f32x4 y = (v[j] - mean) * rstd * (sc + 1.0f) + sh; u32x2 w; w.x = cvt_pk_bf16(y.x, y.y); w.y = cvt_pk_bf16(y.z, y.w); *(u32x2*)(hrow + e) = w; }
}
__device__ __forceinline__ void ph_adaln(const Args& A, int l, int half) {
    const int tid = tid_opaque(), lane = tid & 63, gw = blockIdx.x * NWAVES + (tid >> 6), NGW = gridDim.x * NWAVES;
    bf16_t* H = (bf16_t*)(A.ws + WS_H);
    for (int r = gw; r < HR; r += NGW) {
        const float* src; float* dst; const float* mod; bool is_ctx; row_src(A, l, half, r, src, dst, mod, is_ctx);
        f32x4 v[8];
#pragma unroll
        for (int j = 0; j < 8; ++j) v[j] = *((const f32x4*)src + 64 * j + lane);
        float mean, rstd; ln_stats(v, mean, rstd);
        ada_store(v, mean, rstd, mod, mod + DM, H + (size_t)r * DM, lane);
    }
}
template <bool WITH_H> __device__ __forceinline__ void ph_resln(const Args& A, int l, int half, const bf16_t* Y, int nsplit, int gate_idx, const float* lng, const float* lnb, bool dry, bool next_h = false) {
    const int tid = tid_opaque(), lane = tid & 63, gw = blockIdx.x * NWAVES + (tid >> 6), NGW = gridDim.x * NWAVES;
    bf16_t* H = (bf16_t*)(A.ws + WS_H);
    for (int r = gw; r < HR; r += NGW) {
        const float* src; float* dst; const float* mod; bool is_ctx; row_src(A, l, half, r, src, dst, mod, is_ctx);
        if (is_ctx && l == 1) continue;
        if (!WITH_H) src = dst;
        if (dry) dst = (float*)(A.ws + WS_TRASH) + (tid >> 6) * DM;
        const float* gate = mod + gate_idx * DM; const bf16_t* yrow = Y + (size_t)r * DM;
        f32x4 v[8];
#pragma unroll
        for (int j = 0; j < 8; ++j) { const int e = 64 * j + lane; f32x4 yv;
            if (!is_ctx) { const u32x2 yw = *((const u32x2*)yrow + e); yv = (f32x4){bf_lo(yw.x), bf_hi(yw.x), bf_lo(yw.y), bf_hi(yw.y)}; }
            else { yv = (f32x4){0.f, 0.f, 0.f, 0.f}; const int bl_ = r / RB; const u32x2* pp = (const u32x2*)((const bf16_t*)(A.ws + WS_PART) + (size_t)(bl_ * 256 + (r - bl_ * RB)) * 2048) + e;
                for (int s = 0; s < nsplit; ++s) { const u32x2 yw = pp[(size_t)s * 512 * 2048 / 4]; yv += (f32x4){bf_lo(yw.x), bf_hi(yw.x), bf_lo(yw.y), bf_hi(yw.y)}; } }
            v[j] = *((const f32x4*)src + e) * DN_ALPHA + *((const f32x4*)gate + e) * yv; }
        float mean, rstd; ln_stats(v, mean, rstd);
#pragma unroll
        for (int j = 0; j < 8; ++j) { const int e = 64 * j + lane; v[j] = (v[j] - mean) * rstd * *((const f32x4*)lng + e) + *((const f32x4*)lnb + e); *((f32x4*)dst + e) = v[j]; }
        if (WITH_H) { ln_stats(v, mean, rstd); ada_store(v, mean, rstd, mod + 3 * DM, mod + 4 * DM, dry ? (bf16_t*)(A.ws + WS_TRASH) + 131072 + (tid >> 6) * DM : H + (size_t)r * DM, lane); }
        if (!WITH_H && next_h) { ln_stats(v, mean, rstd); const float* modn = mod + 5 * NMOD; ada_store(v, mean, rstd, modn, modn + DM, H + (size_t)r * DM, lane); }
    }
}
__device__ __forceinline__ void ph_convact(const Args& A, int l_) {
    const int l = opaque_s(l_);
    const int gt = blockIdx.x * NTHR + tid_opaque(), NT = gridDim.x * NTHR;
    const bf16_t* U = (const bf16_t*)(A.ws + WS_U); bf16_t* ACT = (bf16_t*)(A.ws + WS_ACT);
    const float* cw = A.in[I_FCW] + (size_t)l * 3 * NUP; const float* cb = A.in[I_FCB] + (size_t)l * NUP;
    constexpr int NVC = DFF / 8, NRB = HR / 32;
    for (int idx = gt; idx < NRB * NVC; idx += NT) {
        const int rbk = idx / NVC, vc = idx - rbk * NVC, r0 = rbk * 32, tp0 = r0 % RB;
        const bool first_start = (tp0 == 0 || tp0 == CTXL), last_end = (tp0 + 31 == CTXL - 1 || tp0 + 31 == RB - 1);
        const int ca = vc * 8, cbk = DFF + vc * 8;
        float wa[3][8], wb[3][8], ba[8], bb[8];
#pragma unroll
        for (int t = 0; t < 3; ++t) {
#pragma unroll
            for (int k = 0; k < 8; ++k) { wa[t][k] = cw[t * NUP + ca + k]; wb[t][k] = cw[t * NUP + cbk + k]; } }
#pragma unroll
        for (int k = 0; k < 8; ++k) { ba[k] = cb[ca + k]; bb[k] = cb[cbk + k]; }
        const u32x4 z4 = (u32x4){0u, 0u, 0u, 0u};
        const bool cx = (l == 0) && (tp0 < CTXL);
        const bf16_t* U2 = (const bf16_t*)(A.ws + WS_PART) + (ptrdiff_t)(r0 / RB) * (256 - RB) * NUP;
#define CV_ADD8(A_, B_) ((u32x4){cvt_pk_bf16(bf_lo((A_).x) + bf_lo((B_).x), bf_hi((A_).x) + bf_hi((B_).x)), cvt_pk_bf16(bf_lo((A_).y) + bf_lo((B_).y), bf_hi((A_).y) + bf_hi((B_).y)), \
                               cvt_pk_bf16(bf_lo((A_).z) + bf_lo((B_).z), bf_hi((A_).z) + bf_hi((B_).z)), cvt_pk_bf16(bf_lo((A_).w) + bf_lo((B_).w), bf_hi((A_).w) + bf_hi((B_).w))})
#define CV_FIX(dst, row, col) do { if (cx) { const u32x4 y_ = *(const u32x4*)(U2 + (ptrdiff_t)(row) * NUP + (col)); dst = CV_ADD8(dst, y_); } } while (0)
        u32x4 pa = z4, pb = z4, qa, qb;
        if (!first_start) { pa = *(const u32x4*)(U + (size_t)(r0 - 1) * NUP + ca); pb = *(const u32x4*)(U + (size_t)(r0 - 1) * NUP + cbk); CV_FIX(pa, r0 - 1, ca); CV_FIX(pb, r0 - 1, cbk); }
        qa = *(const u32x4*)(U + (size_t)r0 * NUP + ca); qb = *(const u32x4*)(U + (size_t)r0 * NUP + cbk); CV_FIX(qa, r0, ca); CV_FIX(qb, r0, cbk);
        for (int rq = 0; rq < 32; rq += 8) {
            u32x4 na[8], nb[8];
#pragma unroll
            for (int k4 = 0; k4 < 8; ++k4) { const int r = rq + k4;
                if (r == 31 && last_end) { na[k4] = z4; nb[k4] = z4; } else { na[k4] = *(const u32x4*)(U + (size_t)(r0 + r + 1) * NUP + ca); nb[k4] = *(const u32x4*)(U + (size_t)(r0 + r + 1) * NUP + cbk);
                    if (cx) { CV_FIX(na[k4], r0 + r + 1, ca); CV_FIX(nb[k4], r0 + r + 1, cbk); asm volatile("" ::: "memory"); } } }
#pragma unroll
            for (int k4 = 0; k4 < 8; ++k4) { const int r = rq + k4;
                float o[8];
#pragma unroll
                for (int k = 0; k < 4; ++k) {
                    const unsigned a0 = pa[k], a1 = qa[k], a2 = na[k4][k], b0 = pb[k], b1 = qb[k], b2 = nb[k4][k];
                    const float xa0 = wa[0][2 * k] * bf_lo(a0) + wa[1][2 * k] * bf_lo(a1) + wa[2][2 * k] * bf_lo(a2) + ba[2 * k];
                    const float xa1 = wa[0][2 * k + 1] * bf_hi(a0) + wa[1][2 * k + 1] * bf_hi(a1) + wa[2][2 * k + 1] * bf_hi(a2) + ba[2 * k + 1];
                    const float xb0 = wb[0][2 * k] * bf_lo(b0) + wb[1][2 * k] * bf_lo(b1) + wb[2][2 * k] * bf_lo(b2) + bb[2 * k];
                    const float xb1 = wb[0][2 * k + 1] * bf_hi(b0) + wb[1][2 * k + 1] * bf_hi(b1) + wb[2][2 * k + 1] * bf_hi(b2) + bb[2 * k + 1];
                    o[2 * k] = silu_f(xa0) * xb0; o[2 * k + 1] = silu_f(xa1) * xb1; }
                u32x4 w; w.x = cvt_pk_bf16(o[0], o[1]); w.y = cvt_pk_bf16(o[2], o[3]); w.z = cvt_pk_bf16(o[4], o[5]); w.w = cvt_pk_bf16(o[6], o[7]);
                *(u32x4*)(ACT + (size_t)(r0 + r) * DFF + vc * 8) = w;
                pa = qa; pb = qb; qa = na[k4]; qb = nb[k4];
            }
        }
    }
}
__device__ __forceinline__ float max3f(float a, float b, float c) { float r; asm("v_max3_f32 %0, %1, %2, %3" : "=v"(r) : "v"(a), "v"(b), "v"(c)); return r; }
__device__ __forceinline__ float xhalf_max(float m) { auto rr = __builtin_amdgcn_permlane32_swap(__float_as_uint(m), __float_as_uint(m), false, false); float r; asm("v_max_f32_e32 %0, %1, %2" : "=v"(r) : "v"(__uint_as_float(rr[0])), "v"(__uint_as_float(rr[1]))); return r; }
__device__ __forceinline__ float xhalf_sum(float m) { auto rr = __builtin_amdgcn_permlane32_swap(__float_as_uint(m), __float_as_uint(m), false, false); return __uint_as_float(rr[0]) + __uint_as_float(rr[1]); }
#ifndef ATT_EXP
#define ATT_EXP 0
#endif
template <int DQK>
__device__ __forceinline__ void attn_core(LAS unsigned char* lds, const bf16_t* Qrow, int kc0, const bf16_t* K0, const bf16_t* V0, int n0, const bf16_t* K1, const bf16_t* V1, int n1,
                                          bool mask1, int qpos, int k1pos0, f32x16 (&oT)[4], float& mref, float& lsum, bool dryx = false) {
    const int tid = tid_opaque(), lane = tid & 63, r32 = lane & 31, hi = lane >> 5, wave = __builtin_amdgcn_readfirstlane(tid >> 6);
    bf16x8 qf[DQK / 16];
#pragma unroll
    for (int d0 = 0; d0 < DQK / 16; ++d0) qf[d0] = *(const bf16x8*)(Qrow + d0 * 16 + hi * 8);
    const int c0 = 2 * wave, c1 = 2 * wave + 1;
    const unsigned kg0 = (unsigned)((lane ^ c0) * LDP + c0 * 8), kg1 = (unsigned)((lane ^ c1) * LDP + c1 * 8);
    const unsigned vg0 = (unsigned)((16 * (c0 & 3) + (lane >> 2)) * LDP + (4 * (c0 >> 2) + (lane & 3)) * 8), vg1 = (unsigned)((16 * (c1 & 3) + (lane >> 2)) * LDP + (4 * (c1 >> 2) + (lane & 3)) * 8);
    const int vd0 = 49152 + ((c0 >> 2) * 8 + 2 * (c0 & 3)) * 512, vd1 = 49152 + ((c1 >> 2) * 8 + 2 * (c1 & 3)) * 512;
#define AT_DMA_K(t, s) do { const bf16_t* kp_ = ((t) < n0) ? K0 + (size_t)(t) * 64 * LDP : K1 + (size_t)((t) - n0) * 64 * LDP; \
        __builtin_amdgcn_global_load_lds((const unsigned*)(kp_ + kg0), (LAS unsigned*)(lds + (s) * 16384 + c0 * 1024), 16, 0, 0); \
        __builtin_amdgcn_global_load_lds((const unsigned*)(kp_ + kg1), (LAS unsigned*)(lds + (s) * 16384 + c1 * 1024), 16, 0, 0); } while (0)
#define AT_DMA_V(t, s) do { const bf16_t* vp_ = ((t) < n0) ? V0 + (size_t)(t) * 64 * LDP : V1 + (size_t)((t) - n0) * 64 * LDP; \
        __builtin_amdgcn_global_load_lds((const unsigned*)(vp_ + vg0), (LAS unsigned*)(lds + (s) * 16384 + vd0), 16, 0, 0); \
        __builtin_amdgcn_global_load_lds((const unsigned*)(vp_ + vg1), (LAS unsigned*)(lds + (s) * 16384 + vd1), 16, 0, 0); } while (0)
    const int srow = tid >> 4, sch = tid & 15;
    const unsigned kgo0 = (unsigned)(srow * LDP + sch * 8), kgo1 = kgo0 + 32u * LDP;
    const int kl0 = sch * 1024 + ((srow ^ sch) << 4), kl1 = kl0 + 512;
    u32x4 sk0, sk1;
#define AT_LDK(t) do { const bf16_t* kp_ = ((t) < n0) ? K0 + (size_t)(t) * 64 * LDP : K1 + (size_t)((t) - n0) * 64 * LDP; sk0 = *(const u32x4*)(kp_ + kgo0); sk1 = *(const u32x4*)(kp_ + kgo1); } while (0)
#define AT_STK(s) do { *(LAS u32x4*)(lds + (s) * 16384 + kl0) = sk0; *(LAS u32x4*)(lds + (s) * 16384 + kl1) = sk1; } while (0)
    const int nt = n0 + n1;
    const int vbase = 49152 + (4 * hi + ((lane & 15) >> 2)) * 64 + ((lane >> 4) & 1) * 32 + (lane & 3) * 8;
#define AT_KLD(kb) do { kbo = (kb); if (DQK == 64) { _Pragma("unroll") for (int d0 = 0; d0 < 2; ++d0) { const int c_ = (kc0 >> 3) + 2 * d0 + hi; const int off_ = kbo + c_ * 1024 + ((r32 ^ c_) << 4); \
            kf[2 * d0] = *(LAS const bf16x8*)(lds + off_); kf[2 * d0 + 1] = *(LAS const bf16x8*)(lds + off_ + 512); } } } while (0)
#define AT_QK(P0, P1) do { _Pragma("unroll") for (int r_ = 0; r_ < 16; ++r_) { P0[r_] = 0.f; P1[r_] = 0.f; } \
        if (DQK == 64) { bf16x8 kg[4]; _Pragma("unroll") for (int d0 = 2; d0 < 4; ++d0) { const int c_ = (kc0 >> 3) + 2 * d0 + hi; const int off_ = kbo + c_ * 1024 + ((r32 ^ c_) << 4); \
                kg[2 * d0 - 4] = *(LAS const bf16x8*)(lds + off_); kg[2 * d0 - 3] = *(LAS const bf16x8*)(lds + off_ + 512); } \
            _Pragma("unroll") for (int d0 = 0; d0 < 2; ++d0) { P0 = MFMA32(kf[2 * d0], qf[d0], P0); P1 = MFMA32(kf[2 * d0 + 1], qf[d0], P1); } \
            _Pragma("unroll") for (int d0 = 2; d0 < 4; ++d0) { P0 = MFMA32(kg[2 * d0 - 4], qf[d0], P0); P1 = MFMA32(kg[2 * d0 - 3], qf[d0], P1); } } \
        else { _Pragma("unroll") for (int d0 = 0; d0 < DQK / 16; ++d0) { const int c_ = (kc0 >> 3) + 2 * d0 + hi; const int off_ = kbo + c_ * 1024 + ((r32 ^ c_) << 4); \
            const bf16x8 a0_ = *(LAS const bf16x8*)(lds + off_), a1_ = *(LAS const bf16x8*)(lds + off_ + 512); P0 = MFMA32(a0_, qf[d0], P0); P1 = MFMA32(a1_, qf[d0], P1); } } } while (0)
    bf16x8 kf[4]; int kbo = 0;
    f32x16 pc0, pc1;
    AT_LDK(0); AT_DMA_V(0, 0); AT_STK(0); if (nt > 1) { AT_LDK(1); AT_DMA_V(1, 1); AT_STK(1); }
    asm volatile("s_waitcnt vmcnt(0)" ::: "memory"); __syncthreads();
    AT_KLD(0); AT_QK(pc0, pc1);
    __syncthreads();
    int s0 = 0, s1 = 1, s2 = 2;
    for (int t = 0; t < nt; ++t) {
        const bool more1 = (t + 1 < nt), more2 = (t + 2 < nt), more3 = (t + 3 < nt);
        if (!(ATT_EXP == 7 && dryx)) {
        if (more2) AT_LDK(t + 2);
        if (more2) AT_DMA_V(t + 2, s2);
        }
        if (more1) { AT_KLD(((t + 1) & 1) * 16384); }
        if (mask1 && t >= n0) { const int kb = k1pos0 + (t - n0) * 64 + 4 * hi - qpos;
#pragma unroll
            for (int r = 0; r < 16; ++r) { const int dl = kb + (r & 3) + 8 * (r >> 2); if (dl > 128 || dl < -128) pc0[r] = -INFINITY; if (dl + 32 > 128 || dl + 32 < -128) pc1[r] = -INFINITY; } }
        if (!(ATT_EXP == 1 && dryx)) {
        float tm = max3f(pc0[0], pc1[0], pc0[1]), tm2 = max3f(pc1[1], pc0[2], pc1[2]);
#pragma unroll
        for (int r = 3; r < 15; r += 2) { tm = max3f(tm, pc0[r], pc1[r]); tm2 = max3f(tm2, pc0[r + 1], pc1[r + 1]); }
        tm = max3f(tm, pc0[15], pc1[15]); tm = max3f(tm, tm2, tm2);
        tm = xhalf_max(tm);
        if (__any(tm > mref + 8.0f)) { const float mn = fmaxf(mref, tm); const float al = __builtin_amdgcn_exp2f(mref - mn);
#pragma unroll
            for (int q = 0; q < 4; ++q) oT[q] = oT[q] * al;
            lsum *= al; mref = mn; }
        float rs = 0.f;
#pragma unroll
        for (int r = 0; r < 16; ++r) { pc0[r] = __builtin_amdgcn_exp2f(pc0[r] - mref); pc1[r] = __builtin_amdgcn_exp2f(pc1[r] - mref); rs += pc0[r] + pc1[r]; }
        lsum += rs;
        }
        bf16x8 pw[4];
        pw[0] = pack8(pc0[0], pc0[1], pc0[2], pc0[3], pc0[4], pc0[5], pc0[6], pc0[7]); pw[1] = pack8(pc0[8], pc0[9], pc0[10], pc0[11], pc0[12], pc0[13], pc0[14], pc0[15]);
        pw[2] = pack8(pc1[0], pc1[1], pc1[2], pc1[3], pc1[4], pc1[5], pc1[6], pc1[7]); pw[3] = pack8(pc1[8], pc1[9], pc1[10], pc1[11], pc1[12], pc1[13], pc1[14], pc1[15]);
        const unsigned vt = (unsigned)(uintptr_t)(lds + s0 * 16384 + vbase);
        s16x4 va[4], vc[4];
#define AT_TR(dst, off) asm volatile("ds_read_b64_tr_b16 %0, %1 offset:%2" : "=&v"(dst) : "v"(vt), "n"(off) : "memory")
#define AT_VRD(dst, g) do { AT_TR(dst[0], (((g) >> 1) * 8 + 4 * ((g) & 1)) * 512); AT_TR(dst[1], (((g) >> 1) * 8 + 4 * ((g) & 1)) * 512 + 512); \
        AT_TR(dst[2], (((g) >> 1) * 8 + 4 * ((g) & 1)) * 512 + 1024); AT_TR(dst[3], (((g) >> 1) * 8 + 4 * ((g) & 1)) * 512 + 1536); } while (0)
#define AT_LW(n) asm volatile("s_waitcnt lgkmcnt(" #n ")" ::: "memory")
#define AT_PV(src, g) do { oT[(g) >> 1] = MFMA32(((bf16x8){src[0][0], src[0][1], src[0][2], src[0][3], src[1][0], src[1][1], src[1][2], src[1][3]}), pw[2 * ((g) & 1)], oT[(g) >> 1]); \
        oT[(g) >> 1] = MFMA32(((bf16x8){src[2][0], src[2][1], src[2][2], src[2][3], src[3][0], src[3][1], src[3][2], src[3][3]}), pw[2 * ((g) & 1) + 1], oT[(g) >> 1]); } while (0)
        if (ATT_EXP == 2 && dryx) { if (more1) { AT_QK(pc0, pc1); } } else {
        AT_VRD(va, 0);
        if (more1 && !(ATT_EXP == 3 && dryx)) { AT_QK(pc0, pc1); }
        __builtin_amdgcn_sched_barrier(0);
        AT_VRD(vc, 1); AT_LW(4); __builtin_amdgcn_sched_barrier(0); AT_PV(va, 0); __builtin_amdgcn_sched_barrier(0);
        AT_VRD(va, 2); AT_LW(4); __builtin_amdgcn_sched_barrier(0); AT_PV(vc, 1); __builtin_amdgcn_sched_barrier(0);
        AT_VRD(vc, 3); AT_LW(4); __builtin_amdgcn_sched_barrier(0); AT_PV(va, 2); __builtin_amdgcn_sched_barrier(0);
        AT_VRD(va, 4); AT_LW(4); __builtin_amdgcn_sched_barrier(0); AT_PV(vc, 3); __builtin_amdgcn_sched_barrier(0);
        AT_VRD(vc, 5); AT_LW(4); __builtin_amdgcn_sched_barrier(0); AT_PV(va, 4); __builtin_amdgcn_sched_barrier(0);
        AT_VRD(va, 6); AT_LW(4); __builtin_amdgcn_sched_barrier(0); AT_PV(vc, 5); __builtin_amdgcn_sched_barrier(0);
        AT_VRD(vc, 7); AT_LW(4); __builtin_amdgcn_sched_barrier(0); AT_PV(va, 6); __builtin_amdgcn_sched_barrier(0);
        AT_LW(0); __builtin_amdgcn_sched_barrier(0);
        AT_PV(vc, 7);
        }
#undef AT_VRD
#undef AT_PV
#undef AT_TR
#undef AT_LW
        if (more2) { AT_STK(t & 1); asm volatile("s_waitcnt vmcnt(2)" ::: "memory"); } else { asm volatile("s_waitcnt vmcnt(0)" ::: "memory"); }
        asm volatile("s_waitcnt lgkmcnt(0)" ::: "memory"); if (!(ATT_EXP == 6 && dryx)) __builtin_amdgcn_s_barrier();
        { const int tmp = s0; s0 = s1; s1 = s2; s2 = tmp; }
    }
    __syncthreads();
#undef AT_LDK
#undef AT_STK
#undef AT_DMA_K
#undef AT_DMA_V
#undef AT_QK
#undef AT_KLD
}
__device__ __forceinline__ void attn_store(bf16_t* orow, const f32x16 (&o)[4], int hi) {
#pragma unroll
    for (int q = 0; q < 4; ++q)
#pragma unroll
        for (int g = 0; g < 4; ++g) { u32x2 w; w.x = cvt_pk_bf16(o[q][4 * g], o[q][4 * g + 1]); w.y = cvt_pk_bf16(o[q][4 * g + 2], o[q][4 * g + 3]); *(u32x2*)(orow + 32 * q + 8 * g + 4 * hi) = w; }
}
__device__ __forceinline__ void attnA_unit(const Args& A, LAS unsigned char* lds, int l_, int bl, int nb, int pr, bool ctxq, bool dry) {
    const int l = opaque_s(l_);
    const int tid = tid_opaque(), lane = tid & 63, r32 = lane & 31, hi = lane >> 5, wave = __builtin_amdgcn_readfirstlane(tid >> 6);
    bf16_t* P = (bf16_t*)(A.ws + WS_P);
    const int head = 2 * pr + (wave >> 2), kvh = pr >> 1, qloc = nb * 128 + 32 * (wave & 3) + r32;
    const size_t brow = (size_t)bl * RB;
    const size_t qrow = brow + (ctxq ? 0 : CTXL) + qloc;
    const bf16_t* Kc = P + brow * LDP + C_KA + kvh * 128; const bf16_t* Vc = P + brow * LDP + C_VA + kvh * 128;
    int ks = 128 * (nb - 1), ke = 128 * (nb + 2); if (ks < 0) ks = 0; if (ke > SEQ) ke = SEQ;
    const int n1 = ctxq ? 0 : (ke - ks) / 64;
    f32x16 oT[4];
#pragma unroll
    for (int q = 0; q < 4; ++q)
#pragma unroll
        for (int r = 0; r < 16; ++r) oT[q][r] = 0.f;
    float mref = -INFINITY, lsum = 0.f;
    attn_core<128>(lds, P + qrow * LDP + C_QA + head * 128, 0, Kc, Vc, 4, Kc + (size_t)(CTXL + ks) * LDP, Vc + (size_t)(CTXL + ks) * LDP, n1, true, qloc, ks, oT, mref, lsum, dry);
    const float sk = A.in[I_SINK][l * 8 + head] * LOG2E;
    const float mf = fmaxf(mref, sk), sc = __builtin_amdgcn_exp2f(mref - mf);
    lsum = xhalf_sum(lsum);
    const float f = sc / (lsum * sc + __builtin_amdgcn_exp2f(sk - mf));
#pragma unroll
    for (int q = 0; q < 4; ++q) oT[q] = oT[q] * f;
    attn_store(dry ? (bf16_t*)(A.ws + WS_TRASH) + tid * 128 : P + qrow * LDP + C_QA + head * 128, oT, hi);
}
__device__ __forceinline__ void attnB_unit(const Args& A, LAS unsigned char* lds, int l_, int bl, int h, int qb, bool ctxq, bool dry) {
    const int l = opaque_s(l_);
    const int tid = tid_opaque(), lane = tid & 63, r32 = lane & 31, hi = lane >> 5, wave = __builtin_amdgcn_readfirstlane(tid >> 6);
    bf16_t* P = (bf16_t*)(A.ws + WS_P);
    const int sub = wave >> 2;
    const size_t brow = (size_t)bl * RB;
    const size_t qrow = brow + (ctxq ? 0 : CTXL) + qb * 128 + 32 * (wave & 3) + r32;
    const bf16_t* Kc = P + brow * LDP + C_KD + h * 128; const bf16_t* Vc = P + brow * LDP + C_VD + h * 128;
    f32x16 oT[4];
#pragma unroll
    for (int q = 0; q < 4; ++q)
#pragma unroll
        for (int r = 0; r < 16; ++r) oT[q][r] = 0.f;
    float mref = -INFINITY, lsum = 0.f;
    attn_core<64>(lds, P + qrow * LDP + C_QD + h * 128 + sub * 64, sub * 64, Kc, Vc, ctxq ? 4 : NCH, Kc, Vc, 0, false, 0, 0, oT, mref, lsum, dry);
    lsum = xhalf_sum(lsum);
    const float inv = 1.0f / lsum;
    LAS float* xch = (LAS float*)lds + (wave & 3) * 4096;
    if (sub == 1) {
#pragma unroll
        for (int q = 0; q < 4; ++q)
#pragma unroll
            for (int r = 0; r < 16; ++r) xch[(q * 16 + r) * 64 + lane] = oT[q][r] * inv;
    }
    __syncthreads();
    if (sub == 0) {
        const float lam = ((const float*)(A.ws + WS_LAM))[2 * l], post = ((const float*)(A.ws + WS_LAM))[2 * l + 1];
        float ss = 0.f;
#pragma unroll
        for (int q = 0; q < 4; ++q)
#pragma unroll
            for (int r = 0; r < 16; ++r) { const float v = oT[q][r] * inv - lam * xch[(q * 16 + r) * 64 + lane]; oT[q][r] = v; ss += v * v; }
        ss = xhalf_sum(ss);
        const float rn = post / sqrtf(ss * (1.0f / 128.0f) + 1e-6f);
        const float* sw = A.in[I_SUBLN] + l * 128;
#pragma unroll
        for (int q = 0; q < 4; ++q)
#pragma unroll
            for (int r = 0; r < 16; ++r) oT[q][r] *= rn * sw[32 * q + 8 * (r >> 2) + 4 * hi + (r & 3)];
        attn_store(dry ? (bf16_t*)(A.ws + WS_TRASH) + tid * 128 : P + qrow * LDP + C_QD + h * 128, oT, hi);
    }
    __syncthreads();
}
__device__ __forceinline__ void ph_attention(const Args& A, LAS unsigned char* lds, int l, int half, int it, bool dry) {
    const int tid = tid_opaque();
    unsigned* ctr = (unsigned*)(A.ws + WS_CTL) + CW_Q + 64 * 8 * (2 * it + (dry ? 1 : 0));
    volatile LAS int* qw = (volatile LAS int*)(lds + LDSCTL_OFF + 64);
    const int nq = 128 + 64 + (l == 0 ? 6 : 0);
    const int x0 = (int)(xb_xcc_id() & 7u);
    for (int k = 0; k < 8; ++k) {
        const int x = (x0 + k) & 7;
        for (;;) {
            if (tid == 0) *qw = (int)__hip_atomic_fetch_add(ctr + 64 * x, 1u, __ATOMIC_RELAXED, __HIP_MEMORY_SCOPE_AGENT);
            __syncthreads();
            int j = *qw;
            __syncthreads();
            if (j >= nq) break;
            if (j < 128) { const int s = x + 8 * (j >> 6); attnB_unit(A, lds, l, s >> 3, s & 7, j & 63, false, dry); continue; } j -= 128;
            if (j < 64) { const int u = x * 64 + j; attnA_unit(A, lds, l, u >> 8, (u >> 2) & 63, u & 3, false, dry); continue; } j -= 64;
            if (j < 4) { const int u = x * 4 + j; attnB_unit(A, lds, l, u >> 4, (u >> 1) & 7, u & 1, true, dry); continue; } j -= 4;
            { const int u = x * 2 + j; attnA_unit(A, lds, l, u >> 3, (u >> 2) & 1, u & 3, true, dry); }
        }
    }
}
constexpr int GL_QN = 0, GL_KN = 17408, GL_VK = 34816, GL_MM = 100352, GL_TB = 135168, GPITCH = 272;
#define FNMA(acc, a, b) asm("v_fma_f32 %0, -%1, %2, %0" : "+v"(acc) : "v"(a), "v"(b))
#define FNMS(acc, a, b) asm("v_fma_f32 %0, -%1, %2, %0" : "+v"(acc) : "s"(a), "v"(b))
#define BFV(x) __uint_as_float(((unsigned)(unsigned short)(x)) << 16)
__device__ __forceinline__ void gdn_intra_unit(const Args& A, LAS unsigned char* lds, int l_, int bl, int ch, int h) {
    const int l = opaque_s(l_);
    const int tid = tid_opaque(), lane = tid & 63, r32 = lane & 31, hi = lane >> 5, wave = __builtin_amdgcn_readfirstlane(tid >> 6);
    const bf16_t* P = (const bf16_t*)(A.ws + WS_P); const float* AB = (const float*)(A.ws + WS_AB);
    const int uidx0 = ((bl * NCH + ch) * 8 + h) * 2;
    const size_t R0 = (size_t)bl * RB + ch * 64;
    LAS float* VK = (LAS float*)(lds + GL_VK);
    if (wave < 2) {
        const int d = wave; LAS float* TB = (LAS float*)(lds + GL_TB + d * 1024); LAS float* MMd = (LAS float*)(lds + GL_MM + d * 17408);
        const size_t row = R0 + (d ? 63 - lane : lane);
        float g = AB[row * 32 + d * 8 + h]; const float be = AB[row * 32 + 16 + d * 8 + h];
#pragma unroll
        for (int o = 1; o < 64; o <<= 1) { const float t = __shfl_up(g, o); if (lane >= o) g += t; }
        const float glast = __shfl(g, 63); const float eg = __expf(g);
        TB[lane] = g; TB[64 + lane] = be; TB[128 + lane] = eg; TB[192 + lane] = __expf(glast - g);
        MMd[lane * 68 + 64] = be; MMd[lane * 68 + 65] = be * eg;
        if (lane == 0) ((float*)(A.ws + WS_GL))[uidx0 + d] = __expf(glast);
    }
    {
        const int c = tid >> 3, sub = tid & 7;
        const int tp = ch * 64 + c;
        const bool has_prev = !(tp == 0 || tp == CTXL), has_next = !(tp == CTXL - 1 || tp == RB - 1);
        const bf16_t* xr = P + (R0 + c) * LDP + C_QKV + h * 128 + sub * 16;
        const float* cw = A.in[I_DNCONV] + (size_t)l * 3 * 3072 + h * 128 + sub * 16;
#pragma unroll
        for (int mat = 0; mat < 3; ++mat) {
            const bf16_t* xm = xr + mat * 1024; const float* wm = cw + mat * 1024;
            float y[16];
            const u32x4 z4 = (u32x4){0u, 0u, 0u, 0u};
#pragma unroll
            for (int hf = 0; hf < 2; ++hf) {
                const u32x4 xc = *(const u32x4*)(xm + hf * 8);
                const u32x4 xp = has_prev ? *(const u32x4*)(xm - LDP + hf * 8) : z4;
                const u32x4 xn = has_next ? *(const u32x4*)(xm + LDP + hf * 8) : z4;
#pragma unroll
                for (int k = 0; k < 4; ++k) { const int e = hf * 8 + 2 * k;
                    const float v0 = wm[e] * bf_lo(xp[k]) + wm[3072 + e] * bf_lo(xc[k]) + wm[6144 + e] * bf_lo(xn[k]);
                    const float v1 = wm[e + 1] * bf_hi(xp[k]) + wm[3072 + e + 1] * bf_hi(xc[k]) + wm[6144 + e + 1] * bf_hi(xn[k]);
                    y[e] = silu_f(v0); y[e + 1] = silu_f(v1); }
            }
            if (mat < 2) {
                float ss = 0.f;
#pragma unroll
                for (int e = 0; e < 16; ++e) ss += y[e] * y[e];
                ss += __shfl_xor(ss, 1); ss += __shfl_xor(ss, 2); ss += __shfl_xor(ss, 4);
                const float rn = (1.0f / sqrtf(ss + 1e-6f)) * (mat == 0 ? 0.08838834764831845f : 1.0f);
#pragma unroll
                for (int e = 0; e < 16; ++e) y[e] *= rn;
                LAS unsigned char* dst = lds + (mat == 0 ? GL_QN : GL_KN) + c * GPITCH + sub * 32;
                u32x4 w0, w1; w0.x = cvt_pk_bf16(y[0], y[1]); w0.y = cvt_pk_bf16(y[2], y[3]); w0.z = cvt_pk_bf16(y[4], y[5]); w0.w = cvt_pk_bf16(y[6], y[7]);
                w1.x = cvt_pk_bf16(y[8], y[9]); w1.y = cvt_pk_bf16(y[10], y[11]); w1.z = cvt_pk_bf16(y[12], y[13]); w1.w = cvt_pk_bf16(y[14], y[15]);
                *(LAS u32x4*)dst = w0; *(LAS u32x4*)(dst + 16) = w1;
            }
            if (mat >= 1) { LAS float* vk = VK + c * 256 + (mat == 1 ? 128 : 0) + sub * 16;
#pragma unroll
                for (int e = 0; e < 16; e += 4) *(LAS f32x4*)(vk + e) = (f32x4){y[e], y[e + 1], y[e + 2], y[e + 3]}; }
        }
    }
    __syncthreads();
#pragma unroll 1
    for (int d = 0; d < 2; ++d) {
        const int mat = wave >> 2, rbk = (wave >> 1) & 1, cbk = wave & 1;
        LAS const float* GC = (LAS const float*)(lds + GL_TB + d * 1024); LAS const float* BETA = GC + 64; LAS float* MM = (LAS float*)(lds + GL_MM + d * 17408);
        const int ra = 32 * rbk + r32, rb_ = 32 * cbk + r32;
        LAS const unsigned char* Ab = lds + GL_KN + (d ? 63 - ra : ra) * GPITCH + hi * 16;
        LAS const unsigned char* Bb = lds + (mat == 0 ? GL_KN : GL_QN) + (d ? 63 - rb_ : rb_) * GPITCH + hi * 16;
        f32x16 acc;
#pragma unroll
        for (int r = 0; r < 16; ++r) acc[r] = 0.f;
#pragma unroll
        for (int d0 = 0; d0 < 8; ++d0) { const bf16x8 a = *(LAS const bf16x8*)(Ab + d0 * 32), b = *(LAS const bf16x8*)(Bb + d0 * 32); acc = MFMA32(a, b, acc); }
        const int cc = 32 * cbk + r32; const float gcc = GC[cc];
        if (mat == 0) {
#pragma unroll
            for (int r = 0; r < 16; ++r) { const int i = 32 * rbk + crow(r, hi); const float v = (i > cc) ? BETA[i] * acc[r] * __expf(GC[i] - gcc) : 0.f; MM[i * 68 + cc] = v; }
        } else {
            float v[16];
#pragma unroll
            for (int r = 0; r < 16; ++r) { const int j = 32 * rbk + crow(r, hi); v[r] = (cc >= j) ? acc[r] * __expf(gcc - GC[j]) : 0.f; }
            bf16x8* at = (bf16x8*)(A.ws + WS_G + (size_t)(uidx0 + d) * GU_BYTES + GU_AT);
            at[(cbk * 4 + 2 * rbk + 0) * 64 + lane] = pack8(v[0], v[1], v[2], v[3], v[4], v[5], v[6], v[7]);
            at[(cbk * 4 + 2 * rbk + 1) * 64 + lane] = pack8(v[8], v[9], v[10], v[11], v[12], v[13], v[14], v[15]);
        }
    }
    {
        const int d = wave >> 2, w4 = wave & 3;
        LAS const float* EG = (LAS const float*)(lds + GL_TB + d * 1024 + 512); LAS const float* DKS = EG + 64;
        unsigned char* rec = A.ws + WS_G + (size_t)(uidx0 + d) * GU_BYTES;
        if (w4 < 2) {
#pragma unroll
            for (int ff = 0; ff < 8; ++ff) { const int f = w4 * 8 + ff, ib = f >> 3, rb = (f >> 1) & 3, s = f & 1; const int i = 32 * ib + r32, dk0 = 32 * rb + 16 * s + 4 * hi; const int row = d ? 63 - i : i;
                const u32x2 a = *(LAS const u32x2*)(lds + GL_QN + row * GPITCH + dk0 * 2), b = *(LAS const u32x2*)(lds + GL_QN + row * GPITCH + (dk0 + 8) * 2); const float e = EG[i];
                ((bf16x8*)(rec + GU_QG))[f * 64 + lane] = pack8(bf_lo(a.x) * e, bf_hi(a.x) * e, bf_lo(a.y) * e, bf_hi(a.y) * e, bf_lo(b.x) * e, bf_hi(b.x) * e, bf_lo(b.y) * e, bf_hi(b.y) * e); }
        } else {
#pragma unroll
            for (int ff = 0; ff < 8; ++ff) { const int f = (w4 - 2) * 8 + ff, rb = f >> 2, ib = (f >> 1) & 1, s = f & 1; const int i0 = 32 * ib + 16 * s + 4 * hi; const int ia = i0 + ((lane & 15) >> 2);
                LAS const unsigned char* kp = lds + GL_KN + (d ? 63 - ia : ia) * GPITCH + (32 * rb + 16 * ((lane >> 4) & 1) + 4 * (lane & 3)) * 2;
                const s16x4 lo = lds_tr(kp), hh = lds_tr(d ? kp - 8 * GPITCH : kp + 8 * GPITCH);
                const f32x4 s0 = *(LAS const f32x4*)(DKS + i0), s1 = *(LAS const f32x4*)(DKS + i0 + 8);
                ((bf16x8*)(rec + GU_KD))[f * 64 + lane] = pack8(BFV(lo[0]) * s0[0], BFV(lo[1]) * s0[1], BFV(lo[2]) * s0[2], BFV(lo[3]) * s0[3], BFV(hh[0]) * s1[0], BFV(hh[1]) * s1[1], BFV(hh[2]) * s1[2], BFV(hh[3]) * s1[3]);
            }
        }
    }
    __syncthreads();
    float x[64];
    const int dD = opaque_s(wave >> 2), col = tid & 255;
    {
        LAS const float* MMv = (LAS const float*)(lds + GL_MM + dD * 17408) + lane; asm volatile("" : "+v"(MMv));
        LAS const float* RHv = VK + col + (dD ? 63 * 256 : 0); asm volatile("" : "+v"(RHv));
        const int colhalf = (col >> 7), strd = dD ? -256 : 256;
#define SUBST_ROW(i, m0, UPD) do { const int rowv = __float_as_int(MMv[(i) * 68]); const f32x2 sc2 = *(LAS const f32x2*)(MMv - lane + (i) * 68 + 64); \
            float a = RHv[(i) * strd] * (colhalf ? sc2.y : sc2.x) - ((i) >= 16 ? UPD[(i) & 31] : 0.f), a1 = 0.f, a2 = 0.f, a3 = 0.f; \
            _Pragma("unroll") for (int m = (m0); m < (i); ++m) { const float s = __int_as_float(__builtin_amdgcn_readlane(rowv, m)); \
                if ((m & 3) == 0) FNMS(a, s, x[m]); else if ((m & 3) == 1) FNMS(a1, s, x[m]); else if ((m & 3) == 2) FNMS(a2, s, x[m]); else FNMS(a3, s, x[m]); } \
            x[(i)] = (a + a1) + (a2 + a3); asm volatile("" ::: "memory"); } while (0)
#define XFRAG(kb) u32x4 b1, b2; { u32x4 lo, hh; \
            lo.x = cvt_pk_bf16(x[16 * (kb) + 0], x[16 * (kb) + 1]); lo.y = cvt_pk_bf16(x[16 * (kb) + 2], x[16 * (kb) + 3]); lo.z = cvt_pk_bf16(x[16 * (kb) + 4], x[16 * (kb) + 5]); lo.w = cvt_pk_bf16(x[16 * (kb) + 6], x[16 * (kb) + 7]); \
            hh.x = cvt_pk_bf16(x[16 * (kb) + 8], x[16 * (kb) + 9]); hh.y = cvt_pk_bf16(x[16 * (kb) + 10], x[16 * (kb) + 11]); hh.z = cvt_pk_bf16(x[16 * (kb) + 12], x[16 * (kb) + 13]); hh.w = cvt_pk_bf16(x[16 * (kb) + 14], x[16 * (kb) + 15]); \
            _Pragma("unroll") for (int q = 0; q < 4; ++q) { auto rr = __builtin_amdgcn_permlane32_swap(lo[q], hh[q], false, false); b1[q] = rr[0]; b2[q] = rr[1]; } }
#define MFRAG(rb, kb) ({ LAS const float* mr_ = MMv - lane + (32 * (rb) + r32) * 68 + 16 * (kb) + 8 * hi; const f32x4 ma_ = *(LAS const f32x4*)mr_, mb_ = *(LAS const f32x4*)(mr_ + 4); \
            pack8(ma_[0], ma_[1], ma_[2], ma_[3], mb_[0], mb_[1], mb_[2], mb_[3]); })
#define EXTRACT(UPD, O1, O2) do { _Pragma("unroll") for (int r = 0; r < 16; ++r) { auto rr = __builtin_amdgcn_permlane32_swap(__float_as_uint(O1[r]), __float_as_uint(O2[r]), false, false); \
            UPD[(r & 3) + 8 * (r >> 2)] = __uint_as_float(rr[0]); UPD[(r & 3) + 8 * (r >> 2) + 4] = __uint_as_float(rr[1]); } } while (0)
        float updl[32], updh[32];
        f32x16 o1l, o2l, o1h, o2h;
#pragma unroll
        for (int r = 0; r < 16; ++r) { o1l[r] = 0.f; o2l[r] = 0.f; o1h[r] = 0.f; o2h[r] = 0.f; }
#pragma unroll
        for (int q = 0; q < 32; ++q) { updl[q] = 0.f; updh[q] = 0.f; }
#pragma unroll
        for (int i = 0; i < 16; ++i) SUBST_ROW(i, 0, updl);
        { XFRAG(0); const bf16x8 al = MFRAG(0, 0), ah = MFRAG(1, 0);
          o1l = MFMA32(al, __builtin_bit_cast(bf16x8, b1), o1l); o2l = MFMA32(al, __builtin_bit_cast(bf16x8, b2), o2l);
          o1h = MFMA32(ah, __builtin_bit_cast(bf16x8, b1), o1h); o2h = MFMA32(ah, __builtin_bit_cast(bf16x8, b2), o2h); }
        EXTRACT(updl, o1l, o2l);
#pragma unroll
        for (int i = 16; i < 32; ++i) SUBST_ROW(i, 16, updl);
        { XFRAG(1); const bf16x8 ah = MFRAG(1, 1);
          o1h = MFMA32(ah, __builtin_bit_cast(bf16x8, b1), o1h); o2h = MFMA32(ah, __builtin_bit_cast(bf16x8, b2), o2h); }
        EXTRACT(updh, o1h, o2h);
#pragma unroll
        for (int i = 32; i < 48; ++i) SUBST_ROW(i, 32, updh);
        { XFRAG(2); const bf16x8 ah = MFRAG(1, 2);
          o1h = MFMA32(ah, __builtin_bit_cast(bf16x8, b1), o1h); o2h = MFMA32(ah, __builtin_bit_cast(bf16x8, b2), o2h); }
        EXTRACT(updh, o1h, o2h);
#pragma unroll
        for (int i = 48; i < 64; ++i) SUBST_ROW(i, 48, updh);
#undef SUBST_ROW
#undef XFRAG
#undef MFRAG
#undef EXTRACT
    }
    __syncthreads();
    {
        unsigned char* rec = A.ws + WS_G + (size_t)(uidx0 + dD) * GU_BYTES;
        if (col < 128) {
            unsigned* up = (unsigned*)(rec + GU_U); const int sl = col >> 5, dvl = col & 31;
#pragma unroll
            for (int ib = 0; ib < 2; ++ib)
#pragma unroll
                for (int p = 0; p < 8; ++p)
#pragma unroll
                    for (int hh = 0; hh < 2; ++hh) { const int i = 32 * ib + (2 * p & 3) + 8 * (2 * p >> 2) + 4 * hh; up[((ib * 4 + sl) * 8 + p) * 64 + hh * 32 + dvl] = cvt_pk_bf16(x[i], x[i + 1]); }
        } else {
            LAS bf16_t* wl = (LAS bf16_t*)(lds + (dD ? GL_KN : GL_QN));
#pragma unroll
            for (int i = 0; i < 64; ++i) wl[i * (GPITCH / 2) + (col - 128)] = (bf16_t)(cvt_pk_bf16(x[i], 0.f) & 0xffffu);
        }
    }
    __syncthreads();
    {
        unsigned char* rec = A.ws + WS_G + (size_t)(uidx0 + dD) * GU_BYTES; const int wl0 = dD ? GL_KN : GL_QN;
#pragma unroll
        for (int ff = 0; ff < 4; ++ff) { const int f = (wave & 3) * 4 + ff, ib = f >> 3, rb = (f >> 1) & 3, s = f & 1; const int i = 32 * ib + r32, dk0 = 32 * rb + 16 * s + 4 * hi;
            const u32x2 a = *(LAS const u32x2*)(lds + wl0 + i * GPITCH + dk0 * 2), b = *(LAS const u32x2*)(lds + wl0 + i * GPITCH + (dk0 + 8) * 2);
            ((u32x4*)(rec + GU_W))[f * 64 + lane] = (u32x4){a.x, a.y, b.x, b.y}; }
    }
    __syncthreads();
}
#undef FNMA
#undef FNMS
#undef BFV
constexpr int CW_GI = 24576;
__device__ __forceinline__ void ph_gdn_intra(const Args& A, LAS unsigned char* lds, int l, int it) {
    const int G = (int)gridDim.x, u0 = (int)((blockIdx.x + G - (G > 32 ? 32 : 0)) % G);
    unsigned done = 0u;
    for (int u = u0; u < HB * NCH * 8; u += G) { const int h = u & 7, t = u >> 3, ch = t % NCH, bl = t / NCH; gdn_intra_unit(A, lds, l, bl, ch, h); ++done; }
    asm volatile("s_waitcnt vmcnt(0)" ::: "memory"); __syncthreads();
    if (threadIdx.x == 0) { __builtin_amdgcn_fence(__ATOMIC_RELEASE, "agent"); asm volatile("s_waitcnt vmcnt(0)" ::: "memory"); (void)xb_add((unsigned*)(A.ws + WS_CTL) + CW_GI + 64 * it, done); }
}
__device__ __forceinline__ void gdn_scan_wait(const Args& A, int it) {
    unsigned* ctl = (unsigned*)(A.ws + WS_CTL); unsigned* gc = ctl + CW_GI + 64 * it;
    if (threadIdx.x == 0) { XB_SPIN(xb_ld(gc) < (unsigned)(HB * NCH * 8), ctl + CW_BAR); __builtin_amdgcn_fence(__ATOMIC_ACQUIRE, "agent"); asm volatile("s_waitcnt vmcnt(0)" ::: "memory"); }
    __syncthreads();
}
constexpr int SC_SLOT = 57344, SC_OST = 2 * SC_SLOT;
__device__ __forceinline__ void gdn_scan_unit(const Args& A, LAS unsigned char* lds, int bl, int h, int d) {
    const int tid = tid_opaque(), lane = tid & 63, r32 = lane & 31, hi = lane >> 5, wave = __builtin_amdgcn_readfirstlane(tid >> 6);
#define SC_CH(step) (d ? ((step) < 4 ? 3 - (step) : NCH + 3 - (step)) : (step))
#define SC_UIDX(step) (((bl * NCH + SC_CH(step)) * 8 + h) * 2 + d)
    if (wave >= 4) {
        const int lw = wave - 4;
#define SC_ISSUE(step, slot) do { const unsigned char* rec_ = A.ws + WS_G + (size_t)SC_UIDX(step) * GU_BYTES + lane * 16; \
        _Pragma("unroll") for (int k_ = 0; k_ < 14; ++k_) __builtin_amdgcn_global_load_lds((const unsigned*)(rec_ + (lw * 14 + k_) * 1024), (LAS unsigned*)(lds + (slot) * SC_SLOT + (lw * 14 + k_) * 1024), 16, 0, 0); } while (0)
        SC_ISSUE(0, 0);
        asm volatile("s_waitcnt vmcnt(0)" ::: "memory"); __builtin_amdgcn_s_barrier();
        for (int step = 0; step < NCH; ++step) {
            if (step + 1 < NCH) SC_ISSUE(step + 1, (step + 1) & 1);
            asm volatile("s_waitcnt vmcnt(0)" ::: "memory"); __builtin_amdgcn_s_barrier();
        }
#undef SC_ISSUE
        return;
    }
    const int sl = wave;
    bf16_t* O = (bf16_t*)(A.ws + WS_H) + (size_t)d * HR * 1024;
    const float* GLv = (const float*)(A.ws + WS_GL);
    LAS unsigned char* ost = lds + SC_OST + sl * 4096;
    f32x16 S[4];
#pragma unroll
    for (int rb = 0; rb < 4; ++rb)
#pragma unroll
        for (int r = 0; r < 16; ++r) S[rb][r] = 0.f;
    unsigned un[16]; float gln;
    { const unsigned* Up = (const unsigned*)(A.ws + WS_G + (size_t)SC_UIDX(0) * GU_BYTES + GU_U) + lane;
#pragma unroll
      for (int q = 0; q < 16; ++q) un[q] = Up[(((q >> 3) * 4 + sl) * 8 + (q & 7)) * 64];
      gln = GLv[SC_UIDX(0)]; }
    __builtin_amdgcn_s_barrier();
    for (int step = 0; step < NCH; ++step) {
        const int ch = SC_CH(step);
        LAS const unsigned char* slot = lds + (step & 1) * SC_SLOT + lane * 16;
        unsigned uc[16]; const float gl = gln;
#pragma unroll
        for (int q = 0; q < 16; ++q) uc[q] = un[q];
        if (step + 1 < NCH) { const unsigned* Up = (const unsigned*)(A.ws + WS_G + (size_t)SC_UIDX(step + 1) * GU_BYTES + GU_U) + lane;
#pragma unroll
            for (int q = 0; q < 16; ++q) un[q] = Up[(((q >> 3) * 4 + sl) * 8 + (q & 7)) * 64];
            gln = GLv[SC_UIDX(step + 1)]; }
        f32x16 vn[2], o[2];
#pragma unroll
        for (int ib = 0; ib < 2; ++ib)
#pragma unroll
            for (int r = 0; r < 16; ++r) { vn[ib][r] = 0.f; o[ib][r] = 0.f; }
#pragma unroll
        for (int rb = 0; rb < 4; ++rb)
#pragma unroll
            for (int s = 0; s < 2; ++s) {
                const bf16x8 sb = pack8(S[rb][8 * s], S[rb][8 * s + 1], S[rb][8 * s + 2], S[rb][8 * s + 3], S[rb][8 * s + 4], S[rb][8 * s + 5], S[rb][8 * s + 6], S[rb][8 * s + 7]);
#pragma unroll
                for (int ib = 0; ib < 2; ++ib) { const int f = (ib * 4 + rb) * 2 + s;
                    vn[ib] = MFMA32(*(LAS const bf16x8*)(slot + GU_W + f * 1024), sb, vn[ib]); o[ib] = MFMA32(*(LAS const bf16x8*)(slot + GU_QG + f * 1024), sb, o[ib]); }
            }
#pragma unroll
        for (int ib = 0; ib < 2; ++ib)
#pragma unroll
            for (int p = 0; p < 8; ++p) { const unsigned w = uc[ib * 8 + p]; vn[ib][2 * p] = bf_lo(w) - vn[ib][2 * p]; vn[ib][2 * p + 1] = bf_hi(w) - vn[ib][2 * p + 1]; }
        bf16x8 vb[2][2];
#pragma unroll
        for (int ib = 0; ib < 2; ++ib) { vb[ib][0] = pack8(vn[ib][0], vn[ib][1], vn[ib][2], vn[ib][3], vn[ib][4], vn[ib][5], vn[ib][6], vn[ib][7]);
            vb[ib][1] = pack8(vn[ib][8], vn[ib][9], vn[ib][10], vn[ib][11], vn[ib][12], vn[ib][13], vn[ib][14], vn[ib][15]); }
#pragma unroll
        for (int ib = 0; ib < 2; ++ib)
#pragma unroll
            for (int jb = 0; jb < 2; ++jb)
#pragma unroll
                for (int s = 0; s < 2; ++s) o[ib] = MFMA32(*(LAS const bf16x8*)(slot + GU_AT + (ib * 4 + 2 * jb + s) * 1024), vb[jb][s], o[ib]);
#pragma unroll
        for (int rb = 0; rb < 4; ++rb) { S[rb] = S[rb] * gl;
#pragma unroll
            for (int ib = 0; ib < 2; ++ib)
#pragma unroll
                for (int s = 0; s < 2; ++s) S[rb] = MFMA32(*(LAS const bf16x8*)(slot + GU_KD + ((rb * 2 + ib) * 2 + s) * 1024), vb[ib][s], S[rb]); }
#pragma unroll
        for (int ib = 0; ib < 2; ++ib)
#pragma unroll
            for (int r = 0; r < 16; ++r) { const int i = 32 * ib + crow(r, hi); const int c = d ? 63 - i : i; *(LAS bf16_t*)(ost + c * 64 + r32 * 2) = (bf16_t)(cvt_pk_bf16(o[ib][r], 0.f) & 0xffffu); }
        asm volatile("s_waitcnt lgkmcnt(0)" ::: "memory");
        bf16_t* obase = O + ((size_t)bl * RB + ch * 64) * 1024 + h * 128 + 32 * sl;
#pragma unroll
        for (int k = 0; k < 4; ++k) { const int id = k * 64 + lane; const u32x4 v = *(LAS const u32x4*)(ost + id * 16); *(u32x4*)(obase + (size_t)(id >> 2) * 1024 + (id & 3) * 8) = v; }
        asm volatile("s_waitcnt lgkmcnt(0)" ::: "memory"); __builtin_amdgcn_s_barrier();
    }
#undef SC_CH
#undef SC_UIDX
}
__device__ __forceinline__ void ph_gdn_post(const Args& A, int l_, bool dry) {
    const int l = opaque_s(l_);
    const int tid = tid_opaque(), lane = tid & 63, gw = blockIdx.x * NWAVES + (tid >> 6), NGW = gridDim.x * NWAVES;
    const bf16_t* OF = (const bf16_t*)(A.ws + WS_H); const bf16_t* OB = OF + (size_t)HR * 1024; bf16_t* P = (bf16_t*)(A.ws + WS_P);
    const float* nw = A.in[I_DNNORM] + l * 128 + (lane & 7) * 16;
    for (int r0 = 2 * gw; r0 < HR; r0 += 2 * NGW) {
        u32x4 f0[2], f1[2], b0[2], b1[2], z0[2], z1[2];
#pragma unroll
        for (int k = 0; k < 2; ++k) { const size_t r = (size_t)(r0 + k);
            f0[k] = *(const u32x4*)(OF + r * 1024 + lane * 16); f1[k] = *(const u32x4*)(OF + r * 1024 + lane * 16 + 8);
            b0[k] = *(const u32x4*)(OB + r * 1024 + lane * 16); b1[k] = *(const u32x4*)(OB + r * 1024 + lane * 16 + 8);
            const bf16_t* zq = P + r * LDP + C_Z + lane * 16; z0[k] = *(const u32x4*)zq; z1[k] = *(const u32x4*)(zq + 8); }
#pragma unroll
        for (int k = 0; k < 2; ++k) { const size_t r = (size_t)(r0 + k);
            bf16_t* zp = P + r * LDP + C_Z + lane * 16;
            float o[16], z[16]; float ss = 0.f;
#pragma unroll
            for (int q = 0; q < 4; ++q) { o[2 * q] = bf_lo(f0[k][q]) + bf_lo(b0[k][q]); o[2 * q + 1] = bf_hi(f0[k][q]) + bf_hi(b0[k][q]); o[8 + 2 * q] = bf_lo(f1[k][q]) + bf_lo(b1[k][q]); o[8 + 2 * q + 1] = bf_hi(f1[k][q]) + bf_hi(b1[k][q]);
                z[2 * q] = bf_lo(z0[k][q]); z[2 * q + 1] = bf_hi(z0[k][q]); z[8 + 2 * q] = bf_lo(z1[k][q]); z[8 + 2 * q + 1] = bf_hi(z1[k][q]); }
#pragma unroll
            for (int e = 0; e < 16; ++e) ss += o[e] * o[e];
            ss += __shfl_xor(ss, 1); ss += __shfl_xor(ss, 2); ss += __shfl_xor(ss, 4);
            const float rn = 1.0f / sqrtf(ss * (1.0f / 128.0f) + 1e-6f);
#pragma unroll
            for (int e = 0; e < 16; ++e) o[e] = o[e] * rn * nw[e] * silu_f(z[e]);
            u32x4 w0, w1; w0.x = cvt_pk_bf16(o[0], o[1]); w0.y = cvt_pk_bf16(o[2], o[3]); w0.z = cvt_pk_bf16(o[4], o[5]); w0.w = cvt_pk_bf16(o[6], o[7]);
            w1.x = cvt_pk_bf16(o[8], o[9]); w1.y = cvt_pk_bf16(o[10], o[11]); w1.z = cvt_pk_bf16(o[12], o[13]); w1.w = cvt_pk_bf16(o[14], o[15]);
            bf16_t* zo = dry ? (bf16_t*)(A.ws + WS_TRASH) + tid * 16 : zp;
            *(u32x4*)zo = w0; *(u32x4*)(zo + 8) = w1;
        }
    }
}
constexpr int NPH = 1 + 14 * 4;
__host__ __device__ inline bool phase_is_noop(int id) { if (id == 0) return false; const int it = (id - 1) / 14, k = (id - 1) % 14; return (k == 0 && it != 2) || k == 4 || k == 6 || (k == 1 && it == 2); }
__global__ void __launch_bounds__(NTHR, 2) fwd(Args A0) {
    extern __shared__ __attribute__((aligned(16))) unsigned char lds_raw[];
    LAS unsigned char* lds = (LAS unsigned char*)lds_raw;
    volatile LAS unsigned* MISC = (volatile LAS unsigned*)(lds + LDSCTL_OFF + 320);
    for (int u = threadIdx.x; u < (LDS_BYTES - LDSCTL_OFF) / 4; u += NTHR) ((LAS unsigned*)(lds + LDSCTL_OFF))[u] = 0u;
    __syncthreads();
    const int lo = A0.ph_lo, hi = A0.ph_hi, G = gridDim.x, bid = blockIdx.x;
    unsigned char* ws0 = A0.ws;
    XcdBarrier bar; bar.bar = (unsigned*)(ws0 + WS_CTL) + CW_BAR; bar.x = 0; bar.st = nullptr;
    if (hi - lo > 1) bar = xcd_barrier_post((unsigned*)(ws0 + WS_CTL) + CW_BAR, MISC + 8);
#ifndef PHMASK
#define PHMASK 0x7fff
#endif
#ifndef DUP_MASK
#define DUP_MASK 0
#endif
#define EXTRA_BAR 0
#define STAGGER_TICKS 500
#define GA_ true
#define GS_ true
#define RUNK(k, id, ...) do { if (((PHMASK >> (k)) & 1) && lo <= (id) && (id) < hi) { \
    KA_T ap_ = (KA_T)__builtin_amdgcn_kernarg_segment_ptr(); asm volatile("" : "+s"(ap_)); const Args& A = *(const Args*)ap_; unsigned char* ws = A.ws; \
    bf16_t* H = (bf16_t*)(ws + WS_H); bf16_t* P = (bf16_t*)(ws + WS_P); (void)H; (void)P; \
    if ((DUP_MASK >> (k)) & 1) { dry = true; __VA_ARGS__; xcd_barrier(bar); dry = false; } \
    __VA_ARGS__; if ((id) + 1 < hi) { xcd_barrier(bar); if (EXTRA_BAR) { xcd_barrier(bar); xcd_barrier(bar); } } } } while (0)
    typedef const __attribute__((address_space(4))) Args* KA_T;
    bool dry = false;
#define STAGGER() do { const unsigned long long t0_ = __builtin_amdgcn_s_memrealtime(); const unsigned long long dl_ = (unsigned long long)(STAGGER_TICKS * (bid & 7)); while (__builtin_amdgcn_s_memrealtime() - t0_ < dl_) __builtin_amdgcn_s_sleep(16); } while (0)
    RUNK(14, 0, { ph_prologue(A, lds); __syncthreads(); ph_weights(A, lds, 0); });
    for (int it = 0; it < 4; ++it) {
        const int l = it >> 1, half = (it ^ (it >> 1)) & 1, base = 1 + 14 * it;
        if (it == 2) RUNK(0, base + 0, { ph_weights(A, lds, 1); });
        if (it != 2) RUNK(1, base + 1, { ph_adaln(A, l, half); });
        RUNK(2, base + 2, {
            pg8::Gemm g{H, (const bf16_t*)(ws + WS_WIN), HR, NWIN, 2048, 2048, 2048};
            pg8::EpiInProj E{P, LDP, (float*)(ws + WS_AB), (const float*)(ws + WS_ROPEA), (const float*)(ws + WS_ROPED), A.in[I_ALOG] + l * 16, A.in[I_DTB] + l * 16, 0.08838834764831845f * LOG2E, 0.125f * LOG2E, dry};
            if (l == 0) { pg8::InProjFirstOrder S; S.init(G, bid); pg8::gemm_phase<pg8::EpiInProj, pg8::InProjFirstOrder, GA_, GS_>(lds, g, S, E); }
            else { pg8::InProjLastOrder S; S.init(NWIN, G, bid); pg8::gemm_phase<pg8::EpiInProj, pg8::InProjLastOrder, GA_, GS_>(lds, g, S, E); } });
        RUNK(3, base + 3, {
            if (l == 0) {
                pg8::Gemm g{H, (const bf16_t*)(ws + WS_WIN), HR, NWIN, 2048, 2048, 2048};
                pg8::EpiInProj E{P, LDP, (float*)(ws + WS_AB), (const float*)(ws + WS_ROPEA), (const float*)(ws + WS_ROPED), A.in[I_ALOG] + l * 16, A.in[I_DTB] + l * 16, 0.08838834764831845f * LOG2E, 0.125f * LOG2E, false};
                pg8::InProjDeferOrder S; S.init(G, bid); pg8::gemm_phase<pg8::EpiInProj, pg8::InProjDeferOrder, GA_, GS_>(lds, g, S, E);
                asm volatile("s_waitcnt vmcnt(0)" ::: "memory"); __syncthreads(); }
            ph_gdn_intra(A, lds, l, it);
            if (bid < HB * 8 * 2) { gdn_scan_wait(A, it); gdn_scan_unit(A, lds, bid >> 4, (bid >> 1) & 7, bid & 1); }
            ph_attention(A, lds, l, half, it, dry); });
        RUNK(5, base + 5, { ph_gdn_post(A, l, dry); });
        RUNK(7, base + 7, {
            pg8::Gemm g{P + C_QA, (const bf16_t*)(ws + WS_WPA), HR, 2048, 1024, LDP, 1024}; pg8::EpiMerge3 E{P + C_G, LDP, (bf16_t*)(ws + WS_M), 2048};
            { pg8::Merge3Order<pg8::LatentOrder> S; S.base.init(2048, G, bid); S.aofs1 = C_QD - C_QA; S.aofs2 = C_Z - C_QA; S.bstride = 2048 * 1024;
                pg8::gemm_phase<pg8::EpiMerge3, pg8::Merge3Order<pg8::LatentOrder>, GA_, GS_>(lds, g, S, E); }
            if (l == 0) { pg8::CtxBranchOrder S; S.aofs1 = C_QD - C_QA; S.aofs2 = C_Z - C_QA; S.bstride = 2048 * 1024; S.G = G; S.c = bid;
                pg8::EpiMergeCtx Ec{P + C_G, LDP, (bf16_t*)(ws + WS_MC)}; pg8::gemm_phase<pg8::EpiMergeCtx, pg8::CtxBranchOrder, GA_, GS_>(lds, g, S, Ec); } });
        RUNK(8, base + 8, {
            pg8::Gemm g{(const bf16_t*)(ws + WS_M), (const bf16_t*)(ws + WS_WO), HR, 2048, 2048, 2048, 2048}; pg8::EpiBf16 E{(bf16_t*)(ws + WS_OX), 2048};
            { pg8::LatentOrder S; S.init(2048, G, bid); pg8::gemm_phase<pg8::EpiBf16, pg8::LatentOrder, GA_, GS_>(lds, g, S, E); }
            if (l == 0) { pg8::Gemm gs{(const bf16_t*)(ws + WS_MC), (const bf16_t*)(ws + WS_WO), 512, 2048, 512, 2048, 2048}; pg8::CtxSplit3Order S; S.G = G; S.c = bid;
                pg8::EpiBf16Part Ep{(bf16_t*)(ws + WS_PART)}; pg8::gemm_phase<pg8::EpiBf16Part, pg8::CtxSplit3Order, GA_, GS_>(lds, gs, S, Ep); } });
        RUNK(9, base + 9, { ph_resln<true>(A, l, half, (const bf16_t*)(ws + WS_OX), 12, 2, A.in[I_LN1G] + l * DM, A.in[I_LN1B] + l * DM, dry); });
        RUNK(10, base + 10, {
            pg8::Gemm g{H, (const bf16_t*)(ws + WS_WUP), HR, NUP, 2048, 2048, 2048}; pg8::EpiBf16 E{(bf16_t*)(ws + WS_U), NUP};
            { pg8::LatentOrder S; S.init(NUP, G, bid); pg8::gemm_phase<pg8::EpiBf16, pg8::LatentOrder, GA_, GS_>(lds, g, S, E); }
            if (l == 0) { pg8::Gemm gs{H, (const bf16_t*)(ws + WS_WUP), HR, NUP, 1024, 2048, 2048}; pg8::UpCtxOrder S; S.G = G; S.c = bid;
                pg8::EpiUpCtx Ec{(bf16_t*)(ws + WS_U), (bf16_t*)(ws + WS_PART), NUP}; pg8::gemm_phase<pg8::EpiUpCtx, pg8::UpCtxOrder, GA_, GS_>(lds, gs, S, Ec); } });
        RUNK(11, base + 11, { ph_convact(A, l); });
        RUNK(12, base + 12, {
            pg8::Gemm g{(const bf16_t*)(ws + WS_ACT), (const bf16_t*)(ws + WS_WDN), HR, 2048, DFF, DFF, DFF}; pg8::EpiBf16 E{(bf16_t*)(ws + WS_FX), 2048};
            { pg8::LatentOrder S; S.init(2048, G, bid); pg8::gemm_phase<pg8::EpiBf16, pg8::LatentOrder, GA_, GS_>(lds, g, S, E); }
            if (l == 0) { pg8::Gemm gs{(const bf16_t*)(ws + WS_ACT), (const bf16_t*)(ws + WS_WDN), HR, 2048, 512, DFF, DFF}; pg8::CtxSplitOrder S; S.init(11, 512, G, bid);
                pg8::EpiBf16Part Ep{(bf16_t*)(ws + WS_PART)}; pg8::gemm_phase<pg8::EpiBf16Part, pg8::CtxSplitOrder, GA_, GS_>(lds, gs, S, Ep); } });
        RUNK(13, base + 13, { ph_resln<false>(A, l, half, (const bf16_t*)(ws + WS_FX), 11, 5, A.in[I_LN2G] + l * DM, A.in[I_LN2B] + l * DM, dry, it == 1); });
    }
#undef RUNK
}

#ifndef MK_ONE_LAUNCH
#define MK_ONE_LAUNCH 1
#endif
extern "C" void kernel_launch(void* const* d_in, const int* in_sizes, int n_in, void* d_out, int out_size, void* d_ws, size_t ws_size, hipStream_t stream) {
    static int grid = 0;
    if (grid == 0) {
        if (n_in != 29 || out_size != NBATCH * SEQ * DM || ws_size < WS_END) { fprintf(stderr, "kernel_launch: unexpected problem (n_in %d, out %d, ws %zu < %zu)\n", n_in, out_size, ws_size, (size_t)WS_END); grid = -1; return; }
        int dev = 0, cus = 0, per_cu = 0;
        if (hipGetDevice(&dev) != hipSuccess || hipDeviceGetAttribute(&cus, hipDeviceAttributeMultiprocessorCount, dev) != hipSuccess) { grid = -1; return; }
        if (hipFuncSetAttribute((const void*)fwd, hipFuncAttributeMaxDynamicSharedMemorySize, LDS_BYTES) != hipSuccess) { fprintf(stderr, "kernel_launch: hipFuncSetAttribute failed\n"); grid = -1; return; }
        if (hipOccupancyMaxActiveBlocksPerMultiprocessor(&per_cu, (const void*)fwd, NTHR, LDS_BYTES) != hipSuccess || per_cu < 1) fprintf(stderr, "kernel_launch: occupancy query reports %d\n", per_cu);
        (void)hipGetLastError();
        grid = cus > 256 ? 256 : cus;
    }
    if (grid < 0) return;
    (void)hipMemsetAsync((char*)d_ws + WS_CTL, 0, CTL_ZERO_BYTES, stream);
    Args a{};
    for (int i = 0; i < 29; ++i) a.in[i] = (const float*)d_in[i];
    a.out = (float*)d_out; a.ws = (unsigned char*)d_ws;
#if MK_ONE_LAUNCH
    a.ph_lo = 0; a.ph_hi = NPH;
    hipLaunchKernelGGL(fwd, dim3(grid), dim3(NTHR), LDS_BYTES, stream, a);
#else
    for (int id = 0; id < NPH; ++id) { if (phase_is_noop(id)) continue; a.ph_lo = id; a.ph_hi = id + 1; hipLaunchKernelGGL(fwd, dim3(grid), dim3(NTHR), LDS_BYTES, stream, a); }
#endif
}
```

```cpp
#include <hip/hip_runtime.h>
#include <cstdio>
#include <cstdint>
#include <cmath>
namespace pg8 {
#define PG8_LAS __attribute__((address_space(3)))
typedef unsigned short bf16_t;
typedef short bf16x8 __attribute__((ext_vector_type(8)));
typedef float f32x4 __attribute__((ext_vector_type(4)));
typedef unsigned u32x4 __attribute__((ext_vector_type(4)));
constexpr int BM = 256, BK = 64, HALF = 128, HTB = HALF * BK * 2  , STAGE_BYTES = 8 * HTB, NXCD = 8, WGM = 4;

__host__ __device__ __forceinline__ int lds_byte(int r, int c) { const int st = (r >> 4) * 2 + (c >> 5), rr = r & 15, cc = c & 31, ob = rr * 64 + cc * 2; return st * 1024 + (ob ^ (((ob >> 9) & 1) << 5)); }
__host__ __device__ __forceinline__ void stage_rc(int b, int& R, int& C) { const int st = b / 1024, sb = b % 1024, swz = sb ^ (((sb >> 9) & 1) << 5); R = (st >> 1) * 16 + swz / 64; C = (st & 1) * 32 + (swz % 64) / 2; }
__host__ __device__ __forceinline__ int perm32(int rho) { const int n = rho >> 4, i = rho & 15; return 8 * (i >> 2) + 4 * n + (i & 3); }

struct Unit { int pm, pn, kofs, bofs, ks, keep; };
struct Gemm { const bf16_t* A; const bf16_t* Bt; int M, N, K, lda, ldb; };

struct StaticOrder {
    int nM, nN, nwg, G, c;
    __host__ __device__ void init(int M, int N, int G_, int c_) { nM = M / BM; nN = N / BM; nwg = nM * nN; G = G_; c = c_; }
    __host__ __device__ bool next(int i, Unit& u) const {
        const long L = (long)i * G + c; if (L >= nwg) return false;
        int wgid = (int)L; { const int q = nwg / NXCD, r = nwg % NXCD, xcd = wgid % NXCD, off = wgid / NXCD; wgid = (xcd < r ? xcd * (q + 1) : r * (q + 1) + (xcd - r) * q) + off; }
        const int nig = WGM * nN, gid = wgid / nig, fm = gid * WGM, gsz = (nM - fm) < WGM ? (nM - fm) : WGM;
        u.pm = fm + ((wgid % nig) % gsz); u.pn = (wgid % nig) / gsz; u.kofs = 0; u.bofs = 0; u.ks = 0; u.keep = 0; return true;
    }
    __device__ __forceinline__ void a_ready(const Unit&) const {}
    __device__ __forceinline__ void done(const Unit&) const {}
};
struct InProjLastOrder : StaticOrder {
    __host__ __device__ void init(int N, int G_, int c_) { StaticOrder::init(64 * BM, N, G_, c_); }
    __host__ __device__ bool next(int i, Unit& u) const {
        const long L = (long)i * G + c;
        if (L < nwg) { StaticOrder::next(i, u); u.pm += 1 + (u.pm >= 32 ? 1 : 0); return true; }
        const int e = (int)(L - nwg); if (e >= 46) return false;
        const int k = e % 23; u.pm = (e >= 23) ? 33 : 0; u.pn = (k < 2) ? 4 + k : (k < 22) ? 8 + k : 58; u.kofs = 0; u.bofs = 0; u.ks = 0; u.keep = 0; return true;
    }
};
#define DEFER_TAIL 12
struct InProjFirstOrder : StaticOrder {
    __host__ __device__ void init(int G_, int c_) { StaticOrder::init(66 * BM, 58 * BM, G_, c_); }
    __host__ __device__ bool next(int i, Unit& u) const {
        const long L = (long)i * G + c;
        if (L < nwg) { StaticOrder::next(i, u); if (u.pn >= 57) u.pn = 58; return true; }
        const int e = (int)(L - nwg); if (e >= DEFER_TAIL) return false;
        u.pm = 66 - DEFER_TAIL + e; u.pn = 57; u.kofs = 0; u.bofs = 0; u.ks = 0; u.keep = 0; return true;
    }
};
struct InProjDeferOrder {
    int G, c;
    __host__ __device__ void init(int G_, int bid) { G = G_; c = (G_ > 48) ? (bid >= 48 ? bid - 48 : bid + G_ - 48) : bid; }
    __device__ bool next(int i, Unit& u) const { const long L = (long)i * G + c; if (L >= 66 - DEFER_TAIL) return false; int pn_ = 57; asm volatile("" : "+s"(pn_)); u.pm = (int)L; u.pn = pn_; u.kofs = 0; u.bofs = 0; u.ks = 0; u.keep = 0; return true; }
    __device__ __forceinline__ void a_ready(const Unit&) const {}
    __device__ __forceinline__ void done(const Unit&) const {}
};
struct CtxSplitOrder {
    int S, ksub, G, c;
    __host__ __device__ void init(int S_, int ksub_, int G_, int c_) { S = S_; ksub = ksub_; G = G_; c = c_; }
    __host__ __device__ bool next(int i, Unit& u) const { const long L = (long)i * G + c; if (L >= 16 * S) return false; const int e = (int)L, ks = e % S, t = e / S; u.pn = t & 7; u.pm = (t >> 3) ? 33 : 0; u.kofs = ks * ksub; u.bofs = u.kofs; u.ks = ks; u.keep = 0; return true; }
    __device__ __forceinline__ void a_ready(const Unit&) const {}
    __device__ __forceinline__ void done(const Unit&) const {}
};
struct CtxBranchOrder {
    int aofs1, aofs2, bstride, G, c;
    __host__ __device__ bool next(int i, Unit& u) const { const long L = (long)i * G + c; if (L >= 48) return false; const int e = (int)L, br = e % 3, t = e / 3; u.pn = t & 7; u.pm = (t >> 3) ? 33 : 0;
        u.kofs = (br == 0) ? 0 : (br == 1) ? aofs1 : aofs2; u.bofs = br * bstride; u.ks = br; u.keep = 0; return true; }
    __device__ __forceinline__ void a_ready(const Unit&) const {}
    __device__ __forceinline__ void done(const Unit&) const {}
};
struct CtxSplit3Order {
    int G, c;
    __host__ __device__ bool next(int i, Unit& u) const { const long L = (long)i * G + c; if (L >= 192) return false; const int e = (int)L, s = e % 12, t = e / 12, br = s >> 2, kq = s & 3; u.pn = t & 7; u.pm = t >> 3;
        u.kofs = br * 512 * 2048 + kq * 512; u.bofs = kq * 512; u.ks = s; u.keep = 0; return true; }
    __device__ __forceinline__ void a_ready(const Unit&) const {}
    __device__ __forceinline__ void done(const Unit&) const {}
};
struct LatentOrder : StaticOrder {
    __host__ __device__ void init(int N, int G_, int c_) { StaticOrder::init(64 * BM, N, G_, c_); }
    __host__ __device__ bool next(int i, Unit& u) const { if (!StaticOrder::next(i, u)) return false; u.pm += 1 + (u.pm >= 32 ? 1 : 0); return true; }
};


__device__ __forceinline__ unsigned cvt_pk_bf16(float lo, float hi) { unsigned r; asm volatile("v_cvt_pk_bf16_f32 %0, %1, %2" : "=v"(r) : "v"(lo), "v"(hi)); return r; }
__device__ __forceinline__ float bf_lo(unsigned w) { return __uint_as_float(w << 16); }
__device__ __forceinline__ float bf_hi(unsigned w) { return __uint_as_float(w & 0xffff0000u); }
__device__ __forceinline__ float sigm(float x) { return __builtin_amdgcn_rcpf(1.0f + __builtin_amdgcn_exp2f(x * -1.4426950408889634f)); }

struct EpiF32 {
    static constexpr bool PERM = false, AFTER_DRAIN = false;
    float* C; int ldc;
    __device__ __forceinline__ void operator()(const f32x4 (&acc)[2][2][4][2], const Unit& u, int wr, int wc, int fr, int fq) const {
        const int row0 = u.pm * BM + wr * 64 + fr, col0 = u.pn * BM + wc * 32 + 4 * fq;
#pragma unroll
        for (int ai = 0; ai < 2; ++ai)
#pragma unroll
            for (int m = 0; m < 4; ++m) { float* rowp = C + (size_t)(row0 + ai * HALF + m * 16) * ldc + col0;
#pragma unroll
                for (int bj = 0; bj < 2; ++bj)
#pragma unroll
                    for (int n = 0; n < 2; ++n) *(f32x4*)(rowp + bj * HALF + n * 16) = acc[ai][bj][m][n]; }
    }
};
struct EpiBf16 {
    static constexpr bool PERM = true, AFTER_DRAIN = false;
    bf16_t* O; int ldc;
    __device__ __forceinline__ void operator()(const f32x4 (&acc)[2][2][4][2], const Unit& u, int wr, int wc, int fr, int fq) const {
        const int row0 = u.pm * BM + wr * 64 + fr, col0 = u.pn * BM + wc * 32 + 8 * fq;
#pragma unroll
        for (int ai = 0; ai < 2; ++ai)
#pragma unroll
            for (int m = 0; m < 4; ++m) { bf16_t* rowp = O + (size_t)(row0 + ai * HALF + m * 16) * ldc + col0;
#pragma unroll
                for (int bj = 0; bj < 2; ++bj) { const f32x4 v0 = acc[ai][bj][m][0], v1 = acc[ai][bj][m][1];
                    u32x4 w; w.x = cvt_pk_bf16(v0[0], v0[1]); w.y = cvt_pk_bf16(v0[2], v0[3]); w.z = cvt_pk_bf16(v1[0], v1[1]); w.w = cvt_pk_bf16(v1[2], v1[3]);
                    *(u32x4*)(rowp + bj * HALF) = w; } }
    }
};
struct EpiBf16Part {
    static constexpr bool PERM = true, AFTER_DRAIN = false;
    bf16_t* O;
    __device__ __forceinline__ void operator()(const f32x4 (&acc)[2][2][4][2], const Unit& u, int wr, int wc, int fr, int fq) const {
        asm volatile("" : "+v"(fr), "+v"(fq));
        const int row0 = (u.pm ? 256 : 0) + wr * 64 + fr, col0 = u.pn * BM + wc * 32 + 8 * fq;
        bf16_t* base = O + (size_t)u.ks * 512 * 2048;
#pragma unroll
        for (int ai = 0; ai < 2; ++ai)
#pragma unroll
            for (int m = 0; m < 4; ++m) { bf16_t* rowp = base + (size_t)(row0 + ai * HALF + m * 16) * 2048 + col0;
#pragma unroll
                for (int bj = 0; bj < 2; ++bj) { const f32x4 v0 = acc[ai][bj][m][0], v1 = acc[ai][bj][m][1];
                    u32x4 w; w.x = cvt_pk_bf16(v0[0], v0[1]); w.y = cvt_pk_bf16(v0[2], v0[3]); w.z = cvt_pk_bf16(v1[0], v1[1]); w.w = cvt_pk_bf16(v1[2], v1[3]);
                    *(u32x4*)(rowp + bj * HALF) = w; } }
    }
};
template <int MODE> struct EpiMerge {
    static constexpr bool PERM = true, AFTER_DRAIN = false;
    const bf16_t* G; int ldg; bf16_t* T1; bf16_t* T2; bf16_t* Mo; int ldc;
    __device__ __forceinline__ void operator()(const f32x4 (&acc)[2][2][4][2], const Unit& u, int wr, int wc, int fr, int fq) const {
        asm volatile("" : "+v"(fr), "+v"(fq));
        const int row0 = u.pm * BM + wr * 64 + fr, col0 = u.pn * BM + wc * 32 + 8 * fq;
#pragma unroll
        for (int ai = 0; ai < 2; ++ai)
#pragma unroll
            for (int m = 0; m < 4; ++m) { const size_t row = (size_t)(row0 + ai * HALF + m * 16);
#pragma unroll
                for (int bj = 0; bj < 2; ++bj) { const int col = col0 + bj * HALF;
                    const u32x4 gw = *(const u32x4*)(G + row * ldg + col);
                    f32x4 g0 = (f32x4){bf_lo(gw.x), bf_hi(gw.x), bf_lo(gw.y), bf_hi(gw.y)}, g1 = (f32x4){bf_lo(gw.z), bf_hi(gw.z), bf_lo(gw.w), bf_hi(gw.w)};
                    f32x4 v0 = acc[ai][bj][m][0] * g0, v1 = acc[ai][bj][m][1] * g1;
                    if (MODE == 2) { const u32x4 a = *(const u32x4*)(T1 + row * ldc + col), b = *(const u32x4*)(T2 + row * ldc + col);
                        v0 += (f32x4){bf_lo(a.x) + bf_lo(b.x), bf_hi(a.x) + bf_hi(b.x), bf_lo(a.y) + bf_lo(b.y), bf_hi(a.y) + bf_hi(b.y)};
                        v1 += (f32x4){bf_lo(a.z) + bf_lo(b.z), bf_hi(a.z) + bf_hi(b.z), bf_lo(a.w) + bf_lo(b.w), bf_hi(a.w) + bf_hi(b.w)}; }
                    u32x4 w; w.x = cvt_pk_bf16(v0[0], v0[1]); w.y = cvt_pk_bf16(v0[2], v0[3]); w.z = cvt_pk_bf16(v1[0], v1[1]); w.w = cvt_pk_bf16(v1[2], v1[3]);
                    bf16_t* dst = (MODE == 0) ? T1 : (MODE == 1) ? T2 : Mo;
                    *(u32x4*)(dst + row * ldc + col) = w; }
                asm volatile("" ::: "memory"); }
    }
};
template <class Base> struct Merge3Order {
    Base base; int aofs1, aofs2, bstride;
    __host__ __device__ bool next(int i, Unit& u) const { const int t = i / 3, br = i - 3 * t; if (!base.next(t, u)) return false;
        u.kofs = (br == 0) ? 0 : (br == 1) ? aofs1 : aofs2; u.bofs = br * bstride; u.ks = br; u.keep = (br < 2) ? 1 : 0; return true; }
    __device__ __forceinline__ void a_ready(const Unit&) const {}
    __device__ __forceinline__ void done(const Unit&) const {}
};
struct EpiMerge3 {
    static constexpr bool PERM = true, AFTER_DRAIN = false;
    const bf16_t* G; int ldg; bf16_t* Mo; int ldc;
    __device__ __forceinline__ void operator()(f32x4 (&acc)[2][2][4][2], const Unit& u, int wr, int wc, int fr, int fq) const {
        asm volatile("" : "+v"(fr), "+v"(fq));
        const int row0 = u.pm * BM + wr * 64 + fr, col0 = u.pn * BM + wc * 32 + 8 * fq, br = u.ks;
#pragma unroll
        for (int ai = 0; ai < 2; ++ai)
#pragma unroll
            for (int m = 0; m < 4; ++m) { const size_t row = (size_t)(row0 + ai * HALF + m * 16);
#pragma unroll
                for (int bj = 0; bj < 2; ++bj) { const int col = col0 + bj * HALF;
                    const u32x4 gw = *(const u32x4*)(G + row * ldg + br * 2048 + col);
                    f32x4 g0 = (f32x4){bf_lo(gw.x), bf_hi(gw.x), bf_lo(gw.y), bf_hi(gw.y)}, g1 = (f32x4){bf_lo(gw.z), bf_hi(gw.z), bf_lo(gw.w), bf_hi(gw.w)};
                    if (br < 2) { const u32x4 hw = *(const u32x4*)(G + row * ldg + (br + 1) * 2048 + col);
#pragma unroll
                        for (int k = 0; k < 4; ++k) { const unsigned hv = k < 2 ? (k == 0 ? hw.x : hw.y) : (k == 2 ? hw.z : hw.w);
                            const float d0 = fmaxf(bf_lo(hv), 1e-30f), d1 = fmaxf(bf_hi(hv), 1e-30f);
                            if (k < 2) { g0[2 * k] *= __builtin_amdgcn_rcpf(d0); g0[2 * k + 1] *= __builtin_amdgcn_rcpf(d1); } else { g1[2 * k - 4] *= __builtin_amdgcn_rcpf(d0); g1[2 * k - 3] *= __builtin_amdgcn_rcpf(d1); } }
                        acc[ai][bj][m][0] = acc[ai][bj][m][0] * g0; acc[ai][bj][m][1] = acc[ai][bj][m][1] * g1;
                    } else { const f32x4 v0 = acc[ai][bj][m][0] * g0, v1 = acc[ai][bj][m][1] * g1;
                        u32x4 w; w.x = cvt_pk_bf16(v0[0], v0[1]); w.y = cvt_pk_bf16(v0[2], v0[3]); w.z = cvt_pk_bf16(v1[0], v1[1]); w.w = cvt_pk_bf16(v1[2], v1[3]);
                        *(u32x4*)(Mo + row * ldc + col) = w; } }
                asm volatile("" ::: "memory"); }
    }
};
struct EpiMergeCtx {
    static constexpr bool PERM = true, AFTER_DRAIN = false;
    const bf16_t* G; int ldg; bf16_t* O;
    __device__ __forceinline__ void operator()(const f32x4 (&acc)[2][2][4][2], const Unit& u, int wr, int wc, int fr, int fq) const {
        asm volatile("" : "+v"(fr), "+v"(fq));
        const int rl0 = wr * 64 + fr, col0 = u.pn * BM + wc * 32 + 8 * fq, br = u.ks;
        const bf16_t* Gp = G + (size_t)u.pm * BM * ldg + br * 2048; bf16_t* Op = O + ((size_t)br * 512 + (u.pm ? 256 : 0)) * 2048;
#pragma unroll
        for (int ai = 0; ai < 2; ++ai)
#pragma unroll
            for (int m = 0; m < 4; ++m) { const size_t r = (size_t)(rl0 + ai * HALF + m * 16);
#pragma unroll
                for (int bj = 0; bj < 2; ++bj) { const int col = col0 + bj * HALF;
                    const u32x4 gw = *(const u32x4*)(Gp + r * ldg + col);
                    const f32x4 g0 = (f32x4){bf_lo(gw.x), bf_hi(gw.x), bf_lo(gw.y), bf_hi(gw.y)}, g1 = (f32x4){bf_lo(gw.z), bf_hi(gw.z), bf_lo(gw.w), bf_hi(gw.w)};
                    const f32x4 v0 = acc[ai][bj][m][0] * g0, v1 = acc[ai][bj][m][1] * g1;
                    u32x4 w; w.x = cvt_pk_bf16(v0[0], v0[1]); w.y = cvt_pk_bf16(v0[2], v0[3]); w.z = cvt_pk_bf16(v1[0], v1[1]); w.w = cvt_pk_bf16(v1[2], v1[3]);
                    *(u32x4*)(Op + r * 2048 + col) = w; }
                asm volatile("" ::: "memory"); }
    }
};
struct EpiInProj {
    static constexpr bool PERM = true, AFTER_DRAIN = false;
    bf16_t* P; int ldp; float* AB; const float* ropeA; const float* ropeD; const float* a_log; const float* dt_bias; float sA, sD; bool light;
    __device__ __forceinline__ void operator()(const f32x4 (&acc)[2][2][4][2], const Unit& u, int wr, int wc, int fr, int fq) const {
        asm volatile("" : "+v"(fr), "+v"(fq));
        const int pn = u.pn, tib = u.pm % 33; const bool is_ctx = (tib == 0);
        const int row0 = u.pm * BM + wr * 64 + fr, t0 = tib * 256 - 256 + wr * 64 + fr, cl = wc * 32 + 8 * fq;
        int type; float scale = 1.f;
        if (pn <= 3) { type = 1; scale = sA; } else if (pn == 4) type = 1; else if (pn == 5) type = 0; else if (pn <= 9) { type = 2; scale = sD; } else if (pn <= 13) type = 2;
        else if (pn <= 33) type = 0; else if (pn <= 57) type = 3; else type = 4;
        if (light && type != 4) type = 0;
        if (type == 4) {
            if (wc == 0) {
                const int c = 8 * fq;
#pragma unroll
                for (int ai = 0; ai < 2; ++ai)
#pragma unroll
                    for (int m = 0; m < 4; ++m) { const size_t row = (size_t)(row0 + ai * HALF + m * 16); f32x4 v0 = acc[ai][0][m][0], v1 = acc[ai][0][m][1]; float o[8] = {v0[0], v0[1], v0[2], v0[3], v1[0], v1[1], v1[2], v1[3]};
#pragma unroll
                        for (int k = 0; k < 8; ++k) { if (c < 16) { const float x = o[k] + dt_bias[c + k]; const float sp = fmaxf(x, 0.f) + log1pf(__expf(-fabsf(x))); o[k] = -__expf(a_log[c + k]) * sp; } else o[k] = sigm(o[k]); }
                        *(f32x4*)(AB + row * 32 + c) = (f32x4){o[0], o[1], o[2], o[3]}; *(f32x4*)(AB + row * 32 + c + 4) = (f32x4){o[4], o[5], o[6], o[7]}; }
            }
            return;
        }
#pragma unroll
        for (int ai = 0; ai < 2; ++ai)
#pragma unroll
            for (int m = 0; m < 4; ++m) { const size_t row = (size_t)(row0 + ai * HALF + m * 16); const int t = t0 + ai * HALF + m * 16;
#pragma unroll
                for (int bj = 0; bj < 2; ++bj) { const int c = cl + bj * HALF; f32x4 v0 = acc[ai][bj][m][0], v1 = acc[ai][bj][m][1];
                    if ((type == 1 || type == 2) && !is_ctx) {
                        const float* tab;
                        if (type == 1) { const int p0 = (c & 127) >> 1; const int pos = (p0 >= 32) ? (t & 63) : (t >> 6); tab = ropeA + (pos * 32 + (p0 & 31)) * 2; }
                        else { const int p0 = (c & 63) >> 1; const int pos = (p0 >= 16) ? (t & 63) : (t >> 6); tab = ropeD + (pos * 16 + (p0 & 15)) * 2; }
                        const f32x4 cs0 = *(const f32x4*)tab, cs1 = *(const f32x4*)(tab + 4);
                        f32x4 r0, r1;
                        r0[0] = v0[0] * cs0[0] - v0[1] * cs0[1]; r0[1] = v0[1] * cs0[0] + v0[0] * cs0[1]; r0[2] = v0[2] * cs0[2] - v0[3] * cs0[3]; r0[3] = v0[3] * cs0[2] + v0[2] * cs0[3];
                        r1[0] = v1[0] * cs1[0] - v1[1] * cs1[1]; r1[1] = v1[1] * cs1[0] + v1[0] * cs1[1]; r1[2] = v1[2] * cs1[2] - v1[3] * cs1[3]; r1[3] = v1[3] * cs1[2] + v1[2] * cs1[3];
                        v0 = r0; v1 = r1;
                    }
                    if (type == 3) {
#pragma unroll
                        for (int k = 0; k < 4; ++k) { v0[k] = sigm(v0[k]); v1[k] = sigm(v1[k]); } }
                    v0 = v0 * scale; v1 = v1 * scale;
                    u32x4 w; w.x = cvt_pk_bf16(v0[0], v0[1]); w.y = cvt_pk_bf16(v0[2], v0[3]); w.z = cvt_pk_bf16(v1[0], v1[1]); w.w = cvt_pk_bf16(v1[2], v1[3]);
                    *(u32x4*)(P + row * ldp + pn * BM + c) = w; }
                asm volatile("" ::: "memory"); }
    }
};

template <class Epi, class Sched, bool ALIGN_EPI = false, bool SP2 = false>
__device__ __forceinline__ void gemm_phase(PG8_LAS unsigned char* lds, const Gemm g, const Sched& S, const Epi& E) {
    int tid_ = threadIdx.x; asm volatile("" : "+v"(tid_));
    const int tid = tid_, wid = __builtin_amdgcn_readfirstlane(tid >> 6), lane = tid & 63, wr = wid >> 2, wc = wid & 3, fr = lane & 15, fq = lane >> 4;
    const int K = g.K, nt = K / BK;
    unsigned voffA[2], voffB[2];
#pragma unroll
    for (int i = 0; i < 2; ++i) { int R, C; stage_rc(tid * 16 + i * 8192, R, C); const int Rb = Epi::PERM ? ((R & ~31) + perm32(R & 31)) : R;
        voffA[i] = (unsigned)(R * g.lda + C) * 2u; voffB[i] = (unsigned)(Rb * g.ldb + C) * 2u; }
    const size_t kstep = (size_t)(BK * 2);
    const size_t hstepB = (size_t)HALF * g.ldb * 2, hstepA = (size_t)HALF * g.lda * 2;
    const size_t tstepA = 2 * hstepA, tstepB = 2 * hstepB;
    const unsigned ldsw = (unsigned)wid * 1024u;
    const int aoff = lds_byte(wr * 64 + fr, fq * 8), boff = lds_byte(wc * 32 + fr, fq * 8);
#define PG8_SA(b, h) (((b) * 2 + (h)) * HTB)
#define PG8_SB(b, h) ((4 + (b) * 2 + (h)) * HTB)
#define PG8_STAGE(bufoff, gbase, voff) do { _Pragma("unroll") for (int _i = 0; _i < 2; ++_i) \
        __builtin_amdgcn_global_load_lds((const unsigned*)((const char*)(gbase) + (voff)[_i]), (PG8_LAS unsigned*)(lds + (bufoff) + ldsw + _i * 8192), 16, 0, 0); } while (0)
#define PG8_LDA(dst, b, h) do { _Pragma("unroll") for (int m = 0; m < 4; ++m) _Pragma("unroll") for (int k = 0; k < 2; ++k) dst[m][k] = *(const PG8_LAS bf16x8*)(lds + PG8_SA(b, h) + aoff + m * 2048 + k * 1024); } while (0)
#define PG8_LDB(dst, b, h) do { _Pragma("unroll") for (int n = 0; n < 2; ++n) _Pragma("unroll") for (int k = 0; k < 2; ++k) dst[n][k] = *(const PG8_LAS bf16x8*)(lds + PG8_SB(b, h) + boff + n * 2048 + k * 1024); } while (0)
#define PG8_MMA(ai, bj, At, Bt) do { __builtin_amdgcn_s_setprio(1); _Pragma("unroll") for (int m = 0; m < 4; ++m) _Pragma("unroll") for (int n = 0; n < 2; ++n) _Pragma("unroll") for (int k = 0; k < 2; ++k) \
        acc[ai][bj][m][n] = __builtin_amdgcn_mfma_f32_16x16x32_bf16(Bt[n][k], At[m][k], acc[ai][bj][m][n], 0, 0, 0); __builtin_amdgcn_s_setprio(0); } while (0)
#define PG8_WAIT_V(n) asm volatile("s_waitcnt vmcnt(" #n ")" ::: "memory")
#define PG8_WAIT_L(n) asm volatile("s_waitcnt lgkmcnt(" #n ")" ::: "memory")
#define PG8_BAR __builtin_amdgcn_s_barrier()
#define PG8_SCHED __builtin_amdgcn_sched_barrier(0)
    Unit cur, nxt; int ui = 0;
    if (!S.next(0, cur)) return;
    f32x4 acc[2][2][4][2];
#pragma unroll
    for (int a = 0; a < 2; ++a)
#pragma unroll
        for (int b = 0; b < 2; ++b)
#pragma unroll
            for (int m = 0; m < 4; ++m)
#pragma unroll
                for (int n = 0; n < 2; ++n) acc[a][b][m][n] = (f32x4){0.f, 0.f, 0.f, 0.f};
    bf16x8 At[4][2], B0[2][2], B1[2][2];
    const char* cA = (const char*)g.A + (size_t)cur.pm * tstepA + (size_t)cur.kofs * 2; const char* cB = (const char*)g.Bt + (size_t)cur.pn * tstepB + (size_t)cur.bofs * 2;
    S.a_ready(cur);
    if constexpr (SP2) {
        PG8_STAGE(PG8_SB(0, 0), cB, voffB); PG8_STAGE(PG8_SB(0, 1), cB + hstepB, voffB); PG8_STAGE(PG8_SA(0, 0), cA, voffA); PG8_STAGE(PG8_SA(0, 1), cA + hstepA, voffA);
        if (wr == 1) PG8_BAR;
        PG8_WAIT_V(2); PG8_BAR;
        PG8_STAGE(PG8_SB(1, 0), cB + kstep, voffB); PG8_STAGE(PG8_SA(1, 0), cA + kstep, voffA); PG8_STAGE(PG8_SB(1, 1), cB + hstepB + kstep, voffB);
        PG8_WAIT_V(6); PG8_BAR;
    } else {
        PG8_STAGE(PG8_SB(0, 0), cB, voffB); PG8_STAGE(PG8_SA(0, 0), cA, voffA); PG8_STAGE(PG8_SB(0, 1), cB + hstepB, voffB); PG8_STAGE(PG8_SA(0, 1), cA + hstepA, voffA);
        if (wr == 1) PG8_BAR;
        PG8_WAIT_V(4); PG8_BAR;
        PG8_STAGE(PG8_SB(1, 0), cB + kstep, voffB); PG8_STAGE(PG8_SA(1, 0), cA + kstep, voffA); PG8_STAGE(PG8_SB(1, 1), cB + hstepB + kstep, voffB);
        PG8_WAIT_V(6); PG8_BAR;
    }
    for (;;) {
        const bool has_next = S.next(ui + 1, nxt);
        const char* nA = has_next ? (const char*)g.A + (size_t)nxt.pm * tstepA + (size_t)nxt.kofs * 2 : cA; const char* nB = has_next ? (const char*)g.Bt + (size_t)nxt.pn * tstepB + (size_t)nxt.bofs * 2 : cB;
        for (int t = 0; t < nt; t += 2) {
            const bool last = (t == nt - 2);
            const char* a1 = cA + (size_t)(t + 1) * kstep;
            const char* a2 = last ? nA : cA + (size_t)(t + 2) * kstep; const char* b2 = last ? nB : cB + (size_t)(t + 2) * kstep;
            const char* a3 = a2 + kstep; const char* b3 = b2 + kstep;
            if (last && has_next) S.a_ready(nxt);
            if constexpr (SP2) {
            PG8_LDB(B0, 0, 0); PG8_LDB(B1, 0, 1); PG8_SCHED; PG8_LDA(At, 0, 0); PG8_STAGE(PG8_SA(1, 1), a1 + hstepA, voffA);
            PG8_WAIT_V(8); PG8_WAIT_L(0); PG8_BAR; PG8_MMA(0, 0, At, B0); PG8_MMA(0, 1, At, B1); PG8_BAR; PG8_SCHED;
            PG8_LDA(At, 0, 1); PG8_STAGE(PG8_SB(0, 0), b2, voffB); PG8_STAGE(PG8_SB(0, 1), b2 + hstepB, voffB); PG8_STAGE(PG8_SA(0, 0), a2, voffA);
            PG8_WAIT_V(8); PG8_WAIT_L(0); PG8_BAR; PG8_MMA(1, 0, At, B0); PG8_MMA(1, 1, At, B1); PG8_BAR; PG8_SCHED;
            PG8_LDB(B0, 1, 0); PG8_LDB(B1, 1, 1); PG8_SCHED; PG8_LDA(At, 1, 0); PG8_STAGE(PG8_SA(0, 1), a2 + hstepA, voffA);
            PG8_WAIT_V(8); PG8_WAIT_L(0); PG8_BAR; PG8_MMA(0, 0, At, B0); PG8_MMA(0, 1, At, B1); PG8_BAR; PG8_SCHED;
            PG8_LDA(At, 1, 1); PG8_STAGE(PG8_SB(1, 0), b3, voffB); PG8_STAGE(PG8_SB(1, 1), b3 + hstepB, voffB); PG8_STAGE(PG8_SA(1, 0), a3, voffA);
            PG8_WAIT_V(8); PG8_WAIT_L(0); PG8_BAR; PG8_MMA(1, 0, At, B0); PG8_MMA(1, 1, At, B1); PG8_BAR; PG8_SCHED;
            } else {
            PG8_LDB(B0, 0, 0); PG8_SCHED; PG8_LDA(At, 0, 0); PG8_STAGE(PG8_SA(1, 1), a1 + hstepA, voffA);
            PG8_WAIT_L(8); PG8_BAR; PG8_WAIT_L(0); PG8_MMA(0, 0, At, B0); PG8_BAR; PG8_SCHED;
            PG8_LDB(B1, 0, 1); PG8_STAGE(PG8_SB(0, 0), b2, voffB);
            PG8_BAR; PG8_WAIT_L(0); PG8_MMA(0, 1, At, B1); PG8_BAR;
            PG8_LDA(At, 0, 1); PG8_STAGE(PG8_SA(0, 0), a2, voffA);
            PG8_BAR; PG8_WAIT_L(0); PG8_MMA(1, 0, At, B0); PG8_BAR; PG8_SCHED;
            PG8_STAGE(PG8_SB(0, 1), b2 + hstepB, voffB);
            PG8_WAIT_V(6); PG8_BAR; PG8_MMA(1, 1, At, B1); PG8_BAR;
            PG8_LDB(B0, 1, 0); PG8_SCHED; PG8_LDA(At, 1, 0); PG8_STAGE(PG8_SA(0, 1), a2 + hstepA, voffA);
            PG8_WAIT_L(8); PG8_BAR; PG8_WAIT_L(0); PG8_MMA(0, 0, At, B0); PG8_BAR; PG8_SCHED;
            PG8_LDB(B1, 1, 1); PG8_STAGE(PG8_SB(1, 0), b3, voffB);
            PG8_BAR; PG8_WAIT_L(0); PG8_MMA(0, 1, At, B1); PG8_BAR;
            PG8_LDA(At, 1, 1); PG8_STAGE(PG8_SA(1, 0), a3, voffA);
            PG8_BAR; PG8_WAIT_L(0); PG8_MMA(1, 0, At, B0); PG8_BAR; PG8_SCHED;
            PG8_STAGE(PG8_SB(1, 1), b3 + hstepB, voffB);
            PG8_WAIT_V(6); PG8_BAR; PG8_MMA(1, 1, At, B1); PG8_BAR;
            }
        }
        if constexpr (ALIGN_EPI) { if (wr == 0) PG8_BAR; }
        if constexpr (!Epi::AFTER_DRAIN) { E(acc, cur, wr, wc, fr, fq); S.done(cur); }
        if (!has_next) break;
        if (!cur.keep) {
#pragma unroll
        for (int a = 0; a < 2; ++a)
#pragma unroll
            for (int b = 0; b < 2; ++b)
#pragma unroll
                for (int m = 0; m < 4; ++m)
#pragma unroll
                    for (int n = 0; n < 2; ++n) acc[a][b][m][n] = (f32x4){0.f, 0.f, 0.f, 0.f};
        }
        cur = nxt; cA = nA; cB = nB; ++ui;
        if constexpr (ALIGN_EPI) { if (wr == 1) PG8_BAR; }
    }
    PG8_WAIT_V(0);
    if constexpr (!ALIGN_EPI) { if (wr == 0) PG8_BAR; }
    PG8_BAR;
    if constexpr (Epi::AFTER_DRAIN) { E.fused(acc, cur, wr, wc, fr, fq, lds, wid, lane); S.done(cur); }
#undef PG8_SA
#undef PG8_SB
#undef PG8_STAGE
#undef PG8_LDA
#undef PG8_LDB
#undef PG8_MMA
#undef PG8_WAIT_V
#undef PG8_WAIT_L
#undef PG8_BAR
#undef PG8_SCHED
}
}

constexpr int DM = 2048, NBATCH = 4, SEQ = 8192, CTXL = 256, RB = CTXL + SEQ  , HB = 2  , HR = HB * RB  ;
constexpr int DFF = 5632, NUP = 2 * DFF, NMOD = 6 * DM, NCH = RB / 64  ;
constexpr int LDP = 14848;
constexpr int NWIN = 15104, INW = 14880;
constexpr int C_QA = 0, C_KA = 1024, C_VA = 1280, C_QD = 1536, C_KD = 2560, C_VD = 3584, C_QKV = 4608, C_Z = 7680, C_G = 8704;
constexpr float LN_EPS = 1e-6f, DN_ALPHA = 1.41421356237f  , LOG2E = 1.4426950408889634f;
constexpr int NWAVES = 8, NTHR = 512;
constexpr size_t MiB = 1u << 20;
constexpr size_t WS_CTL = 0, CTL_ZERO_BYTES = 1 * MiB;
constexpr size_t WS_MOD = 1 * MiB;
constexpr size_t WS_ROPEA = WS_MOD + 512 * 1024, WS_ROPED = WS_ROPEA + 32768, WS_LAM = WS_ROPED + 16384;
constexpr size_t WS_CX = 2 * MiB;
constexpr size_t WS_WIN = 10 * MiB, WS_WPA = 69 * MiB, WS_WPB = 73 * MiB, WS_WPC = 77 * MiB, WS_WO = 81 * MiB, WS_WUP = 89 * MiB, WS_WDN = 133 * MiB;
constexpr size_t WS_H = 155 * MiB;
constexpr size_t WS_AB = 221 * MiB;
constexpr size_t WS_GL = WS_AB + 5 * MiB / 2;
constexpr size_t WS_P = 224 * MiB;
constexpr size_t WS_G = 703 * MiB;
constexpr size_t GU_BYTES = 73728, GU_W = 0, GU_QG = 16384, GU_KD = 32768, GU_AT = 49152, GU_U = 57344;
constexpr size_t WS_PART = WS_G + 297 * MiB;
constexpr size_t WS_MC = WS_PART + 24 * MiB;
constexpr size_t WS_END = WS_MC + 6 * MiB;
constexpr size_t WS_TOT = WS_G, WS_M = WS_G + 132 * MiB, WS_OX = WS_P, WS_U = WS_P, WS_ACT = WS_G, WS_FX = WS_P;
static_assert((size_t)HR * LDP * 2 <= 479 * MiB && (size_t)4224 * GU_BYTES <= 297 * MiB && (size_t)HR * NUP * 2 <= 479 * MiB && (size_t)HR * DFF * 2 <= 297 * MiB, "d_ws map");
constexpr size_t WS_TRASH = 512 * 1024;
constexpr int CW_BAR = 4096, CW_Q = 16384;
constexpr int RING_BYTES = 131072, LDS_BYTES = 147456, LDSCTL_OFF = LDS_BYTES - 1024;

#define GAS __attribute__((address_space(1)))
#define LAS __attribute__((address_space(3)))
typedef unsigned short bf16_t;
typedef short bf16x8 __attribute__((ext_vector_type(8)));
typedef short s16x4 __attribute__((ext_vector_type(4)));
typedef float f32x4 __attribute__((ext_vector_type(4)));
typedef float f32x2 __attribute__((ext_vector_type(2)));
typedef float f32x16 __attribute__((ext_vector_type(16)));
typedef unsigned u32x4 __attribute__((ext_vector_type(4)));
typedef unsigned u32x2 __attribute__((ext_vector_type(2)));
using pg8::cvt_pk_bf16; using pg8::bf_lo; using pg8::bf_hi; using pg8::sigm;
__device__ __forceinline__ float wave_sum(float v) {
#pragma unroll
    for (int o = 1; o < 64; o <<= 1) v += __shfl_xor(v, o);
    return v;
}
__device__ __forceinline__ int tid_opaque() { int t = threadIdx.x; asm volatile("" : "+v"(t)); return t; }
__device__ __forceinline__ int opaque_s(int v) { asm volatile("" : "+s"(v)); return v; }
__device__ __forceinline__ float silu_f(float x) { return x * sigm(x); }
__device__ __forceinline__ int crow(int r, int hi) { return (r & 3) + 8 * (r >> 2) + 4 * hi; }
__device__ __forceinline__ bf16x8 pack8(float a0, float a1, float a2, float a3, float a4, float a5, float a6, float a7) {
    u32x4 w; w.x = cvt_pk_bf16(a0, a1); w.y = cvt_pk_bf16(a2, a3); w.z = cvt_pk_bf16(a4, a5); w.w = cvt_pk_bf16(a6, a7); return __builtin_bit_cast(bf16x8, w); }
typedef short v4i16_t __attribute__((ext_vector_type(4)));
__device__ __forceinline__ s16x4 lds_tr(LAS const unsigned char* p) { return __builtin_bit_cast(s16x4, __builtin_amdgcn_ds_read_tr16_b64_v4i16((LAS v4i16_t*)p)); }
#define MFMA32(a, b, c) __builtin_amdgcn_mfma_f32_32x32x16_bf16((a), (b), (c), 0, 0, 0)

#define XB_TMO      128
#define XB_XCNT(j)  (256  + 64 * (j))
#define XB_XSUB(j)  (1280 + 64 * (j))
#define XB_XGEN(j)  (2304 + 64 * (j))
#define XB_TOP      3328
#define XB_TOPGEN   3392
#define XCD_BAR_WORDS 3456
#define XB_SPIN_CAP (1u << 18)

__device__ __forceinline__ unsigned xb_ld(unsigned* p)              { return __hip_atomic_load(p, __ATOMIC_RELAXED, __HIP_MEMORY_SCOPE_AGENT); }
__device__ __forceinline__ unsigned xb_add(unsigned* p, unsigned v) { return __hip_atomic_fetch_add(p, v, __ATOMIC_RELAXED, __HIP_MEMORY_SCOPE_AGENT); }
__device__ __forceinline__ unsigned xb_xcc_id() { return (unsigned)__builtin_amdgcn_s_getreg((3 << 11) | 20) & 0xFu; }
#define XB_SPIN(cond, bar) do { unsigned _sp = 0; while (cond) { __builtin_amdgcn_s_sleep(1); \
    if ((++_sp & 255u) == 0u) { if (xb_ld(&(bar)[XB_TMO])) break; if (_sp > XB_SPIN_CAP) { atomicAdd(&(bar)[XB_TMO], 1u); break; } } } } while (0)

struct XcdBarrier {
    unsigned* bar; unsigned x;
    volatile LAS unsigned* st;
};

__device__ __forceinline__ XcdBarrier xcd_barrier_post(unsigned* bar, volatile LAS unsigned* st) {
    XcdBarrier b; b.bar = bar; b.x = xb_xcc_id(); b.st = st;
    if (threadIdx.x == 0) (void)xb_add(&bar[XB_XCNT(b.x)], 1u);
    return b;
}
__device__ __forceinline__ void xcd_barrier_complete(unsigned* bar, unsigned x, unsigned& nloc, unsigned& nx) {
    const unsigned G = gridDim.x * gridDim.y * gridDim.z;
    unsigned sum, cnt, mine, sp = 0u;
    for (;;) {
        sum = 0u; cnt = 0u; mine = 0u;
#pragma unroll
        for (unsigned j = 0; j < 16; ++j) { const unsigned c = xb_ld(&bar[XB_XCNT(j)]); sum += c; cnt += (c > 0u) ? 1u : 0u; mine = (j == x) ? c : mine; }
        if (sum == G) break;
        __builtin_amdgcn_s_sleep(1);
        if ((++sp & 255u) == 0u) { if (xb_ld(&bar[XB_TMO])) break; if (sp > XB_SPIN_CAP) { atomicAdd(&bar[XB_TMO], 1u); break; } }
    }
    nloc = mine > 0u ? mine : 1u; nx = cnt > 0u ? cnt : 1u;
}

__device__ __forceinline__ void xcd_barrier(const XcdBarrier& b) {
    asm volatile("s_waitcnt vmcnt(0)" ::: "memory");
    __syncthreads();
    if (threadIdx.x == 0) {
        unsigned* bar = b.bar;
        __builtin_amdgcn_s_waitcnt(0);
        unsigned nloc = b.st[0], nx = b.st[1];
        if (nloc == 0u) { xcd_barrier_complete(bar, b.x, nloc, nx); b.st[0] = nloc; b.st[1] = nx; }
        const unsigned old = xb_add(&bar[XB_XSUB(b.x)], 1u);
        const unsigned gen = old / nloc;
        if (old + 1u == (gen + 1u) * nloc) {
            __builtin_amdgcn_fence(__ATOMIC_RELEASE, "agent");
            asm volatile("s_waitcnt vmcnt(0)" ::: "memory");
            const unsigned og = xb_add(&bar[XB_TOP], 1u);
            const unsigned tg = og / nx;
            if (og + 1u == (tg + 1u) * nx) xb_add(&bar[XB_TOPGEN], 1u);
            else XB_SPIN(xb_ld(&bar[XB_TOPGEN]) == tg, bar);
            __builtin_amdgcn_fence(__ATOMIC_ACQUIRE, "agent");
            xb_add(&bar[XB_XGEN(b.x)], 1u);
            asm volatile("s_waitcnt vmcnt(0)" ::: "memory");
        } else {
            XB_SPIN(xb_ld(&bar[XB_XGEN(b.x)]) == gen, bar);
            __builtin_amdgcn_fence(__ATOMIC_ACQUIRE, "agent");
            asm volatile("s_waitcnt vmcnt(0)" ::: "memory");
        }
    }
    __syncthreads();
}
struct Args { const float* in[29]; float* out; unsigned char* ws; int ph_lo, ph_hi; };
enum { I_X = 0, I_C, I_CTX, I_CCTX, I_WMOD, I_BMOD, I_WIN, I_SINK, I_LQ1, I_LK1, I_LQ2, I_LK2, I_SUBLN, I_DNCONV, I_ALOG, I_DTB, I_DNNORM, I_WPA, I_WPB, I_WPC, I_WO, I_LN1G, I_LN1B, I_WUP, I_FCW, I_FCB, I_WDN, I_LN2G, I_LN2B };

__device__ __forceinline__ void ph_prologue(const Args& A, LAS unsigned char* lds) {
    const int tid = tid_opaque(), lane = tid & 63, wave = tid >> 6, G = gridDim.x, bid = blockIdx.x;
    const int gt = bid * NTHR + tid, NT = G * NTHR;
    float* ropeA = (float*)(A.ws + WS_ROPEA); float* ropeD = (float*)(A.ws + WS_ROPED); float* LAM = (float*)(A.ws + WS_LAM); float* MOD = (float*)(A.ws + WS_MOD);
    for (int e = gt; e < 128 * 32; e += NT) { const int pos = e >> 5, f = e & 31; const float inv = powf(10000.0f, -(float)(2 * f) / 64.0f); const float ang = (float)pos * inv; ropeA[2 * e] = cosf(ang); ropeA[2 * e + 1] = sinf(ang); }
    for (int e = gt; e < 128 * 16; e += NT) { const int pos = e >> 4, f = e & 15; const float inv = powf(10000.0f, -(float)(2 * f) / 32.0f); const float ang = (float)pos * inv; ropeD[2 * e] = cosf(ang); ropeD[2 * e + 1] = sinf(ang); }
    if (gt < 2) { const int l = gt; float s1 = 0.f, s2 = 0.f;
        for (int i = 0; i < 64; ++i) { s1 += A.in[I_LQ1][l * 64 + i] * A.in[I_LK1][l * 64 + i]; s2 += A.in[I_LQ2][l * 64 + i] * A.in[I_LK2][l * 64 + i]; }
        const float lam_init = 0.8f - 0.6f * expf(-0.3f * (float)l); LAM[2 * l] = expf(s1) - expf(s2) + lam_init; LAM[2 * l + 1] = 1.0f - lam_init; }
    LAS float* sc = (LAS float*)lds;
    LAS float* red = (LAS float*)(lds + 40960);
    for (int e = tid; e < 5 * 2048; e += NTHR) { const int idx = e >> 11, k = e & 2047; const float v = (idx < 4) ? A.in[I_C][idx * 2048 + k] : A.in[I_CCTX][k]; sc[e] = silu_f(v); }
    __syncthreads();
    for (int u = bid; u < 192; u += G) {
        const int l = u / 96, n0 = (u % 96) * 128;
        const float* W = A.in[I_WMOD] + (size_t)l * 2048 * NMOD + n0 + 2 * lane;
        float acc[5][2];
#pragma unroll
        for (int i = 0; i < 5; ++i) { acc[i][0] = 0.f; acc[i][1] = 0.f; }
        const int k0 = wave * 256;
#pragma unroll 4
        for (int k = k0; k < k0 + 256; ++k) { const f32x2 w = *(const f32x2*)(W + (size_t)k * NMOD);
#pragma unroll
            for (int i = 0; i < 5; ++i) { const float s = sc[i * 2048 + k]; acc[i][0] += s * w.x; acc[i][1] += s * w.y; } }
#pragma unroll
        for (int i = 0; i < 5; ++i) { red[(wave * 5 + i) * 128 + 2 * lane] = acc[i][0]; red[(wave * 5 + i) * 128 + 2 * lane + 1] = acc[i][1]; }
        __syncthreads();
        for (int e = tid; e < 640; e += NTHR) { const int idx = e >> 7, n = e & 127; float s = 0.f;
#pragma unroll
            for (int w = 0; w < 8; ++w) s += red[(w * 5 + idx) * 128 + n];
            MOD[(size_t)(l * 5 + idx) * NMOD + n0 + n] = s + A.in[I_BMOD][l * NMOD + n0 + n]; }
        __syncthreads();
    }
}
__device__ __forceinline__ int win_src(int n) {
    if (n < 1280) { const int j = n & 127, p = j >> 1, s = j & 1; const int dim = (p < 32) ? (s * 32 + p) : (64 + s * 32 + (p - 32)); return (n & ~127) + dim; }
    if (n < 1536) return n;
    if (n < 3584) { const int j = n & 63, p = j >> 1, s = j & 1; const int dim = (p < 16) ? (s * 16 + p) : (32 + s * 16 + (p - 16)); return (n & ~63) + dim; }
    if (n < 8704) return n;
    if (n < 14848) return n + 32;
    if (n < 14880) return n - 14848 + 8704;
    return -1;
}
template <int MODE> __device__ __forceinline__ void transpose_item(const float* W, int K, int N, bf16_t* WT, LAS float* scr, int kb, int nb, int lane) {
    const int k0 = 64 * kb, n0 = 32 * nb, nn = n0 + (lane & 31);
    const int sc = (MODE == 1) ? win_src(nn) : nn;
    const float* src = W + (size_t)(k0 + (lane >> 5)) * N + (sc >= 0 ? sc : 0);
#pragma unroll 8
    for (int i = 0; i < 32; ++i) { const float v = src[(size_t)(2 * i) * N]; scr[(2 * i + (lane >> 5)) * 33 + (lane & 31)] = (sc >= 0) ? v : 0.f; }
    asm volatile("s_waitcnt lgkmcnt(0)" ::: "memory");
    const int c = lane & 7;
#pragma unroll
    for (int j = 0; j < 4; ++j) { const int n = (lane >> 3) + 8 * j; const LAS float* s = scr + (8 * c) * 33 + n;
        u32x4 o; o.x = cvt_pk_bf16(s[0 * 33], s[1 * 33]); o.y = cvt_pk_bf16(s[2 * 33], s[3 * 33]); o.z = cvt_pk_bf16(s[4 * 33], s[5 * 33]); o.w = cvt_pk_bf16(s[6 * 33], s[7 * 33]);
        *(u32x4*)(WT + (size_t)(n0 + n) * K + k0 + 8 * c) = o; }
    asm volatile("s_waitcnt lgkmcnt(0)" ::: "memory");
}
__device__ __forceinline__ void ph_weights(const Args& A, LAS unsigned char* lds, int l) {
    const int tid = tid_opaque(), lane = tid & 63, wave = tid >> 6, G = gridDim.x, bid = blockIdx.x;
    LAS float* scr = (LAS float*)(lds + wave * 8448);
    unsigned char* ws = A.ws;
    constexpr int I0 = 32 * 472, I1 = 16 * 64, I2 = 32 * 64, I3 = 32 * 352, I4 = 88 * 64, NIT = I0 + 3 * I1 + I2 + I3 + I4;
    for (int it = bid * NWAVES + wave; it < NIT; it += G * NWAVES) {
        int r = it;
        if (r < I0) { transpose_item<1>(A.in[I_WIN] + (size_t)l * 2048 * INW, 2048, INW, (bf16_t*)(ws + WS_WIN), scr, r / 472, r % 472, lane); continue; } r -= I0;
        if (r < I1) { transpose_item<0>(A.in[I_WPA] + (size_t)l * 1024 * 2048, 1024, 2048, (bf16_t*)(ws + WS_WPA), scr, r / 64, r % 64, lane); continue; } r -= I1;
        if (r < I1) { transpose_item<0>(A.in[I_WPB] + (size_t)l * 1024 * 2048, 1024, 2048, (bf16_t*)(ws + WS_WPB), scr, r / 64, r % 64, lane); continue; } r -= I1;
        if (r < I1) { transpose_item<0>(A.in[I_WPC] + (size_t)l * 1024 * 2048, 1024, 2048, (bf16_t*)(ws + WS_WPC), scr, r / 64, r % 64, lane); continue; } r -= I1;
        if (r < I2) { transpose_item<0>(A.in[I_WO] + (size_t)l * 2048 * 2048, 2048, 2048, (bf16_t*)(ws + WS_WO), scr, r / 64, r % 64, lane); continue; } r -= I2;
        if (r < I3) { transpose_item<0>(A.in[I_WUP] + (size_t)l * 2048 * NUP, 2048, NUP, (bf16_t*)(ws + WS_WUP), scr, r / 352, r % 352, lane); continue; } r -= I3;
        transpose_item<0>(A.in[I_WDN] + (size_t)l * DFF * 2048, DFF, 2048, (bf16_t*)(ws + WS_WDN), scr, r / 64, r % 64, lane);
    }
}
__device__ __forceinline__ void row_src(const Args& A, int l, int half, int r, const float*& src, float*& dst, const float*& mod, bool& is_ctx) {
    const int bl = r / RB, tp = r - bl * RB, b = opaque_s(half) * HB + bl; is_ctx = tp < CTXL;
    float* cx = (float*)(A.ws + WS_CX);
    dst = is_ctx ? cx + (size_t)(b * CTXL + tp) * DM : A.out + (size_t)(b * SEQ + tp - CTXL) * DM;
    if (l == 0) src = is_ctx ? A.in[I_CTX] + (size_t)(b * CTXL + tp) * DM : A.in[I_X] + (size_t)(b * SEQ + tp - CTXL) * DM; else src = dst;
    mod = (const float*)(A.ws + WS_MOD) + (size_t)(l * 5 + (is_ctx ? 4 : b)) * NMOD;
}
__device__ __forceinline__ void ln_stats(const f32x4 (&v)[8], float& mean, float& rstd) {
    float s = 0.f;
#pragma unroll
    for (int j = 0; j < 8; ++j) s += (v[j].x + v[j].y) + (v[j].z + v[j].w);
    mean = wave_sum(s) * (1.0f / DM); float q = 0.f;
#pragma unroll
    for (int j = 0; j < 8; ++j) { const f32x4 d = v[j] - mean; q += (d.x * d.x + d.y * d.y) + (d.z * d.z + d.w * d.w); }
    rstd = 1.0f / sqrtf(wave_sum(q) * (1.0f / DM) + LN_EPS);
}
__device__ __forceinline__ void ada_store(const f32x4 (&v)[8], float mean, float rstd, const float* shift, const float* scale, bf16_t* hrow, int lane) {
#pragma unroll
    for (int j = 0; j < 8; ++j) { const int e = (64 * j + lane) * 4; const f32x4 sh = *(const f32x4*)(shift + e), sc = *(const f32x4*)(scale + e);
        const f32x4 y = (v[j] - mean) * rstd * (sc + 1.0f) + sh; u32x2 w; w.x = cvt_pk_bf16(y.x, y.y); w.y = cvt_pk_bf16(y.z, y.w); *(u32x2*)(hrow + e) = w; }
}
__device__ __forceinline__ void ph_adaln(const Args& A, int l, int half) {
    const int tid = tid_opaque(), lane = tid & 63, gw = blockIdx.x * NWAVES + (tid >> 6), NGW = gridDim.x * NWAVES;
    bf16_t* H = (bf16_t*)(A.ws + WS_H);
    for (int r = gw; r < HR; r += NGW) {
        const float* src; float* dst; const float* mod; bool is_ctx; row_src(A, l, half, r, src, dst, mod, is_ctx);
        f32x4 v[8];
#pragma unroll
        for (int j = 0; j < 8; ++j) v[j] = *((const f32x4*)src + 64 * j + lane);
        float mean, rstd; ln_stats(v, mean, rstd);
        ada_store(v, mean, rstd, mod, mod + DM, H + (size_t)r * DM, lane);
    }
}
template <bool WITH_H> __device__ __forceinline__ void ph_resln(const Args& A, int l, int half, const bf16_t* Y, int nsplit, int gate_idx, const float* lng, const float* lnb, bool dry, bool next_h = false) {
    const int tid = tid_opaque(), lane = tid & 63, gw = blockIdx.x * NWAVES + (tid >> 6), NGW = gridDim.x * NWAVES;
    bf16_t* H = (bf16_t*)(A.ws + WS_H);
    for (int r = gw; r < HR; r += NGW) {
        const float* src; float* dst; const float* mod; bool is_ctx; row_src(A, l, half, r, src, dst, mod, is_ctx);
        if (is_ctx && l == 1) continue;
        if (!WITH_H) src = dst;
        if (dry) dst = (float*)(A.ws + WS_TRASH) + (tid >> 6) * DM;
        const float* gate = mod + gate_idx * DM; const bf16_t* yrow = Y + (size_t)r * DM;
        f32x4 v[8];
#pragma unroll
        for (int j = 0; j < 8; ++j) { const int e = 64 * j + lane; f32x4 yv;
            if (!is_ctx) { const u32x2 yw = *((const u32x2*)yrow + e); yv = (f32x4){bf_lo(yw.x), bf_hi(yw.x), bf_lo(yw.y), bf_hi(yw.y)}; }
            else { yv = (f32x4){0.f, 0.f, 0.f, 0.f}; const int bl_ = r / RB; const u32x2* pp = (const u32x2*)((const bf16_t*)(A.ws + WS_PART) + (size_t)(bl_ * 256 + (r - bl_ * RB)) * 2048) + e;
                for (int s = 0; s < nsplit; ++s) { const u32x2 yw = pp[(size_t)s * 512 * 2048 / 4]; yv += (f32x4){bf_lo(yw.x), bf_hi(yw.x), bf_lo(yw.y), bf_hi(yw.y)}; } }
            v[j] = *((const f32x4*)src + e) * DN_ALPHA + *((const f32x4*)gate + e) * yv; }
        float mean, rstd; ln_stats(v, mean, rstd);
#pragma unroll
        for (int j = 0; j < 8; ++j) { const int e = 64 * j + lane; v[j] = (v[j] - mean) * rstd * *((const f32x4*)lng + e) + *((const f32x4*)lnb + e); *((f32x4*)dst + e) = v[j]; }
        if (WITH_H) { ln_stats(v, mean, rstd); ada_store(v, mean, rstd, mod + 3 * DM, mod + 4 * DM, dry ? (bf16_t*)(A.ws + WS_TRASH) + 131072 + (tid >> 6) * DM : H + (size_t)r * DM, lane); }
        if (!WITH_H && next_h) { ln_stats(v, mean, rstd); const float* modn = mod + 5 * NMOD; ada_store(v, mean, rstd, modn, modn + DM, H + (size_t)r * DM, lane); }
    }
}
__device__ __forceinline__ void ph_convact(const Args& A, int l_) {
    const int l = opaque_s(l_);
    const int gt = blockIdx.x * NTHR + tid_opaque(), NT = gridDim.x * NTHR;
    const bf16_t* U = (const bf16_t*)(A.ws + WS_U); bf16_t* ACT = (bf16_t*)(A.ws + WS_ACT);
    const float* cw = A.in[I_FCW] + (size_t)l * 3 * NUP; const float* cb = A.in[I_FCB] + (size_t)l * NUP;
    constexpr int NVC = DFF / 8, NRB = HR / 32;
    for (int idx = gt; idx < NRB * NVC; idx += NT) {
        const int rbk = idx / NVC, vc = idx - rbk * NVC, r0 = rbk * 32, tp0 = r0 % RB;
        const bool first_start = (tp0 == 0 || tp0 == CTXL), last_end = (tp0 + 31 == CTXL - 1 || tp0 + 31 == RB - 1);
        const int ca = vc * 8, cbk = DFF + vc * 8;
        float wa[3][8], wb[3][8], ba[8], bb[8];
#pragma unroll
        for (int t = 0; t < 3; ++t) {
#pragma unroll
            for (int k = 0; k < 8; ++k) { wa[t][k] = cw[t * NUP + ca + k]; wb[t][k] = cw[t * NUP + cbk + k]; } }
#pragma unroll
        for (int k = 0; k < 8; ++k) { ba[k] = cb[ca + k]; bb[k] = cb[cbk + k]; }
        const u32x4 z4 = (u32x4){0u, 0u, 0u, 0u};
        u32x4 pa = z4, pb = z4, qa, qb;
        if (!first_start) { pa = *(const u32x4*)(U + (size_t)(r0 - 1) * NUP + ca); pb = *(const u32x4*)(U + (size_t)(r0 - 1) * NUP + cbk); }
        qa = *(const u32x4*)(U + (size_t)r0 * NUP + ca); qb = *(const u32x4*)(U + (size_t)r0 * NUP + cbk);
        for (int rq = 0; rq < 32; rq += 8) {
            u32x4 na[8], nb[8];
#pragma unroll
            for (int k4 = 0; k4 < 8; ++k4) { const int r = rq + k4;
                if (r == 31 && last_end) { na[k4] = z4; nb[k4] = z4; } else { na[k4] = *(const u32x4*)(U + (size_t)(r0 + r + 1) * NUP + ca); nb[k4] = *(const u32x4*)(U + (size_t)(r0 + r + 1) * NUP + cbk); } }
#pragma unroll
            for (int k4 = 0; k4 < 8; ++k4) { const int r = rq + k4;
                float o[8];
#pragma unroll
                for (int k = 0; k < 4; ++k) {
                    const unsigned a0 = pa[k], a1 = qa[k], a2 = na[k4][k], b0 = pb[k], b1 = qb[k], b2 = nb[k4][k];
                    const float xa0 = wa[0][2 * k] * bf_lo(a0) + wa[1][2 * k] * bf_lo(a1) + wa[2][2 * k] * bf_lo(a2) + ba[2 * k];
                    const float xa1 = wa[0][2 * k + 1] * bf_hi(a0) + wa[1][2 * k + 1] * bf_hi(a1) + wa[2][2 * k + 1] * bf_hi(a2) + ba[2 * k + 1];
                    const float xb0 = wb[0][2 * k] * bf_lo(b0) + wb[1][2 * k] * bf_lo(b1) + wb[2][2 * k] * bf_lo(b2) + bb[2 * k];
                    const float xb1 = wb[0][2 * k + 1] * bf_hi(b0) + wb[1][2 * k + 1] * bf_hi(b1) + wb[2][2 * k + 1] * bf_hi(b2) + bb[2 * k + 1];
                    o[2 * k] = silu_f(xa0) * xb0; o[2 * k + 1] = silu_f(xa1) * xb1; }
                u32x4 w; w.x = cvt_pk_bf16(o[0], o[1]); w.y = cvt_pk_bf16(o[2], o[3]); w.z = cvt_pk_bf16(o[4], o[5]); w.w = cvt_pk_bf16(o[6], o[7]);
                *(u32x4*)(ACT + (size_t)(r0 + r) * DFF + vc * 8) = w;
                pa = qa; pb = qb; qa = na[k4]; qb = nb[k4];
            }
        }
    }
}
__device__ __forceinline__ float max3f(float a, float b, float c) { float r; asm("v_max3_f32 %0, %1, %2, %3" : "=v"(r) : "v"(a), "v"(b), "v"(c)); return r; }
__device__ __forceinline__ float xhalf_max(float m) { auto rr = __builtin_amdgcn_permlane32_swap(__float_as_uint(m), __float_as_uint(m), false, false); float r; asm("v_max_f32_e32 %0, %1, %2" : "=v"(r) : "v"(__uint_as_float(rr[0])), "v"(__uint_as_float(rr[1]))); return r; }
__device__ __forceinline__ float xhalf_sum(float m) { auto rr = __builtin_amdgcn_permlane32_swap(__float_as_uint(m), __float_as_uint(m), false, false); return __uint_as_float(rr[0]) + __uint_as_float(rr[1]); }
#ifndef ATT_EXP
#define ATT_EXP 0
#endif
template <int DQK>
__device__ __forceinline__ void attn_core(LAS unsigned char* lds, const bf16_t* Qrow, int kc0, const bf16_t* K0, const bf16_t* V0, int n0, const bf16_t* K1, const bf16_t* V1, int n1,
                                          bool mask1, int qpos, int k1pos0, f32x16 (&oT)[4], float& mref, float& lsum, bool dryx = false) {
    const int tid = tid_opaque(), lane = tid & 63, r32 = lane & 31, hi = lane >> 5, wave = __builtin_amdgcn_readfirstlane(tid >> 6);
    bf16x8 qf[DQK / 16];
#pragma unroll
    for (int d0 = 0; d0 < DQK / 16; ++d0) qf[d0] = *(const bf16x8*)(Qrow + d0 * 16 + hi * 8);
    const int c0 = 2 * wave, c1 = 2 * wave + 1;
    const unsigned kg0 = (unsigned)((lane ^ c0) * LDP + c0 * 8), kg1 = (unsigned)((lane ^ c1) * LDP + c1 * 8);
    const unsigned vg0 = (unsigned)((16 * (c0 & 3) + (lane >> 2)) * LDP + (4 * (c0 >> 2) + (lane & 3)) * 8), vg1 = (unsigned)((16 * (c1 & 3) + (lane >> 2)) * LDP + (4 * (c1 >> 2) + (lane & 3)) * 8);
    const int vd0 = 49152 + ((c0 >> 2) * 8 + 2 * (c0 & 3)) * 512, vd1 = 49152 + ((c1 >> 2) * 8 + 2 * (c1 & 3)) * 512;
#define AT_DMA_K(t, s) do { const bf16_t* kp_ = ((t) < n0) ? K0 + (size_t)(t) * 64 * LDP : K1 + (size_t)((t) - n0) * 64 * LDP; \
        __builtin_amdgcn_global_load_lds((const unsigned*)(kp_ + kg0), (LAS unsigned*)(lds + (s) * 16384 + c0 * 1024), 16, 0, 0); \
        __builtin_amdgcn_global_load_lds((const unsigned*)(kp_ + kg1), (LAS unsigned*)(lds + (s) * 16384 + c1 * 1024), 16, 0, 0); } while (0)
#define AT_DMA_V(t, s) do { const bf16_t* vp_ = ((t) < n0) ? V0 + (size_t)(t) * 64 * LDP : V1 + (size_t)((t) - n0) * 64 * LDP; \
        __builtin_amdgcn_global_load_lds((const unsigned*)(vp_ + vg0), (LAS unsigned*)(lds + (s) * 16384 + vd0), 16, 0, 0); \
        __builtin_amdgcn_global_load_lds((const unsigned*)(vp_ + vg1), (LAS unsigned*)(lds + (s) * 16384 + vd1), 16, 0, 0); } while (0)
    const int srow = tid >> 4, sch = tid & 15;
    const unsigned kgo0 = (unsigned)(srow * LDP + sch * 8), kgo1 = kgo0 + 32u * LDP;
    const int kl0 = sch * 1024 + ((srow ^ sch) << 4), kl1 = kl0 + 512;
    u32x4 sk0, sk1;
#define AT_LDK(t) do { const bf16_t* kp_ = ((t) < n0) ? K0 + (size_t)(t) * 64 * LDP : K1 + (size_t)((t) - n0) * 64 * LDP; sk0 = *(const u32x4*)(kp_ + kgo0); sk1 = *(const u32x4*)(kp_ + kgo1); } while (0)
#define AT_STK(s) do { *(LAS u32x4*)(lds + (s) * 16384 + kl0) = sk0; *(LAS u32x4*)(lds + (s) * 16384 + kl1) = sk1; } while (0)
    const int nt = n0 + n1;
    const int vbase = 49152 + (4 * hi + ((lane & 15) >> 2)) * 64 + ((lane >> 4) & 1) * 32 + (lane & 3) * 8;
#define AT_KLD(kb) do { kbo = (kb); if (DQK == 64) { _Pragma("unroll") for (int d0 = 0; d0 < 2; ++d0) { const int c_ = (kc0 >> 3) + 2 * d0 + hi; const int off_ = kbo + c_ * 1024 + ((r32 ^ c_) << 4); \
            kf[2 * d0] = *(LAS const bf16x8*)(lds + off_); kf[2 * d0 + 1] = *(LAS const bf16x8*)(lds + off_ + 512); } } } while (0)
#define AT_QK(P0, P1) do { _Pragma("unroll") for (int r_ = 0; r_ < 16; ++r_) { P0[r_] = 0.f; P1[r_] = 0.f; } \
        if (DQK == 64) { bf16x8 kg[4]; _Pragma("unroll") for (int d0 = 2; d0 < 4; ++d0) { const int c_ = (kc0 >> 3) + 2 * d0 + hi; const int off_ = kbo + c_ * 1024 + ((r32 ^ c_) << 4); \
                kg[2 * d0 - 4] = *(LAS const bf16x8*)(lds + off_); kg[2 * d0 - 3] = *(LAS const bf16x8*)(lds + off_ + 512); } \
            _Pragma("unroll") for (int d0 = 0; d0 < 2; ++d0) { P0 = MFMA32(kf[2 * d0], qf[d0], P0); P1 = MFMA32(kf[2 * d0 + 1], qf[d0], P1); } \
            _Pragma("unroll") for (int d0 = 2; d0 < 4; ++d0) { P0 = MFMA32(kg[2 * d0 - 4], qf[d0], P0); P1 = MFMA32(kg[2 * d0 - 3], qf[d0], P1); } } \
        else { _Pragma("unroll") for (int d0 = 0; d0 < DQK / 16; ++d0) { const int c_ = (kc0 >> 3) + 2 * d0 + hi; const int off_ = kbo + c_ * 1024 + ((r32 ^ c_) << 4); \
            const bf16x8 a0_ = *(LAS const bf16x8*)(lds + off_), a1_ = *(LAS const bf16x8*)(lds + off_ + 512); P0 = MFMA32(a0_, qf[d0], P0); P1 = MFMA32(a1_, qf[d0], P1); } } } while (0)
    bf16x8 kf[4]; int kbo = 0;
    f32x16 pc0, pc1;
    AT_LDK(0); AT_DMA_V(0, 0); AT_STK(0); if (nt > 1) { AT_LDK(1); AT_DMA_V(1, 1); AT_STK(1); }
    asm volatile("s_waitcnt vmcnt(0)" ::: "memory"); __syncthreads();
    AT_KLD(0); AT_QK(pc0, pc1);
    __syncthreads();
    int s0 = 0, s1 = 1, s2 = 2;
    for (int t = 0; t < nt; ++t) {
        const bool more1 = (t + 1 < nt), more2 = (t + 2 < nt), more3 = (t + 3 < nt);
        if (!(ATT_EXP == 7 && dryx)) {
        if (more2) AT_LDK(t + 2);
        if (more2) AT_DMA_V(t + 2, s2);
        }
        if (more1) { AT_KLD(((t + 1) & 1) * 16384); }
        if (mask1 && t >= n0) { const int kb = k1pos0 + (t - n0) * 64 + 4 * hi - qpos;
#pragma unroll
            for (int r = 0; r < 16; ++r) { const int dl = kb + (r & 3) + 8 * (r >> 2); if (dl > 128 || dl < -128) pc0[r] = -INFINITY; if (dl + 32 > 128 || dl + 32 < -128) pc1[r] = -INFINITY; } }
        if (!(ATT_EXP == 1 && dryx)) {
        float tm = max3f(pc0[0], pc1[0], pc0[1]), tm2 = max3f(pc1[1], pc0[2], pc1[2]);
#pragma unroll
        for (int r = 3; r < 15; r += 2) { tm = max3f(tm, pc0[r], pc1[r]); tm2 = max3f(tm2, pc0[r + 1], pc1[r + 1]); }
        tm = max3f(tm, pc0[15], pc1[15]); tm = max3f(tm, tm2, tm2);
        tm = xhalf_max(tm);
        if (__any(tm > mref + 8.0f)) { const float mn = fmaxf(mref, tm); const float al = __builtin_amdgcn_exp2f(mref - mn);
#pragma unroll
            for (int q = 0; q < 4; ++q) oT[q] = oT[q] * al;
            lsum *= al; mref = mn; }
        float rs = 0.f;
#pragma unroll
        for (int r = 0; r < 16; ++r) { pc0[r] = __builtin_amdgcn_exp2f(pc0[r] - mref); pc1[r] = __builtin_amdgcn_exp2f(pc1[r] - mref); rs += pc0[r] + pc1[r]; }
        lsum += rs;
        }
        bf16x8 pw[4];
        pw[0] = pack8(pc0[0], pc0[1], pc0[2], pc0[3], pc0[4], pc0[5], pc0[6], pc0[7]); pw[1] = pack8(pc0[8], pc0[9], pc0[10], pc0[11], pc0[12], pc0[13], pc0[14], pc0[15]);
        pw[2] = pack8(pc1[0], pc1[1], pc1[2], pc1[3], pc1[4], pc1[5], pc1[6], pc1[7]); pw[3] = pack8(pc1[8], pc1[9], pc1[10], pc1[11], pc1[12], pc1[13], pc1[14], pc1[15]);
        const unsigned vt = (unsigned)(uintptr_t)(lds + s0 * 16384 + vbase);
        s16x4 va[4], vc[4];
#define AT_TR(dst, off) asm volatile("ds_read_b64_tr_b16 %0, %1 offset:%2" : "=&v"(dst) : "v"(vt), "n"(off) : "memory")
#define AT_VRD(dst, g) do { AT_TR(dst[0], (((g) >> 1) * 8 + 4 * ((g) & 1)) * 512); AT_TR(dst[1], (((g) >> 1) * 8 + 4 * ((g) & 1)) * 512 + 512); \
        AT_TR(dst[2], (((g) >> 1) * 8 + 4 * ((g) & 1)) * 512 + 1024); AT_TR(dst[3], (((g) >> 1) * 8 + 4 * ((g) & 1)) * 512 + 1536); } while (0)
#define AT_LW(n) asm volatile("s_waitcnt lgkmcnt(" #n ")" ::: "memory")
#define AT_PV(src, g) do { oT[(g) >> 1] = MFMA32(((bf16x8){src[0][0], src[0][1], src[0][2], src[0][3], src[1][0], src[1][1], src[1][2], src[1][3]}), pw[2 * ((g) & 1)], oT[(g) >> 1]); \
        oT[(g) >> 1] = MFMA32(((bf16x8){src[2][0], src[2][1], src[2][2], src[2][3], src[3][0], src[3][1], src[3][2], src[3][3]}), pw[2 * ((g) & 1) + 1], oT[(g) >> 1]); } while (0)
        if (ATT_EXP == 2 && dryx) { if (more1) { AT_QK(pc0, pc1); } } else {
        AT_VRD(va, 0);
        if (more1 && !(ATT_EXP == 3 && dryx)) { AT_QK(pc0, pc1); }
        __builtin_amdgcn_sched_barrier(0);
        AT_VRD(vc, 1); AT_LW(4); __builtin_amdgcn_sched_barrier(0); AT_PV(va, 0); __builtin_amdgcn_sched_barrier(0);
        AT_VRD(va, 2); AT_LW(4); __builtin_amdgcn_sched_barrier(0); AT_PV(vc, 1); __builtin_amdgcn_sched_barrier(0);
        AT_VRD(vc, 3); AT_LW(4); __builtin_amdgcn_sched_barrier(0); AT_PV(va, 2); __builtin_amdgcn_sched_barrier(0);
        AT_VRD(va, 4); AT_LW(4); __builtin_amdgcn_sched_barrier(0); AT_PV(vc, 3); __builtin_amdgcn_sched_barrier(0);
        AT_VRD(vc, 5); AT_LW(4); __builtin_amdgcn_sched_barrier(0); AT_PV(va, 4); __builtin_amdgcn_sched_barrier(0);
        AT_VRD(va, 6); AT_LW(4); __builtin_amdgcn_sched_barrier(0); AT_PV(vc, 5); __builtin_amdgcn_sched_barrier(0);
        AT_VRD(vc, 7); AT_LW(4); __builtin_amdgcn_sched_barrier(0); AT_PV(va, 6); __builtin_amdgcn_sched_barrier(0);
        AT_LW(0); __builtin_amdgcn_sched_barrier(0);
        AT_PV(vc, 7);
        }
#undef AT_VRD
#undef AT_PV
#undef AT_TR
#undef AT_LW
        if (more2) { AT_STK(t & 1); asm volatile("s_waitcnt vmcnt(2)" ::: "memory"); } else { asm volatile("s_waitcnt vmcnt(0)" ::: "memory"); }
        asm volatile("s_waitcnt lgkmcnt(0)" ::: "memory"); if (!(ATT_EXP == 6 && dryx)) __builtin_amdgcn_s_barrier();
        { const int tmp = s0; s0 = s1; s1 = s2; s2 = tmp; }
    }
    __syncthreads();
#undef AT_LDK
#undef AT_STK
#undef AT_DMA_K
#undef AT_DMA_V
#undef AT_QK
#undef AT_KLD
}
__device__ __forceinline__ void attn_store(bf16_t* orow, const f32x16 (&o)[4], int hi) {
#pragma unroll
    for (int q = 0; q < 4; ++q)
#pragma unroll
        for (int g = 0; g < 4; ++g) { u32x2 w; w.x = cvt_pk_bf16(o[q][4 * g], o[q][4 * g + 1]); w.y = cvt_pk_bf16(o[q][4 * g + 2], o[q][4 * g + 3]); *(u32x2*)(orow + 32 * q + 8 * g + 4 * hi) = w; }
}
__device__ __forceinline__ void attnA_unit(const Args& A, LAS unsigned char* lds, int l_, int bl, int nb, int pr, bool ctxq, bool dry) {
    const int l = opaque_s(l_);
    const int tid = tid_opaque(), lane = tid & 63, r32 = lane & 31, hi = lane >> 5, wave = __builtin_amdgcn_readfirstlane(tid >> 6);
    bf16_t* P = (bf16_t*)(A.ws + WS_P);
    const int head = 2 * pr + (wave >> 2), kvh = pr >> 1, qloc = nb * 128 + 32 * (wave & 3) + r32;
    const size_t brow = (size_t)bl * RB;
    const size_t qrow = brow + (ctxq ? 0 : CTXL) + qloc;
    const bf16_t* Kc = P + brow * LDP + C_KA + kvh * 128; const bf16_t* Vc = P + brow * LDP + C_VA + kvh * 128;
    int ks = 128 * (nb - 1), ke = 128 * (nb + 2); if (ks < 0) ks = 0; if (ke > SEQ) ke = SEQ;
    const int n1 = ctxq ? 0 : (ke - ks) / 64;
    f32x16 oT[4];
#pragma unroll
    for (int q = 0; q < 4; ++q)
#pragma unroll
        for (int r = 0; r < 16; ++r) oT[q][r] = 0.f;
    float mref = -INFINITY, lsum = 0.f;
    attn_core<128>(lds, P + qrow * LDP + C_QA + head * 128, 0, Kc, Vc, 4, Kc + (size_t)(CTXL + ks) * LDP, Vc + (size_t)(CTXL + ks) * LDP, n1, true, qloc, ks, oT, mref, lsum, dry);
    const float sk = A.in[I_SINK][l * 8 + head] * LOG2E;
    const float mf = fmaxf(mref, sk), sc = __builtin_amdgcn_exp2f(mref - mf);
    lsum = xhalf_sum(lsum);
    const float f = sc / (lsum * sc + __builtin_amdgcn_exp2f(sk - mf));
#pragma unroll
    for (int q = 0; q < 4; ++q) oT[q] = oT[q] * f;
    attn_store(dry ? (bf16_t*)(A.ws + WS_TRASH) + tid * 128 : P + qrow * LDP + C_QA + head * 128, oT, hi);
}
__device__ __forceinline__ void attnB_unit(const Args& A, LAS unsigned char* lds, int l_, int bl, int h, int qb, bool ctxq, bool dry) {
    const int l = opaque_s(l_);
    const int tid = tid_opaque(), lane = tid & 63, r32 = lane & 31, hi = lane >> 5, wave = __builtin_amdgcn_readfirstlane(tid >> 6);
    bf16_t* P = (bf16_t*)(A.ws + WS_P);
    const int sub = wave >> 2;
    const size_t brow = (size_t)bl * RB;
    const size_t qrow = brow + (ctxq ? 0 : CTXL) + qb * 128 + 32 * (wave & 3) + r32;
    const bf16_t* Kc = P + brow * LDP + C_KD + h * 128; const bf16_t* Vc = P + brow * LDP + C_VD + h * 128;
    f32x16 oT[4];
#pragma unroll
    for (int q = 0; q < 4; ++q)
#pragma unroll
        for (int r = 0; r < 16; ++r) oT[q][r] = 0.f;
    float mref = -INFINITY, lsum = 0.f;
    attn_core<64>(lds, P + qrow * LDP + C_QD + h * 128 + sub * 64, sub * 64, Kc, Vc, ctxq ? 4 : NCH, Kc, Vc, 0, false, 0, 0, oT, mref, lsum, dry);
    lsum = xhalf_sum(lsum);
    const float inv = 1.0f / lsum;
    LAS float* xch = (LAS float*)lds + (wave & 3) * 4096;
    if (sub == 1) {
#pragma unroll
        for (int q = 0; q < 4; ++q)
#pragma unroll
            for (int r = 0; r < 16; ++r) xch[(q * 16 + r) * 64 + lane] = oT[q][r] * inv;
    }
    __syncthreads();
    if (sub == 0) {
        const float lam = ((const float*)(A.ws + WS_LAM))[2 * l], post = ((const float*)(A.ws + WS_LAM))[2 * l + 1];
        float ss = 0.f;
#pragma unroll
        for (int q = 0; q < 4; ++q)
#pragma unroll
            for (int r = 0; r < 16; ++r) { const float v = oT[q][r] * inv - lam * xch[(q * 16 + r) * 64 + lane]; oT[q][r] = v; ss += v * v; }
        ss = xhalf_sum(ss);
        const float rn = post / sqrtf(ss * (1.0f / 128.0f) + 1e-6f);
        const float* sw = A.in[I_SUBLN] + l * 128;
#pragma unroll
        for (int q = 0; q < 4; ++q)
#pragma unroll
            for (int r = 0; r < 16; ++r) oT[q][r] *= rn * sw[32 * q + 8 * (r >> 2) + 4 * hi + (r & 3)];
        attn_store(dry ? (bf16_t*)(A.ws + WS_TRASH) + tid * 128 : P + qrow * LDP + C_QD + h * 128, oT, hi);
    }
    __syncthreads();
}
__device__ __forceinline__ void ph_attention(const Args& A, LAS unsigned char* lds, int l, int half, int it, bool dry) {
    const int tid = tid_opaque();
    unsigned* ctr = (unsigned*)(A.ws + WS_CTL) + CW_Q + 64 * 8 * (2 * it + (dry ? 1 : 0));
    volatile LAS int* qw = (volatile LAS int*)(lds + LDSCTL_OFF + 64);
    const int nq = 128 + 64 + (l == 0 ? 6 : 0);
    const int x0 = (int)(xb_xcc_id() & 7u);
    for (int k = 0; k < 8; ++k) {
        const int x = (x0 + k) & 7;
        for (;;) {
            if (tid == 0) *qw = (int)__hip_atomic_fetch_add(ctr + 64 * x, 1u, __ATOMIC_RELAXED, __HIP_MEMORY_SCOPE_AGENT);
            __syncthreads();
            int j = *qw;
            __syncthreads();
            if (j >= nq) break;
            if (j < 128) { const int s = x + 8 * (j >> 6); attnB_unit(A, lds, l, s >> 3, s & 7, j & 63, false, dry); continue; } j -= 128;
            if (j < 64) { const int u = x * 64 + j; attnA_unit(A, lds, l, u >> 8, (u >> 2) & 63, u & 3, false, dry); continue; } j -= 64;
            if (j < 4) { const int u = x * 4 + j; attnB_unit(A, lds, l, u >> 4, (u >> 1) & 7, u & 1, true, dry); continue; } j -= 4;
            { const int u = x * 2 + j; attnA_unit(A, lds, l, u >> 3, (u >> 2) & 1, u & 3, true, dry); }
        }
    }
}
constexpr int GL_QN = 0, GL_KN = 17408, GL_VK = 34816, GL_MM = 100352, GL_TB = 135168, GPITCH = 272;
#define FNMA(acc, a, b) asm("v_fma_f32 %0, -%1, %2, %0" : "+v"(acc) : "v"(a), "v"(b))
#define FNMS(acc, a, b) asm("v_fma_f32 %0, -%1, %2, %0" : "+v"(acc) : "s"(a), "v"(b))
#define BFV(x) __uint_as_float(((unsigned)(unsigned short)(x)) << 16)
__device__ __forceinline__ void gdn_intra_unit(const Args& A, LAS unsigned char* lds, int l_, int bl, int ch, int h) {
    const int l = opaque_s(l_);
    const int tid = tid_opaque(), lane = tid & 63, r32 = lane & 31, hi = lane >> 5, wave = __builtin_amdgcn_readfirstlane(tid >> 6);
    const bf16_t* P = (const bf16_t*)(A.ws + WS_P); const float* AB = (const float*)(A.ws + WS_AB);
    const int uidx0 = ((bl * NCH + ch) * 8 + h) * 2;
    const size_t R0 = (size_t)bl * RB + ch * 64;
    LAS float* VK = (LAS float*)(lds + GL_VK);
    if (wave < 2) {
        const int d = wave; LAS float* TB = (LAS float*)(lds + GL_TB + d * 1024); LAS float* MMd = (LAS float*)(lds + GL_MM + d * 17408);
        const size_t row = R0 + (d ? 63 - lane : lane);
        float g = AB[row * 32 + d * 8 + h]; const float be = AB[row * 32 + 16 + d * 8 + h];
#pragma unroll
        for (int o = 1; o < 64; o <<= 1) { const float t = __shfl_up(g, o); if (lane >= o) g += t; }
        const float glast = __shfl(g, 63); const float eg = __expf(g);
        TB[lane] = g; TB[64 + lane] = be; TB[128 + lane] = eg; TB[192 + lane] = __expf(glast - g);
        MMd[lane * 68 + 64] = be; MMd[lane * 68 + 65] = be * eg;
        if (lane == 0) ((float*)(A.ws + WS_GL))[uidx0 + d] = __expf(glast);
    }
    {
        const int c = tid >> 3, sub = tid & 7;
        const int tp = ch * 64 + c;
        const bool has_prev = !(tp == 0 || tp == CTXL), has_next = !(tp == CTXL - 1 || tp == RB - 1);
        const bf16_t* xr = P + (R0 + c) * LDP + C_QKV + h * 128 + sub * 16;
        const float* cw = A.in[I_DNCONV] + (size_t)l * 3 * 3072 + h * 128 + sub * 16;
#pragma unroll
        for (int mat = 0; mat < 3; ++mat) {
            const bf16_t* xm = xr + mat * 1024; const float* wm = cw + mat * 1024;
            float y[16];
            const u32x4 z4 = (u32x4){0u, 0u, 0u, 0u};
#pragma unroll
            for (int hf = 0; hf < 2; ++hf) {
                const u32x4 xc = *(const u32x4*)(xm + hf * 8);
                const u32x4 xp = has_prev ? *(const u32x4*)(xm - LDP + hf * 8) : z4;
                const u32x4 xn = has_next ? *(const u32x4*)(xm + LDP + hf * 8) : z4;
#pragma unroll
                for (int k = 0; k < 4; ++k) { const int e = hf * 8 + 2 * k;
                    const float v0 = wm[e] * bf_lo(xp[k]) + wm[3072 + e] * bf_lo(xc[k]) + wm[6144 + e] * bf_lo(xn[k]);
                    const float v1 = wm[e + 1] * bf_hi(xp[k]) + wm[3072 + e + 1] * bf_hi(xc[k]) + wm[6144 + e + 1] * bf_hi(xn[k]);
                    y[e] = silu_f(v0); y[e + 1] = silu_f(v1); }
            }
            if (mat < 2) {
                float ss = 0.f;
#pragma unroll
                for (int e = 0; e < 16; ++e) ss += y[e] * y[e];
                ss += __shfl_xor(ss, 1); ss += __shfl_xor(ss, 2); ss += __shfl_xor(ss, 4);
                const float rn = (1.0f / sqrtf(ss + 1e-6f)) * (mat == 0 ? 0.08838834764831845f : 1.0f);
#pragma unroll
                for (int e = 0; e < 16; ++e) y[e] *= rn;
                LAS unsigned char* dst = lds + (mat == 0 ? GL_QN : GL_KN) + c * GPITCH + sub * 32;
                u32x4 w0, w1; w0.x = cvt_pk_bf16(y[0], y[1]); w0.y = cvt_pk_bf16(y[2], y[3]); w0.z = cvt_pk_bf16(y[4], y[5]); w0.w = cvt_pk_bf16(y[6], y[7]);
                w1.x = cvt_pk_bf16(y[8], y[9]); w1.y = cvt_pk_bf16(y[10], y[11]); w1.z = cvt_pk_bf16(y[12], y[13]); w1.w = cvt_pk_bf16(y[14], y[15]);
                *(LAS u32x4*)dst = w0; *(LAS u32x4*)(dst + 16) = w1;
            }
            if (mat >= 1) { LAS float* vk = VK + c * 256 + (mat == 1 ? 128 : 0) + sub * 16;
#pragma unroll
                for (int e = 0; e < 16; e += 4) *(LAS f32x4*)(vk + e) = (f32x4){y[e], y[e + 1], y[e + 2], y[e + 3]}; }
        }
    }
    __syncthreads();
#pragma unroll 1
    for (int d = 0; d < 2; ++d) {
        const int mat = wave >> 2, rbk = (wave >> 1) & 1, cbk = wave & 1;
        LAS const float* GC = (LAS const float*)(lds + GL_TB + d * 1024); LAS const float* BETA = GC + 64; LAS float* MM = (LAS float*)(lds + GL_MM + d * 17408);
        const int ra = 32 * rbk + r32, rb_ = 32 * cbk + r32;
        LAS const unsigned char* Ab = lds + GL_KN + (d ? 63 - ra : ra) * GPITCH + hi * 16;
        LAS const unsigned char* Bb = lds + (mat == 0 ? GL_KN : GL_QN) + (d ? 63 - rb_ : rb_) * GPITCH + hi * 16;
        f32x16 acc;
#pragma unroll
        for (int r = 0; r < 16; ++r) acc[r] = 0.f;
#pragma unroll
        for (int d0 = 0; d0 < 8; ++d0) { const bf16x8 a = *(LAS const bf16x8*)(Ab + d0 * 32), b = *(LAS const bf16x8*)(Bb + d0 * 32); acc = MFMA32(a, b, acc); }
        const int cc = 32 * cbk + r32; const float gcc = GC[cc];
        if (mat == 0) {
#pragma unroll
            for (int r = 0; r < 16; ++r) { const int i = 32 * rbk + crow(r, hi); const float v = (i > cc) ? BETA[i] * acc[r] * __expf(GC[i] - gcc) : 0.f; MM[i * 68 + cc] = v; }
        } else {
            float v[16];
#pragma unroll
            for (int r = 0; r < 16; ++r) { const int j = 32 * rbk + crow(r, hi); v[r] = (cc >= j) ? acc[r] * __expf(gcc - GC[j]) : 0.f; }
            bf16x8* at = (bf16x8*)(A.ws + WS_G + (size_t)(uidx0 + d) * GU_BYTES + GU_AT);
            at[(cbk * 4 + 2 * rbk + 0) * 64 + lane] = pack8(v[0], v[1], v[2], v[3], v[4], v[5], v[6], v[7]);
            at[(cbk * 4 + 2 * rbk + 1) * 64 + lane] = pack8(v[8], v[9], v[10], v[11], v[12], v[13], v[14], v[15]);
        }
    }
    {
        const int d = wave >> 2, w4 = wave & 3;
        LAS const float* EG = (LAS const float*)(lds + GL_TB + d * 1024 + 512); LAS const float* DKS = EG + 64;
        unsigned char* rec = A.ws + WS_G + (size_t)(uidx0 + d) * GU_BYTES;
        if (w4 < 2) {
#pragma unroll
            for (int ff = 0; ff < 8; ++ff) { const int f = w4 * 8 + ff, ib = f >> 3, rb = (f >> 1) & 3, s = f & 1; const int i = 32 * ib + r32, dk0 = 32 * rb + 16 * s + 4 * hi; const int row = d ? 63 - i : i;
                const u32x2 a = *(LAS const u32x2*)(lds + GL_QN + row * GPITCH + dk0 * 2), b = *(LAS const u32x2*)(lds + GL_QN + row * GPITCH + (dk0 + 8) * 2); const float e = EG[i];
                ((bf16x8*)(rec + GU_QG))[f * 64 + lane] = pack8(bf_lo(a.x) * e, bf_hi(a.x) * e, bf_lo(a.y) * e, bf_hi(a.y) * e, bf_lo(b.x) * e, bf_hi(b.x) * e, bf_lo(b.y) * e, bf_hi(b.y) * e); }
        } else {
#pragma unroll
            for (int ff = 0; ff < 8; ++ff) { const int f = (w4 - 2) * 8 + ff, rb = f >> 2, ib = (f >> 1) & 1, s = f & 1; const int i0 = 32 * ib + 16 * s + 4 * hi; const int ia = i0 + ((lane & 15) >> 2);
                LAS const unsigned char* kp = lds + GL_KN + (d ? 63 - ia : ia) * GPITCH + (32 * rb + 16 * ((lane >> 4) & 1) + 4 * (lane & 3)) * 2;
                const s16x4 lo = lds_tr(kp), hh = lds_tr(d ? kp - 8 * GPITCH : kp + 8 * GPITCH);
                const f32x4 s0 = *(LAS const f32x4*)(DKS + i0), s1 = *(LAS const f32x4*)(DKS + i0 + 8);
                ((bf16x8*)(rec + GU_KD))[f * 64 + lane] = pack8(BFV(lo[0]) * s0[0], BFV(lo[1]) * s0[1], BFV(lo[2]) * s0[2], BFV(lo[3]) * s0[3], BFV(hh[0]) * s1[0], BFV(hh[1]) * s1[1], BFV(hh[2]) * s1[2], BFV(hh[3]) * s1[3]);
            }
        }
    }
    __syncthreads();
    float x[64];
    const int dD = opaque_s(wave >> 2), col = tid & 255;
    {
        LAS const float* MMv = (LAS const float*)(lds + GL_MM + dD * 17408) + lane; asm volatile("" : "+v"(MMv));
        LAS const float* RHv = VK + col + (dD ? 63 * 256 : 0); asm volatile("" : "+v"(RHv));
        const int colhalf = (col >> 7), strd = dD ? -256 : 256;
#define SUBST_ROW(i, m0, UPD) do { const int rowv = __float_as_int(MMv[(i) * 68]); const f32x2 sc2 = *(LAS const f32x2*)(MMv - lane + (i) * 68 + 64); \
            float a = RHv[(i) * strd] * (colhalf ? sc2.y : sc2.x) - ((i) >= 16 ? UPD[(i) & 31] : 0.f), a1 = 0.f, a2 = 0.f, a3 = 0.f; \
            _Pragma("unroll") for (int m = (m0); m < (i); ++m) { const float s = __int_as_float(__builtin_amdgcn_readlane(rowv, m)); \
                if ((m & 3) == 0) FNMS(a, s, x[m]); else if ((m & 3) == 1) FNMS(a1, s, x[m]); else if ((m & 3) == 2) FNMS(a2, s, x[m]); else FNMS(a3, s, x[m]); } \
            x[(i)] = (a + a1) + (a2 + a3); asm volatile("" ::: "memory"); } while (0)
#define XFRAG(kb) u32x4 b1, b2; { u32x4 lo, hh; \
            lo.x = cvt_pk_bf16(x[16 * (kb) + 0], x[16 * (kb) + 1]); lo.y = cvt_pk_bf16(x[16 * (kb) + 2], x[16 * (kb) + 3]); lo.z = cvt_pk_bf16(x[16 * (kb) + 4], x[16 * (kb) + 5]); lo.w = cvt_pk_bf16(x[16 * (kb) + 6], x[16 * (kb) + 7]); \
            hh.x = cvt_pk_bf16(x[16 * (kb) + 8], x[16 * (kb) + 9]); hh.y = cvt_pk_bf16(x[16 * (kb) + 10], x[16 * (kb) + 11]); hh.z = cvt_pk_bf16(x[16 * (kb) + 12], x[16 * (kb) + 13]); hh.w = cvt_pk_bf16(x[16 * (kb) + 14], x[16 * (kb) + 15]); \
            _Pragma("unroll") for (int q = 0; q < 4; ++q) { auto rr = __builtin_amdgcn_permlane32_swap(lo[q], hh[q], false, false); b1[q] = rr[0]; b2[q] = rr[1]; } }
#define MFRAG(rb, kb) ({ LAS const float* mr_ = MMv - lane + (32 * (rb) + r32) * 68 + 16 * (kb) + 8 * hi; const f32x4 ma_ = *(LAS const f32x4*)mr_, mb_ = *(LAS const f32x4*)(mr_ + 4); \
            pack8(ma_[0], ma_[1], ma_[2], ma_[3], mb_[0], mb_[1], mb_[2], mb_[3]); })
#define EXTRACT(UPD, O1, O2) do { _Pragma("unroll") for (int r = 0; r < 16; ++r) { auto rr = __builtin_amdgcn_permlane32_swap(__float_as_uint(O1[r]), __float_as_uint(O2[r]), false, false); \
            UPD[(r & 3) + 8 * (r >> 2)] = __uint_as_float(rr[0]); UPD[(r & 3) + 8 * (r >> 2) + 4] = __uint_as_float(rr[1]); } } while (0)
        float updl[32], updh[32];
        f32x16 o1l, o2l, o1h, o2h;
#pragma unroll
        for (int r = 0; r < 16; ++r) { o1l[r] = 0.f; o2l[r] = 0.f; o1h[r] = 0.f; o2h[r] = 0.f; }
#pragma unroll
        for (int q = 0; q < 32; ++q) { updl[q] = 0.f; updh[q] = 0.f; }
#pragma unroll
        for (int i = 0; i < 16; ++i) SUBST_ROW(i, 0, updl);
        { XFRAG(0); const bf16x8 al = MFRAG(0, 0), ah = MFRAG(1, 0);
          o1l = MFMA32(al, __builtin_bit_cast(bf16x8, b1), o1l); o2l = MFMA32(al, __builtin_bit_cast(bf16x8, b2), o2l);
          o1h = MFMA32(ah, __builtin_bit_cast(bf16x8, b1), o1h); o2h = MFMA32(ah, __builtin_bit_cast(bf16x8, b2), o2h); }
        EXTRACT(updl, o1l, o2l);
#pragma unroll
        for (int i = 16; i < 32; ++i) SUBST_ROW(i, 16, updl);
        { XFRAG(1); const bf16x8 ah = MFRAG(1, 1);
          o1h = MFMA32(ah, __builtin_bit_cast(bf16x8, b1), o1h); o2h = MFMA32(ah, __builtin_bit_cast(bf16x8, b2), o2h); }
        EXTRACT(updh, o1h, o2h);
#pragma unroll
        for (int i = 32; i < 48; ++i) SUBST_ROW(i, 32, updh);
        { XFRAG(2); const bf16x8 ah = MFRAG(1, 2);
          o1h = MFMA32(ah, __builtin_bit_cast(bf16x8, b1), o1h); o2h = MFMA32(ah, __builtin_bit_cast(bf16x8, b2), o2h); }
        EXTRACT(updh, o1h, o2h);
#pragma unroll
        for (int i = 48; i < 64; ++i) SUBST_ROW(i, 48, updh);
#undef SUBST_ROW
#undef XFRAG
#undef MFRAG
#undef EXTRACT
    }
    __syncthreads();
    {
        unsigned char* rec = A.ws + WS_G + (size_t)(uidx0 + dD) * GU_BYTES;
        if (col < 128) {
            unsigned* up = (unsigned*)(rec + GU_U); const int sl = col >> 5, dvl = col & 31;
#pragma unroll
            for (int ib = 0; ib < 2; ++ib)
#pragma unroll
                for (int p = 0; p < 8; ++p)
#pragma unroll
                    for (int hh = 0; hh < 2; ++hh) { const int i = 32 * ib + (2 * p & 3) + 8 * (2 * p >> 2) + 4 * hh; up[((ib * 4 + sl) * 8 + p) * 64 + hh * 32 + dvl] = cvt_pk_bf16(x[i], x[i + 1]); }
        } else {
            LAS bf16_t* wl = (LAS bf16_t*)(lds + (dD ? GL_KN : GL_QN));
#pragma unroll
            for (int i = 0; i < 64; ++i) wl[i * (GPITCH / 2) + (col - 128)] = (bf16_t)(cvt_pk_bf16(x[i], 0.f) & 0xffffu);
        }
    }
    __syncthreads();
    {
        unsigned char* rec = A.ws + WS_G + (size_t)(uidx0 + dD) * GU_BYTES; const int wl0 = dD ? GL_KN : GL_QN;
#pragma unroll
        for (int ff = 0; ff < 4; ++ff) { const int f = (wave & 3) * 4 + ff, ib = f >> 3, rb = (f >> 1) & 3, s = f & 1; const int i = 32 * ib + r32, dk0 = 32 * rb + 16 * s + 4 * hi;
            const u32x2 a = *(LAS const u32x2*)(lds + wl0 + i * GPITCH + dk0 * 2), b = *(LAS const u32x2*)(lds + wl0 + i * GPITCH + (dk0 + 8) * 2);
            ((u32x4*)(rec + GU_W))[f * 64 + lane] = (u32x4){a.x, a.y, b.x, b.y}; }
    }
    __syncthreads();
}
#undef FNMA
#undef FNMS
#undef BFV
constexpr int CW_GI = 24576;
__device__ __forceinline__ void ph_gdn_intra(const Args& A, LAS unsigned char* lds, int l, int it) {
    const int G = (int)gridDim.x, u0 = (int)((blockIdx.x + G - (G > 32 ? 32 : 0)) % G);
    unsigned done = 0u;
    for (int u = u0; u < HB * NCH * 8; u += G) { const int h = u & 7, t = u >> 3, ch = t % NCH, bl = t / NCH; gdn_intra_unit(A, lds, l, bl, ch, h); ++done; }
    asm volatile("s_waitcnt vmcnt(0)" ::: "memory"); __syncthreads();
    if (threadIdx.x == 0) { __builtin_amdgcn_fence(__ATOMIC_RELEASE, "agent"); asm volatile("s_waitcnt vmcnt(0)" ::: "memory"); (void)xb_add((unsigned*)(A.ws + WS_CTL) + CW_GI + 64 * it, done); }
}
__device__ __forceinline__ void gdn_scan_wait(const Args& A, int it) {
    unsigned* ctl = (unsigned*)(A.ws + WS_CTL); unsigned* gc = ctl + CW_GI + 64 * it;
    if (threadIdx.x == 0) { XB_SPIN(xb_ld(gc) < (unsigned)(HB * NCH * 8), ctl + CW_BAR); __builtin_amdgcn_fence(__ATOMIC_ACQUIRE, "agent"); asm volatile("s_waitcnt vmcnt(0)" ::: "memory"); }
    __syncthreads();
}
constexpr int SC_SLOT = 57344, SC_OST = 2 * SC_SLOT;
__device__ __forceinline__ void gdn_scan_unit(const Args& A, LAS unsigned char* lds, int bl, int h, int d) {
    const int tid = tid_opaque(), lane = tid & 63, r32 = lane & 31, hi = lane >> 5, wave = __builtin_amdgcn_readfirstlane(tid >> 6);
#define SC_CH(step) (d ? ((step) < 4 ? 3 - (step) : NCH + 3 - (step)) : (step))
#define SC_UIDX(step) (((bl * NCH + SC_CH(step)) * 8 + h) * 2 + d)
    if (wave >= 4) {
        const int lw = wave - 4;
#define SC_ISSUE(step, slot) do { const unsigned char* rec_ = A.ws + WS_G + (size_t)SC_UIDX(step) * GU_BYTES + lane * 16; \
        _Pragma("unroll") for (int k_ = 0; k_ < 14; ++k_) __builtin_amdgcn_global_load_lds((const unsigned*)(rec_ + (lw * 14 + k_) * 1024), (LAS unsigned*)(lds + (slot) * SC_SLOT + (lw * 14 + k_) * 1024), 16, 0, 0); } while (0)
        SC_ISSUE(0, 0);
        asm volatile("s_waitcnt vmcnt(0)" ::: "memory"); __builtin_amdgcn_s_barrier();
        for (int step = 0; step < NCH; ++step) {
            if (step + 1 < NCH) SC_ISSUE(step + 1, (step + 1) & 1);
            asm volatile("s_waitcnt vmcnt(0)" ::: "memory"); __builtin_amdgcn_s_barrier();
        }
#undef SC_ISSUE
        return;
    }
    const int sl = wave;
    bf16_t* O = (bf16_t*)(A.ws + WS_H) + (size_t)d * HR * 1024;
    const float* GLv = (const float*)(A.ws + WS_GL);
    LAS unsigned char* ost = lds + SC_OST + sl * 4096;
    f32x16 S[4];
#pragma unroll
    for (int rb = 0; rb < 4; ++rb)
#pragma unroll
        for (int r = 0; r < 16; ++r) S[rb][r] = 0.f;
    unsigned un[16]; float gln;
    { const unsigned* Up = (const unsigned*)(A.ws + WS_G + (size_t)SC_UIDX(0) * GU_BYTES + GU_U) + lane;
#pragma unroll
      for (int q = 0; q < 16; ++q) un[q] = Up[(((q >> 3) * 4 + sl) * 8 + (q & 7)) * 64];
      gln = GLv[SC_UIDX(0)]; }
    __builtin_amdgcn_s_barrier();
    for (int step = 0; step < NCH; ++step) {
        const int ch = SC_CH(step);
        LAS const unsigned char* slot = lds + (step & 1) * SC_SLOT + lane * 16;
        unsigned uc[16]; const float gl = gln;
#pragma unroll
        for (int q = 0; q < 16; ++q) uc[q] = un[q];
        if (step + 1 < NCH) { const unsigned* Up = (const unsigned*)(A.ws + WS_G + (size_t)SC_UIDX(step + 1) * GU_BYTES + GU_U) + lane;
#pragma unroll
            for (int q = 0; q < 16; ++q) un[q] = Up[(((q >> 3) * 4 + sl) * 8 + (q & 7)) * 64];
            gln = GLv[SC_UIDX(step + 1)]; }
        f32x16 vn[2], o[2];
#pragma unroll
        for (int ib = 0; ib < 2; ++ib)
#pragma unroll
            for (int r = 0; r < 16; ++r) { vn[ib][r] = 0.f; o[ib][r] = 0.f; }
#pragma unroll
        for (int rb = 0; rb < 4; ++rb)
#pragma unroll
            for (int s = 0; s < 2; ++s) {
                const bf16x8 sb = pack8(S[rb][8 * s], S[rb][8 * s + 1], S[rb][8 * s + 2], S[rb][8 * s + 3], S[rb][8 * s + 4], S[rb][8 * s + 5], S[rb][8 * s + 6], S[rb][8 * s + 7]);
#pragma unroll
                for (int ib = 0; ib < 2; ++ib) { const int f = (ib * 4 + rb) * 2 + s;
                    vn[ib] = MFMA32(*(LAS const bf16x8*)(slot + GU_W + f * 1024), sb, vn[ib]); o[ib] = MFMA32(*(LAS const bf16x8*)(slot + GU_QG + f * 1024), sb, o[ib]); }
            }
#pragma unroll
        for (int ib = 0; ib < 2; ++ib)
#pragma unroll
            for (int p = 0; p < 8; ++p) { const unsigned w = uc[ib * 8 + p]; vn[ib][2 * p] = bf_lo(w) - vn[ib][2 * p]; vn[ib][2 * p + 1] = bf_hi(w) - vn[ib][2 * p + 1]; }
        bf16x8 vb[2][2];
#pragma unroll
        for (int ib = 0; ib < 2; ++ib) { vb[ib][0] = pack8(vn[ib][0], vn[ib][1], vn[ib][2], vn[ib][3], vn[ib][4], vn[ib][5], vn[ib][6], vn[ib][7]);
            vb[ib][1] = pack8(vn[ib][8], vn[ib][9], vn[ib][10], vn[ib][11], vn[ib][12], vn[ib][13], vn[ib][14], vn[ib][15]); }
#pragma unroll
        for (int ib = 0; ib < 2; ++ib)
#pragma unroll
            for (int jb = 0; jb < 2; ++jb)
#pragma unroll
                for (int s = 0; s < 2; ++s) o[ib] = MFMA32(*(LAS const bf16x8*)(slot + GU_AT + (ib * 4 + 2 * jb + s) * 1024), vb[jb][s], o[ib]);
#pragma unroll
        for (int rb = 0; rb < 4; ++rb) { S[rb] = S[rb] * gl;
#pragma unroll
            for (int ib = 0; ib < 2; ++ib)
#pragma unroll
                for (int s = 0; s < 2; ++s) S[rb] = MFMA32(*(LAS const bf16x8*)(slot + GU_KD + ((rb * 2 + ib) * 2 + s) * 1024), vb[ib][s], S[rb]); }
#pragma unroll
        for (int ib = 0; ib < 2; ++ib)
#pragma unroll
            for (int r = 0; r < 16; ++r) { const int i = 32 * ib + crow(r, hi); const int c = d ? 63 - i : i; *(LAS bf16_t*)(ost + c * 64 + r32 * 2) = (bf16_t)(cvt_pk_bf16(o[ib][r], 0.f) & 0xffffu); }
        asm volatile("s_waitcnt lgkmcnt(0)" ::: "memory");
        bf16_t* obase = O + ((size_t)bl * RB + ch * 64) * 1024 + h * 128 + 32 * sl;
#pragma unroll
        for (int k = 0; k < 4; ++k) { const int id = k * 64 + lane; const u32x4 v = *(LAS const u32x4*)(ost + id * 16); *(u32x4*)(obase + (size_t)(id >> 2) * 1024 + (id & 3) * 8) = v; }
        asm volatile("s_waitcnt lgkmcnt(0)" ::: "memory"); __builtin_amdgcn_s_barrier();
    }
#undef SC_CH
#undef SC_UIDX
}
__device__ __forceinline__ void ph_gdn_post(const Args& A, int l_, bool dry) {
    const int l = opaque_s(l_);
    const int tid = tid_opaque(), lane = tid & 63, gw = blockIdx.x * NWAVES + (tid >> 6), NGW = gridDim.x * NWAVES;
    const bf16_t* OF = (const bf16_t*)(A.ws + WS_H); const bf16_t* OB = OF + (size_t)HR * 1024; bf16_t* P = (bf16_t*)(A.ws + WS_P);
    const float* nw = A.in[I_DNNORM] + l * 128 + (lane & 7) * 16;
    for (int r0 = 2 * gw; r0 < HR; r0 += 2 * NGW) {
        u32x4 f0[2], f1[2], b0[2], b1[2], z0[2], z1[2];
#pragma unroll
        for (int k = 0; k < 2; ++k) { const size_t r = (size_t)(r0 + k);
            f0[k] = *(const u32x4*)(OF + r * 1024 + lane * 16); f1[k] = *(const u32x4*)(OF + r * 1024 + lane * 16 + 8);
            b0[k] = *(const u32x4*)(OB + r * 1024 + lane * 16); b1[k] = *(const u32x4*)(OB + r * 1024 + lane * 16 + 8);
            const bf16_t* zq = P + r * LDP + C_Z + lane * 16; z0[k] = *(const u32x4*)zq; z1[k] = *(const u32x4*)(zq + 8); }
#pragma unroll
        for (int k = 0; k < 2; ++k) { const size_t r = (size_t)(r0 + k);
            bf16_t* zp = P + r * LDP + C_Z + lane * 16;
            float o[16], z[16]; float ss = 0.f;
#pragma unroll
            for (int q = 0; q < 4; ++q) { o[2 * q] = bf_lo(f0[k][q]) + bf_lo(b0[k][q]); o[2 * q + 1] = bf_hi(f0[k][q]) + bf_hi(b0[k][q]); o[8 + 2 * q] = bf_lo(f1[k][q]) + bf_lo(b1[k][q]); o[8 + 2 * q + 1] = bf_hi(f1[k][q]) + bf_hi(b1[k][q]);
                z[2 * q] = bf_lo(z0[k][q]); z[2 * q + 1] = bf_hi(z0[k][q]); z[8 + 2 * q] = bf_lo(z1[k][q]); z[8 + 2 * q + 1] = bf_hi(z1[k][q]); }
#pragma unroll
            for (int e = 0; e < 16; ++e) ss += o[e] * o[e];
            ss += __shfl_xor(ss, 1); ss += __shfl_xor(ss, 2); ss += __shfl_xor(ss, 4);
            const float rn = 1.0f / sqrtf(ss * (1.0f / 128.0f) + 1e-6f);
#pragma unroll
            for (int e = 0; e < 16; ++e) o[e] = o[e] * rn * nw[e] * silu_f(z[e]);
            u32x4 w0, w1; w0.x = cvt_pk_bf16(o[0], o[1]); w0.y = cvt_pk_bf16(o[2], o[3]); w0.z = cvt_pk_bf16(o[4], o[5]); w0.w = cvt_pk_bf16(o[6], o[7]);
            w1.x = cvt_pk_bf16(o[8], o[9]); w1.y = cvt_pk_bf16(o[10], o[11]); w1.z = cvt_pk_bf16(o[12], o[13]); w1.w = cvt_pk_bf16(o[14], o[15]);
            bf16_t* zo = dry ? (bf16_t*)(A.ws + WS_TRASH) + tid * 16 : zp;
            *(u32x4*)zo = w0; *(u32x4*)(zo + 8) = w1;
        }
    }
}
__device__ __forceinline__ void gdn_post_rows(const Args& A, int l_, int rbeg, int rend) {
    const bool dry = false;
    const int l = opaque_s(l_);
    const int tid = tid_opaque(), lane = tid & 63, wv = tid >> 6;
    const bf16_t* OF = (const bf16_t*)(A.ws + WS_H); const bf16_t* OB = OF + (size_t)HR * 1024; bf16_t* P = (bf16_t*)(A.ws + WS_P);
    const float* nw = A.in[I_DNNORM] + l * 128 + (lane & 7) * 16;
    for (int r0 = rbeg + 2 * wv; r0 < rend; r0 += 2 * NWAVES) {
        u32x4 f0[2], f1[2], b0[2], b1[2], z0[2], z1[2];
#pragma unroll
        for (int k = 0; k < 2; ++k) { const size_t r = (size_t)(r0 + k);
            f0[k] = *(const u32x4*)(OF + r * 1024 + lane * 16); f1[k] = *(const u32x4*)(OF + r * 1024 + lane * 16 + 8);
            b0[k] = *(const u32x4*)(OB + r * 1024 + lane * 16); b1[k] = *(const u32x4*)(OB + r * 1024 + lane * 16 + 8);
            const bf16_t* zq = P + r * LDP + C_Z + lane * 16; z0[k] = *(const u32x4*)zq; z1[k] = *(const u32x4*)(zq + 8); }
#pragma unroll
        for (int k = 0; k < 2; ++k) { const size_t r = (size_t)(r0 + k);
            bf16_t* zp = P + r * LDP + C_Z + lane * 16;
            float o[16], z[16]; float ss = 0.f;
#pragma unroll
            for (int q = 0; q < 4; ++q) { o[2 * q] = bf_lo(f0[k][q]) + bf_lo(b0[k][q]); o[2 * q + 1] = bf_hi(f0[k][q]) + bf_hi(b0[k][q]); o[8 + 2 * q] = bf_lo(f1[k][q]) + bf_lo(b1[k][q]); o[8 + 2 * q + 1] = bf_hi(f1[k][q]) + bf_hi(b1[k][q]);
                z[2 * q] = bf_lo(z0[k][q]); z[2 * q + 1] = bf_hi(z0[k][q]); z[8 + 2 * q] = bf_lo(z1[k][q]); z[8 + 2 * q + 1] = bf_hi(z1[k][q]); }
#pragma unroll
            for (int e = 0; e < 16; ++e) ss += o[e] * o[e];
            ss += __shfl_xor(ss, 1); ss += __shfl_xor(ss, 2); ss += __shfl_xor(ss, 4);
            const float rn = 1.0f / sqrtf(ss * (1.0f / 128.0f) + 1e-6f);
#pragma unroll
            for (int e = 0; e < 16; ++e) o[e] = o[e] * rn * nw[e] * silu_f(z[e]);
            u32x4 w0, w1; w0.x = cvt_pk_bf16(o[0], o[1]); w0.y = cvt_pk_bf16(o[2], o[3]); w0.z = cvt_pk_bf16(o[4], o[5]); w0.w = cvt_pk_bf16(o[6], o[7]);
            w1.x = cvt_pk_bf16(o[8], o[9]); w1.y = cvt_pk_bf16(o[10], o[11]); w1.z = cvt_pk_bf16(o[12], o[13]); w1.w = cvt_pk_bf16(o[14], o[15]);
            bf16_t* zo = dry ? (bf16_t*)(A.ws + WS_TRASH) + tid * 16 : zp;
            *(u32x4*)zo = w0; *(u32x4*)(zo + 8) = w1;
        }
    }
}
constexpr int CW_GS = CW_GI + 512, CW_GQ = CW_GI + 1024, GP_CHUNK = 32;
__device__ __forceinline__ void gdn_scan_done(const Args& A, int it) {
    asm volatile("s_waitcnt vmcnt(0)" ::: "memory"); __syncthreads();
    if (threadIdx.x == 0) { __builtin_amdgcn_fence(__ATOMIC_RELEASE, "agent"); asm volatile("s_waitcnt vmcnt(0)" ::: "memory"); (void)xb_add((unsigned*)(A.ws + WS_CTL) + CW_GS + 64 * it, 1u); }
}
__device__ __forceinline__ void ph_gdn_post_dyn(const Args& A, LAS unsigned char* lds, int l, int it) {
    unsigned* ctl = (unsigned*)(A.ws + WS_CTL);
    if (threadIdx.x == 0) { XB_SPIN(xb_ld(ctl + CW_GS + 64 * it) < (unsigned)(HB * 8 * 2), ctl + CW_BAR); __builtin_amdgcn_fence(__ATOMIC_ACQUIRE, "agent"); asm volatile("s_waitcnt vmcnt(0)" ::: "memory"); }
    __syncthreads();
    volatile LAS int* qw = (volatile LAS int*)(lds + LDSCTL_OFF + 64);
    for (;;) {
        if (threadIdx.x == 0) *qw = (int)__hip_atomic_fetch_add(ctl + CW_GQ + 64 * it, 1u, __ATOMIC_RELAXED, __HIP_MEMORY_SCOPE_AGENT);
        __syncthreads();
        const int j = *qw;
        __syncthreads();
        if (j >= HR / GP_CHUNK) break;
        gdn_post_rows(A, l, j * GP_CHUNK, j * GP_CHUNK + GP_CHUNK);
    }
}
constexpr int NPH = 1 + 14 * 4;
__host__ __device__ inline bool phase_is_noop(int id) { if (id == 0) return false; const int it = (id - 1) / 14, k = (id - 1) % 14; return (k == 0 && it != 2) || k == 4 || k == 5 || k == 6 || (k == 1 && it == 2); }
__global__ void __launch_bounds__(NTHR, 2) fwd(Args A0) {
    extern __shared__ __attribute__((aligned(16))) unsigned char lds_raw[];
    LAS unsigned char* lds = (LAS unsigned char*)lds_raw;
    volatile LAS unsigned* MISC = (volatile LAS unsigned*)(lds + LDSCTL_OFF + 320);
    for (int u = threadIdx.x; u < (LDS_BYTES - LDSCTL_OFF) / 4; u += NTHR) ((LAS unsigned*)(lds + LDSCTL_OFF))[u] = 0u;
    __syncthreads();
    const int lo = A0.ph_lo, hi = A0.ph_hi, G = gridDim.x, bid = blockIdx.x;
    unsigned char* ws0 = A0.ws;
    XcdBarrier bar; bar.bar = (unsigned*)(ws0 + WS_CTL) + CW_BAR; bar.x = 0; bar.st = nullptr;
    if (hi - lo > 1) bar = xcd_barrier_post((unsigned*)(ws0 + WS_CTL) + CW_BAR, MISC + 8);
#ifndef PHMASK
#define PHMASK 0x7fff
#endif
#ifndef DUP_MASK
#define DUP_MASK 0
#endif
#define EXTRA_BAR 0
#define STAGGER_TICKS 500
#define GA_ true
#define GS_ true
#define RUNK(k, id, ...) do { if (((PHMASK >> (k)) & 1) && lo <= (id) && (id) < hi) { \
    KA_T ap_ = (KA_T)__builtin_amdgcn_kernarg_segment_ptr(); asm volatile("" : "+s"(ap_)); const Args& A = *(const Args*)ap_; unsigned char* ws = A.ws; \
    bf16_t* H = (bf16_t*)(ws + WS_H); bf16_t* P = (bf16_t*)(ws + WS_P); (void)H; (void)P; \
    if ((DUP_MASK >> (k)) & 1) { dry = true; __VA_ARGS__; xcd_barrier(bar); dry = false; } \
    __VA_ARGS__; if ((id) + 1 < hi) { xcd_barrier(bar); if (EXTRA_BAR) { xcd_barrier(bar); xcd_barrier(bar); } } } } while (0)
    typedef const __attribute__((address_space(4))) Args* KA_T;
    bool dry = false;
#define STAGGER() do { const unsigned long long t0_ = __builtin_amdgcn_s_memrealtime(); const unsigned long long dl_ = (unsigned long long)(STAGGER_TICKS * (bid & 7)); while (__builtin_amdgcn_s_memrealtime() - t0_ < dl_) __builtin_amdgcn_s_sleep(16); } while (0)
    RUNK(14, 0, { ph_prologue(A, lds); __syncthreads(); ph_weights(A, lds, 0); });
    for (int it = 0; it < 4; ++it) {
        const int l = it >> 1, half = (it ^ (it >> 1)) & 1, base = 1 + 14 * it;
        if (it == 2) RUNK(0, base + 0, { ph_weights(A, lds, 1); });
        if (it != 2) RUNK(1, base + 1, { ph_adaln(A, l, half); });
        RUNK(2, base + 2, {
            pg8::Gemm g{H, (const bf16_t*)(ws + WS_WIN), HR, NWIN, 2048, 2048, 2048};
            pg8::EpiInProj E{P, LDP, (float*)(ws + WS_AB), (const float*)(ws + WS_ROPEA), (const float*)(ws + WS_ROPED), A.in[I_ALOG] + l * 16, A.in[I_DTB] + l * 16, 0.08838834764831845f * LOG2E, 0.125f * LOG2E, dry};
            if (l == 0) { pg8::InProjFirstOrder S; S.init(G, bid); pg8::gemm_phase<pg8::EpiInProj, pg8::InProjFirstOrder, GA_, GS_>(lds, g, S, E); }
            else { pg8::InProjLastOrder S; S.init(NWIN, G, bid); pg8::gemm_phase<pg8::EpiInProj, pg8::InProjLastOrder, GA_, GS_>(lds, g, S, E); } });
        RUNK(3, base + 3, {
            if (l == 0) {
                pg8::Gemm g{H, (const bf16_t*)(ws + WS_WIN), HR, NWIN, 2048, 2048, 2048};
                pg8::EpiInProj E{P, LDP, (float*)(ws + WS_AB), (const float*)(ws + WS_ROPEA), (const float*)(ws + WS_ROPED), A.in[I_ALOG] + l * 16, A.in[I_DTB] + l * 16, 0.08838834764831845f * LOG2E, 0.125f * LOG2E, false};
                pg8::InProjDeferOrder S; S.init(G, bid); pg8::gemm_phase<pg8::EpiInProj, pg8::InProjDeferOrder, GA_, GS_>(lds, g, S, E);
                asm volatile("s_waitcnt vmcnt(0)" ::: "memory"); __syncthreads(); }
            ph_gdn_intra(A, lds, l, it);
            if (bid < HB * 8 * 2) { gdn_scan_wait(A, it); gdn_scan_unit(A, lds, bid >> 4, (bid >> 1) & 7, bid & 1); gdn_scan_done(A, it); }
            ph_attention(A, lds, l, half, it, dry);
            ph_gdn_post_dyn(A, lds, l, it); });
        RUNK(7, base + 7, {
            pg8::Gemm g{P + C_QA, (const bf16_t*)(ws + WS_WPA), HR, 2048, 1024, LDP, 1024}; pg8::EpiMerge3 E{P + C_G, LDP, (bf16_t*)(ws + WS_M), 2048};
            { pg8::Merge3Order<pg8::LatentOrder> S; S.base.init(2048, G, bid); S.aofs1 = C_QD - C_QA; S.aofs2 = C_Z - C_QA; S.bstride = 2048 * 1024;
                pg8::gemm_phase<pg8::EpiMerge3, pg8::Merge3Order<pg8::LatentOrder>, GA_, GS_>(lds, g, S, E); }
            if (l == 0) { pg8::CtxBranchOrder S; S.aofs1 = C_QD - C_QA; S.aofs2 = C_Z - C_QA; S.bstride = 2048 * 1024; S.G = G; S.c = bid;
                pg8::EpiMergeCtx Ec{P + C_G, LDP, (bf16_t*)(ws + WS_MC)}; pg8::gemm_phase<pg8::EpiMergeCtx, pg8::CtxBranchOrder, GA_, GS_>(lds, g, S, Ec); } });
        RUNK(8, base + 8, {
            pg8::Gemm g{(const bf16_t*)(ws + WS_M), (const bf16_t*)(ws + WS_WO), HR, 2048, 2048, 2048, 2048}; pg8::EpiBf16 E{(bf16_t*)(ws + WS_OX), 2048};
            { pg8::LatentOrder S; S.init(2048, G, bid); pg8::gemm_phase<pg8::EpiBf16, pg8::LatentOrder, GA_, GS_>(lds, g, S, E); }
            if (l == 0) { pg8::Gemm gs{(const bf16_t*)(ws + WS_MC), (const bf16_t*)(ws + WS_WO), 512, 2048, 512, 2048, 2048}; pg8::CtxSplit3Order S; S.G = G; S.c = bid;
                pg8::EpiBf16Part Ep{(bf16_t*)(ws + WS_PART)}; pg8::gemm_phase<pg8::EpiBf16Part, pg8::CtxSplit3Order, GA_, GS_>(lds, gs, S, Ep); } });
        RUNK(9, base + 9, { ph_resln<true>(A, l, half, (const bf16_t*)(ws + WS_OX), 12, 2, A.in[I_LN1G] + l * DM, A.in[I_LN1B] + l * DM, dry); });
        RUNK(10, base + 10, {
            pg8::Gemm g{H, (const bf16_t*)(ws + WS_WUP), HR, NUP, 2048, 2048, 2048}; pg8::EpiBf16 E{(bf16_t*)(ws + WS_U), NUP};
            if (l == 0) { pg8::StaticOrder S; S.init(HR, NUP, G, bid); pg8::gemm_phase<pg8::EpiBf16, pg8::StaticOrder, GA_, GS_>(lds, g, S, E); }
            else { pg8::LatentOrder S; S.init(NUP, G, bid); pg8::gemm_phase<pg8::EpiBf16, pg8::LatentOrder, GA_, GS_>(lds, g, S, E); } });
        RUNK(11, base + 11, { ph_convact(A, l); });
        RUNK(12, base + 12, {
            pg8::Gemm g{(const bf16_t*)(ws + WS_ACT), (const bf16_t*)(ws + WS_WDN), HR, 2048, DFF, DFF, DFF}; pg8::EpiBf16 E{(bf16_t*)(ws + WS_FX), 2048};
            { pg8::LatentOrder S; S.init(2048, G, bid); pg8::gemm_phase<pg8::EpiBf16, pg8::LatentOrder, GA_, GS_>(lds, g, S, E); }
            if (l == 0) { pg8::Gemm gs{(const bf16_t*)(ws + WS_ACT), (const bf16_t*)(ws + WS_WDN), HR, 2048, 512, DFF, DFF}; pg8::CtxSplitOrder S; S.init(11, 512, G, bid);
                pg8::EpiBf16Part Ep{(bf16_t*)(ws + WS_PART)}; pg8::gemm_phase<pg8::EpiBf16Part, pg8::CtxSplitOrder, GA_, GS_>(lds, gs, S, Ep); } });
        RUNK(13, base + 13, { ph_resln<false>(A, l, half, (const bf16_t*)(ws + WS_FX), 11, 5, A.in[I_LN2G] + l * DM, A.in[I_LN2B] + l * DM, dry, it == 1); });
    }
#undef RUNK
}

#ifndef MK_ONE_LAUNCH
#define MK_ONE_LAUNCH 1
#endif
extern "C" void kernel_launch(void* const* d_in, const int* in_sizes, int n_in, void* d_out, int out_size, void* d_ws, size_t ws_size, hipStream_t stream) {
    static int grid = 0;
    if (grid == 0) {
        if (n_in != 29 || out_size != NBATCH * SEQ * DM || ws_size < WS_END) { fprintf(stderr, "kernel_launch: unexpected problem (n_in %d, out %d, ws %zu < %zu)\n", n_in, out_size, ws_size, (size_t)WS_END); grid = -1; return; }
        int dev = 0, cus = 0, per_cu = 0;
        if (hipGetDevice(&dev) != hipSuccess || hipDeviceGetAttribute(&cus, hipDeviceAttributeMultiprocessorCount, dev) != hipSuccess) { grid = -1; return; }
        if (hipFuncSetAttribute((const void*)fwd, hipFuncAttributeMaxDynamicSharedMemorySize, LDS_BYTES) != hipSuccess) { fprintf(stderr, "kernel_launch: hipFuncSetAttribute failed\n"); grid = -1; return; }
        if (hipOccupancyMaxActiveBlocksPerMultiprocessor(&per_cu, (const void*)fwd, NTHR, LDS_BYTES) != hipSuccess || per_cu < 1) fprintf(stderr, "kernel_launch: occupancy query reports %d\n", per_cu);
        (void)hipGetLastError();
        grid = cus > 256 ? 256 : cus;
    }
    if (grid < 0) return;
    (void)hipMemsetAsync((char*)d_ws + WS_CTL, 0, CTL_ZERO_BYTES, stream);
    Args a{};
    for (int i = 0; i < 29; ++i) a.in[i] = (const float*)d_in[i];
    a.out = (float*)d_out; a.ws = (unsigned char*)d_ws;
#if MK_ONE_LAUNCH
    a.ph_lo = 0; a.ph_hi = NPH;
    hipLaunchKernelGGL(fwd, dim3(grid), dim3(NTHR), LDS_BYTES, stream, a);
#else
    for (int id = 0; id < NPH; ++id) { if (phase_is_noop(id)) continue; a.ph_lo = id; a.ph_hi = id + 1; hipLaunchKernelGGL(fwd, dim3(grid), dim3(NTHR), LDS_BYTES, stream, a); }
#endif
}
```
